# Optimizing an MI355X kernel written in HIP

```python
import math
import jax, jax.numpy as jnp
from jax import lax
import numpy as np

D_MODEL = 1024
BATCH = 4
SEQ = 4096
DEPTH = 2

N_MEM = 256
DN_HEADS = 4
DN_HEAD_DIM = 128
DN_WIDTH = DN_HEADS * DN_HEAD_DIM
DN_CONV = 4
DN_CHUNK = 64
DA_HEADS = 8
DA_HEAD_DIM = 64
DA_WIDTH = DA_HEADS * DA_HEAD_DIM
DA_BRANCHES = ((128, 1), (512, 4), (2048, 16))
DA_BLOCK = 128
MIX_WIDTH = DN_WIDTH + DA_WIDTH
AB_IN = 4 * DN_WIDTH + 2 * DN_HEADS + 3 * DA_WIDTH
SC_WIDTH = D_MODEL
SC_CONV = 3
XA_HEADS = 4
XA_HEAD_DIM = D_MODEL // XA_HEADS
N_EXPERTS = 16
N_GROUPS = 4
EXPERTS_PER_GROUP = N_EXPERTS // N_GROUPS
TOP_K = 2
D_EXPERT = D_MODEL // 2
DEEPNORM_ALPHA = (2 * DEPTH) ** 0.25
DEEPNORM_BETA = (8 * DEPTH) ** -0.25
LN_EPS = 1e-5
RMS_EPS = 1e-6
N_EVEN = (DEPTH + 1) // 2
N_ODD = DEPTH // 2

kernel_name = 'hybrid_deltanet_dilated_shortconv_moe'


def layer_norm(x, g, b):
    xf = x.astype(jnp.float32)
    mu = jnp.mean(xf, -1, keepdims=True)
    var = jnp.mean(jnp.square(xf - mu), -1, keepdims=True)
    return ((xf - mu) * lax.rsqrt(var + LN_EPS) * g.astype(jnp.float32) + b.astype(jnp.float32)).astype(x.dtype)


def causal_dwconv(x, w):
    k, c = w.shape
    return lax.conv_general_dilated(x, w[:, None, :].astype(x.dtype), window_strides=(1,), padding=[(k - 1, 0)], dimension_numbers=('NWC', 'WIO', 'NWC'), feature_group_count=c)


def l2norm(t):
    return t * lax.rsqrt(jnp.sum(t * t, -1, keepdims=True) + RMS_EPS)


def gated_delta_rule_chunked(q, k, v, g, beta):
    b, h, s, dk = q.shape
    dv = v.shape[-1]
    n = s // DN_CHUNK
    q, k, v = (t.reshape(b, h, n, DN_CHUNK, t.shape[-1]) for t in (q, k, v))
    g = jnp.cumsum(g.reshape(b, h, n, DN_CHUNK), -1)
    beta = beta.reshape(b, h, n, DN_CHUNK)
    incl = jnp.tril(jnp.ones((DN_CHUNK, DN_CHUNK), bool))
    strict = jnp.tril(jnp.ones((DN_CHUNK, DN_CHUNK), bool), -1)
    decay = jnp.exp(jnp.where(incl, g[..., :, None] - g[..., None, :], -jnp.inf))
    kb = k * beta[..., None]
    a_mat = jnp.where(strict, jnp.einsum('bhnik,bhnjk->bhnij', kb, k) * decay, 0.0)
    lower = a_mat + jnp.eye(DN_CHUNK, dtype=q.dtype)
    rhs = jnp.concatenate([v * beta[..., None], kb * jnp.exp(g)[..., None]], -1)
    sol = lax.linalg.triangular_solve(lower, rhs, left_side=True, lower=True, unit_diagonal=True)
    u, w = sol[..., :dv], sol[..., dv:]
    attn = jnp.where(incl, jnp.einsum('bhnik,bhnjk->bhnij', q, k) * decay, 0.0)
    q_dec = q * jnp.exp(g)[..., None]
    k_tail = k * jnp.exp(g[..., -1:] - g)[..., None]
    g_last = jnp.exp(g[..., -1])

    def step(state, xs):
        q_i, k_i, u_i, w_i, a_i, gl_i = xs
        v_new = u_i - jnp.einsum('bhck,bhkv->bhcv', w_i, state)
        o_i = jnp.einsum('bhck,bhkv->bhcv', q_i, state) + jnp.einsum('bhcj,bhjv->bhcv', a_i, v_new)
        state = state * gl_i[..., None, None] + jnp.einsum('bhck,bhcv->bhkv', k_i, v_new)
        return state, o_i

    xs = tuple(jnp.moveaxis(t, 2, 0) for t in (q_dec, k_tail, u, w, attn, g_last))
    _, o = lax.scan(step, jnp.zeros((b, h, dk, dv), q.dtype), xs)
    return jnp.moveaxis(o, 0, 2).reshape(b, h, s, dv)


def dilated_branch(q, k, v, window, dilation):
    b, h, s, dh = q.shape
    length = s // dilation
    span = window // dilation
    n_blk = -(-length // DA_BLOCK)
    padded = n_blk * DA_BLOCK

    def to_blocks(t):
        t = t.reshape(b, h, length, dilation, dh).transpose(0, 1, 3, 2, 4)
        t = jnp.pad(t, ((0, 0), (0, 0), (0, 0), (0, padded - length), (0, 0)))
        return t.reshape(b, h, dilation, n_blk, DA_BLOCK, dh)

    def with_prev(t):
        prev = jnp.pad(t, ((0, 0), (0, 0), (0, 0), (1, 0), (0, 0), (0, 0)))[:, :, :, :-1]
        return jnp.concatenate([prev, t], axis=4)

    qb = to_blocks(q)
    kw = with_prev(to_blocks(k))
    vw = with_prev(to_blocks(v))
    sc = jnp.einsum('bhrnqd,bhrnkd->bhrnqk', qb, kw) * (dh ** -0.5)
    qpos = jnp.arange(n_blk)[:, None] * DA_BLOCK + jnp.arange(DA_BLOCK)[None, :]
    kpos = (jnp.arange(n_blk)[:, None] - 1) * DA_BLOCK + jnp.arange(2 * DA_BLOCK)[None, :]
    dist = qpos[:, :, None] - kpos[:, None, :]
    valid = (dist >= 0) & (dist <= span) & (kpos[:, None, :] >= 0)
    sc = jnp.where(valid, sc, -jnp.inf)
    m = jnp.max(sc, -1, keepdims=True)
    p = jnp.exp(sc - m)
    den = jnp.sum(p, -1)
    o = jnp.einsum('bhrnqk,bhrnkd->bhrnqd', p, vw) / den[..., None]
    lse = m[..., 0] + jnp.log(den)
    o = o.reshape(b, h, dilation, padded, dh)[:, :, :, :length].transpose(0, 1, 3, 2, 4).reshape(b, h, s, dh)
    lse = lse.reshape(b, h, dilation, padded)[..., :length].transpose(0, 1, 3, 2).reshape(b, h, s)
    return o, lse


def dilated_attention(q, k, v):
    outs, lses = zip(*[dilated_branch(q, k, v, wnd, dil) for wnd, dil in DA_BRANCHES])
    wts = jax.nn.softmax(jnp.stack(lses), axis=0)
    return jnp.einsum('ibhs,ibhsd->bhsd', wts, jnp.stack(outs))


def mixer_ab(x, w_in, conv_w, a_log, dt_bias, norm_w, w_out):
    b, s, _ = x.shape
    f32 = jnp.float32
    qkv, z, beta_in, a_in, qkv_d = jnp.split(x @ w_in, [3 * DN_WIDTH, 4 * DN_WIDTH, 4 * DN_WIDTH + DN_HEADS, 4 * DN_WIDTH + 2 * DN_HEADS], axis=-1)
    qkv = jax.nn.silu(causal_dwconv(qkv, conv_w)).astype(f32)
    q, k, v = (t.reshape(b, s, DN_HEADS, DN_HEAD_DIM).transpose(0, 2, 1, 3) for t in jnp.split(qkv, 3, -1))
    q = l2norm(q) * (DN_HEAD_DIM ** -0.5)
    k = l2norm(k)
    beta = jax.nn.sigmoid(beta_in.astype(f32)).transpose(0, 2, 1)
    g = (-jnp.exp(a_log.astype(f32)) * jax.nn.softplus(a_in.astype(f32) + dt_bias.astype(f32))).transpose(0, 2, 1)
    o = gated_delta_rule_chunked(q, k, v, g, beta).transpose(0, 2, 1, 3)
    o = o * lax.rsqrt(jnp.mean(o * o, -1, keepdims=True) + RMS_EPS) * norm_w.astype(f32)
    o_a = (o * jax.nn.silu(z.astype(f32).reshape(b, s, DN_HEADS, DN_HEAD_DIM))).reshape(b, s, DN_WIDTH)
    qd, kd, vd = (t.astype(f32).reshape(b, s, DA_HEADS, DA_HEAD_DIM).transpose(0, 2, 1, 3) for t in jnp.split(qkv_d, 3, -1))
    o_b = dilated_attention(qd, kd, vd).transpose(0, 2, 1, 3).reshape(b, s, DA_WIDTH)
    return jnp.concatenate([o_a, o_b], -1).astype(x.dtype) @ w_out


def short_conv_mixer(x, w_in, conv_w, w_out):
    gate_b, gate_c, hid = jnp.split(x @ w_in, 3, axis=-1)
    return (gate_b * causal_dwconv(gate_c * hid, conv_w)) @ w_out


def memory_cross_attention(x, mem, w_q, w_kv, w_o):
    b, s, d = x.shape
    q = (x @ w_q).astype(jnp.float32).reshape(b, s, XA_HEADS, XA_HEAD_DIM)
    k, v = (t.astype(jnp.float32).reshape(b, -1, XA_HEADS, XA_HEAD_DIM) for t in jnp.split(mem @ w_kv, 2, -1))
    p = jax.nn.softmax(jnp.einsum('bshd,bmhd->bhsm', q, k) * (XA_HEAD_DIM ** -0.5), axis=-1)
    o = jnp.einsum('bhsm,bmhd->bshd', p, v).reshape(b, s, d).astype(x.dtype)
    return o @ w_o


def grouped_moe(x, router_w, router_b, w_gate, w_up, w_down):
    b, s, d = x.shape
    xt = x.reshape(b * s, d)
    scores = jax.nn.softmax((xt @ router_w).astype(jnp.float32), axis=-1)
    sel = scores + router_b.astype(jnp.float32)
    group_score = jnp.sum(lax.top_k(sel.reshape(-1, N_GROUPS, EXPERTS_PER_GROUP), TOP_K)[0], -1)
    group = jnp.argmax(group_score, -1)
    in_group = (jnp.arange(N_EXPERTS) // EXPERTS_PER_GROUP)[None, :] == group[:, None]
    _, idx = lax.top_k(jnp.where(in_group, sel, -jnp.inf), TOP_K)
    wts = jnp.take_along_axis(scores, idx, -1)
    wts = wts / jnp.sum(wts, -1, keepdims=True)
    gates = jnp.einsum('tk,tke->te', wts, jax.nn.one_hot(idx, N_EXPERTS, dtype=jnp.float32)).astype(x.dtype)
    y = jnp.zeros_like(xt)
    for e in range(N_EXPERTS):
        hdn = jax.nn.silu(xt @ w_gate[e]) * (xt @ w_up[e])
        y = y + gates[:, e:e + 1] * (hdn @ w_down[e])
    return y.reshape(b, s, d)


def setup_inputs(seed: int = 0) -> dict:
    key = jax.random.key(seed)
    ks = jax.random.split(key, 24)
    f32 = jnp.float32

    def nrm(k, shape, scale):
        return scale * jax.random.normal(k, shape, f32)

    d = D_MODEL
    dt = jnp.exp(jax.random.uniform(ks[5], (N_EVEN, DN_HEADS), f32, math.log(1e-3), math.log(1e-1)))
    return {
        'x': nrm(ks[0], (BATCH, SEQ, d), 1.0),
        'mem': nrm(ks[1], (BATCH, N_MEM, d), 1.0),
        'ab_w_in': nrm(ks[2], (N_EVEN, d, AB_IN), d ** -0.5),
        'ab_conv_w': nrm(ks[3], (N_EVEN, DN_CONV, 3 * DN_WIDTH), DN_CONV ** -0.5),
        'ab_a_log': jnp.log(jax.random.uniform(ks[4], (N_EVEN, DN_HEADS), f32, 1.0, 16.0)),
        'ab_dt_bias': dt + jnp.log(-jnp.expm1(-dt)),
        'ab_norm_w': 1.0 + nrm(ks[6], (N_EVEN, DN_HEAD_DIM), 0.02),
        'ab_w_out': nrm(ks[7], (N_EVEN, MIX_WIDTH, d), DEEPNORM_BETA * MIX_WIDTH ** -0.5),
        'sc_w_in': nrm(ks[8], (N_ODD, d, 3 * SC_WIDTH), d ** -0.5),
        'sc_conv_w': nrm(ks[9], (N_ODD, SC_CONV, SC_WIDTH), SC_CONV ** -0.5),
        'sc_w_out': nrm(ks[10], (N_ODD, SC_WIDTH, d), DEEPNORM_BETA * SC_WIDTH ** -0.5),
        'xa_w_q': nrm(ks[11], (DEPTH, d, d), d ** -0.5),
        'xa_w_kv': nrm(ks[12], (DEPTH, d, 2 * d), d ** -0.5),
        'xa_w_o': nrm(ks[13], (DEPTH, d, d), DEEPNORM_BETA * d ** -0.5),
        'router_w': nrm(ks[14], (d, N_EXPERTS), d ** -0.5),
        'router_b': nrm(ks[15], (N_EXPERTS,), 0.01),
        'moe_w_gate': nrm(ks[16], (DEPTH, N_EXPERTS, d, D_EXPERT), d ** -0.5),
        'moe_w_up': nrm(ks[17], (DEPTH, N_EXPERTS, d, D_EXPERT), d ** -0.5),
        'moe_w_down': nrm(ks[18], (DEPTH, N_EXPERTS, D_EXPERT, d), DEEPNORM_BETA * D_EXPERT ** -0.5),
        'ln_g': 1.0 + nrm(ks[19], (DEPTH, 3, d), 0.02),
        'ln_b': nrm(ks[20], (DEPTH, 3, d), 0.02),
    }


def reference(x, mem, ab_w_in, ab_conv_w, ab_a_log, ab_dt_bias, ab_norm_w, ab_w_out, sc_w_in, sc_conv_w, sc_w_out, xa_w_q, xa_w_kv, xa_w_o, router_w, router_b, moe_w_gate, moe_w_up, moe_w_down, ln_g, ln_b):
    h = x
    for layer in range(DEPTH):
        i = layer // 2
        if layer % 2 == 0:
            y = mixer_ab(h, ab_w_in[i], ab_conv_w[i], ab_a_log[i], ab_dt_bias[i], ab_norm_w[i], ab_w_out[i])
        else:
            y = short_conv_mixer(h, sc_w_in[i], sc_conv_w[i], sc_w_out[i])
        h = layer_norm(DEEPNORM_ALPHA * h + y, ln_g[layer, 0], ln_b[layer, 0])
        y = memory_cross_attention(h, mem, xa_w_q[layer], xa_w_kv[layer], xa_w_o[layer])
        h = layer_norm(DEEPNORM_ALPHA * h + y, ln_g[layer, 1], ln_b[layer, 1])
        y = grouped_moe(h, router_w, router_b, moe_w_gate[layer], moe_w_up[layer], moe_w_down[layer])
        h = layer_norm(DEEPNORM_ALPHA * h + y, ln_g[layer, 2], ln_b[layer, 2])
    return h
```

```cpp
#include <hip/hip_runtime.h>
#include <cstdio>
#include <cstdint>

#ifndef MK_ONE_LAUNCH
#define MK_ONE_LAUNCH 0
#endif

#define LAS __attribute__((address_space(3)))
#define GAS __attribute__((address_space(1)))
typedef unsigned short bf16;
typedef short bf16x8 __attribute__((ext_vector_type(8)));
typedef short s16x4 __attribute__((ext_vector_type(4)));
typedef float f32x4 __attribute__((ext_vector_type(4)));
typedef float f32x2 __attribute__((ext_vector_type(2)));
typedef unsigned u32x4 __attribute__((ext_vector_type(4)));
typedef unsigned u32x2 __attribute__((ext_vector_type(2)));
typedef GAS unsigned gu32;
#define RLX_AGENT __ATOMIC_RELAXED, __HIP_MEMORY_SCOPE_AGENT
#define LDS_WAIT() asm volatile("s_waitcnt lgkmcnt(0)" ::: "memory")
#define VM_WAIT() asm volatile("s_waitcnt vmcnt(0)" ::: "memory")

constexpr int NB = 4, SEQ = 4096, T = NB * SEQ, D = 1024;
constexpr int NMEM = 256, TM = NB * NMEM;
constexpr int DNH = 4, DND = 128, DNW = 512, DNC = 64, NCHUNK = SEQ / DNC;
constexpr int DAH = 8, DAD = 64, DAW = 512;
constexpr int AB_IN = 3592;
constexpr int XH = 4, XD = 256;
constexpr int NE = 16, DE = 512;
constexpr float ALPHA = 1.41421356237f;
constexpr float LN_EPS = 1e-5f, RMS_EPS = 1e-6f;
constexpr int MOE_ROWS = 2 * T + NE * 256;

constexpr size_t MiB = 1u << 20;
constexpr size_t WS_CTL = 0, CTL_ZERO_BYTES = 1 * MiB;
constexpr size_t WS_W_IN = 1 * MiB, WS_W_ABO = 8 * MiB, WS_W_SCI = 10 * MiB, WS_W_SCO = 16 * MiB, WS_W_Q = 18 * MiB, WS_W_KV = 22 * MiB, WS_W_O = 30 * MiB;
constexpr size_t WS_MEMB = 34 * MiB, WS_KMEM = 36 * MiB, WS_VT = 40 * MiB, WS_BETA = 44 * MiB, WS_GG = 45 * MiB, WS_ROUTE = 46 * MiB, WS_GLAST = 47 * MiB;
constexpr size_t WS_HB = 48 * MiB, WS_H = 80 * MiB, WS_ARENA = 144 * MiB, WS_END = 320 * MiB;
constexpr size_t WS_QKVPRE = 144 * MiB, WS_ZB = 192 * MiB, WS_QKVD = 208 * MiB, WS_MNEG = 80 * MiB, WS_BMT = 112 * MiB, WS_QEFF = 256 * MiB, WS_OLOCT = 272 * MiB;
constexpr size_t WS_OUN = 288 * MiB, WS_LSE = 304 * MiB, WS_OPART = 144 * MiB, WS_MIX = 256 * MiB;
constexpr size_t WS_MOEW_GU = 144 * MiB, WS_MOEW_D = 176 * MiB, WS_XG = 192 * MiB, WS_HACT = 264 * MiB;
static_assert((size_t)MOE_ROWS * D * 2 <= 72 * MiB && (size_t)MOE_ROWS * DE * 2 <= 36 * MiB, "moe buffers");
constexpr int CW_TMO = 0, CW_BAR = 4096, CW_QUEUE = 64, CW_CNT0 = 128, CW_CNT1 = 192;

constexpr int LDS_BYTES = 163840, MISC_OFF = 162816, XCH_OFF = 131072;

__device__ __forceinline__ unsigned f2bf(float f) { unsigned u = __builtin_bit_cast(unsigned, f); return (u + 0x7fffu + ((u >> 16) & 1u)) >> 16; }
__device__ __forceinline__ unsigned pk2(float lo, float hi) { return f2bf(lo) | (f2bf(hi) << 16); }
__device__ __forceinline__ float bf2f(unsigned short b) { return __builtin_bit_cast(float, (unsigned)b << 16); }
__device__ __forceinline__ float bflo(unsigned w) { return __builtin_bit_cast(float, w << 16); }
__device__ __forceinline__ float bfhi(unsigned w) { return __builtin_bit_cast(float, w & 0xffff0000u); }
__device__ __forceinline__ float wave_sum(float v) {
#pragma unroll
    for (int o = 1; o < 64; o <<= 1) v += __shfl_xor(v, o);
    return v;
}
template <class P> __device__ __forceinline__ P opq_v(P p) { asm volatile("" : "+v"(p)); return p; }
template <class P> __device__ __forceinline__ P opq_s(P p) { asm volatile("" : "+s"(p)); return p; }
__device__ __forceinline__ float silu_f(float x) { return x / (1.f + __expf(-x)); }

namespace pg8 {
constexpr int BM = 256, BK = 64, HALF = 128, HTB = HALF * BK * 2, STAGE_BYTES = 8 * HTB;
__host__ __device__ __forceinline__ int lds_byte(int r, int c) { const int st = (r >> 4) * 2 + (c >> 5), rr = r & 15, cc = c & 31, ob = rr * 64 + cc * 2; return st * 1024 + (ob ^ (((ob >> 9) & 1) << 5)); }
__host__ __device__ __forceinline__ void stage_rc(int b, int& R, int& C) { const int st = b / 1024, sb = b % 1024, swz = sb ^ (((sb >> 9) & 1) << 5); R = (st >> 1) * 16 + swz / 64; C = (st & 1) * 32 + (swz % 64) / 2; }
__host__ __device__ __forceinline__ int perm32(int rho) { const int n = rho >> 4, i = rho & 15; return 8 * (i >> 2) + 4 * n + (i & 3); }

struct Unit { int pm, pn, aux; const char* a; const char* b; };
struct Gemm { int lda, ldb, K; };
__device__ __forceinline__ unsigned cvt_pk_bf16(float lo, float hi) { unsigned r; asm volatile("v_cvt_pk_bf16_f32 %0, %1, %2" : "=v"(r) : "v"(lo), "v"(hi)); return r; }

__device__ __forceinline__ void swz_tile(int L, int nM, int nN, int& pm, int& pn) {
    const int nwg = nM * nN; int wgid = L; { const int q = nwg / 8, r = nwg % 8, xcd = wgid % 8, off = wgid / 8; wgid = (xcd < r ? xcd * (q + 1) : r * (q + 1) + (xcd - r) * q) + off; }
    const int nig = 8 * nN, gid = wgid / nig, fm = gid * 8, gsz = (nM - fm) < 8 ? (nM - fm) : 8;
    pm = fm + ((wgid % nig) % gsz); pn = (wgid % nig) / gsz;
}

template <class Epi, class Sched>
__device__ __forceinline__ void gemm_phase(LAS unsigned char* lds, LAS unsigned char* xch, const Gemm g, const Sched& S, const Epi& E) {
    const int tid = opq_v((int)threadIdx.x), wid = __builtin_amdgcn_readfirstlane(tid >> 6), lane = tid & 63, wr = wid >> 2, wc = wid & 3, fr = lane & 15, fq = lane >> 4;
    const int K = g.K, nt = K / BK;
    unsigned voffA[2], voffB[2];
#pragma unroll
    for (int i = 0; i < 2; ++i) { int R, C; stage_rc(tid * 16 + i * 8192, R, C); const int Rb = Epi::PERM ? ((R & ~31) + perm32(R & 31)) : R;
        voffA[i] = (unsigned)(R * g.lda + C) * 2u; voffB[i] = (unsigned)(Rb * g.ldb + C) * 2u; }
    const size_t kstep = (size_t)(BK * 2);
    const size_t hstepA = (size_t)HALF * g.lda * 2, hstepB = (size_t)HALF * g.ldb * 2;
    const unsigned ldsw = (unsigned)wid * 1024u;
    const int aoff = lds_byte(wr * 64 + fr, fq * 8), boff = lds_byte(wc * 32 + fr, fq * 8);
#define PG8_SA(b, h) (((b) * 2 + (h)) * HTB)
#define PG8_SB(b, h) ((4 + (b) * 2 + (h)) * HTB)
#define PG8_STAGE(bufoff, gbase, voff) do { _Pragma("unroll") for (int _i = 0; _i < 2; ++_i) \
        __builtin_amdgcn_global_load_lds((const unsigned*)((const char*)(gbase) + (voff)[_i]), (LAS unsigned*)(lds + (bufoff) + ldsw + _i * 8192), 16, 0, 0); } while (0)
#define PG8_LDA(dst, b, h) do { _Pragma("unroll") for (int m = 0; m < 4; ++m) _Pragma("unroll") for (int k = 0; k < 2; ++k) dst[m][k] = *(const LAS bf16x8*)(lds + PG8_SA(b, h) + aoff + m * 2048 + k * 1024); } while (0)
#define PG8_LDB(dst, b, h) do { _Pragma("unroll") for (int n = 0; n < 2; ++n) _Pragma("unroll") for (int k = 0; k < 2; ++k) dst[n][k] = *(const LAS bf16x8*)(lds + PG8_SB(b, h) + boff + n * 2048 + k * 1024); } while (0)
#define PG8_MMA(ai, bj, At, Bt) do { __builtin_amdgcn_s_setprio(1); _Pragma("unroll") for (int m = 0; m < 4; ++m) _Pragma("unroll") for (int n = 0; n < 2; ++n) _Pragma("unroll") for (int k = 0; k < 2; ++k) \
        acc[ai][bj][m][n] = __builtin_amdgcn_mfma_f32_16x16x32_bf16(Bt[n][k], At[m][k], acc[ai][bj][m][n], 0, 0, 0); __builtin_amdgcn_s_setprio(0); } while (0)
#define PG8_WAIT_V(n) asm volatile("s_waitcnt vmcnt(" #n ")" ::: "memory")
#define PG8_WAIT_L(n) asm volatile("s_waitcnt lgkmcnt(" #n ")" ::: "memory")
#define PG8_BAR __builtin_amdgcn_s_barrier()
#define PG8_SCHED __builtin_amdgcn_sched_barrier(0)
    Unit cur, nxt; int ui = 0;
    if (!S.next(0, cur)) return;
    f32x4 acc[2][2][4][2];
#pragma unroll
    for (int a = 0; a < 2; ++a)
#pragma unroll
        for (int b = 0; b < 2; ++b)
#pragma unroll
            for (int m = 0; m < 4; ++m)
#pragma unroll
                for (int n = 0; n < 2; ++n) acc[a][b][m][n] = (f32x4){0.f, 0.f, 0.f, 0.f};
    bf16x8 At[4][2], B0[2][2], B1[2][2];
    const char* cA = cur.a; const char* cB = cur.b;
    PG8_STAGE(PG8_SB(0, 0), cB, voffB); PG8_STAGE(PG8_SB(0, 1), cB + hstepB, voffB); PG8_STAGE(PG8_SA(0, 0), cA, voffA); PG8_STAGE(PG8_SA(0, 1), cA + hstepA, voffA);
    if (wr == 1) PG8_BAR;
    PG8_WAIT_V(2); PG8_BAR;
    PG8_STAGE(PG8_SB(1, 0), cB + kstep, voffB); PG8_STAGE(PG8_SA(1, 0), cA + kstep, voffA); PG8_STAGE(PG8_SB(1, 1), cB + hstepB + kstep, voffB);
    PG8_WAIT_V(6); PG8_BAR;
#pragma unroll 1
    for (;;) {
        const bool has_next = S.next(ui + 1, nxt);
        const char* nA = has_next ? nxt.a : cA; const char* nB = has_next ? nxt.b : cB;
#pragma unroll 1
        for (int t = 0; t < nt; t += 2) {
            const bool last = (t == nt - 2);
            const char* a1 = cA + (size_t)(t + 1) * kstep;
            const char* a2 = last ? nA : cA + (size_t)(t + 2) * kstep; const char* b2 = last ? nB : cB + (size_t)(t + 2) * kstep;
            const char* a3 = a2 + kstep; const char* b3 = b2 + kstep;
            PG8_LDB(B0, 0, 0); PG8_LDB(B1, 0, 1); PG8_SCHED; PG8_LDA(At, 0, 0); PG8_STAGE(PG8_SA(1, 1), a1 + hstepA, voffA);
            PG8_WAIT_V(8); PG8_WAIT_L(0); PG8_BAR; PG8_MMA(0, 0, At, B0); PG8_MMA(0, 1, At, B1); PG8_BAR; PG8_SCHED;
            PG8_LDA(At, 0, 1); PG8_STAGE(PG8_SB(0, 0), b2, voffB); PG8_STAGE(PG8_SB(0, 1), b2 + hstepB, voffB); PG8_STAGE(PG8_SA(0, 0), a2, voffA);
            PG8_WAIT_V(8); PG8_WAIT_L(0); PG8_BAR; PG8_MMA(1, 0, At, B0); PG8_MMA(1, 1, At, B1); PG8_BAR; PG8_SCHED;
            PG8_LDB(B0, 1, 0); PG8_LDB(B1, 1, 1); PG8_SCHED; PG8_LDA(At, 1, 0); PG8_STAGE(PG8_SA(0, 1), a2 + hstepA, voffA);
            PG8_WAIT_V(8); PG8_WAIT_L(0); PG8_BAR; PG8_MMA(0, 0, At, B0); PG8_MMA(0, 1, At, B1); PG8_BAR; PG8_SCHED;
            PG8_LDA(At, 1, 1); PG8_STAGE(PG8_SB(1, 0), b3, voffB); PG8_STAGE(PG8_SB(1, 1), b3 + hstepB, voffB); PG8_STAGE(PG8_SA(1, 0), a3, voffA);
            PG8_WAIT_V(8); PG8_WAIT_L(0); PG8_BAR; PG8_MMA(1, 0, At, B0); PG8_MMA(1, 1, At, B1); PG8_BAR; PG8_SCHED;
        }
        if (wr == 0) PG8_BAR;
        E(acc, cur, wr, wc, fr, fq, xch);
        if (!has_next) break;
#pragma unroll
        for (int a = 0; a < 2; ++a)
#pragma unroll
            for (int b = 0; b < 2; ++b)
#pragma unroll
                for (int m = 0; m < 4; ++m)
#pragma unroll
                    for (int n = 0; n < 2; ++n) acc[a][b][m][n] = (f32x4){0.f, 0.f, 0.f, 0.f};
        cur = nxt; cA = nA; cB = nB; ++ui;
        if (wr == 1) PG8_BAR;
    }
    PG8_WAIT_V(0);
    PG8_BAR;
#undef PG8_SA
#undef PG8_SB
#undef PG8_STAGE
#undef PG8_LDA
#undef PG8_LDB
#undef PG8_MMA
#undef PG8_WAIT_V
#undef PG8_WAIT_L
#undef PG8_BAR
#undef PG8_SCHED
}

struct Dst { bf16* p; int ld; };
__device__ __forceinline__ void store_tile_bf16(const f32x4 (&acc)[2][2][4][2], const Dst d, float sc, int wr, int wc, int fr, int fq) {
    unsigned lane_off = (unsigned)((wr * 64 + fr) * d.ld + wc * 32 + 8 * fq);
    asm volatile("" : "+v"(lane_off));
#pragma unroll
    for (int ai = 0; ai < 2; ++ai)
#pragma unroll
        for (int m = 0; m < 4; ++m) { bf16* rowp = d.p + (size_t)lane_off + (size_t)((ai * HALF + m * 16) * d.ld);
#pragma unroll
            for (int bj = 0; bj < 2; ++bj) { const f32x4 v0 = acc[ai][bj][m][0] * sc, v1 = acc[ai][bj][m][1] * sc;
                u32x4 w; w.x = cvt_pk_bf16(v0[0], v0[1]); w.y = cvt_pk_bf16(v0[2], v0[3]); w.z = cvt_pk_bf16(v1[0], v1[1]); w.w = cvt_pk_bf16(v1[2], v1[3]);
                *(u32x4*)(rowp + bj * HALF) = w; } }
}
}

#define XB_TMO      128
#define XB_XCNT(j)  (256  + 64 * (j))
#define XB_XSUB(j)  (1280 + 64 * (j))
#define XB_XGEN(j)  (2304 + 64 * (j))
#define XB_TOP      3328
#define XB_TOPGEN   3392
#define XCD_BAR_WORDS 3456
#define XB_SPIN_CAP (1u << 20)
__device__ __forceinline__ unsigned xb_ld(unsigned* p)              { return __hip_atomic_load(p, __ATOMIC_RELAXED, __HIP_MEMORY_SCOPE_AGENT); }
__device__ __forceinline__ unsigned xb_add(unsigned* p, unsigned v) { return __hip_atomic_fetch_add(p, v, __ATOMIC_RELAXED, __HIP_MEMORY_SCOPE_AGENT); }
__device__ __forceinline__ unsigned xb_xcc_id() { return (unsigned)__builtin_amdgcn_s_getreg((3 << 11) | 20) & 0xFu; }
#define XB_SPIN(cond, bar) do { unsigned _sp = 0; while (cond) { __builtin_amdgcn_s_sleep(1); \
    if ((++_sp & 255u) == 0u) { if (xb_ld(&(bar)[XB_TMO])) break; if (_sp > XB_SPIN_CAP) { atomicAdd(&(bar)[XB_TMO], 1u); break; } } } } while (0)
struct XcdBarrier { unsigned* bar; unsigned x; volatile LAS unsigned* st; };
__device__ __forceinline__ XcdBarrier xcd_barrier_post(unsigned* bar, volatile LAS unsigned* st) {
    XcdBarrier b; b.bar = bar; b.x = xb_xcc_id(); b.st = st;
    if (threadIdx.x == 0) (void)xb_add(&bar[XB_XCNT(b.x)], 1u);
    return b;
}
__device__ __forceinline__ void xcd_barrier_complete(unsigned* bar, unsigned x, unsigned& nloc, unsigned& nx) {
    const unsigned G = gridDim.x * gridDim.y * gridDim.z;
    unsigned sum, cnt, mine, sp = 0u;
    for (;;) {
        sum = 0u; cnt = 0u; mine = 0u;
#pragma unroll
        for (unsigned j = 0; j < 16; ++j) { const unsigned c = xb_ld(&bar[XB_XCNT(j)]); sum += c; cnt += (c > 0u) ? 1u : 0u; mine = (j == x) ? c : mine; }
        if (sum == G) break;
        __builtin_amdgcn_s_sleep(1);
        if ((++sp & 255u) == 0u) { if (xb_ld(&bar[XB_TMO])) break; if (sp > XB_SPIN_CAP) { atomicAdd(&bar[XB_TMO], 1u); break; } }
    }
    nloc = mine > 0u ? mine : 1u; nx = cnt > 0u ? cnt : 1u;
}
__device__ __forceinline__ void xcd_barrier(const XcdBarrier& b) {
    asm volatile("s_waitcnt vmcnt(0)" ::: "memory");
    __syncthreads();
    if (threadIdx.x == 0) {
        unsigned* bar = b.bar;
        __builtin_amdgcn_s_waitcnt(0);
        unsigned nloc = b.st[0], nx = b.st[1];
        if (nloc == 0u) { xcd_barrier_complete(bar, b.x, nloc, nx); b.st[0] = nloc; b.st[1] = nx; }
        const unsigned old = xb_add(&bar[XB_XSUB(b.x)], 1u);
        const unsigned gen = old / nloc;
        if (old + 1u == (gen + 1u) * nloc) {
            __builtin_amdgcn_fence(__ATOMIC_RELEASE, "agent");
            asm volatile("s_waitcnt vmcnt(0)" ::: "memory");
            const unsigned og = xb_add(&bar[XB_TOP], 1u);
            const unsigned tg = og / nx;
            if (og + 1u == (tg + 1u) * nx) xb_add(&bar[XB_TOPGEN], 1u);
            else XB_SPIN(xb_ld(&bar[XB_TOPGEN]) == tg, bar);
            __builtin_amdgcn_fence(__ATOMIC_ACQUIRE, "agent");
            xb_add(&bar[XB_XGEN(b.x)], 1u);
            asm volatile("s_waitcnt vmcnt(0)" ::: "memory");
        } else {
            XB_SPIN(xb_ld(&bar[XB_XGEN(b.x)]) == gen, bar);
            __builtin_amdgcn_fence(__ATOMIC_ACQUIRE, "agent");
            asm volatile("s_waitcnt vmcnt(0)" ::: "memory");
        }
    }
    __syncthreads();
}

struct Args { const float* in[21]; float* out; unsigned char* ws; int ph_lo, ph_hi; };
struct Frame {
    LAS unsigned char* lds;
    unsigned char* ws;
    gu32* ctl;
    int tid, lane, wave, G, gw, NGW;
};
#define WSP(T_, off) ((T_*)(F.ws + (off)))

__device__ __forceinline__ void tr_item(const float* W, int ldw, int k0, int c0, bf16* dst, int ldd, LAS float* scr, int lane) {
    const int r8 = lane >> 3, c4 = lane & 7;
#pragma unroll
    for (int it = 0; it < 8; ++it) { const int kk = it * 8 + r8; const f32x4 v = *(const GAS f32x4*)(W + (size_t)(k0 + kk) * ldw + c0 + 4 * c4);
        LAS float* s = scr + kk * 33 + 4 * c4; s[0] = v[0]; s[1] = v[1]; s[2] = v[2]; s[3] = v[3]; }
    LDS_WAIT(); asm volatile("" ::: "memory");
    const int c = lane & 7;
#pragma unroll
    for (int j = 0; j < 4; ++j) { const int n = (lane >> 3) + 8 * j; const LAS float* s = scr + (8 * c) * 33 + n;
        u32x4 o; o.x = pk2(s[0 * 33], s[1 * 33]); o.y = pk2(s[2 * 33], s[3 * 33]); o.z = pk2(s[4 * 33], s[5 * 33]); o.w = pk2(s[6 * 33], s[7 * 33]);
        *(GAS u32x4*)(dst + (size_t)n * ldd + k0 + 8 * c) = o; }
    LDS_WAIT(); asm volatile("" ::: "memory");
}
__device__ __forceinline__ void tr_matrix(Frame& F, const float* W, int K, int N, int ldw, bf16* dst, LAS float* scr, int it) {
    const int nblk = N / 32, kb = it / nblk, nb = it % nblk;
    tr_item(W, ldw, 64 * kb, 32 * nb, dst + (size_t)(32 * nb) * K, K, scr, F.lane);
}
__device__ __forceinline__ void p0_prologue(Frame& F, const Args& A) {
    LAS float* scr = (LAS float*)(F.lds + F.wave * 16384);
    constexpr int I_IN = 16 * 112, I_SQ = 16 * 32, I_SCI = 16 * 96, I_KV = 16 * 64;
    constexpr int NITEMS = I_IN + I_SQ + I_SCI + I_SQ + 2 * I_SQ + 2 * I_KV + 2 * I_SQ;
    for (int it = F.gw; it < NITEMS; it += F.NGW) {
        int r = it;
        if (r < I_IN) { const int kb = r / 112, nb = r % 112;
            tr_item(A.in[2], AB_IN, 64 * kb, 32 * nb + (nb >= 64 ? 8 : 0), WSP(bf16, WS_W_IN) + (size_t)(32 * nb) * D, D, scr, F.lane); continue; } r -= I_IN;
        if (r < I_SQ) { tr_matrix(F, A.in[7], D, D, D, WSP(bf16, WS_W_ABO), scr, r); continue; } r -= I_SQ;
        if (r < I_SCI) { tr_matrix(F, A.in[8], D, 3 * D, 3 * D, WSP(bf16, WS_W_SCI), scr, r); continue; } r -= I_SCI;
        if (r < I_SQ) { tr_matrix(F, A.in[10], D, D, D, WSP(bf16, WS_W_SCO), scr, r); continue; } r -= I_SQ;
        if (r < 2 * I_SQ) { const int l = r / I_SQ; tr_matrix(F, A.in[11] + (size_t)l * D * D, D, D, D, WSP(bf16, WS_W_Q) + (size_t)l * D * D, scr, r % I_SQ); continue; } r -= 2 * I_SQ;
        if (r < 2 * I_KV) { const int l = r / I_KV; tr_matrix(F, A.in[12] + (size_t)l * D * 2 * D, D, 2 * D, 2 * D, WSP(bf16, WS_W_KV) + (size_t)l * 2 * D * D, scr, r % I_KV); continue; } r -= 2 * I_KV;
        { const int l = r / I_SQ; tr_matrix(F, A.in[13] + (size_t)l * D * D, D, D, D, WSP(bf16, WS_W_O) + (size_t)l * D * D, scr, r % I_SQ); }
    }
    __syncthreads();
    LAS float* wt = (LAS float*)F.lds;
    for (int i = F.tid; i < 8 * D; i += 512) { const int k = i >> 3, c = i & 7; wt[c * D + k] = A.in[2][(size_t)k * AB_IN + 2048 + c]; }
    __syncthreads();
    const float* x = A.in[0];
    float alg[4], dtb[4];
#pragma unroll
    for (int h = 0; h < 4; ++h) { alg[h] = -__expf(A.in[4][h]); dtb[h] = A.in[5][h]; }
    for (int m = F.gw; m < T; m += F.NGW) {
        const GAS f32x4* xr = (const GAS f32x4*)(x + (size_t)m * D) + F.lane;
        f32x4 v[4];
#pragma unroll
        for (int j = 0; j < 4; ++j) v[j] = xr[64 * j];
        GAS u32x2* o8 = (GAS u32x2*)(WSP(bf16, WS_HB) + (size_t)m * D) + F.lane;
#pragma unroll
        for (int j = 0; j < 4; ++j) { u32x2 w; w.x = pk2(v[j][0], v[j][1]); w.y = pk2(v[j][2], v[j][3]); o8[64 * j] = w; }
        float dot[8];
#pragma unroll
        for (int c = 0; c < 8; ++c) { float s = 0.f;
#pragma unroll
            for (int j = 0; j < 4; ++j) { const f32x4 w = *(const LAS f32x4*)(wt + c * D + 256 * j + 4 * F.lane); s += v[j][0] * w[0] + v[j][1] * w[1] + v[j][2] * w[2] + v[j][3] * w[3]; }
            dot[c] = wave_sum(s); }
        if (F.lane == 0) {
            f32x4 bo, go;
#pragma unroll
            for (int hq = 0; hq < 4; ++hq) { bo[hq] = 1.f / (1.f + __expf(-dot[hq])); const float xx = dot[4 + hq] + dtb[hq]; const float sp = xx > 20.f ? xx : log1pf(__expf(xx)); go[hq] = alg[hq] * sp; }
            *(GAS f32x4*)(WSP(float, WS_BETA) + (size_t)m * 4) = bo;
            *(GAS f32x4*)(WSP(float, WS_GG) + (size_t)m * 4) = go;
        }
    }
    for (int m = F.gw; m < TM; m += F.NGW) {
        const GAS f32x4* xr = (const GAS f32x4*)(A.in[1] + (size_t)m * D) + F.lane;
        GAS u32x2* o8 = (GAS u32x2*)(WSP(bf16, WS_MEMB) + (size_t)m * D) + F.lane;
#pragma unroll
        for (int j = 0; j < 4; ++j) { const f32x4 v = xr[64 * j]; u32x2 w; w.x = pk2(v[0], v[1]); w.y = pk2(v[2], v[3]); o8[64 * j] = w; }
    }
}
__device__ __forceinline__ void convert_moe(Frame& F, const Args& A, int layer) {
    LAS float* scr = (LAS float*)(F.lds + F.wave * 16384);
    constexpr int I_GU = 16 * 32, I_D = 8 * 32;
    constexpr int NITEMS = NE * (I_GU + I_D);
    for (int it = F.gw; it < NITEMS; it += F.NGW) {
        const int e = it / (I_GU + I_D); int r = it % (I_GU + I_D);
        if (r < I_GU) { const int kb = r / 32, rb = r % 32, pn = rb >> 3, sub = rb & 7;
            const float* src = (sub < 4 ? A.in[16] : A.in[17]) + ((size_t)layer * NE + e) * D * DE;
            tr_item(src, DE, 64 * kb, 128 * pn + 32 * (sub & 3), WSP(bf16, WS_MOEW_GU) + ((size_t)e * D + 32 * rb) * D, D, scr, F.lane);
        } else { r -= I_GU; const int kb = r / 32, nb = r % 32;
            tr_item(A.in[18] + ((size_t)layer * NE + e) * DE * D, D, 64 * kb, 32 * nb, WSP(bf16, WS_MOEW_D) + ((size_t)e * D + 32 * nb) * DE, DE, scr, F.lane); }
    }
}

struct SchedDense {
    const char* A; const char* B; int lda, ldb, nM, nN, G, c;
    __device__ __forceinline__ bool next(int i, pg8::Unit& u) const {
        const int L = i * G + c; if (L >= nM * nN) return false;
        pg8::swz_tile(L, nM, nN, u.pm, u.pn); u.aux = 0;
        u.a = A + (size_t)u.pm * 256 * lda * 2; u.b = B + (size_t)u.pn * 256 * ldb * 2; return true; }
};
struct EpiDense {
    static constexpr bool PERM = true;
    bf16* O; int ld; float sc;
    __device__ __forceinline__ void operator()(const f32x4 (&acc)[2][2][4][2], const pg8::Unit& u, int wr, int wc, int fr, int fq, LAS unsigned char*) const {
        pg8::store_tile_bf16(acc, pg8::Dst{O + (size_t)u.pm * 256 * ld + u.pn * 256, ld}, sc, wr, wc, fr, fq); }
};
struct SchedP1 {
    const char* XB; const char* WIN; const char* MEMB; const char* WKV; int G, c;
    __device__ __forceinline__ bool next(int i, pg8::Unit& u) const {
        const int L = i * G + c; if (L >= 896 + 64) return false;
        if (L < 896) { pg8::swz_tile(L, 64, 14, u.pm, u.pn); u.aux = 0; u.a = XB + (size_t)u.pm * 256 * D * 2; u.b = WIN + (size_t)u.pn * 256 * D * 2; }
        else { const int r = L - 896, l = r >> 5; u.pm = (r & 31) >> 3; u.pn = r & 7; u.aux = 1 + l; u.a = MEMB + (size_t)u.pm * 256 * D * 2; u.b = WKV + ((size_t)l * 2 * D + u.pn * 256) * D * 2; }
        return true; }
};
struct EpiP1 {
    static constexpr bool PERM = true;
    bf16 *QKVPRE, *ZB, *QKVD, *KMEM, *VT;
    __device__ __forceinline__ void operator()(const f32x4 (&acc)[2][2][4][2], const pg8::Unit& u, int wr, int wc, int fr, int fq, LAS unsigned char*) const {
        if (u.aux == 0) {
            pg8::Dst d;
            if (u.pn < 6) d = pg8::Dst{QKVPRE + (size_t)u.pm * 256 * 1536 + u.pn * 256, 1536};
            else if (u.pn < 8) d = pg8::Dst{ZB + (size_t)u.pm * 256 * 512 + (u.pn - 6) * 256, 512};
            else d = pg8::Dst{QKVD + (size_t)u.pm * 256 * 1536 + (u.pn - 8) * 256, 1536};
            pg8::store_tile_bf16(acc, d, 1.f, wr, wc, fr, fq);
        } else {
            const int l = u.aux - 1;
            if (u.pn < 4) pg8::store_tile_bf16(acc, pg8::Dst{KMEM + ((size_t)l * TM + u.pm * 256) * D + u.pn * 256, D}, 1.f, wr, wc, fr, fq);
            else {
                unsigned lane_off = (unsigned)((wc * 32 + 8 * fq) * NMEM + wr * 64 + fr);
                asm volatile("" : "+v"(lane_off));
                bf16* vt = VT + (((size_t)l * NB + u.pm) * XH + (u.pn - 4)) * XD * NMEM + lane_off;
#pragma unroll
                for (int ai = 0; ai < 2; ++ai)
#pragma unroll
                    for (int m = 0; m < 4; ++m)
#pragma unroll
                        for (int bj = 0; bj < 2; ++bj)
#pragma unroll
                            for (int n = 0; n < 2; ++n)
#pragma unroll
                                for (int e = 0; e < 4; ++e) vt[(bj * 128 + 4 * n + e) * NMEM + ai * 128 + m * 16] = (bf16)f2bf(acc[ai][bj][m][n][e]);
            }
        }
    }
};
struct SchedXS {
    const char* QB; const char* KM; int G, c;
    __device__ __forceinline__ bool next(int i, pg8::Unit& u) const {
        const int L = i * G + c; if (L >= 256) return false;
        u.pm = L >> 2; u.pn = L & 3; u.aux = 0;
        u.a = QB + ((size_t)u.pm * 256 * D + u.pn * XD) * 2; u.b = KM + ((size_t)(u.pm >> 4) * NMEM * D + u.pn * XD) * 2; return true; }
};
struct EpiSoftmax {
    static constexpr bool PERM = true;
    bf16* P;
    __device__ __forceinline__ void operator()(f32x4 (&acc)[2][2][4][2], const pg8::Unit& u, int wr, int wc, int fr, int fq, LAS unsigned char* xch) const {
        LAS float* MX = (LAS float*)xch;
        LAS float* SM = (LAS float*)(xch + 4096);
#pragma unroll
        for (int ai = 0; ai < 2; ++ai)
#pragma unroll
            for (int m = 0; m < 4; ++m) { float v = -3.0e38f;
#pragma unroll
                for (int bj = 0; bj < 2; ++bj)
#pragma unroll
                    for (int n = 0; n < 2; ++n) { const f32x4 x = acc[ai][bj][m][n]; v = fmaxf(v, fmaxf(fmaxf(x[0], x[1]), fmaxf(x[2], x[3]))); }
                v = fmaxf(v, __shfl_xor(v, 16)); v = fmaxf(v, __shfl_xor(v, 32));
                if (fq == 0) MX[(ai * 128 + wr * 64 + m * 16 + fr) * 4 + wc] = v; }
        LDS_WAIT(); __builtin_amdgcn_s_barrier(); asm volatile("" ::: "memory");
#pragma unroll
        for (int ai = 0; ai < 2; ++ai)
#pragma unroll
            for (int m = 0; m < 4; ++m) { float s = 0.f; const f32x4 q = *(const LAS f32x4*)(MX + (ai * 128 + wr * 64 + m * 16 + fr) * 4); const float mxr = fmaxf(fmaxf(q[0], q[1]), fmaxf(q[2], q[3]));
#pragma unroll
                for (int bj = 0; bj < 2; ++bj)
#pragma unroll
                    for (int n = 0; n < 2; ++n) { f32x4 x = acc[ai][bj][m][n];
#pragma unroll
                        for (int e = 0; e < 4; ++e) { x[e] = __builtin_amdgcn_exp2f(x[e] - mxr); s += x[e]; }
                        acc[ai][bj][m][n] = x; }
                s += __shfl_xor(s, 16); s += __shfl_xor(s, 32);
                if (fq == 0) SM[(ai * 128 + wr * 64 + m * 16 + fr) * 4 + wc] = s; }
        LDS_WAIT(); __builtin_amdgcn_s_barrier(); asm volatile("" ::: "memory");
        bf16* base = P + (size_t)u.pm * 256 * D + u.pn * XD;
#pragma unroll
        for (int ai = 0; ai < 2; ++ai)
#pragma unroll
            for (int m = 0; m < 4; ++m) { const f32x4 q = *(const LAS f32x4*)(SM + (ai * 128 + wr * 64 + m * 16 + fr) * 4); const float inv = 1.f / ((q[0] + q[1]) + (q[2] + q[3]));
                bf16* rowp = base + (size_t)(ai * 128 + wr * 64 + m * 16 + fr) * D + wc * 32 + 8 * fq;
#pragma unroll
                for (int bj = 0; bj < 2; ++bj) { const f32x4 v0 = acc[ai][bj][m][0] * inv, v1 = acc[ai][bj][m][1] * inv;
                    u32x4 w; w.x = pg8::cvt_pk_bf16(v0[0], v0[1]); w.y = pg8::cvt_pk_bf16(v0[2], v0[3]); w.z = pg8::cvt_pk_bf16(v1[0], v1[1]); w.w = pg8::cvt_pk_bf16(v1[2], v1[3]);
                    *(u32x4*)(rowp + bj * 128) = w; } }
        LDS_WAIT(); __builtin_amdgcn_s_barrier(); asm volatile("" ::: "memory");
    }
};
struct SchedXP {
    const char* PB; const char* VT; int G, c;
    __device__ __forceinline__ bool next(int i, pg8::Unit& u) const {
        const int L = i * G + c; if (L >= 256) return false;
        u.pm = L >> 2; u.pn = L & 3; u.aux = 0;
        u.a = PB + ((size_t)u.pm * 256 * D + u.pn * XD) * 2; u.b = VT + ((size_t)((u.pm >> 4) * XH + u.pn) * XD * NMEM) * 2; return true; }
};
struct SchedMoE {
    const char* Aall; const char* Wall; volatile LAS unsigned* tab; int lda, wrows  , ldb, G, c;
    __device__ __forceinline__ bool next(int i, pg8::Unit& u) const {
        const int L = i * G + c; const int ntile = (int)tab[16]; if (L >= ntile * 4) return false;
        u.pm = L >> 2; u.pn = L & 3; int e = 0;
#pragma unroll
        for (int j = 1; j < 16; ++j) e += ((int)tab[j] <= u.pm) ? 1 : 0;
        u.aux = e; u.a = Aall + (size_t)u.pm * 256 * lda * 2; u.b = Wall + ((size_t)e * wrows + u.pn * 256) * ldb * 2; return true; }
};
struct EpiSwiglu {
    static constexpr bool PERM = true;
    bf16* HACT;
    __device__ __forceinline__ void operator()(const f32x4 (&acc)[2][2][4][2], const pg8::Unit& u, int wr, int wc, int fr, int fq, LAS unsigned char*) const {
#pragma unroll
        for (int ai = 0; ai < 2; ++ai)
#pragma unroll
            for (int m = 0; m < 4; ++m) { bf16* rowp = HACT + (size_t)(u.pm * 256 + ai * 128 + wr * 64 + m * 16 + fr) * DE + u.pn * 128 + wc * 32 + 8 * fq;
                float h[8];
#pragma unroll
                for (int n = 0; n < 2; ++n)
#pragma unroll
                    for (int e = 0; e < 4; ++e) { const float gt = acc[ai][0][m][n][e], up = acc[ai][1][m][n][e]; h[n * 4 + e] = silu_f(gt) * up; }
                u32x4 w; w.x = pg8::cvt_pk_bf16(h[0], h[1]); w.y = pg8::cvt_pk_bf16(h[2], h[3]); w.z = pg8::cvt_pk_bf16(h[4], h[5]); w.w = pg8::cvt_pk_bf16(h[6], h[7]);
                *(u32x4*)rowp = w; }
    }
};

struct Route { int e0, e1, r0, r1; float w0, w1; int s0, s1; };
template <int MODE, bool ROUTER, bool FINAL>
__device__ __forceinline__ void ln_pass(Frame& F, const Args& A, const float* hold, const bf16* Y, int li  , float* hnew, bf16* hb, unsigned* cnt) {
    const float* gam = A.in[19] + (size_t)li * D; const float* bet = A.in[20] + (size_t)li * D;
    f32x4 gv[4], bv[4];
#pragma unroll
    for (int j = 0; j < 4; ++j) { gv[j] = *(const GAS f32x4*)(gam + 256 * j + 4 * F.lane); bv[j] = *(const GAS f32x4*)(bet + 256 * j + 4 * F.lane); }
    LAS float* rw = (LAS float*)F.lds;
    LAS int* sel = (LAS int*)(F.lds + 65536);
    LAS float* selw = (LAS float*)(F.lds + 65536 + 1024);
    if (ROUTER) { for (int i = F.tid; i < NE * D; i += 512) { const int k = i >> 4, e = i & 15; rw[e * D + k] = A.in[14][i]; } __syncthreads(); }
    Route* route = WSP(Route, WS_ROUTE);
    const int nblk = T / 64;
    for (int blk = blockIdx.x; blk < nblk; blk += F.G) {
#pragma unroll 1
        for (int rr = 0; rr < 8; ++rr) {
            const int m = blk * 64 + F.wave * 8 + rr;
            f32x4 v[4];
#pragma unroll
            for (int j = 0; j < 4; ++j) v[j] = *((const GAS f32x4*)(hold + (size_t)m * D) + F.lane + 64 * j) * ALPHA;
            if (MODE == 0) {
#pragma unroll
                for (int j = 0; j < 4; ++j) { const u32x2 w = *((const GAS u32x2*)(Y + (size_t)m * D) + F.lane + 64 * j); v[j][0] += bflo(w.x); v[j][1] += bfhi(w.x); v[j][2] += bflo(w.y); v[j][3] += bfhi(w.y); }
            } else {
                const Route r = route[m];
#pragma unroll
                for (int j = 0; j < 4; ++j) { const u32x2 w0 = *((const GAS u32x2*)(Y + (size_t)r.s0 * D) + F.lane + 64 * j), w1 = *((const GAS u32x2*)(Y + (size_t)r.s1 * D) + F.lane + 64 * j);
                    v[j][0] += r.w0 * bflo(w0.x) + r.w1 * bflo(w1.x); v[j][1] += r.w0 * bfhi(w0.x) + r.w1 * bfhi(w1.x); v[j][2] += r.w0 * bflo(w0.y) + r.w1 * bflo(w1.y); v[j][3] += r.w0 * bfhi(w0.y) + r.w1 * bfhi(w1.y); }
            }
            float s = 0.f;
#pragma unroll
            for (int j = 0; j < 4; ++j) s += (v[j][0] + v[j][1]) + (v[j][2] + v[j][3]);
            const float mean = wave_sum(s) * (1.f / D); float s2 = 0.f;
#pragma unroll
            for (int j = 0; j < 4; ++j) { v[j] = v[j] - mean; s2 += (v[j][0] * v[j][0] + v[j][1] * v[j][1]) + (v[j][2] * v[j][2] + v[j][3] * v[j][3]); }
            const float rstd = 1.f / sqrtf(wave_sum(s2) * (1.f / D) + LN_EPS);
#pragma unroll
            for (int j = 0; j < 4; ++j) v[j] = v[j] * rstd * gv[j] + bv[j];
#pragma unroll
            for (int j = 0; j < 4; ++j) *((GAS f32x4*)(hnew + (size_t)m * D) + F.lane + 64 * j) = v[j];
            if (!FINAL) {
#pragma unroll
                for (int j = 0; j < 4; ++j) { u32x2 w; w.x = pk2(v[j][0], v[j][1]); w.y = pk2(v[j][2], v[j][3]); *((GAS u32x2*)(hb + (size_t)m * D) + F.lane + 64 * j) = w; }
            }
            if (ROUTER) {
                float lg[16];
#pragma unroll
                for (int e = 0; e < 16; ++e) { float d = 0.f;
#pragma unroll
                    for (int j = 0; j < 4; ++j) { const f32x4 w = *(const LAS f32x4*)(rw + e * D + 256 * j + 4 * F.lane); d += v[j][0] * w[0] + v[j][1] * w[1] + v[j][2] * w[2] + v[j][3] * w[3]; }
                    lg[e] = wave_sum(d); }
                float mxl = lg[0];
#pragma unroll
                for (int e = 1; e < 16; ++e) mxl = fmaxf(mxl, lg[e]);
                float sc[16], se = 0.f;
#pragma unroll
                for (int e = 0; e < 16; ++e) { sc[e] = __expf(lg[e] - mxl); se += sc[e]; }
                const float inv = 1.f / se; float sl[16];
#pragma unroll
                for (int e = 0; e < 16; ++e) { sc[e] *= inv; sl[e] = sc[e] + A.in[15][e]; }
                int bg = 0; float bgs = -3.0e38f;
#pragma unroll
                for (int g4 = 0; g4 < 4; ++g4) { const float a = sl[4 * g4], b = sl[4 * g4 + 1], c = sl[4 * g4 + 2], d = sl[4 * g4 + 3];
                    const float hi1 = fmaxf(a, b), lo1 = fminf(a, b), hi2 = fmaxf(c, d), lo2 = fminf(c, d);
                    const float top = fmaxf(hi1, hi2), second = fmaxf(fminf(hi1, hi2), fmaxf(lo1, lo2)); const float gs = top + second;
                    if (gs > bgs) { bgs = gs; bg = g4; } }
                float s4[4], c4[4];
#pragma unroll
                for (int q = 0; q < 4; ++q) { s4[q] = bg == 0 ? sl[q] : bg == 1 ? sl[4 + q] : bg == 2 ? sl[8 + q] : sl[12 + q]; c4[q] = bg == 0 ? sc[q] : bg == 1 ? sc[4 + q] : bg == 2 ? sc[8 + q] : sc[12 + q]; }
                int i0 = 0; float b0 = s4[0];
#pragma unroll
                for (int q = 1; q < 4; ++q) if (s4[q] > b0) { b0 = s4[q]; i0 = q; }
                int i1 = -1; float b1 = -3.0e38f;
#pragma unroll
                for (int q = 0; q < 4; ++q) if (q != i0 && s4[q] > b1) { b1 = s4[q]; i1 = q; }
                const float p0 = i0 == 0 ? c4[0] : i0 == 1 ? c4[1] : i0 == 2 ? c4[2] : c4[3];
                const float p1 = i1 == 0 ? c4[0] : i1 == 1 ? c4[1] : i1 == 2 ? c4[2] : c4[3];
                if (F.lane == 0) { const int tk = F.wave * 8 + rr; sel[tk * 4 + 0] = bg * 4 + i0; sel[tk * 4 + 1] = bg * 4 + i1; selw[tk * 2 + 0] = p0 / (p0 + p1); selw[tk * 2 + 1] = p1 / (p0 + p1); }
            }
        }
        if (ROUTER) {
            __syncthreads();
            if (F.tid < 16) {
                const int e = F.tid; int n = 0;
                for (int i = 0; i < 64; ++i) { if (sel[i * 4 + 0] == e) { sel[i * 4 + 2] = n; ++n; } if (sel[i * 4 + 1] == e) { sel[i * 4 + 3] = n; ++n; } }
                const int base = n ? (int)atomicAdd(cnt + e, (unsigned)n) : 0;
                for (int i = 0; i < 64; ++i) { if (sel[i * 4 + 0] == e) sel[i * 4 + 2] += base; if (sel[i * 4 + 1] == e) sel[i * 4 + 3] += base; }
            }
            __syncthreads();
            if (F.tid < 64) { Route r; r.e0 = sel[F.tid * 4 + 0]; r.e1 = sel[F.tid * 4 + 1]; r.r0 = sel[F.tid * 4 + 2]; r.r1 = sel[F.tid * 4 + 3]; r.w0 = selw[F.tid * 2 + 0]; r.w1 = selw[F.tid * 2 + 1]; r.s0 = 0; r.s1 = 0; route[blk * 64 + F.tid] = r; }
            __syncthreads();
        }
    }
}
__device__ __forceinline__ void moe_table(Frame& F, const unsigned* cnt, volatile LAS unsigned* tab) {
    if (F.tid == 0) { unsigned t = 0; for (int e = 0; e < 16; ++e) { tab[e] = t; t += (__hip_atomic_load(cnt + e, RLX_AGENT) + 255u) >> 8; } tab[16] = t; }
    __syncthreads();
}
__device__ __forceinline__ void moe_gather(Frame& F, const bf16* hb, bf16* xg, volatile LAS unsigned* tab) {
    Route* route = WSP(Route, WS_ROUTE);
    for (int m = F.gw; m < T; m += F.NGW) {
        Route r = route[m];
        const int s0 = (int)tab[r.e0] * 256 + r.r0, s1 = (int)tab[r.e1] * 256 + r.r1;
        if (F.lane == 0) { route[m].s0 = s0; route[m].s1 = s1; }
        const GAS u32x4* src = (const GAS u32x4*)(hb + (size_t)m * D) + F.lane;
        const u32x4 a = src[0], b = src[64];
        GAS u32x4* d0 = (GAS u32x4*)(xg + (size_t)s0 * D) + F.lane; GAS u32x4* d1 = (GAS u32x4*)(xg + (size_t)s1 * D) + F.lane;
        d0[0] = a; d0[64] = b; d1[0] = a; d1[64] = b;
    }
}

__device__ __forceinline__ void conv_pass(Frame& F, const Args& A, const bf16* prj, bf16* ub) {
    const float* cw = A.in[9];
    for (int it = F.gw; it < (T / 16) * 2; it += F.NGW) {
        const int tb = it >> 1, c0 = (it & 1) * 512 + F.lane * 8; const int t0 = tb * 16, pos0 = t0 % SEQ;
        float w[3][8];
#pragma unroll
        for (int j = 0; j < 3; ++j) { const f32x4 a = *(const GAS f32x4*)(cw + j * D + c0), b = *(const GAS f32x4*)(cw + j * D + c0 + 4);
#pragma unroll
            for (int e = 0; e < 4; ++e) { w[j][e] = a[e]; w[j][4 + e] = b[e]; } }
        float p2[8], p1[8];
#pragma unroll
        for (int e = 0; e < 8; ++e) { p2[e] = 0.f; p1[e] = 0.f; }
#pragma unroll
        for (int q = 0; q < 2; ++q) { if (pos0 - 2 + q >= 0) { const bf16* r = prj + (size_t)(t0 - 2 + q) * 3072;
                const u32x4 gc = *(const GAS u32x4*)(r + 1024 + c0), hd = *(const GAS u32x4*)(r + 2048 + c0);
#pragma unroll
                for (int e = 0; e < 4; ++e) { const float lo = bflo(gc[e]) * bflo(hd[e]), hi = bfhi(gc[e]) * bfhi(hd[e]); if (q == 0) { p2[2 * e] = lo; p2[2 * e + 1] = hi; } else { p1[2 * e] = lo; p1[2 * e + 1] = hi; } } } }
#pragma unroll 4
        for (int tt = 0; tt < 16; ++tt) { const bf16* r = prj + (size_t)(t0 + tt) * 3072;
            const u32x4 gb = *(const GAS u32x4*)(r + c0), gc = *(const GAS u32x4*)(r + 1024 + c0), hd = *(const GAS u32x4*)(r + 2048 + c0);
            float p0[8], o[8];
#pragma unroll
            for (int e = 0; e < 4; ++e) { p0[2 * e] = bflo(gc[e]) * bflo(hd[e]); p0[2 * e + 1] = bfhi(gc[e]) * bfhi(hd[e]); }
#pragma unroll
            for (int e = 0; e < 8; ++e) { const float cv = w[0][e] * p2[e] + w[1][e] * p1[e] + w[2][e] * p0[e]; const float g = (e & 1) ? bfhi(gb[e >> 1]) : bflo(gb[e >> 1]); o[e] = g * cv; p2[e] = p1[e]; p1[e] = p0[e]; }
            u32x4 wv; wv.x = pk2(o[0], o[1]); wv.y = pk2(o[2], o[3]); wv.z = pk2(o[4], o[5]); wv.w = pk2(o[6], o[7]);
            *(GAS u32x4*)(ub + (size_t)(t0 + tt) * D + c0) = wv; }
    }
}

constexpr int D1_KF = 0, D1_VF = 32768, D1_UW = 0, D1_QB = 65536, D1_KB = D1_QB + 17408, D1_AM = D1_KB + 17408, D1_AT = D1_AM + 16384, D1_KT = D1_AT + 9216, D1_GC = D1_KT + 18432;
constexpr int RSB = 272, RSS = 144;
static_assert(D1_GC + 3 * 256 <= MISC_OFF, "D1 LDS");
__device__ __forceinline__ f32x4 tile_k64(const LAS unsigned char* xr, const LAS unsigned char* yr) {
    f32x4 acc = {0.f, 0.f, 0.f, 0.f};
#pragma unroll
    for (int s = 0; s < 2; ++s) acc = __builtin_amdgcn_mfma_f32_16x16x32_bf16(*(const LAS bf16x8*)(xr + 64 * s), *(const LAS bf16x8*)(yr + 64 * s), acc, 0, 0, 0);
    return acc;
}
__device__ __forceinline__ void d1_unit(Frame& F, const Args& A, int unit) {
    const int bh = unit >> 6, n = unit & 63, b = bh >> 2, h = bh & 3;
    const int t0 = b * SEQ + n * 64;
    const int lane = F.lane, wave = F.wave, g = lane >> 4, c = lane & 15;
    LAS unsigned char* L = F.lds;
    LAS float* KF = opq_v((LAS float*)(L + D1_KF)); LAS float* VF = opq_v((LAS float*)(L + D1_VF)); LAS float* AM = opq_v((LAS float*)(L + D1_AM));
    LAS float* gcs = opq_v((LAS float*)(L + D1_GC)); LAS float* betas = gcs + 64; LAS float* bexp = gcs + 128;
    LAS unsigned char* LQB = opq_v(L + D1_QB); LAS unsigned char* LKB = opq_v(L + D1_KB); LAS unsigned char* LAT = opq_v(L + D1_AT); LAS unsigned char* LKT = opq_v(L + D1_KT); LAS unsigned char* LUW = opq_v(L + D1_UW);
    float gc = WSP(float, WS_GG)[(size_t)(t0 + lane) * 4 + h];
#pragma unroll
    for (int o = 1; o < 64; o <<= 1) { const float t = __shfl_up(gc, o); if (lane >= o) gc += t; }
    const float bt = WSP(float, WS_BETA)[(size_t)(t0 + lane) * 4 + h];
    const float gc63 = __shfl(gc, 63);
    if (wave == 0) { gcs[lane] = gc; betas[lane] = bt; bexp[lane] = bt * __expf(gc); }
    {
        const bf16* pre = WSP(bf16, WS_QKVPRE);
        const float* cwp = A.in[3];
        float ov[3][8][2];
#pragma unroll
        for (int x = 0; x < 3; ++x) {
            const int ch = x * 512 + h * 128 + 2 * lane;
            float cw[4][2];
#pragma unroll
            for (int j = 0; j < 4; ++j) { const f32x2 w2 = *(const GAS f32x2*)(cwp + j * 1536 + ch); cw[j][0] = w2[0]; cw[j][1] = w2[1]; }
            float win[11][2];
#pragma unroll
            for (int r = 0; r < 11; ++r) { const int pos = n * 64 + wave * 8 + r - 3; unsigned dw = 0u;
                if (pos >= 0) dw = *(const GAS unsigned*)(pre + (size_t)(t0 + wave * 8 + r - 3) * 1536 + ch);
                win[r][0] = bflo(dw); win[r][1] = bfhi(dw); }
#pragma unroll
            for (int tt = 0; tt < 8; ++tt)
#pragma unroll
                for (int e = 0; e < 2; ++e) { const float s = cw[0][e] * win[tt][e] + cw[1][e] * win[tt + 1][e] + cw[2][e] * win[tt + 2][e] + cw[3][e] * win[tt + 3][e]; ov[x][tt][e] = silu_f(s); }
        }
#pragma unroll
        for (int tt = 0; tt < 8; ++tt) {
            const int i = wave * 8 + tt;
            const float sq = wave_sum(ov[0][tt][0] * ov[0][tt][0] + ov[0][tt][1] * ov[0][tt][1]);
            const float sk = wave_sum(ov[1][tt][0] * ov[1][tt][0] + ov[1][tt][1] * ov[1][tt][1]);
            const float rq = rsqrtf(sq + RMS_EPS) * 0.08838834764831845f, rk = rsqrtf(sk + RMS_EPS);
            const float q0 = ov[0][tt][0] * rq, q1 = ov[0][tt][1] * rq, k0 = ov[1][tt][0] * rk, k1 = ov[1][tt][1] * rk;
            const float gci = __shfl(gc, i);
            const float kt = __expf(gc63 - gci);
            *(LAS f32x2*)(KF + i * 128 + 2 * lane) = (f32x2){k0, k1};
            *(LAS f32x2*)(VF + i * 128 + 2 * lane) = (f32x2){ov[2][tt][0], ov[2][tt][1]};
            *(LAS unsigned*)(LQB + i * RSB + 4 * lane) = pk2(q0, q1);
            *(LAS unsigned*)(LKB + i * RSB + 4 * lane) = pk2(k0, k1);
            *(LAS unsigned short*)(LKT + (2 * lane) * RSS + 2 * i) = (unsigned short)f2bf(k0 * kt);
            *(LAS unsigned short*)(LKT + (2 * lane + 1) * RSS + 2 * i) = (unsigned short)f2bf(k1 * kt);
        }
    }
    __syncthreads();
#pragma unroll 1
    for (int it = 0; it < 4; ++it) {
        const int id = wave + 8 * it, isq = id >> 4, mi = (id & 15) >> 2, nj = id & 3;
        f32x4 acc = {0.f, 0.f, 0.f, 0.f};
        if (mi >= nj) {
            const LAS unsigned char* xr = (isq ? LQB : LKB) + (16 * mi + c) * RSB + 16 * g;
            const LAS unsigned char* yr = LKB + (16 * nj + c) * RSB + 16 * g;
#pragma unroll
            for (int s = 0; s < 4; ++s) acc = __builtin_amdgcn_mfma_f32_16x16x32_bf16(*(const LAS bf16x8*)(xr + 64 * s), *(const LAS bf16x8*)(yr + 64 * s), acc, 0, 0, 0);
        }
        const int j = 16 * nj + c; const float gj = gcs[j];
#pragma unroll
        for (int r = 0; r < 4; ++r) { const int i = 16 * mi + 4 * g + r; const float dec = (i >= j) ? __expf(gcs[i] - gj) : 0.f;
            if (!isq) AM[i * 64 + j] = (i > j) ? betas[i] * acc[r] * dec : 0.f;
            else *(LAS unsigned short*)(LAT + i * RSS + 2 * j) = (unsigned short)f2bf((i >= j) ? acc[r] * dec : 0.f); }
    }
    __syncthreads();
    float u[64];
    if (F.tid < 256) {
        const int col = F.tid;
        const LAS float* cp = (col < 128) ? VF + col : KF + (col - 128);
        const LAS float* sp = (col < 128) ? betas : bexp;
#pragma unroll
        for (int i = 0; i < 64; ++i) u[i] = 0.f;
#pragma unroll
        for (int i = 0; i < 64; ++i) {
            float acc = sp[i] * cp[i * 128];
#pragma unroll
            for (int j4 = 0; j4 < (i + 3) / 4; ++j4) { const f32x4 a = *(const LAS f32x4*)(AM + i * 64 + 4 * j4);
                acc -= a[0] * u[4 * j4]; acc -= a[1] * u[4 * j4 + 1]; acc -= a[2] * u[4 * j4 + 2]; acc -= a[3] * u[4 * j4 + 3]; }
            u[i] = acc;
        }
    }
    __syncthreads();
    if (F.tid < 256) {
        LAS unsigned char* row = LUW + F.tid * RSS;
#pragma unroll
        for (int q = 0; q < 8; ++q) { u32x4 w; w.x = pk2(u[8 * q], u[8 * q + 1]); w.y = pk2(u[8 * q + 2], u[8 * q + 3]); w.z = pk2(u[8 * q + 4], u[8 * q + 5]); w.w = pk2(u[8 * q + 6], u[8 * q + 7]); *(LAS u32x4*)(row + 16 * q) = w; }
    }
    __syncthreads();
    const LAS unsigned char* UWr = LUW; const LAS unsigned char* ATr = LAT; const LAS unsigned char* KTr = LKT;
    const size_t cbase = (size_t)unit;
    for (int t = wave; t < 32; t += 8) { const int xi = t >> 3, yj = t & 7;
        const f32x4 d = tile_k64(ATr + (16 * xi + c) * RSS + 16 * g, UWr + (16 * yj + c) * RSS + 16 * g);
        u32x2 w; w.x = pk2(d[0], d[1]); w.y = pk2(d[2], d[3]);
        *(GAS u32x2*)(WSP(bf16, WS_OLOCT) + cbase * 8192 + (size_t)(16 * yj + c) * 64 + 16 * xi + 4 * g) = w; }
    for (int t = wave; t < 32; t += 8) { const int xi = t >> 2, yj = t & 3;
        const f32x4 d = tile_k64(UWr + (128 + 16 * xi + c) * RSS + 16 * g, ATr + (16 * yj + c) * RSS + 16 * g);
        const int i = 16 * yj + c, dd = 16 * xi + 4 * g; const float eg = __expf(gcs[i]);
        const u32x2 qv = *(const LAS u32x2*)(LQB + i * RSB + 2 * dd);
        u32x2 w; w.x = pk2(bflo(qv.x) * eg - d[0], bfhi(qv.x) * eg - d[1]); w.y = pk2(bflo(qv.y) * eg - d[2], bfhi(qv.y) * eg - d[3]);
        *(GAS u32x2*)(WSP(bf16, WS_QEFF) + cbase * 8192 + (size_t)i * 128 + dd) = w; }
    for (int t = wave; t < 64; t += 8) { const int xi = t >> 3, yj = t & 7;
        const f32x4 d = tile_k64(KTr + (16 * xi + c) * RSS + 16 * g, UWr + (16 * yj + c) * RSS + 16 * g);
        u32x2 w; w.x = pk2(d[0], d[1]); w.y = pk2(d[2], d[3]);
        *(GAS u32x2*)(WSP(bf16, WS_BMT) + cbase * 16384 + (size_t)(16 * yj + c) * 128 + 16 * xi + 4 * g) = w; }
    for (int t = wave; t < 64; t += 8) { const int xi = t >> 3, yj = t & 7;
        const f32x4 d = tile_k64(UWr + (128 + 16 * xi + c) * RSS + 16 * g, KTr + (16 * yj + c) * RSS + 16 * g);
        u32x2 w; w.x = pk2(-d[0], -d[1]); w.y = pk2(-d[2], -d[3]);
        *(GAS u32x2*)(WSP(bf16, WS_MNEG) + cbase * 16384 + (size_t)(16 * yj + c) * 128 + 16 * xi + 4 * g) = w; }
    if (F.tid == 0) WSP(float, WS_GLAST)[unit] = __expf(gc63);
    __syncthreads();
}

constexpr int SCAN_PF = 4;
__device__ __forceinline__ void scan_wg(Frame& F, int sw) {
    const int bh = sw >> 3, slice = sw & 7, b = bh >> 2, h = bh & 3;
    const int lane = F.lane, wave = F.wave, g = lane >> 4, c = lane & 15;
    LAS unsigned char* ST = opq_v(F.lds);
    for (int i = F.tid; i < 2 * 4352 / 4; i += 512) ((LAS unsigned*)ST)[i] = 0u;
    __syncthreads();
    const bf16* MN = WSP(bf16, WS_MNEG) + (size_t)bh * 64 * 16384; const bf16* BM = WSP(bf16, WS_BMT) + (size_t)bh * 64 * 16384;
    const bf16* QE = WSP(bf16, WS_QEFF) + (size_t)bh * 64 * 8192; const bf16* OL = WSP(bf16, WS_OLOCT) + (size_t)bh * 64 * 8192;
    const float* GL = WSP(float, WS_GLAST) + bh * 64;
    if (wave < 4) {
        f32x4 Sreg[2] = {{0.f, 0.f, 0.f, 0.f}, {0.f, 0.f, 0.f, 0.f}};
        bf16x8 Af[SCAN_PF][2][4]; u32x2 bm[SCAN_PF][2]; float gl[SCAN_PF];
#define SCAN_LOAD_REC(j, n) do { const size_t cb_ = (size_t)(n) * 16384; \
        _Pragma("unroll") for (int mt = 0; mt < 2; ++mt) { _Pragma("unroll") for (int s = 0; s < 4; ++s) Af[j][mt][s] = *(const GAS bf16x8*)(MN + cb_ + (size_t)(32 * wave + 16 * mt + c) * 128 + 32 * s + 8 * g); \
            bm[j][mt] = *(const GAS u32x2*)(BM + cb_ + (size_t)(16 * slice + c) * 128 + 32 * wave + 16 * mt + 4 * g); } gl[j] = GL[n]; } while (0)
#pragma unroll
        for (int j = 0; j < SCAN_PF; ++j) SCAN_LOAD_REC(j, j);
#pragma unroll 1
        for (int n0 = 0; n0 < 64; n0 += SCAN_PF) {
#pragma unroll
            for (int j = 0; j < SCAN_PF; ++j) {
                const int n = n0 + j; const int cur = n & 1;
                bf16x8 Sb[4];
#pragma unroll
                for (int s = 0; s < 4; ++s) Sb[s] = *(const LAS bf16x8*)(ST + cur * 4352 + c * 272 + 64 * s + 16 * g);
#pragma unroll
                for (int mt = 0; mt < 2; ++mt) {
                    f32x4 acc; acc[0] = gl[j] * Sreg[mt][0] + bflo(bm[j][mt].x); acc[1] = gl[j] * Sreg[mt][1] + bfhi(bm[j][mt].x); acc[2] = gl[j] * Sreg[mt][2] + bflo(bm[j][mt].y); acc[3] = gl[j] * Sreg[mt][3] + bfhi(bm[j][mt].y);
#pragma unroll
                    for (int s = 0; s < 4; ++s) acc = __builtin_amdgcn_mfma_f32_16x16x32_bf16(Af[j][mt][s], Sb[s], acc, 0, 0, 0);
                    Sreg[mt] = acc;
                    u32x2 w; w.x = pk2(acc[0], acc[1]); w.y = pk2(acc[2], acc[3]);
                    *(LAS u32x2*)(ST + (cur ^ 1) * 4352 + c * 272 + 2 * (32 * wave + 16 * mt + 4 * g)) = w;
                }
                if (n + SCAN_PF < 64) SCAN_LOAD_REC(j, n + SCAN_PF);
                __syncthreads();
            }
        }
#undef SCAN_LOAD_REC
    } else {
        const int m = wave - 4;
        bf16x8 Qf[SCAN_PF][4]; u32x2 ol[SCAN_PF];
        bf16* OU = WSP(bf16, WS_OUN) + (size_t)(b * SEQ) * 512 + h * 128 + 16 * slice + c;
#define SCAN_LOAD_OUT(j, n) do { const size_t cb_ = (size_t)(n) * 8192; \
        _Pragma("unroll") for (int s = 0; s < 4; ++s) Qf[j][s] = *(const GAS bf16x8*)(QE + cb_ + (size_t)(16 * m + c) * 128 + 32 * s + 8 * g); \
        ol[j] = *(const GAS u32x2*)(OL + cb_ + (size_t)(16 * slice + c) * 64 + 16 * m + 4 * g); } while (0)
#pragma unroll
        for (int j = 0; j < SCAN_PF; ++j) SCAN_LOAD_OUT(j, j);
#pragma unroll 1
        for (int n0 = 0; n0 < 64; n0 += SCAN_PF) {
#pragma unroll
            for (int j = 0; j < SCAN_PF; ++j) {
                const int n = n0 + j; const int cur = n & 1;
                bf16x8 Sb[4];
#pragma unroll
                for (int s = 0; s < 4; ++s) Sb[s] = *(const LAS bf16x8*)(ST + cur * 4352 + c * 272 + 64 * s + 16 * g);
                f32x4 acc; acc[0] = bflo(ol[j].x); acc[1] = bfhi(ol[j].x); acc[2] = bflo(ol[j].y); acc[3] = bfhi(ol[j].y);
#pragma unroll
                for (int s = 0; s < 4; ++s) acc = __builtin_amdgcn_mfma_f32_16x16x32_bf16(Qf[j][s], Sb[s], acc, 0, 0, 0);
#pragma unroll
                for (int r = 0; r < 4; ++r) OU[(size_t)(n * 64 + 16 * m + 4 * g + r) * 512] = (bf16)f2bf(acc[r]);
                if (n + SCAN_PF < 64) SCAN_LOAD_OUT(j, n + SCAN_PF);
                __syncthreads();
            }
        }
#undef SCAN_LOAD_OUT
    }
}

constexpr int AT_KS = 0, AT_VS = 36864;
__device__ __forceinline__ s16x4 vtr(const LAS unsigned char* p) { typedef short v4i16_t __attribute__((ext_vector_type(4))); return __builtin_bit_cast(s16x4, __builtin_amdgcn_ds_read_tr16_b64_v4i16((LAS v4i16_t*)p)); }
__device__ __forceinline__ void attn_unit(Frame& F, int a) {
    const int bhh = a / 96, rem = a % 96, br = rem >> 5, idx = rem & 31, b = bhh >> 3, hh = bhh & 7;
    const int dil = br == 0 ? 1 : br == 1 ? 4 : 16, nblk = 32 / dil, res = idx / nblk, n = idx % nblk;
    const int lane = F.lane, wave = F.wave, g = lane >> 4, c = lane & 15;
    LAS unsigned char* L = opq_v(F.lds);
    const bf16* QKVD = WSP(bf16, WS_QKVD);
    {
        const int j = F.tid >> 1, half = F.tid & 1; const int kidx = 128 * (n - 1) + j;
        u32x4 kv[4], vv[4];
        if (kidx >= 0) { const bf16* src = QKVD + (size_t)(b * SEQ + kidx * dil + res) * 1536 + hh * 64 + half * 32;
#pragma unroll
            for (int q = 0; q < 4; ++q) { kv[q] = *(const GAS u32x4*)(src + 512 + 8 * q); vv[q] = *(const GAS u32x4*)(src + 1024 + 8 * q); } }
        else {
#pragma unroll
            for (int q = 0; q < 4; ++q) { kv[q] = (u32x4){0u, 0u, 0u, 0u}; vv[q] = (u32x4){0u, 0u, 0u, 0u}; } }
#pragma unroll
        for (int q = 0; q < 4; ++q) { *(LAS u32x4*)(L + AT_KS + j * RSS + half * 64 + 16 * q) = kv[q]; *(LAS u32x4*)(L + AT_VS + j * RSS + half * 64 + 16 * q) = vv[q]; }
    }
    const int qi = 16 * wave + c;
    const size_t qtok = (size_t)(b * SEQ + (128 * n + qi) * dil + res);
    bf16x8 Bq[2];
#pragma unroll
    for (int s = 0; s < 2; ++s) Bq[s] = *(const GAS bf16x8*)(QKVD + qtok * 1536 + hh * 64 + 32 * s + 8 * g);
    __syncthreads();
    f32x4 sc[9];
    float mx = -1.0e30f;
#pragma unroll
    for (int t = 0; t < 9; ++t) {
        const LAS unsigned char* kr = L + AT_KS + (16 * (wave + t) + c) * RSS + 16 * g;
        f32x4 acc = {0.f, 0.f, 0.f, 0.f};
        acc = __builtin_amdgcn_mfma_f32_16x16x32_bf16(*(const LAS bf16x8*)kr, Bq[0], acc, 0, 0, 0);
        acc = __builtin_amdgcn_mfma_f32_16x16x32_bf16(*(const LAS bf16x8*)(kr + 64), Bq[1], acc, 0, 0, 0);
#pragma unroll
        for (int r = 0; r < 4; ++r) { const int j = 16 * (wave + t) + 4 * g + r; const bool ok = (j >= qi) && (j <= qi + 128) && (n > 0 || j >= 128);
            acc[r] = ok ? acc[r] * (0.125f * 1.4426950408889634f) : -1.0e30f; mx = fmaxf(mx, acc[r]); }
        sc[t] = acc;
    }
    mx = fmaxf(mx, __shfl_xor(mx, 16)); mx = fmaxf(mx, __shfl_xor(mx, 32));
    float lsum = 0.f;
#pragma unroll
    for (int t = 0; t < 9; ++t)
#pragma unroll
        for (int r = 0; r < 4; ++r) { const float p = __builtin_amdgcn_exp2f(sc[t][r] - mx); sc[t][r] = p; lsum += p; }
    lsum += __shfl_xor(lsum, 16); lsum += __shfl_xor(lsum, 32);
    bf16x8 pf[5];
#pragma unroll
    for (int u = 0; u < 5; ++u) { u32x4 w; w.x = pk2(sc[2 * u][0], sc[2 * u][1]); w.y = pk2(sc[2 * u][2], sc[2 * u][3]);
        if (u < 4) { w.z = pk2(sc[2 * u + 1][0], sc[2 * u + 1][1]); w.w = pk2(sc[2 * u + 1][2], sc[2 * u + 1][3]); } else { w.z = 0u; w.w = 0u; }
        pf[u] = __builtin_bit_cast(bf16x8, w); }
    float linv[4];
#pragma unroll
    for (int r = 0; r < 4; ++r) linv[r] = 1.f / __shfl(lsum, 4 * g + r);
    bf16* OP = WSP(bf16, WS_OPART) + (size_t)br * T * 512;
#pragma unroll
    for (int dt = 0; dt < 4; ++dt) {
        f32x4 acc = {0.f, 0.f, 0.f, 0.f};
#pragma unroll
        for (int u = 0; u < 5; ++u) { const int kb = 16 * (wave + 2 * u);
            const LAS unsigned char* vp = L + AT_VS + (kb + 4 * g + (c >> 2)) * RSS + (16 * dt + 4 * (c & 3)) * 2;
            const s16x4 lo = vtr(vp); s16x4 hi = {0, 0, 0, 0}; if (u < 4) hi = vtr(vp + 16 * RSS);
            const bf16x8 bv = {lo[0], lo[1], lo[2], lo[3], hi[0], hi[1], hi[2], hi[3]};
            acc = __builtin_amdgcn_mfma_f32_16x16x32_bf16(pf[u], bv, acc, 0, 0, 0); }
#pragma unroll
        for (int r = 0; r < 4; ++r) { const size_t tok = (size_t)(b * SEQ + (128 * n + 16 * wave + 4 * g + r) * dil + res);
            OP[tok * 512 + hh * 64 + 16 * dt + c] = (bf16)f2bf(acc[r] * linv[r]); }
    }
    if (g == 0) WSP(float, WS_LSE)[((size_t)br * T + qtok) * 8 + hh] = (mx + __log2f(lsum)) * 0.6931471805599453f;
    __syncthreads();
}

__device__ __forceinline__ void mix_pass(Frame& F, const Args& A) {
    const int lane = F.lane;
    float nw[8];
    { const f32x4 a = *(const GAS f32x4*)(A.in[6] + 8 * (lane & 15)), b = *(const GAS f32x4*)(A.in[6] + 8 * (lane & 15) + 4);
#pragma unroll
      for (int e = 0; e < 4; ++e) { nw[e] = a[e]; nw[4 + e] = b[e]; } }
    const bf16* OU = WSP(bf16, WS_OUN); const bf16* ZB = WSP(bf16, WS_ZB); const bf16* OP = WSP(bf16, WS_OPART); const float* LSE = WSP(float, WS_LSE); bf16* MIX = WSP(bf16, WS_MIX);
    for (int t = F.gw; t < T; t += F.NGW) {
        const u32x4 uo = *(const GAS u32x4*)(OU + (size_t)t * 512 + 8 * lane), uz = *(const GAS u32x4*)(ZB + (size_t)t * 512 + 8 * lane);
        float x[8], z[8];
#pragma unroll
        for (int e = 0; e < 4; ++e) { x[2 * e] = bflo(uo[e]); x[2 * e + 1] = bfhi(uo[e]); z[2 * e] = bflo(uz[e]); z[2 * e + 1] = bfhi(uz[e]); }
        float ss = 0.f;
#pragma unroll
        for (int e = 0; e < 8; ++e) ss += x[e] * x[e];
        ss += __shfl_xor(ss, 1); ss += __shfl_xor(ss, 2); ss += __shfl_xor(ss, 4); ss += __shfl_xor(ss, 8);
        const float rstd = rsqrtf(ss * (1.f / 128.f) + RMS_EPS);
        float o[8];
#pragma unroll
        for (int e = 0; e < 8; ++e) o[e] = x[e] * rstd * nw[e] * silu_f(z[e]);
        u32x4 w; w.x = pk2(o[0], o[1]); w.y = pk2(o[2], o[3]); w.z = pk2(o[4], o[5]); w.w = pk2(o[6], o[7]);
        *(GAS u32x4*)(MIX + (size_t)t * D + 8 * lane) = w;
        const int hh = lane >> 3;
        const float l0 = LSE[((size_t)0 * T + t) * 8 + hh], l1 = LSE[((size_t)1 * T + t) * 8 + hh], l2 = LSE[((size_t)2 * T + t) * 8 + hh];
        const float lm = fmaxf(l0, fmaxf(l1, l2)); const float e0 = __expf(l0 - lm), e1 = __expf(l1 - lm), e2 = __expf(l2 - lm); const float inv = 1.f / (e0 + e1 + e2);
        const u32x4 p0 = *(const GAS u32x4*)(OP + ((size_t)0 * T + t) * 512 + 8 * lane), p1 = *(const GAS u32x4*)(OP + ((size_t)1 * T + t) * 512 + 8 * lane), p2 = *(const GAS u32x4*)(OP + ((size_t)2 * T + t) * 512 + 8 * lane);
        const float w0 = e0 * inv, w1 = e1 * inv, w2 = e2 * inv;
        u32x4 wo;
#pragma unroll
        for (int e = 0; e < 4; ++e) wo[e] = pk2(w0 * bflo(p0[e]) + w1 * bflo(p1[e]) + w2 * bflo(p2[e]), w0 * bfhi(p0[e]) + w1 * bfhi(p1[e]) + w2 * bfhi(p2[e]));
        *(GAS u32x4*)(MIX + (size_t)t * D + 512 + 8 * lane) = wo;
    }
}

constexpr int N_PHASES = 29;
__global__ void __launch_bounds__(512, 2) fwd_kernel(Args args) {
    extern __shared__ __attribute__((aligned(16))) unsigned char lds_raw[];
    Frame F;
    F.lds = (LAS unsigned char*)lds_raw; F.ws = args.ws; F.ctl = (gu32*)(args.ws + WS_CTL);
    F.tid = threadIdx.x; F.lane = F.tid & 63; F.wave = __builtin_amdgcn_readfirstlane(F.tid >> 6);
    F.G = gridDim.x; F.gw = blockIdx.x * 8 + F.wave; F.NGW = F.G * 8;
    volatile LAS unsigned* MISC = (volatile LAS unsigned*)(F.lds + MISC_OFF); const char* wsb = (const char*)args.ws;
    for (int u = F.tid; u < 256; u += 512) MISC[u] = 0u;
    __syncthreads();
    const int lo = args.ph_lo, hi = args.ph_hi;
    XcdBarrier bar; bar.bar = (unsigned*)(F.ctl + CW_BAR); bar.x = 0; bar.st = MISC + 8;
    if (hi - lo > 1) bar = xcd_barrier_post((unsigned*)(F.ctl + CW_BAR), MISC + 8);
    LAS unsigned char* ring = F.lds; LAS unsigned char* xch = F.lds + XCH_OFF;
    volatile LAS unsigned* tab = MISC + 32;
    const int c = blockIdx.x, G = F.G;
#ifndef PHASE_MASK
#define PHASE_MASK 0xFFFFFFFFu
#endif
#define IN(k) ((((PHASE_MASK) >> (k)) & 1u) && lo <= (k) && (k) < hi)
#define SEAM(k) do { if (IN(k) && IN((k) + 1)) xcd_barrier(bar); } while (0)
#define PH_BEGIN() do { const int t_ = opq_v((int)threadIdx.x); F.tid = t_; F.lane = t_ & 63; F.wave = __builtin_amdgcn_readfirstlane(t_ >> 6); F.gw = blockIdx.x * 8 + F.wave; \
        unsigned char* w_ = opq_s(args.ws); F.ws = w_; F.ctl = (gu32*)(w_ + WS_CTL); xch = opq_v(F.lds + XCH_OFF); MISC = (volatile LAS unsigned*)opq_v(F.lds + MISC_OFF); tab = MISC + 32; bar.st = MISC + 8; wsb = (const char*)w_; } while (0)
#define HBc (wsb + WS_HB)

    if (IN(0)) { PH_BEGIN(); p0_prologue(F, args); SEAM(0); }
    if (IN(1)) { PH_BEGIN();
        SchedP1 S{HBc, (const char*)(wsb + WS_W_IN), (const char*)(wsb + WS_MEMB), (const char*)(wsb + WS_W_KV), G, c};
        EpiP1 E{WSP(bf16, WS_QKVPRE), WSP(bf16, WS_ZB), WSP(bf16, WS_QKVD), WSP(bf16, WS_KMEM), WSP(bf16, WS_VT)};
        pg8::gemm_phase(ring, xch, pg8::Gemm{D, D, D}, S, E); SEAM(1);
    }
    if (IN(2)) { PH_BEGIN(); for (int u = c; u < NB * DNH * NCHUNK; u += G) d1_unit(F, args, u); SEAM(2); }
    if (IN(3)) { PH_BEGIN();
        if (c < 128) scan_wg(F, c);
        for (;;) {
            if (F.tid == 0) MISC[20] = __hip_atomic_fetch_add((unsigned*)(F.ctl + CW_QUEUE), 1u, RLX_AGENT);
            __syncthreads(); const int a = (int)MISC[20]; __syncthreads();
            if (a >= NB * DAH * 96) break;
            attn_unit(F, a);
        }
        SEAM(3);
    }
    if (IN(4)) { PH_BEGIN(); mix_pass(F, args); SEAM(4); }

#pragma unroll
    for (int layer = 0; layer < 2; ++layer) {
        const int pb = layer * 13;
        if (layer == 0) {
            if (IN(5)) { PH_BEGIN(); convert_moe(F, args, 0); __syncthreads();
                SchedDense S{(const char*)(wsb + WS_MIX), (const char*)(wsb + WS_W_ABO), D, D, 64, 4, G, c}; EpiDense E{WSP(bf16, 288 * MiB), D, 1.f};
                pg8::gemm_phase(ring, xch, pg8::Gemm{D, D, D}, S, E); SEAM(5); }
            if (IN(6)) { PH_BEGIN(); ln_pass<0, false, false>(F, args, args.in[0], WSP(bf16, 288 * MiB), 0, WSP(float, WS_H), WSP(bf16, WS_HB), nullptr); SEAM(6); }
        } else {
            if (IN(16)) { PH_BEGIN(); convert_moe(F, args, 1); __syncthreads();
                SchedDense S{HBc, (const char*)(wsb + WS_W_SCI), D, D, 64, 12, G, c}; EpiDense E{WSP(bf16, 192 * MiB), 3 * D, 1.f};
                pg8::gemm_phase(ring, xch, pg8::Gemm{D, D, D}, S, E); SEAM(16); }
            if (IN(17)) { PH_BEGIN(); conv_pass(F, args, WSP(bf16, 192 * MiB), WSP(bf16, 288 * MiB)); SEAM(17); }
            if (IN(18)) { PH_BEGIN(); SchedDense S{(const char*)(wsb + 288 * MiB), (const char*)(wsb + WS_W_SCO), D, D, 64, 4, G, c}; EpiDense E{WSP(bf16, 192 * MiB), D, 1.f};
                pg8::gemm_phase(ring, xch, pg8::Gemm{D, D, D}, S, E); SEAM(18); }
            if (IN(19)) { PH_BEGIN(); ln_pass<0, false, false>(F, args, WSP(float, WS_H), WSP(bf16, 192 * MiB), 3, WSP(float, WS_H), WSP(bf16, WS_HB), nullptr); SEAM(19); }
        }
        const size_t oQ = (layer == 0 ? 192 : 224) * MiB, oP = (layer == 0 ? 224 : 256) * MiB, oO = (layer == 0 ? 256 : 288) * MiB, oY = (layer == 0 ? 288 : 192) * MiB;
        const int p7 = layer == 0 ? 7 : 20;
        if (IN(p7)) { PH_BEGIN(); SchedDense S{HBc, (const char*)(wsb + WS_W_Q + (size_t)layer * D * D * 2), D, D, 64, 4, G, c}; EpiDense E{WSP(bf16, oQ), D, 0.0625f * 1.4426950408889634f};
            pg8::gemm_phase(ring, xch, pg8::Gemm{D, D, D}, S, E); SEAM(p7); }
        if (IN(p7 + 1)) { PH_BEGIN(); SchedXS S{(const char*)(wsb + oQ), (const char*)(wsb + WS_KMEM + (size_t)layer * TM * D * 2), G, c}; EpiSoftmax E{WSP(bf16, oP)};
            pg8::gemm_phase(ring, xch, pg8::Gemm{D, D, XD}, S, E); SEAM(p7 + 1); }
        if (IN(p7 + 2)) { PH_BEGIN(); SchedXP S{(const char*)(wsb + oP), (const char*)(wsb + WS_VT + (size_t)layer * NB * XH * XD * NMEM * 2), G, c};
            EpiDense E{WSP(bf16, oO), D, 1.f};
            pg8::gemm_phase(ring, xch, pg8::Gemm{D, NMEM, NMEM}, S, E); SEAM(p7 + 2); }
        if (IN(p7 + 3)) { PH_BEGIN(); SchedDense S{(const char*)(wsb + oO), (const char*)(wsb + WS_W_O + (size_t)layer * D * D * 2), D, D, 64, 4, G, c}; EpiDense E{WSP(bf16, oY), D, 1.f};
            pg8::gemm_phase(ring, xch, pg8::Gemm{D, D, D}, S, E); SEAM(p7 + 3); }
        unsigned* cnt = (unsigned*)(F.ctl + (layer == 0 ? CW_CNT0 : CW_CNT1));
        if (IN(p7 + 4)) { PH_BEGIN(); ln_pass<0, true, false>(F, args, WSP(float, WS_H), WSP(bf16, oY), layer * 3 + 1, WSP(float, WS_H), WSP(bf16, WS_HB), cnt); SEAM(p7 + 4); }
        if (IN(p7 + 5)) { PH_BEGIN(); moe_table(F, cnt, tab); moe_gather(F, WSP(bf16, WS_HB), WSP(bf16, WS_XG), tab); SEAM(p7 + 5); }
        if (IN(p7 + 6)) { PH_BEGIN(); moe_table(F, cnt, tab);
            SchedMoE S{(const char*)(wsb + WS_XG), (const char*)(wsb + WS_MOEW_GU), tab, D, D, D, G, c}; EpiSwiglu E{WSP(bf16, WS_HACT)};
            pg8::gemm_phase(ring, xch, pg8::Gemm{D, D, D}, S, E); SEAM(p7 + 6); }
        if (IN(p7 + 7)) { PH_BEGIN(); moe_table(F, cnt, tab);
            SchedMoE S{(const char*)(wsb + WS_HACT), (const char*)(wsb + WS_MOEW_D), tab, DE, D, DE, G, c}; EpiDense E{WSP(bf16, WS_XG), D, 1.f};
            pg8::gemm_phase(ring, xch, pg8::Gemm{DE, DE, DE}, S, E); SEAM(p7 + 7); }
        if (IN(p7 + 8)) { PH_BEGIN();
            if (layer == 0) { ln_pass<1, false, false>(F, args, WSP(float, WS_H), WSP(bf16, WS_XG), 2, WSP(float, WS_H), WSP(bf16, WS_HB), nullptr); SEAM(p7 + 8); }
            else ln_pass<1, false, true>(F, args, WSP(float, WS_H), WSP(bf16, WS_XG), 5, args.out, nullptr, nullptr);
        }
        (void)pb;
    }
#undef IN
#undef SEAM
}

extern "C" void kernel_launch(void* const* d_in, const int* in_sizes, int n_in, void* d_out, int out_size, void* d_ws, size_t ws_size, hipStream_t stream) {
    static int grid = 0;
    if (grid == 0) {
        if (n_in != 21 || out_size != T * D || ws_size < WS_END) { fprintf(stderr, "kernel_launch: unexpected problem (n_in %d, out %d, ws %zu < %zu)\n", n_in, out_size, ws_size, (size_t)WS_END); grid = -1; return; }
        int dev = 0, cus = 0, per_cu = 0;
        if (hipGetDevice(&dev) != hipSuccess || hipDeviceGetAttribute(&cus, hipDeviceAttributeMultiprocessorCount, dev) != hipSuccess) { grid = -1; return; }
        if (hipFuncSetAttribute((const void*)fwd_kernel, hipFuncAttributeMaxDynamicSharedMemorySize, LDS_BYTES) != hipSuccess) { fprintf(stderr, "kernel_launch: hipFuncSetAttribute failed\n"); grid = -1; return; }
        if (hipOccupancyMaxActiveBlocksPerMultiprocessor(&per_cu, (const void*)fwd_kernel, 512, LDS_BYTES) != hipSuccess || per_cu < 1) { fprintf(stderr, "kernel_launch: occupancy query says %d blocks per CU\n", per_cu); (void)hipGetLastError(); per_cu = 1; }
        grid = cus;
    }
    if (grid < 0) return;
    (void)hipMemsetAsync((char*)d_ws + WS_CTL, 0, CTL_ZERO_BYTES, stream);
    Args a{};
    for (int i = 0; i < 21; ++i) a.in[i] = (const float*)d_in[i];
    a.out = (float*)d_out; a.ws = (unsigned char*)d_ws;
#if MK_ONE_LAUNCH
    a.ph_lo = 0; a.ph_hi = N_PHASES;
    hipLaunchKernelGGL(fwd_kernel, dim3(grid), dim3(512), LDS_BYTES, stream, a);
#else
    for (int p = 0; p < N_PHASES; ++p) { a.ph_lo = p; a.ph_hi = p + 1; hipLaunchKernelGGL(fwd_kernel, dim3(grid), dim3(512), LDS_BYTES, stream, a); }
#endif
}
```

```cpp
#include <hip/hip_runtime.h>
#include <cstdio>
#include <cstdint>

#ifndef MK_ONE_LAUNCH
#define MK_ONE_LAUNCH 1
#endif

#define LAS __attribute__((address_space(3)))
#define GAS __attribute__((address_space(1)))
typedef unsigned short bf16;
typedef short bf16x8 __attribute__((ext_vector_type(8)));
typedef short s16x4 __attribute__((ext_vector_type(4)));
typedef float f32x4 __attribute__((ext_vector_type(4)));
typedef float f32x2 __attribute__((ext_vector_type(2)));
typedef unsigned u32x4 __attribute__((ext_vector_type(4)));
typedef unsigned u32x2 __attribute__((ext_vector_type(2)));
typedef GAS unsigned gu32;
#define RLX_AGENT __ATOMIC_RELAXED, __HIP_MEMORY_SCOPE_AGENT
#define LDS_WAIT() asm volatile("s_waitcnt lgkmcnt(0)" ::: "memory")
#define VM_WAIT() asm volatile("s_waitcnt vmcnt(0)" ::: "memory")

constexpr int NB = 4, SEQ = 4096, T = NB * SEQ, D = 1024;
constexpr int NMEM = 256, TM = NB * NMEM;
constexpr int DNH = 4, DND = 128, DNW = 512, DNC = 64, NCHUNK = SEQ / DNC;
constexpr int DAH = 8, DAD = 64, DAW = 512;
constexpr int AB_IN = 3592;
constexpr int XH = 4, XD = 256;
constexpr int NE = 16, DE = 512;
constexpr float ALPHA = 1.41421356237f;
constexpr float LN_EPS = 1e-5f, RMS_EPS = 1e-6f;
constexpr int MOE_ROWS = 2 * T + NE * 256;

constexpr size_t MiB = 1u << 20;
constexpr size_t WS_CTL = 0, CTL_ZERO_BYTES = 1 * MiB;
constexpr size_t WS_W_IN = 1 * MiB, WS_W_ABO = 8 * MiB, WS_W_SCI = 10 * MiB, WS_W_SCO = 16 * MiB, WS_W_Q = 18 * MiB, WS_W_KV = 22 * MiB, WS_W_O = 30 * MiB;
constexpr size_t WS_MEMB = 34 * MiB, WS_KMEM = 36 * MiB, WS_VT = 40 * MiB, WS_BETA = 44 * MiB, WS_GG = 45 * MiB, WS_ROUTE = 46 * MiB, WS_GLAST = 47 * MiB;
constexpr size_t WS_HB = 48 * MiB, WS_H = 80 * MiB, WS_ARENA = 144 * MiB, WS_END = 320 * MiB;
constexpr size_t WS_QKVPRE = 144 * MiB, WS_ZB = 192 * MiB, WS_QKVD = 208 * MiB, WS_MNEG = 80 * MiB, WS_BMT = 112 * MiB, WS_QEFF = 256 * MiB, WS_OLOCT = 272 * MiB;
constexpr size_t WS_OUN = 288 * MiB, WS_LSE = 304 * MiB, WS_OPART = 144 * MiB, WS_MIX = 256 * MiB;
constexpr size_t WS_MOEW_GU = 144 * MiB, WS_MOEW_D = 176 * MiB, WS_XG = 192 * MiB, WS_HACT = 264 * MiB;
static_assert((size_t)MOE_ROWS * D * 2 <= 72 * MiB && (size_t)MOE_ROWS * DE * 2 <= 36 * MiB, "moe buffers");
constexpr int CW_TMO = 0, CW_BAR = 4096, CW_QUEUE = 64, CW_CNT0 = 128, CW_CNT1 = 192;

constexpr int LDS_BYTES = 163840, MISC_OFF = 162816, XCH_OFF = 131072;

__device__ __forceinline__ unsigned f2bf(float f) { unsigned u = __builtin_bit_cast(unsigned, f); return (u + 0x7fffu + ((u >> 16) & 1u)) >> 16; }
__device__ __forceinline__ unsigned pk2(float lo, float hi) { return f2bf(lo) | (f2bf(hi) << 16); }
__device__ __forceinline__ float bf2f(unsigned short b) { return __builtin_bit_cast(float, (unsigned)b << 16); }
__device__ __forceinline__ float bflo(unsigned w) { return __builtin_bit_cast(float, w << 16); }
__device__ __forceinline__ float bfhi(unsigned w) { return __builtin_bit_cast(float, w & 0xffff0000u); }
__device__ __forceinline__ float wave_sum(float v) {
#pragma unroll
    for (int o = 1; o < 64; o <<= 1) v += __shfl_xor(v, o);
    return v;
}
template <class P> __device__ __forceinline__ P opq_v(P p) { asm volatile("" : "+v"(p)); return p; }
template <class P> __device__ __forceinline__ P opq_s(P p) { asm volatile("" : "+s"(p)); return p; }
__device__ __forceinline__ float silu_f(float x) { return x / (1.f + __expf(-x)); }

namespace pg8 {
constexpr int BM = 256, BK = 64, HALF = 128, HTB = HALF * BK * 2, STAGE_BYTES = 8 * HTB;
__host__ __device__ __forceinline__ int lds_byte(int r, int c) { const int st = (r >> 4) * 2 + (c >> 5), rr = r & 15, cc = c & 31, ob = rr * 64 + cc * 2; return st * 1024 + (ob ^ (((ob >> 9) & 1) << 5)); }
__host__ __device__ __forceinline__ void stage_rc(int b, int& R, int& C) { const int st = b / 1024, sb = b % 1024, swz = sb ^ (((sb >> 9) & 1) << 5); R = (st >> 1) * 16 + swz / 64; C = (st & 1) * 32 + (swz % 64) / 2; }
__host__ __device__ __forceinline__ int perm32(int rho) { const int n = rho >> 4, i = rho & 15; return 8 * (i >> 2) + 4 * n + (i & 3); }

struct Unit { int pm, pn, aux; const char* a; const char* b; };
struct Gemm { int lda, ldb, K; };
__device__ __forceinline__ unsigned cvt_pk_bf16(float lo, float hi) { unsigned r; asm volatile("v_cvt_pk_bf16_f32 %0, %1, %2" : "=v"(r) : "v"(lo), "v"(hi)); return r; }

__device__ __forceinline__ void swz_tile(int L, int nM, int nN, int& pm, int& pn) {
    const int nwg = nM * nN; int wgid = L; { const int q = nwg / 8, r = nwg % 8, xcd = wgid % 8, off = wgid / 8; wgid = (xcd < r ? xcd * (q + 1) : r * (q + 1) + (xcd - r) * q) + off; }
    const int nig = 8 * nN, gid = wgid / nig, fm = gid * 8, gsz = (nM - fm) < 8 ? (nM - fm) : 8;
    pm = fm + ((wgid % nig) % gsz); pn = (wgid % nig) / gsz;
}

template <class Epi, class Sched>
__device__ __forceinline__ void gemm_phase(LAS unsigned char* lds, LAS unsigned char* xch, const Gemm g, const Sched& S, const Epi& E) {
    const int tid = opq_v((int)threadIdx.x), wid = __builtin_amdgcn_readfirstlane(tid >> 6), lane = tid & 63, wr = wid >> 2, wc = wid & 3, fr = lane & 15, fq = lane >> 4;
    const int K = g.K, nt = K / BK;
    unsigned voffA[2], voffB[2];
#pragma unroll
    for (int i = 0; i < 2; ++i) { int R, C; stage_rc(tid * 16 + i * 8192, R, C); const int Rb = Epi::PERM ? ((R & ~31) + perm32(R & 31)) : R;
        voffA[i] = (unsigned)(R * g.lda + C) * 2u; voffB[i] = (unsigned)(Rb * g.ldb + C) * 2u; }
    const size_t kstep = (size_t)(BK * 2);
    const size_t hstepA = (size_t)HALF * g.lda * 2, hstepB = (size_t)HALF * g.ldb * 2;
    const unsigned ldsw = (unsigned)wid * 1024u;
    const int aoff = lds_byte(wr * 64 + fr, fq * 8), boff = lds_byte(wc * 32 + fr, fq * 8);
#define PG8_SA(b, h) (((b) * 2 + (h)) * HTB)
#define PG8_SB(b, h) ((4 + (b) * 2 + (h)) * HTB)
#define PG8_STAGE(bufoff, gbase, voff) do { _Pragma("unroll") for (int _i = 0; _i < 2; ++_i) \
        __builtin_amdgcn_global_load_lds((const unsigned*)((const char*)(gbase) + (voff)[_i]), (LAS unsigned*)(lds + (bufoff) + ldsw + _i * 8192), 16, 0, 0); } while (0)
#define PG8_LDA(dst, b, h) do { _Pragma("unroll") for (int m = 0; m < 4; ++m) _Pragma("unroll") for (int k = 0; k < 2; ++k) dst[m][k] = *(const LAS bf16x8*)(lds + PG8_SA(b, h) + aoff + m * 2048 + k * 1024); } while (0)
#define PG8_LDB(dst, b, h) do { _Pragma("unroll") for (int n = 0; n < 2; ++n) _Pragma("unroll") for (int k = 0; k < 2; ++k) dst[n][k] = *(const LAS bf16x8*)(lds + PG8_SB(b, h) + boff + n * 2048 + k * 1024); } while (0)
#define PG8_MMA(ai, bj, At, Bt) do { __builtin_amdgcn_s_setprio(1); _Pragma("unroll") for (int m = 0; m < 4; ++m) _Pragma("unroll") for (int n = 0; n < 2; ++n) _Pragma("unroll") for (int k = 0; k < 2; ++k) \
        acc[ai][bj][m][n] = __builtin_amdgcn_mfma_f32_16x16x32_bf16(Bt[n][k], At[m][k], acc[ai][bj][m][n], 0, 0, 0); __builtin_amdgcn_s_setprio(0); } while (0)
#define PG8_WAIT_V(n) asm volatile("s_waitcnt vmcnt(" #n ")" ::: "memory")
#define PG8_WAIT_L(n) asm volatile("s_waitcnt lgkmcnt(" #n ")" ::: "memory")
#define PG8_BAR __builtin_amdgcn_s_barrier()
#define PG8_SCHED __builtin_amdgcn_sched_barrier(0)
    Unit cur, nxt; int ui = 0;
    if (!S.next(0, cur)) return;
    f32x4 acc[2][2][4][2];
#pragma unroll
    for (int a = 0; a < 2; ++a)
#pragma unroll
        for (int b = 0; b < 2; ++b)
#pragma unroll
            for (int m = 0; m < 4; ++m)
#pragma unroll
                for (int n = 0; n < 2; ++n) acc[a][b][m][n] = (f32x4){0.f, 0.f, 0.f, 0.f};
    bf16x8 At[4][2], B0[2][2], B1[2][2];
    const char* cA = cur.a; const char* cB = cur.b;
    PG8_STAGE(PG8_SB(0, 0), cB, voffB); PG8_STAGE(PG8_SB(0, 1), cB + hstepB, voffB); PG8_STAGE(PG8_SA(0, 0), cA, voffA); PG8_STAGE(PG8_SA(0, 1), cA + hstepA, voffA);
    if (wr == 1) PG8_BAR;
    PG8_WAIT_V(2); PG8_BAR;
    PG8_STAGE(PG8_SB(1, 0), cB + kstep, voffB); PG8_STAGE(PG8_SA(1, 0), cA + kstep, voffA); PG8_STAGE(PG8_SB(1, 1), cB + hstepB + kstep, voffB);
    PG8_WAIT_V(6); PG8_BAR;
#pragma unroll 1
    for (;;) {
        const bool has_next = S.next(ui + 1, nxt);
        const char* nA = has_next ? nxt.a : cA; const char* nB = has_next ? nxt.b : cB;
#pragma unroll 1
        for (int t = 0; t < nt; t += 2) {
            const bool last = (t == nt - 2);
            const char* a1 = cA + (size_t)(t + 1) * kstep;
            const char* a2 = last ? nA : cA + (size_t)(t + 2) * kstep; const char* b2 = last ? nB : cB + (size_t)(t + 2) * kstep;
            const char* a3 = a2 + kstep; const char* b3 = b2 + kstep;
            PG8_LDB(B0, 0, 0); PG8_LDB(B1, 0, 1); PG8_SCHED; PG8_LDA(At, 0, 0); PG8_STAGE(PG8_SA(1, 1), a1 + hstepA, voffA);
            PG8_WAIT_V(8); PG8_WAIT_L(0); PG8_BAR; PG8_MMA(0, 0, At, B0); PG8_MMA(0, 1, At, B1); PG8_BAR; PG8_SCHED;
            PG8_LDA(At, 0, 1); PG8_STAGE(PG8_SB(0, 0), b2, voffB); PG8_STAGE(PG8_SB(0, 1), b2 + hstepB, voffB); PG8_STAGE(PG8_SA(0, 0), a2, voffA);
            PG8_WAIT_V(8); PG8_WAIT_L(0); PG8_BAR; PG8_MMA(1, 0, At, B0); PG8_MMA(1, 1, At, B1); PG8_BAR; PG8_SCHED;
            PG8_LDB(B0, 1, 0); PG8_LDB(B1, 1, 1); PG8_SCHED; PG8_LDA(At, 1, 0); PG8_STAGE(PG8_SA(0, 1), a2 + hstepA, voffA);
            PG8_WAIT_V(8); PG8_WAIT_L(0); PG8_BAR; PG8_MMA(0, 0, At, B0); PG8_MMA(0, 1, At, B1); PG8_BAR; PG8_SCHED;
            PG8_LDA(At, 1, 1); PG8_STAGE(PG8_SB(1, 0), b3, voffB); PG8_STAGE(PG8_SB(1, 1), b3 + hstepB, voffB); PG8_STAGE(PG8_SA(1, 0), a3, voffA);
            PG8_WAIT_V(8); PG8_WAIT_L(0); PG8_BAR; PG8_MMA(1, 0, At, B0); PG8_MMA(1, 1, At, B1); PG8_BAR; PG8_SCHED;
        }
        if (wr == 0) PG8_BAR;
        E(acc, cur, wr, wc, fr, fq, xch);
        if (!has_next) break;
#pragma unroll
        for (int a = 0; a < 2; ++a)
#pragma unroll
            for (int b = 0; b < 2; ++b)
#pragma unroll
                for (int m = 0; m < 4; ++m)
#pragma unroll
                    for (int n = 0; n < 2; ++n) acc[a][b][m][n] = (f32x4){0.f, 0.f, 0.f, 0.f};
        cur = nxt; cA = nA; cB = nB; ++ui;
        if (wr == 1) PG8_BAR;
    }
    PG8_WAIT_V(0);
    PG8_BAR;
#undef PG8_SA
#undef PG8_SB
#undef PG8_STAGE
#undef PG8_LDA
#undef PG8_LDB
#undef PG8_MMA
#undef PG8_WAIT_V
#undef PG8_WAIT_L
#undef PG8_BAR
#undef PG8_SCHED
}

struct Dst { bf16* p; int ld; };
__device__ __forceinline__ void store_tile_bf16(const f32x4 (&acc)[2][2][4][2], const Dst d, float sc, int wr, int wc, int fr, int fq) {
    unsigned lane_off = (unsigned)((wr * 64 + fr) * d.ld + wc * 32 + 8 * fq);
    asm volatile("" : "+v"(lane_off));
#pragma unroll
    for (int ai = 0; ai < 2; ++ai)
#pragma unroll
        for (int m = 0; m < 4; ++m) { bf16* rowp = d.p + (size_t)lane_off + (size_t)((ai * HALF + m * 16) * d.ld);
#pragma unroll
            for (int bj = 0; bj < 2; ++bj) { const f32x4 v0 = acc[ai][bj][m][0] * sc, v1 = acc[ai][bj][m][1] * sc;
                u32x4 w; w.x = cvt_pk_bf16(v0[0], v0[1]); w.y = cvt_pk_bf16(v0[2], v0[3]); w.z = cvt_pk_bf16(v1[0], v1[1]); w.w = cvt_pk_bf16(v1[2], v1[3]);
                *(u32x4*)(rowp + bj * HALF) = w; } }
}
}

#define XB_TMO      128
#define XB_XCNT(j)  (256  + 64 * (j))
#define XB_XSUB(j)  (1280 + 64 * (j))
#define XB_XGEN(j)  (2304 + 64 * (j))
#define XB_TOP      3328
#define XB_TOPGEN   3392
#define XCD_BAR_WORDS 3456
#define XB_SPIN_CAP (1u << 20)
__device__ __forceinline__ unsigned xb_ld(unsigned* p)              { return __hip_atomic_load(p, __ATOMIC_RELAXED, __HIP_MEMORY_SCOPE_AGENT); }
__device__ __forceinline__ unsigned xb_add(unsigned* p, unsigned v) { return __hip_atomic_fetch_add(p, v, __ATOMIC_RELAXED, __HIP_MEMORY_SCOPE_AGENT); }
__device__ __forceinline__ unsigned xb_xcc_id() { return (unsigned)__builtin_amdgcn_s_getreg((3 << 11) | 20) & 0xFu; }
#define XB_SPIN(cond, bar) do { unsigned _sp = 0; while (cond) { __builtin_amdgcn_s_sleep(1); \
    if ((++_sp & 255u) == 0u) { if (xb_ld(&(bar)[XB_TMO])) break; if (_sp > XB_SPIN_CAP) { atomicAdd(&(bar)[XB_TMO], 1u); break; } } } } while (0)
struct XcdBarrier { unsigned* bar; unsigned x; volatile LAS unsigned* st; };
__device__ __forceinline__ XcdBarrier xcd_barrier_post(unsigned* bar, volatile LAS unsigned* st) {
    XcdBarrier b; b.bar = bar; b.x = xb_xcc_id(); b.st = st;
    if (threadIdx.x == 0) (void)xb_add(&bar[XB_XCNT(b.x)], 1u);
    return b;
}
__device__ __forceinline__ void xcd_barrier_complete(unsigned* bar, unsigned x, unsigned& nloc, unsigned& nx) {
    const unsigned G = gridDim.x * gridDim.y * gridDim.z;
    unsigned sum, cnt, mine, sp = 0u;
    for (;;) {
        sum = 0u; cnt = 0u; mine = 0u;
#pragma unroll
        for (unsigned j = 0; j < 16; ++j) { const unsigned c = xb_ld(&bar[XB_XCNT(j)]); sum += c; cnt += (c > 0u) ? 1u : 0u; mine = (j == x) ? c : mine; }
        if (sum == G) break;
        __builtin_amdgcn_s_sleep(1);
        if ((++sp & 255u) == 0u) { if (xb_ld(&bar[XB_TMO])) break; if (sp > XB_SPIN_CAP) { atomicAdd(&bar[XB_TMO], 1u); break; } }
    }
    nloc = mine > 0u ? mine : 1u; nx = cnt > 0u ? cnt : 1u;
}
__device__ __forceinline__ void xcd_barrier(const XcdBarrier& b) {
    asm volatile("s_waitcnt vmcnt(0)" ::: "memory");
    __syncthreads();
    if (threadIdx.x == 0) {
        unsigned* bar = b.bar;
        __builtin_amdgcn_s_waitcnt(0);
        unsigned nloc = b.st[0], nx = b.st[1];
        if (nloc == 0u) { xcd_barrier_complete(bar, b.x, nloc, nx); b.st[0] = nloc; b.st[1] = nx; }
        const unsigned old = xb_add(&bar[XB_XSUB(b.x)], 1u);
        const unsigned gen = old / nloc;
        if (old + 1u == (gen + 1u) * nloc) {
            __builtin_amdgcn_fence(__ATOMIC_RELEASE, "agent");
            asm volatile("s_waitcnt vmcnt(0)" ::: "memory");
            const unsigned og = xb_add(&bar[XB_TOP], 1u);
            const unsigned tg = og / nx;
            if (og + 1u == (tg + 1u) * nx) xb_add(&bar[XB_TOPGEN], 1u);
            else XB_SPIN(xb_ld(&bar[XB_TOPGEN]) == tg, bar);
            __builtin_amdgcn_fence(__ATOMIC_ACQUIRE, "agent");
            xb_add(&bar[XB_XGEN(b.x)], 1u);
            asm volatile("s_waitcnt vmcnt(0)" ::: "memory");
        } else {
            XB_SPIN(xb_ld(&bar[XB_XGEN(b.x)]) == gen, bar);
            __builtin_amdgcn_fence(__ATOMIC_ACQUIRE, "agent");
            asm volatile("s_waitcnt vmcnt(0)" ::: "memory");
        }
    }
    __syncthreads();
}

struct Args { const float* in[21]; float* out; unsigned char* ws; int ph_lo, ph_hi; };
struct Frame {
    LAS unsigned char* lds;
    unsigned char* ws;
    gu32* ctl;
    int tid, lane, wave, G, gw, NGW;
};
#define WSP(T_, off) ((T_*)(F.ws + (off)))

__device__ __forceinline__ void tr_item(const float* W, int ldw, int k0, int c0, bf16* dst, int ldd, LAS float* scr, int lane) {
    const int r8 = lane >> 3, c4 = lane & 7;
#pragma unroll
    for (int it = 0; it < 8; ++it) { const int kk = it * 8 + r8; const f32x4 v = *(const GAS f32x4*)(W + (size_t)(k0 + kk) * ldw + c0 + 4 * c4);
        LAS float* s = scr + kk * 33 + 4 * c4; s[0] = v[0]; s[1] = v[1]; s[2] = v[2]; s[3] = v[3]; }
    LDS_WAIT(); asm volatile("" ::: "memory");
    const int c = lane & 7;
#pragma unroll
    for (int j = 0; j < 4; ++j) { const int n = (lane >> 3) + 8 * j; const LAS float* s = scr + (8 * c) * 33 + n;
        u32x4 o; o.x = pk2(s[0 * 33], s[1 * 33]); o.y = pk2(s[2 * 33], s[3 * 33]); o.z = pk2(s[4 * 33], s[5 * 33]); o.w = pk2(s[6 * 33], s[7 * 33]);
        *(GAS u32x4*)(dst + (size_t)n * ldd + k0 + 8 * c) = o; }
    LDS_WAIT(); asm volatile("" ::: "memory");
}
__device__ __forceinline__ void tr_matrix(Frame& F, const float* W, int K, int N, int ldw, bf16* dst, LAS float* scr, int it) {
    const int nblk = N / 32, kb = it / nblk, nb = it % nblk;
    tr_item(W, ldw, 64 * kb, 32 * nb, dst + (size_t)(32 * nb) * K, K, scr, F.lane);
}
__device__ __forceinline__ void p0_prologue(Frame& F, const Args& A) {
    LAS float* scr = (LAS float*)(F.lds + F.wave * 16384);
    constexpr int I_IN = 16 * 112, I_SQ = 16 * 32, I_SCI = 16 * 96, I_KV = 16 * 64;
    constexpr int NITEMS = I_IN + I_SQ + I_SCI + I_SQ + 2 * I_SQ + 2 * I_KV + 2 * I_SQ;
    for (int it = F.gw; it < NITEMS; it += F.NGW) {
        int r = it;
        if (r < I_IN) { const int kb = r / 112, nb = r % 112;
            tr_item(A.in[2], AB_IN, 64 * kb, 32 * nb + (nb >= 64 ? 8 : 0), WSP(bf16, WS_W_IN) + (size_t)(32 * nb) * D, D, scr, F.lane); continue; } r -= I_IN;
        if (r < I_SQ) { tr_matrix(F, A.in[7], D, D, D, WSP(bf16, WS_W_ABO), scr, r); continue; } r -= I_SQ;
        if (r < I_SCI) { tr_matrix(F, A.in[8], D, 3 * D, 3 * D, WSP(bf16, WS_W_SCI), scr, r); continue; } r -= I_SCI;
        if (r < I_SQ) { tr_matrix(F, A.in[10], D, D, D, WSP(bf16, WS_W_SCO), scr, r); continue; } r -= I_SQ;
        if (r < 2 * I_SQ) { const int l = r / I_SQ; tr_matrix(F, A.in[11] + (size_t)l * D * D, D, D, D, WSP(bf16, WS_W_Q) + (size_t)l * D * D, scr, r % I_SQ); continue; } r -= 2 * I_SQ;
        if (r < 2 * I_KV) { const int l = r / I_KV; tr_matrix(F, A.in[12] + (size_t)l * D * 2 * D, D, 2 * D, 2 * D, WSP(bf16, WS_W_KV) + (size_t)l * 2 * D * D, scr, r % I_KV); continue; } r -= 2 * I_KV;
        { const int l = r / I_SQ; tr_matrix(F, A.in[13] + (size_t)l * D * D, D, D, D, WSP(bf16, WS_W_O) + (size_t)l * D * D, scr, r % I_SQ); }
    }
    __syncthreads();
    LAS float* wt = (LAS float*)F.lds;
    for (int i = F.tid; i < 8 * D; i += 512) { const int k = i >> 3, c = i & 7; wt[c * D + k] = A.in[2][(size_t)k * AB_IN + 2048 + c]; }
    __syncthreads();
    const float* x = A.in[0];
    float alg[4], dtb[4];
#pragma unroll
    for (int h = 0; h < 4; ++h) { alg[h] = -__expf(A.in[4][h]); dtb[h] = A.in[5][h]; }
    for (int m = F.gw; m < T; m += F.NGW) {
        const GAS f32x4* xr = (const GAS f32x4*)(x + (size_t)m * D) + F.lane;
        f32x4 v[4];
#pragma unroll
        for (int j = 0; j < 4; ++j) v[j] = xr[64 * j];
        GAS u32x2* o8 = (GAS u32x2*)(WSP(bf16, WS_HB) + (size_t)m * D) + F.lane;
#pragma unroll
        for (int j = 0; j < 4; ++j) { u32x2 w; w.x = pk2(v[j][0], v[j][1]); w.y = pk2(v[j][2], v[j][3]); o8[64 * j] = w; }
        float dot[8];
#pragma unroll
        for (int c = 0; c < 8; ++c) { float s = 0.f;
#pragma unroll
            for (int j = 0; j < 4; ++j) { const f32x4 w = *(const LAS f32x4*)(wt + c * D + 256 * j + 4 * F.lane); s += v[j][0] * w[0] + v[j][1] * w[1] + v[j][2] * w[2] + v[j][3] * w[3]; }
            dot[c] = wave_sum(s); }
        if (F.lane == 0) {
            f32x4 bo, go;
#pragma unroll
            for (int hq = 0; hq < 4; ++hq) { bo[hq] = 1.f / (1.f + __expf(-dot[hq])); const float xx = dot[4 + hq] + dtb[hq]; const float sp = xx > 20.f ? xx : log1pf(__expf(xx)); go[hq] = alg[hq] * sp; }
            *(GAS f32x4*)(WSP(float, WS_BETA) + (size_t)m * 4) = bo;
            *(GAS f32x4*)(WSP(float, WS_GG) + (size_t)m * 4) = go;
        }
    }
    for (int m = F.gw; m < TM; m += F.NGW) {
        const GAS f32x4* xr = (const GAS f32x4*)(A.in[1] + (size_t)m * D) + F.lane;
        GAS u32x2* o8 = (GAS u32x2*)(WSP(bf16, WS_MEMB) + (size_t)m * D) + F.lane;
#pragma unroll
        for (int j = 0; j < 4; ++j) { const f32x4 v = xr[64 * j]; u32x2 w; w.x = pk2(v[0], v[1]); w.y = pk2(v[2], v[3]); o8[64 * j] = w; }
    }
}
__device__ __forceinline__ void convert_moe(Frame& F, const Args& A, int layer) {
    LAS float* scr = (LAS float*)(F.lds + F.wave * 16384);
    constexpr int I_GU = 16 * 32, I_D = 8 * 32;
    constexpr int NITEMS = NE * (I_GU + I_D);
    for (int it = F.gw; it < NITEMS; it += F.NGW) {
        const int e = it / (I_GU + I_D); int r = it % (I_GU + I_D);
        if (r < I_GU) { const int kb = r / 32, rb = r % 32, pn = rb >> 3, sub = rb & 7;
            const float* src = (sub < 4 ? A.in[16] : A.in[17]) + ((size_t)layer * NE + e) * D * DE;
            tr_item(src, DE, 64 * kb, 128 * pn + 32 * (sub & 3), WSP(bf16, WS_MOEW_GU) + ((size_t)e * D + 32 * rb) * D, D, scr, F.lane);
        } else { r -= I_GU; const int kb = r / 32, nb = r % 32;
            tr_item(A.in[18] + ((size_t)layer * NE + e) * DE * D, D, 64 * kb, 32 * nb, WSP(bf16, WS_MOEW_D) + ((size_t)e * D + 32 * nb) * DE, DE, scr, F.lane); }
    }
}

struct SchedDense {
    const char* A; const char* B; int lda, ldb, nM, nN, G, c;
    __device__ __forceinline__ bool next(int i, pg8::Unit& u) const {
        const int L = i * G + c; if (L >= nM * nN) return false;
        pg8::swz_tile(L, nM, nN, u.pm, u.pn); u.aux = 0;
        u.a = A + (size_t)u.pm * 256 * lda * 2; u.b = B + (size_t)u.pn * 256 * ldb * 2; return true; }
};
struct EpiDense {
    static constexpr bool PERM = true;
    bf16* O; int ld; float sc;
    __device__ __forceinline__ void operator()(const f32x4 (&acc)[2][2][4][2], const pg8::Unit& u, int wr, int wc, int fr, int fq, LAS unsigned char*) const {
        pg8::store_tile_bf16(acc, pg8::Dst{O + (size_t)u.pm * 256 * ld + u.pn * 256, ld}, sc, wr, wc, fr, fq); }
};
struct SchedP1 {
    const char* XB; const char* WIN; const char* MEMB; const char* WKV; int G, c;
    __device__ __forceinline__ bool next(int i, pg8::Unit& u) const {
        const int L = i * G + c; if (L >= 896 + 64) return false;
        if (L < 896) { pg8::swz_tile(L, 64, 14, u.pm, u.pn); u.aux = 0; u.a = XB + (size_t)u.pm * 256 * D * 2; u.b = WIN + (size_t)u.pn * 256 * D * 2; }
        else { const int r = L - 896, l = r >> 5; u.pm = (r & 31) >> 3; u.pn = r & 7; u.aux = 1 + l; u.a = MEMB + (size_t)u.pm * 256 * D * 2; u.b = WKV + ((size_t)l * 2 * D + u.pn * 256) * D * 2; }
        return true; }
};
struct EpiP1 {
    static constexpr bool PERM = true;
    bf16 *QKVPRE, *ZB, *QKVD, *KMEM, *VT;
    __device__ __forceinline__ void operator()(const f32x4 (&acc)[2][2][4][2], const pg8::Unit& u, int wr, int wc, int fr, int fq, LAS unsigned char*) const {
        if (u.aux == 0) {
            pg8::Dst d;
            if (u.pn < 6) d = pg8::Dst{QKVPRE + (size_t)u.pm * 256 * 1536 + u.pn * 256, 1536};
            else if (u.pn < 8) d = pg8::Dst{ZB + (size_t)u.pm * 256 * 512 + (u.pn - 6) * 256, 512};
            else d = pg8::Dst{QKVD + (size_t)u.pm * 256 * 1536 + (u.pn - 8) * 256, 1536};
            pg8::store_tile_bf16(acc, d, 1.f, wr, wc, fr, fq);
        } else {
            const int l = u.aux - 1;
            if (u.pn < 4) pg8::store_tile_bf16(acc, pg8::Dst{KMEM + ((size_t)l * TM + u.pm * 256) * D + u.pn * 256, D}, 1.f, wr, wc, fr, fq);
            else {
                unsigned lane_off = (unsigned)((wc * 32 + 8 * fq) * NMEM + wr * 64 + fr);
                asm volatile("" : "+v"(lane_off));
                bf16* vt = VT + (((size_t)l * NB + u.pm) * XH + (u.pn - 4)) * XD * NMEM + lane_off;
#pragma unroll
                for (int ai = 0; ai < 2; ++ai)
#pragma unroll
                    for (int m = 0; m < 4; ++m)
#pragma unroll
                        for (int bj = 0; bj < 2; ++bj)
#pragma unroll
                            for (int n = 0; n < 2; ++n)
#pragma unroll
                                for (int e = 0; e < 4; ++e) vt[(bj * 128 + 4 * n + e) * NMEM + ai * 128 + m * 16] = (bf16)f2bf(acc[ai][bj][m][n][e]);
            }
        }
    }
};
struct SchedXS {
    const char* QB; const char* KM; int G, c;
    __device__ __forceinline__ bool next(int i, pg8::Unit& u) const {
        const int L = i * G + c; if (L >= 256) return false;
        u.pm = L >> 2; u.pn = L & 3; u.aux = 0;
        u.a = QB + ((size_t)u.pm * 256 * D + u.pn * XD) * 2; u.b = KM + ((size_t)(u.pm >> 4) * NMEM * D + u.pn * XD) * 2; return true; }
};
struct EpiSoftmax {
    static constexpr bool PERM = true;
    bf16* P;
    __device__ __forceinline__ void operator()(f32x4 (&acc)[2][2][4][2], const pg8::Unit& u, int wr, int wc, int fr, int fq, LAS unsigned char* xch) const {
        LAS float* MX = (LAS float*)xch;
        LAS float* SM = (LAS float*)(xch + 4096);
#pragma unroll
        for (int ai = 0; ai < 2; ++ai)
#pragma unroll
            for (int m = 0; m < 4; ++m) { float v = -3.0e38f;
#pragma unroll
                for (int bj = 0; bj < 2; ++bj)
#pragma unroll
                    for (int n = 0; n < 2; ++n) { const f32x4 x = acc[ai][bj][m][n]; v = fmaxf(v, fmaxf(fmaxf(x[0], x[1]), fmaxf(x[2], x[3]))); }
                v = fmaxf(v, __shfl_xor(v, 16)); v = fmaxf(v, __shfl_xor(v, 32));
                if (fq == 0) MX[(ai * 128 + wr * 64 + m * 16 + fr) * 4 + wc] = v; }
        LDS_WAIT(); __builtin_amdgcn_s_barrier(); asm volatile("" ::: "memory");
#pragma unroll
        for (int ai = 0; ai < 2; ++ai)
#pragma unroll
            for (int m = 0; m < 4; ++m) { float s = 0.f; const f32x4 q = *(const LAS f32x4*)(MX + (ai * 128 + wr * 64 + m * 16 + fr) * 4); const float mxr = fmaxf(fmaxf(q[0], q[1]), fmaxf(q[2], q[3]));
#pragma unroll
                for (int bj = 0; bj < 2; ++bj)
#pragma unroll
                    for (int n = 0; n < 2; ++n) { f32x4 x = acc[ai][bj][m][n];
#pragma unroll
                        for (int e = 0; e < 4; ++e) { x[e] = __builtin_amdgcn_exp2f(x[e] - mxr); s += x[e]; }
                        acc[ai][bj][m][n] = x; }
                s += __shfl_xor(s, 16); s += __shfl_xor(s, 32);
                if (fq == 0) SM[(ai * 128 + wr * 64 + m * 16 + fr) * 4 + wc] = s; }
        LDS_WAIT(); __builtin_amdgcn_s_barrier(); asm volatile("" ::: "memory");
        bf16* base = P + (size_t)u.pm * 256 * D + u.pn * XD;
#pragma unroll
        for (int ai = 0; ai < 2; ++ai)
#pragma unroll
            for (int m = 0; m < 4; ++m) { const f32x4 q = *(const LAS f32x4*)(SM + (ai * 128 + wr * 64 + m * 16 + fr) * 4); const float inv = 1.f / ((q[0] + q[1]) + (q[2] + q[3]));
                bf16* rowp = base + (size_t)(ai * 128 + wr * 64 + m * 16 + fr) * D + wc * 32 + 8 * fq;
#pragma unroll
                for (int bj = 0; bj < 2; ++bj) { const f32x4 v0 = acc[ai][bj][m][0] * inv, v1 = acc[ai][bj][m][1] * inv;
                    u32x4 w; w.x = pg8::cvt_pk_bf16(v0[0], v0[1]); w.y = pg8::cvt_pk_bf16(v0[2], v0[3]); w.z = pg8::cvt_pk_bf16(v1[0], v1[1]); w.w = pg8::cvt_pk_bf16(v1[2], v1[3]);
                    *(u32x4*)(rowp + bj * 128) = w; } }
        LDS_WAIT(); __builtin_amdgcn_s_barrier(); asm volatile("" ::: "memory");
    }
};
struct SchedXP {
    const char* PB; const char* VT; int G, c;
    __device__ __forceinline__ bool next(int i, pg8::Unit& u) const {
        const int L = i * G + c; if (L >= 256) return false;
        u.pm = L >> 2; u.pn = L & 3; u.aux = 0;
        u.a = PB + ((size_t)u.pm * 256 * D + u.pn * XD) * 2; u.b = VT + ((size_t)((u.pm >> 4) * XH + u.pn) * XD * NMEM) * 2; return true; }
};
struct SchedMoE {
    const char* Aall; const char* Wall; volatile LAS unsigned* tab; int lda, wrows  , ldb, G, c;
    __device__ __forceinline__ bool next(int i, pg8::Unit& u) const {
        const int L = i * G + c; const int ntile = (int)tab[16]; if (L >= ntile * 4) return false;
        u.pm = L >> 2; u.pn = L & 3; int e = 0;
#pragma unroll
        for (int j = 1; j < 16; ++j) e += ((int)tab[j] <= u.pm) ? 1 : 0;
        u.aux = e; u.a = Aall + (size_t)u.pm * 256 * lda * 2; u.b = Wall + ((size_t)e * wrows + u.pn * 256) * ldb * 2; return true; }
};
struct EpiSwiglu {
    static constexpr bool PERM = true;
    bf16* HACT;
    __device__ __forceinline__ void operator()(const f32x4 (&acc)[2][2][4][2], const pg8::Unit& u, int wr, int wc, int fr, int fq, LAS unsigned char*) const {
#pragma unroll
        for (int ai = 0; ai < 2; ++ai)
#pragma unroll
            for (int m = 0; m < 4; ++m) { bf16* rowp = HACT + (size_t)(u.pm * 256 + ai * 128 + wr * 64 + m * 16 + fr) * DE + u.pn * 128 + wc * 32 + 8 * fq;
                float h[8];
#pragma unroll
                for (int n = 0; n < 2; ++n)
#pragma unroll
                    for (int e = 0; e < 4; ++e) { const float gt = acc[ai][0][m][n][e], up = acc[ai][1][m][n][e]; h[n * 4 + e] = silu_f(gt) * up; }
                u32x4 w; w.x = pg8::cvt_pk_bf16(h[0], h[1]); w.y = pg8::cvt_pk_bf16(h[2], h[3]); w.z = pg8::cvt_pk_bf16(h[4], h[5]); w.w = pg8::cvt_pk_bf16(h[6], h[7]);
                *(u32x4*)rowp = w; }
    }
};

struct Route { int e0, e1, r0, r1; float w0, w1; int s0, s1; };
template <int MODE, bool ROUTER, bool FINAL>
__device__ __forceinline__ void ln_pass(Frame& F, const Args& A, const float* hold, const bf16* Y, int li  , float* hnew, bf16* hb, unsigned* cnt) {
    const float* gam = A.in[19] + (size_t)li * D; const float* bet = A.in[20] + (size_t)li * D;
    f32x4 gv[4], bv[4];
#pragma unroll
    for (int j = 0; j < 4; ++j) { gv[j] = *(const GAS f32x4*)(gam + 256 * j + 4 * F.lane); bv[j] = *(const GAS f32x4*)(bet + 256 * j + 4 * F.lane); }
    LAS float* rw = (LAS float*)F.lds;
    LAS int* sel = (LAS int*)(F.lds + 65536);
    LAS float* selw = (LAS float*)(F.lds + 65536 + 1024);
    if (ROUTER) { for (int i = F.tid; i < NE * D; i += 512) { const int k = i >> 4, e = i & 15; rw[e * D + k] = A.in[14][i]; } __syncthreads(); }
    Route* route = WSP(Route, WS_ROUTE);
    const int nblk = T / 64;
    for (int blk = blockIdx.x; blk < nblk; blk += F.G) {
#pragma unroll 1
        for (int rr = 0; rr < 8; ++rr) {
            const int m = blk * 64 + F.wave * 8 + rr;
            f32x4 v[4];
#pragma unroll
            for (int j = 0; j < 4; ++j) v[j] = *((const GAS f32x4*)(hold + (size_t)m * D) + F.lane + 64 * j) * ALPHA;
            if (MODE == 0) {
#pragma unroll
                for (int j = 0; j < 4; ++j) { const u32x2 w = *((const GAS u32x2*)(Y + (size_t)m * D) + F.lane + 64 * j); v[j][0] += bflo(w.x); v[j][1] += bfhi(w.x); v[j][2] += bflo(w.y); v[j][3] += bfhi(w.y); }
            } else {
                const Route r = route[m];
#pragma unroll
                for (int j = 0; j < 4; ++j) { const u32x2 w0 = *((const GAS u32x2*)(Y + (size_t)r.s0 * D) + F.lane + 64 * j), w1 = *((const GAS u32x2*)(Y + (size_t)r.s1 * D) + F.lane + 64 * j);
                    v[j][0] += r.w0 * bflo(w0.x) + r.w1 * bflo(w1.x); v[j][1] += r.w0 * bfhi(w0.x) + r.w1 * bfhi(w1.x); v[j][2] += r.w0 * bflo(w0.y) + r.w1 * bflo(w1.y); v[j][3] += r.w0 * bfhi(w0.y) + r.w1 * bfhi(w1.y); }
            }
            float s = 0.f;
#pragma unroll
            for (int j = 0; j < 4; ++j) s += (v[j][0] + v[j][1]) + (v[j][2] + v[j][3]);
            const float mean = wave_sum(s) * (1.f / D); float s2 = 0.f;
#pragma unroll
            for (int j = 0; j < 4; ++j) { v[j] = v[j] - mean; s2 += (v[j][0] * v[j][0] + v[j][1] * v[j][1]) + (v[j][2] * v[j][2] + v[j][3] * v[j][3]); }
            const float rstd = 1.f / sqrtf(wave_sum(s2) * (1.f / D) + LN_EPS);
#pragma unroll
            for (int j = 0; j < 4; ++j) v[j] = v[j] * rstd * gv[j] + bv[j];
#pragma unroll
            for (int j = 0; j < 4; ++j) *((GAS f32x4*)(hnew + (size_t)m * D) + F.lane + 64 * j) = v[j];
            if (!FINAL) {
#pragma unroll
                for (int j = 0; j < 4; ++j) { u32x2 w; w.x = pk2(v[j][0], v[j][1]); w.y = pk2(v[j][2], v[j][3]); *((GAS u32x2*)(hb + (size_t)m * D) + F.lane + 64 * j) = w; }
            }
            if (ROUTER) {
                float lg[16];
#pragma unroll
                for (int e = 0; e < 16; ++e) { float d = 0.f;
#pragma unroll
                    for (int j = 0; j < 4; ++j) { const f32x4 w = *(const LAS f32x4*)(rw + e * D + 256 * j + 4 * F.lane); d += v[j][0] * w[0] + v[j][1] * w[1] + v[j][2] * w[2] + v[j][3] * w[3]; }
                    lg[e] = wave_sum(d); }
                float mxl = lg[0];
#pragma unroll
                for (int e = 1; e < 16; ++e) mxl = fmaxf(mxl, lg[e]);
                float sc[16], se = 0.f;
#pragma unroll
                for (int e = 0; e < 16; ++e) { sc[e] = __expf(lg[e] - mxl); se += sc[e]; }
                const float inv = 1.f / se; float sl[16];
#pragma unroll
                for (int e = 0; e < 16; ++e) { sc[e] *= inv; sl[e] = sc[e] + A.in[15][e]; }
                int bg = 0; float bgs = -3.0e38f;
#pragma unroll
                for (int g4 = 0; g4 < 4; ++g4) { const float a = sl[4 * g4], b = sl[4 * g4 + 1], c = sl[4 * g4 + 2], d = sl[4 * g4 + 3];
                    const float hi1 = fmaxf(a, b), lo1 = fminf(a, b), hi2 = fmaxf(c, d), lo2 = fminf(c, d);
                    const float top = fmaxf(hi1, hi2), second = fmaxf(fminf(hi1, hi2), fmaxf(lo1, lo2)); const float gs = top + second;
                    if (gs > bgs) { bgs = gs; bg = g4; } }
                float s4[4], c4[4];
#pragma unroll
                for (int q = 0; q < 4; ++q) { s4[q] = bg == 0 ? sl[q] : bg == 1 ? sl[4 + q] : bg == 2 ? sl[8 + q] : sl[12 + q]; c4[q] = bg == 0 ? sc[q] : bg == 1 ? sc[4 + q] : bg == 2 ? sc[8 + q] : sc[12 + q]; }
                int i0 = 0; float b0 = s4[0];
#pragma unroll
                for (int q = 1; q < 4; ++q) if (s4[q] > b0) { b0 = s4[q]; i0 = q; }
                int i1 = -1; float b1 = -3.0e38f;
#pragma unroll
                for (int q = 0; q < 4; ++q) if (q != i0 && s4[q] > b1) { b1 = s4[q]; i1 = q; }
                const float p0 = i0 == 0 ? c4[0] : i0 == 1 ? c4[1] : i0 == 2 ? c4[2] : c4[3];
                const float p1 = i1 == 0 ? c4[0] : i1 == 1 ? c4[1] : i1 == 2 ? c4[2] : c4[3];
                if (F.lane == 0) { const int tk = F.wave * 8 + rr; sel[tk * 4 + 0] = bg * 4 + i0; sel[tk * 4 + 1] = bg * 4 + i1; selw[tk * 2 + 0] = p0 / (p0 + p1); selw[tk * 2 + 1] = p1 / (p0 + p1); }
            }
        }
        if (ROUTER) {
            __syncthreads();
            if (F.tid < 16) {
                const int e = F.tid; int n = 0;
                for (int i = 0; i < 64; ++i) { if (sel[i * 4 + 0] == e) { sel[i * 4 + 2] = n; ++n; } if (sel[i * 4 + 1] == e) { sel[i * 4 + 3] = n; ++n; } }
                const int base = n ? (int)atomicAdd(cnt + e, (unsigned)n) : 0;
                for (int i = 0; i < 64; ++i) { if (sel[i * 4 + 0] == e) sel[i * 4 + 2] += base; if (sel[i * 4 + 1] == e) sel[i * 4 + 3] += base; }
            }
            __syncthreads();
            if (F.tid < 64) { Route r; r.e0 = sel[F.tid * 4 + 0]; r.e1 = sel[F.tid * 4 + 1]; r.r0 = sel[F.tid * 4 + 2]; r.r1 = sel[F.tid * 4 + 3]; r.w0 = selw[F.tid * 2 + 0]; r.w1 = selw[F.tid * 2 + 1]; r.s0 = 0; r.s1 = 0; route[blk * 64 + F.tid] = r; }
            __syncthreads();
        }
    }
}
__device__ __forceinline__ void moe_table(Frame& F, const unsigned* cnt, volatile LAS unsigned* tab) {
    if (F.tid == 0) { unsigned t = 0; for (int e = 0; e < 16; ++e) { tab[e] = t; t += (__hip_atomic_load(cnt + e, RLX_AGENT) + 255u) >> 8; } tab[16] = t; }
    __syncthreads();
}
__device__ __forceinline__ void moe_gather(Frame& F, const bf16* hb, bf16* xg, volatile LAS unsigned* tab) {
    Route* route = WSP(Route, WS_ROUTE);
    for (int m = F.gw; m < T; m += F.NGW) {
        Route r = route[m];
        const int s0 = (int)tab[r.e0] * 256 + r.r0, s1 = (int)tab[r.e1] * 256 + r.r1;
        if (F.lane == 0) { route[m].s0 = s0; route[m].s1 = s1; }
        const GAS u32x4* src = (const GAS u32x4*)(hb + (size_t)m * D) + F.lane;
        const u32x4 a = src[0], b = src[64];
        GAS u32x4* d0 = (GAS u32x4*)(xg + (size_t)s0 * D) + F.lane; GAS u32x4* d1 = (GAS u32x4*)(xg + (size_t)s1 * D) + F.lane;
        d0[0] = a; d0[64] = b; d1[0] = a; d1[64] = b;
    }
}

__device__ __forceinline__ void conv_pass(Frame& F, const Args& A, const bf16* prj, bf16* ub) {
    const float* cw = A.in[9];
    for (int it = F.gw; it < (T / 16) * 2; it += F.NGW) {
        const int tb = it >> 1, c0 = (it & 1) * 512 + F.lane * 8; const int t0 = tb * 16, pos0 = t0 % SEQ;
        float w[3][8];
#pragma unroll
        for (int j = 0; j < 3; ++j) { const f32x4 a = *(const GAS f32x4*)(cw + j * D + c0), b = *(const GAS f32x4*)(cw + j * D + c0 + 4);
#pragma unroll
            for (int e = 0; e < 4; ++e) { w[j][e] = a[e]; w[j][4 + e] = b[e]; } }
        float p2[8], p1[8];
#pragma unroll
        for (int e = 0; e < 8; ++e) { p2[e] = 0.f; p1[e] = 0.f; }
#pragma unroll
        for (int q = 0; q < 2; ++q) { if (pos0 - 2 + q >= 0) { const bf16* r = prj + (size_t)(t0 - 2 + q) * 3072;
                const u32x4 gc = *(const GAS u32x4*)(r + 1024 + c0), hd = *(const GAS u32x4*)(r + 2048 + c0);
#pragma unroll
                for (int e = 0; e < 4; ++e) { const float lo = bflo(gc[e]) * bflo(hd[e]), hi = bfhi(gc[e]) * bfhi(hd[e]); if (q == 0) { p2[2 * e] = lo; p2[2 * e + 1] = hi; } else { p1[2 * e] = lo; p1[2 * e + 1] = hi; } } } }
#pragma unroll 4
        for (int tt = 0; tt < 16; ++tt) { const bf16* r = prj + (size_t)(t0 + tt) * 3072;
            const u32x4 gb = *(const GAS u32x4*)(r + c0), gc = *(const GAS u32x4*)(r + 1024 + c0), hd = *(const GAS u32x4*)(r + 2048 + c0);
            float p0[8], o[8];
#pragma unroll
            for (int e = 0; e < 4; ++e) { p0[2 * e] = bflo(gc[e]) * bflo(hd[e]); p0[2 * e + 1] = bfhi(gc[e]) * bfhi(hd[e]); }
#pragma unroll
            for (int e = 0; e < 8; ++e) { const float cv = w[0][e] * p2[e] + w[1][e] * p1[e] + w[2][e] * p0[e]; const float g = (e & 1) ? bfhi(gb[e >> 1]) : bflo(gb[e >> 1]); o[e] = g * cv; p2[e] = p1[e]; p1[e] = p0[e]; }
            u32x4 wv; wv.x = pk2(o[0], o[1]); wv.y = pk2(o[2], o[3]); wv.z = pk2(o[4], o[5]); wv.w = pk2(o[6], o[7]);
            *(GAS u32x4*)(ub + (size_t)(t0 + tt) * D + c0) = wv; }
    }
}

constexpr int D1_KF = 0, D1_VF = 32768, D1_UW = 0, D1_QB = 65536, D1_KB = D1_QB + 17408, D1_AM = D1_KB + 17408, D1_AT = D1_AM + 16384, D1_KT = D1_AT + 9216, D1_GC = D1_KT + 18432;
constexpr int RSB = 272, RSS = 144;
static_assert(D1_GC + 3 * 256 <= MISC_OFF, "D1 LDS");
__device__ __forceinline__ f32x4 tile_k64(const LAS unsigned char* xr, const LAS unsigned char* yr) {
    f32x4 acc = {0.f, 0.f, 0.f, 0.f};
#pragma unroll
    for (int s = 0; s < 2; ++s) acc = __builtin_amdgcn_mfma_f32_16x16x32_bf16(*(const LAS bf16x8*)(xr + 64 * s), *(const LAS bf16x8*)(yr + 64 * s), acc, 0, 0, 0);
    return acc;
}
__device__ __forceinline__ void d1_unit(Frame& F, const Args& A, int unit) {
    const int bh = unit >> 6, n = unit & 63, b = bh >> 2, h = bh & 3;
    const int t0 = b * SEQ + n * 64;
    const int lane = F.lane, wave = F.wave, g = lane >> 4, c = lane & 15;
    LAS unsigned char* L = F.lds;
    LAS float* KF = opq_v((LAS float*)(L + D1_KF)); LAS float* VF = opq_v((LAS float*)(L + D1_VF)); LAS float* AM = opq_v((LAS float*)(L + D1_AM));
    LAS float* gcs = opq_v((LAS float*)(L + D1_GC)); LAS float* betas = gcs + 64; LAS float* bexp = gcs + 128;
    LAS unsigned char* LQB = opq_v(L + D1_QB); LAS unsigned char* LKB = opq_v(L + D1_KB); LAS unsigned char* LAT = opq_v(L + D1_AT); LAS unsigned char* LKT = opq_v(L + D1_KT); LAS unsigned char* LUW = opq_v(L + D1_UW);
    float gc = WSP(float, WS_GG)[(size_t)(t0 + lane) * 4 + h];
#pragma unroll
    for (int o = 1; o < 64; o <<= 1) { const float t = __shfl_up(gc, o); if (lane >= o) gc += t; }
    const float bt = WSP(float, WS_BETA)[(size_t)(t0 + lane) * 4 + h];
    const float gc63 = __shfl(gc, 63);
    if (wave == 0) { gcs[lane] = gc; betas[lane] = bt; bexp[lane] = bt * __expf(gc); }
    {
        const bf16* pre = WSP(bf16, WS_QKVPRE);
        const float* cwp = A.in[3];
        float ov[3][8][2];
#pragma unroll
        for (int x = 0; x < 3; ++x) {
            const int ch = x * 512 + h * 128 + 2 * lane;
            float cw[4][2];
#pragma unroll
            for (int j = 0; j < 4; ++j) { const f32x2 w2 = *(const GAS f32x2*)(cwp + j * 1536 + ch); cw[j][0] = w2[0]; cw[j][1] = w2[1]; }
            float win[11][2];
#pragma unroll
            for (int r = 0; r < 11; ++r) { const int pos = n * 64 + wave * 8 + r - 3; unsigned dw = 0u;
                if (pos >= 0) dw = *(const GAS unsigned*)(pre + (size_t)(t0 + wave * 8 + r - 3) * 1536 + ch);
                win[r][0] = bflo(dw); win[r][1] = bfhi(dw); }
#pragma unroll
            for (int tt = 0; tt < 8; ++tt)
#pragma unroll
                for (int e = 0; e < 2; ++e) { const float s = cw[0][e] * win[tt][e] + cw[1][e] * win[tt + 1][e] + cw[2][e] * win[tt + 2][e] + cw[3][e] * win[tt + 3][e]; ov[x][tt][e] = silu_f(s); }
        }
#pragma unroll
        for (int tt = 0; tt < 8; ++tt) {
            const int i = wave * 8 + tt;
            const float sq = wave_sum(ov[0][tt][0] * ov[0][tt][0] + ov[0][tt][1] * ov[0][tt][1]);
            const float sk = wave_sum(ov[1][tt][0] * ov[1][tt][0] + ov[1][tt][1] * ov[1][tt][1]);
            const float rq = rsqrtf(sq + RMS_EPS) * 0.08838834764831845f, rk = rsqrtf(sk + RMS_EPS);
            const float q0 = ov[0][tt][0] * rq, q1 = ov[0][tt][1] * rq, k0 = ov[1][tt][0] * rk, k1 = ov[1][tt][1] * rk;
            const float gci = __shfl(gc, i);
            const float kt = __expf(gc63 - gci);
            *(LAS f32x2*)(KF + i * 128 + 2 * lane) = (f32x2){k0, k1};
            *(LAS f32x2*)(VF + i * 128 + 2 * lane) = (f32x2){ov[2][tt][0], ov[2][tt][1]};
            *(LAS unsigned*)(LQB + i * RSB + 4 * lane) = pk2(q0, q1);
            *(LAS unsigned*)(LKB + i * RSB + 4 * lane) = pk2(k0, k1);
            *(LAS unsigned short*)(LKT + (2 * lane) * RSS + 2 * i) = (unsigned short)f2bf(k0 * kt);
            *(LAS unsigned short*)(LKT + (2 * lane + 1) * RSS + 2 * i) = (unsigned short)f2bf(k1 * kt);
        }
    }
    __syncthreads();
#pragma unroll 1
    for (int it = 0; it < 4; ++it) {
        const int id = wave + 8 * it, isq = id >> 4, mi = (id & 15) >> 2, nj = id & 3;
        f32x4 acc = {0.f, 0.f, 0.f, 0.f};
        if (mi >= nj) {
            const LAS unsigned char* xr = (isq ? LQB : LKB) + (16 * mi + c) * RSB + 16 * g;
            const LAS unsigned char* yr = LKB + (16 * nj + c) * RSB + 16 * g;
#pragma unroll
            for (int s = 0; s < 4; ++s) acc = __builtin_amdgcn_mfma_f32_16x16x32_bf16(*(const LAS bf16x8*)(xr + 64 * s), *(const LAS bf16x8*)(yr + 64 * s), acc, 0, 0, 0);
        }
        const int j = 16 * nj + c; const float gj = gcs[j];
#pragma unroll
        for (int r = 0; r < 4; ++r) { const int i = 16 * mi + 4 * g + r; const float dec = (i >= j) ? __expf(gcs[i] - gj) : 0.f;
            if (!isq) AM[i * 64 + j] = (i > j) ? betas[i] * acc[r] * dec : 0.f;
            else *(LAS unsigned short*)(LAT + i * RSS + 2 * j) = (unsigned short)f2bf((i >= j) ? acc[r] * dec : 0.f); }
    }
    __syncthreads();
    float u[64];
    if (F.tid < 256) {
        const int col = F.tid;
        const LAS float* cp = (col < 128) ? VF + col : KF + (col - 128);
        const LAS float* sp = (col < 128) ? betas : bexp;
#pragma unroll
        for (int i = 0; i < 64; ++i) u[i] = 0.f;
#pragma unroll
        for (int i = 0; i < 64; ++i) {
            float acc = sp[i] * cp[i * 128];
#pragma unroll
            for (int j4 = 0; j4 < (i + 3) / 4; ++j4) { const f32x4 a = *(const LAS f32x4*)(AM + i * 64 + 4 * j4);
                acc -= a[0] * u[4 * j4]; acc -= a[1] * u[4 * j4 + 1]; acc -= a[2] * u[4 * j4 + 2]; acc -= a[3] * u[4 * j4 + 3]; }
            u[i] = acc;
        }
    }
    __syncthreads();
    if (F.tid < 256) {
        LAS unsigned char* row = LUW + F.tid * RSS;
#pragma unroll
        for (int q = 0; q < 8; ++q) { u32x4 w; w.x = pk2(u[8 * q], u[8 * q + 1]); w.y = pk2(u[8 * q + 2], u[8 * q + 3]); w.z = pk2(u[8 * q + 4], u[8 * q + 5]); w.w = pk2(u[8 * q + 6], u[8 * q + 7]); *(LAS u32x4*)(row + 16 * q) = w; }
    }
    __syncthreads();
    const LAS unsigned char* UWr = LUW; const LAS unsigned char* ATr = LAT; const LAS unsigned char* KTr = LKT;
    const size_t cbase = (size_t)unit;
    for (int t = wave; t < 32; t += 8) { const int xi = t >> 3, yj = t & 7;
        const f32x4 d = tile_k64(ATr + (16 * xi + c) * RSS + 16 * g, UWr + (16 * yj + c) * RSS + 16 * g);
        u32x2 w; w.x = pk2(d[0], d[1]); w.y = pk2(d[2], d[3]);
        *(GAS u32x2*)(WSP(bf16, WS_OLOCT) + cbase * 8192 + (size_t)(16 * yj + c) * 64 + 16 * xi + 4 * g) = w; }
    for (int t = wave; t < 32; t += 8) { const int xi = t >> 2, yj = t & 3;
        const f32x4 d = tile_k64(UWr + (128 + 16 * xi + c) * RSS + 16 * g, ATr + (16 * yj + c) * RSS + 16 * g);
        const int i = 16 * yj + c, dd = 16 * xi + 4 * g; const float eg = __expf(gcs[i]);
        const u32x2 qv = *(const LAS u32x2*)(LQB + i * RSB + 2 * dd);
        u32x2 w; w.x = pk2(bflo(qv.x) * eg - d[0], bfhi(qv.x) * eg - d[1]); w.y = pk2(bflo(qv.y) * eg - d[2], bfhi(qv.y) * eg - d[3]);
        *(GAS u32x2*)(WSP(bf16, WS_QEFF) + cbase * 8192 + (size_t)i * 128 + dd) = w; }
    for (int t = wave; t < 64; t += 8) { const int xi = t >> 3, yj = t & 7;
        const f32x4 d = tile_k64(KTr + (16 * xi + c) * RSS + 16 * g, UWr + (16 * yj + c) * RSS + 16 * g);
        u32x2 w; w.x = pk2(d[0], d[1]); w.y = pk2(d[2], d[3]);
        *(GAS u32x2*)(WSP(bf16, WS_BMT) + cbase * 16384 + (size_t)(16 * yj + c) * 128 + 16 * xi + 4 * g) = w; }
    for (int t = wave; t < 64; t += 8) { const int xi = t >> 3, yj = t & 7;
        const f32x4 d = tile_k64(UWr + (128 + 16 * xi + c) * RSS + 16 * g, KTr + (16 * yj + c) * RSS + 16 * g);
        u32x2 w; w.x = pk2(-d[0], -d[1]); w.y = pk2(-d[2], -d[3]);
        *(GAS u32x2*)(WSP(bf16, WS_MNEG) + cbase * 16384 + (size_t)(16 * yj + c) * 128 + 16 * xi + 4 * g) = w; }
    if (F.tid == 0) WSP(float, WS_GLAST)[unit] = __expf(gc63);
    __syncthreads();
}

constexpr int SCAN_PF = 4;
__device__ __forceinline__ void scan_wg(Frame& F, int sw) {
    const int bh = sw >> 3, slice = sw & 7, b = bh >> 2, h = bh & 3;
    const int lane = F.lane, wave = F.wave, g = lane >> 4, c = lane & 15;
    LAS unsigned char* ST = opq_v(F.lds);
    for (int i = F.tid; i < 2 * 4352 / 4; i += 512) ((LAS unsigned*)ST)[i] = 0u;
    __syncthreads();
    const bf16* MN = WSP(bf16, WS_MNEG) + (size_t)bh * 64 * 16384; const bf16* BM = WSP(bf16, WS_BMT) + (size_t)bh * 64 * 16384;
    const bf16* QE = WSP(bf16, WS_QEFF) + (size_t)bh * 64 * 8192; const bf16* OL = WSP(bf16, WS_OLOCT) + (size_t)bh * 64 * 8192;
    const float* GL = WSP(float, WS_GLAST) + bh * 64;
    if (wave < 4) {
        f32x4 Sreg[2] = {{0.f, 0.f, 0.f, 0.f}, {0.f, 0.f, 0.f, 0.f}};
        bf16x8 Af[SCAN_PF][2][4]; u32x2 bm[SCAN_PF][2]; float gl[SCAN_PF];
#define SCAN_LOAD_REC(j, n) do { const size_t cb_ = (size_t)(n) * 16384; \
        _Pragma("unroll") for (int mt = 0; mt < 2; ++mt) { _Pragma("unroll") for (int s = 0; s < 4; ++s) Af[j][mt][s] = *(const GAS bf16x8*)(MN + cb_ + (size_t)(32 * wave + 16 * mt + c) * 128 + 32 * s + 8 * g); \
            bm[j][mt] = *(const GAS u32x2*)(BM + cb_ + (size_t)(16 * slice + c) * 128 + 32 * wave + 16 * mt + 4 * g); } gl[j] = GL[n]; } while (0)
#pragma unroll
        for (int j = 0; j < SCAN_PF; ++j) SCAN_LOAD_REC(j, j);
#pragma unroll 1
        for (int n0 = 0; n0 < 64; n0 += SCAN_PF) {
#pragma unroll
            for (int j = 0; j < SCAN_PF; ++j) {
                const int n = n0 + j; const int cur = n & 1;
                bf16x8 Sb[4];
#pragma unroll
                for (int s = 0; s < 4; ++s) Sb[s] = *(const LAS bf16x8*)(ST + cur * 4352 + c * 272 + 64 * s + 16 * g);
#pragma unroll
                for (int mt = 0; mt < 2; ++mt) {
                    f32x4 acc; acc[0] = gl[j] * Sreg[mt][0] + bflo(bm[j][mt].x); acc[1] = gl[j] * Sreg[mt][1] + bfhi(bm[j][mt].x); acc[2] = gl[j] * Sreg[mt][2] + bflo(bm[j][mt].y); acc[3] = gl[j] * Sreg[mt][3] + bfhi(bm[j][mt].y);
#pragma unroll
                    for (int s = 0; s < 4; ++s) acc = __builtin_amdgcn_mfma_f32_16x16x32_bf16(Af[j][mt][s], Sb[s], acc, 0, 0, 0);
                    Sreg[mt] = acc;
                    u32x2 w; w.x = pk2(acc[0], acc[1]); w.y = pk2(acc[2], acc[3]);
                    *(LAS u32x2*)(ST + (cur ^ 1) * 4352 + c * 272 + 2 * (32 * wave + 16 * mt + 4 * g)) = w;
                }
                if (n + SCAN_PF < 64) SCAN_LOAD_REC(j, n + SCAN_PF);
                __syncthreads();
            }
        }
#undef SCAN_LOAD_REC
    } else {
        const int m = wave - 4;
        bf16x8 Qf[SCAN_PF][4]; u32x2 ol[SCAN_PF];
        bf16* OU = WSP(bf16, WS_OUN) + (size_t)(b * SEQ) * 512 + h * 128 + 16 * slice + c;
#define SCAN_LOAD_OUT(j, n) do { const size_t cb_ = (size_t)(n) * 8192; \
        _Pragma("unroll") for (int s = 0; s < 4; ++s) Qf[j][s] = *(const GAS bf16x8*)(QE + cb_ + (size_t)(16 * m + c) * 128 + 32 * s + 8 * g); \
        ol[j] = *(const GAS u32x2*)(OL + cb_ + (size_t)(16 * slice + c) * 64 + 16 * m + 4 * g); } while (0)
#pragma unroll
        for (int j = 0; j < SCAN_PF; ++j) SCAN_LOAD_OUT(j, j);
#pragma unroll 1
        for (int n0 = 0; n0 < 64; n0 += SCAN_PF) {
#pragma unroll
            for (int j = 0; j < SCAN_PF; ++j) {
                const int n = n0 + j; const int cur = n & 1;
                bf16x8 Sb[4];
#pragma unroll
                for (int s = 0; s < 4; ++s) Sb[s] = *(const LAS bf16x8*)(ST + cur * 4352 + c * 272 + 64 * s + 16 * g);
                f32x4 acc; acc[0] = bflo(ol[j].x); acc[1] = bfhi(ol[j].x); acc[2] = bflo(ol[j].y); acc[3] = bfhi(ol[j].y);
#pragma unroll
                for (int s = 0; s < 4; ++s) acc = __builtin_amdgcn_mfma_f32_16x16x32_bf16(Qf[j][s], Sb[s], acc, 0, 0, 0);
#pragma unroll
                for (int r = 0; r < 4; ++r) OU[(size_t)(n * 64 + 16 * m + 4 * g + r) * 512] = (bf16)f2bf(acc[r]);
                if (n + SCAN_PF < 64) SCAN_LOAD_OUT(j, n + SCAN_PF);
                __syncthreads();
            }
        }
#undef SCAN_LOAD_OUT
    }
}

constexpr int AT_KS = 0, AT_VS = 36864;
__device__ __forceinline__ s16x4 vtr(const LAS unsigned char* p) { typedef short v4i16_t __attribute__((ext_vector_type(4))); return __builtin_bit_cast(s16x4, __builtin_amdgcn_ds_read_tr16_b64_v4i16((LAS v4i16_t*)p)); }
__device__ __forceinline__ void attn_unit(Frame& F, int a) {
    const int bhh = a / 96, rem = a % 96, br = rem >> 5, idx = rem & 31, b = bhh >> 3, hh = bhh & 7;
    const int dil = br == 0 ? 1 : br == 1 ? 4 : 16, nblk = 32 / dil, res = idx / nblk, n = idx % nblk;
    const int lane = F.lane, wave = F.wave, g = lane >> 4, c = lane & 15;
    LAS unsigned char* L = opq_v(F.lds);
    const bf16* QKVD = WSP(bf16, WS_QKVD);
    {
        const int j = F.tid >> 1, half = F.tid & 1; const int kidx = 128 * (n - 1) + j;
        u32x4 kv[4], vv[4];
        if (kidx >= 0) { const bf16* src = QKVD + (size_t)(b * SEQ + kidx * dil + res) * 1536 + hh * 64 + half * 32;
#pragma unroll
            for (int q = 0; q < 4; ++q) { kv[q] = *(const GAS u32x4*)(src + 512 + 8 * q); vv[q] = *(const GAS u32x4*)(src + 1024 + 8 * q); } }
        else {
#pragma unroll
            for (int q = 0; q < 4; ++q) { kv[q] = (u32x4){0u, 0u, 0u, 0u}; vv[q] = (u32x4){0u, 0u, 0u, 0u}; } }
#pragma unroll
        for (int q = 0; q < 4; ++q) { *(LAS u32x4*)(L + AT_KS + j * RSS + half * 64 + 16 * q) = kv[q]; *(LAS u32x4*)(L + AT_VS + j * RSS + half * 64 + 16 * q) = vv[q]; }
    }
    const int qi = 16 * wave + c;
    const size_t qtok = (size_t)(b * SEQ + (128 * n + qi) * dil + res);
    bf16x8 Bq[2];
#pragma unroll
    for (int s = 0; s < 2; ++s) Bq[s] = *(const GAS bf16x8*)(QKVD + qtok * 1536 + hh * 64 + 32 * s + 8 * g);
    __syncthreads();
    f32x4 sc[9];
    float mx = -1.0e30f;
#pragma unroll
    for (int t = 0; t < 9; ++t) {
        const LAS unsigned char* kr = L + AT_KS + (16 * (wave + t) + c) * RSS + 16 * g;
        f32x4 acc = {0.f, 0.f, 0.f, 0.f};
        acc = __builtin_amdgcn_mfma_f32_16x16x32_bf16(*(const LAS bf16x8*)kr, Bq[0], acc, 0, 0, 0);
        acc = __builtin_amdgcn_mfma_f32_16x16x32_bf16(*(const LAS bf16x8*)(kr + 64), Bq[1], acc, 0, 0, 0);
#pragma unroll
        for (int r = 0; r < 4; ++r) { const int j = 16 * (wave + t) + 4 * g + r; const bool ok = (j >= qi) && (j <= qi + 128) && (n > 0 || j >= 128);
            acc[r] = ok ? acc[r] * (0.125f * 1.4426950408889634f) : -1.0e30f; mx = fmaxf(mx, acc[r]); }
        sc[t] = acc;
    }
    mx = fmaxf(mx, __shfl_xor(mx, 16)); mx = fmaxf(mx, __shfl_xor(mx, 32));
    float lsum = 0.f;
#pragma unroll
    for (int t = 0; t < 9; ++t)
#pragma unroll
        for (int r = 0; r < 4; ++r) { const float p = __builtin_amdgcn_exp2f(sc[t][r] - mx); sc[t][r] = p; lsum += p; }
    lsum += __shfl_xor(lsum, 16); lsum += __shfl_xor(lsum, 32);
    bf16x8 pf[5];
#pragma unroll
    for (int u = 0; u < 5; ++u) { u32x4 w; w.x = pk2(sc[2 * u][0], sc[2 * u][1]); w.y = pk2(sc[2 * u][2], sc[2 * u][3]);
        if (u < 4) { w.z = pk2(sc[2 * u + 1][0], sc[2 * u + 1][1]); w.w = pk2(sc[2 * u + 1][2], sc[2 * u + 1][3]); } else { w.z = 0u; w.w = 0u; }
        pf[u] = __builtin_bit_cast(bf16x8, w); }
    float linv[4];
#pragma unroll
    for (int r = 0; r < 4; ++r) linv[r] = 1.f / __shfl(lsum, 4 * g + r);
    bf16* OP = WSP(bf16, WS_OPART) + (size_t)br * T * 512;
#pragma unroll
    for (int dt = 0; dt < 4; ++dt) {
        f32x4 acc = {0.f, 0.f, 0.f, 0.f};
#pragma unroll
        for (int u = 0; u < 5; ++u) { const int kb = 16 * (wave + 2 * u);
            const LAS unsigned char* vp = L + AT_VS + (kb + 4 * g + (c >> 2)) * RSS + (16 * dt + 4 * (c & 3)) * 2;
            const s16x4 lo = vtr(vp); s16x4 hi = {0, 0, 0, 0}; if (u < 4) hi = vtr(vp + 16 * RSS);
            const bf16x8 bv = {lo[0], lo[1], lo[2], lo[3], hi[0], hi[1], hi[2], hi[3]};
            acc = __builtin_amdgcn_mfma_f32_16x16x32_bf16(pf[u], bv, acc, 0, 0, 0); }
#pragma unroll
        for (int r = 0; r < 4; ++r) { const size_t tok = (size_t)(b * SEQ + (128 * n + 16 * wave + 4 * g + r) * dil + res);
            OP[tok * 512 + hh * 64 + 16 * dt + c] = (bf16)f2bf(acc[r] * linv[r]); }
    }
    if (g == 0) WSP(float, WS_LSE)[((size_t)br * T + qtok) * 8 + hh] = (mx + __log2f(lsum)) * 0.6931471805599453f;
    __syncthreads();
}

__device__ __forceinline__ void mix_pass(Frame& F, const Args& A) {
    const int lane = F.lane;
    float nw[8];
    { const f32x4 a = *(const GAS f32x4*)(A.in[6] + 8 * (lane & 15)), b = *(const GAS f32x4*)(A.in[6] + 8 * (lane & 15) + 4);
#pragma unroll
      for (int e = 0; e < 4; ++e) { nw[e] = a[e]; nw[4 + e] = b[e]; } }
    const bf16* OU = WSP(bf16, WS_OUN); const bf16* ZB = WSP(bf16, WS_ZB); const bf16* OP = WSP(bf16, WS_OPART); const float* LSE = WSP(float, WS_LSE); bf16* MIX = WSP(bf16, WS_MIX);
    for (int t = F.gw; t < T; t += F.NGW) {
        const u32x4 uo = *(const GAS u32x4*)(OU + (size_t)t * 512 + 8 * lane), uz = *(const GAS u32x4*)(ZB + (size_t)t * 512 + 8 * lane);
        float x[8], z[8];
#pragma unroll
        for (int e = 0; e < 4; ++e) { x[2 * e] = bflo(uo[e]); x[2 * e + 1] = bfhi(uo[e]); z[2 * e] = bflo(uz[e]); z[2 * e + 1] = bfhi(uz[e]); }
        float ss = 0.f;
#pragma unroll
        for (int e = 0; e < 8; ++e) ss += x[e] * x[e];
        ss += __shfl_xor(ss, 1); ss += __shfl_xor(ss, 2); ss += __shfl_xor(ss, 4); ss += __shfl_xor(ss, 8);
        const float rstd = rsqrtf(ss * (1.f / 128.f) + RMS_EPS);
        float o[8];
#pragma unroll
        for (int e = 0; e < 8; ++e) o[e] = x[e] * rstd * nw[e] * silu_f(z[e]);
        u32x4 w; w.x = pk2(o[0], o[1]); w.y = pk2(o[2], o[3]); w.z = pk2(o[4], o[5]); w.w = pk2(o[6], o[7]);
        *(GAS u32x4*)(MIX + (size_t)t * D + 8 * lane) = w;
        const int hh = lane >> 3;
        const float l0 = LSE[((size_t)0 * T + t) * 8 + hh], l1 = LSE[((size_t)1 * T + t) * 8 + hh], l2 = LSE[((size_t)2 * T + t) * 8 + hh];
        const float lm = fmaxf(l0, fmaxf(l1, l2)); const float e0 = __expf(l0 - lm), e1 = __expf(l1 - lm), e2 = __expf(l2 - lm); const float inv = 1.f / (e0 + e1 + e2);
        const u32x4 p0 = *(const GAS u32x4*)(OP + ((size_t)0 * T + t) * 512 + 8 * lane), p1 = *(const GAS u32x4*)(OP + ((size_t)1 * T + t) * 512 + 8 * lane), p2 = *(const GAS u32x4*)(OP + ((size_t)2 * T + t) * 512 + 8 * lane);
        const float w0 = e0 * inv, w1 = e1 * inv, w2 = e2 * inv;
        u32x4 wo;
#pragma unroll
        for (int e = 0; e < 4; ++e) wo[e] = pk2(w0 * bflo(p0[e]) + w1 * bflo(p1[e]) + w2 * bflo(p2[e]), w0 * bfhi(p0[e]) + w1 * bfhi(p1[e]) + w2 * bfhi(p2[e]));
        *(GAS u32x4*)(MIX + (size_t)t * D + 512 + 8 * lane) = wo;
    }
}

constexpr int N_PHASES = 29;
__global__ void __launch_bounds__(512, 2) fwd_kernel(Args args) {
    extern __shared__ __attribute__((aligned(16))) unsigned char lds_raw[];
    Frame F;
    F.lds = (LAS unsigned char*)lds_raw; F.ws = args.ws; F.ctl = (gu32*)(args.ws + WS_CTL);
    F.tid = threadIdx.x; F.lane = F.tid & 63; F.wave = __builtin_amdgcn_readfirstlane(F.tid >> 6);
    F.G = gridDim.x; F.gw = blockIdx.x * 8 + F.wave; F.NGW = F.G * 8;
    volatile LAS unsigned* MISC = (volatile LAS unsigned*)(F.lds + MISC_OFF); const char* wsb = (const char*)args.ws;
    for (int u = F.tid; u < 256; u += 512) MISC[u] = 0u;
    __syncthreads();
    const int lo = args.ph_lo, hi = args.ph_hi;
    XcdBarrier bar; bar.bar = (unsigned*)(F.ctl + CW_BAR); bar.x = 0; bar.st = MISC + 8;
    if (hi - lo > 1) bar = xcd_barrier_post((unsigned*)(F.ctl + CW_BAR), MISC + 8);
    LAS unsigned char* ring = F.lds; LAS unsigned char* xch = F.lds + XCH_OFF;
    volatile LAS unsigned* tab = MISC + 32;
    const int c = blockIdx.x, G = F.G;
#ifndef PHASE_MASK
#define PHASE_MASK 0xFFFFFFFFu
#endif
#define IN(k) ((((PHASE_MASK) >> (k)) & 1u) && lo <= (k) && (k) < hi)
#define SEAM(k) do { if (IN(k) && IN((k) + 1)) xcd_barrier(bar); } while (0)
#define PH_BEGIN() do { const int t_ = opq_v((int)threadIdx.x); F.tid = t_; F.lane = t_ & 63; F.wave = __builtin_amdgcn_readfirstlane(t_ >> 6); F.gw = blockIdx.x * 8 + F.wave; \
        unsigned char* w_ = opq_s(args.ws); F.ws = w_; F.ctl = (gu32*)(w_ + WS_CTL); xch = opq_v(F.lds + XCH_OFF); MISC = (volatile LAS unsigned*)opq_v(F.lds + MISC_OFF); tab = MISC + 32; bar.st = MISC + 8; wsb = (const char*)w_; } while (0)
#define HBc (wsb + WS_HB)

    if (IN(0)) { PH_BEGIN(); p0_prologue(F, args); SEAM(0); }
    if (IN(1)) { PH_BEGIN();
        SchedP1 S{HBc, (const char*)(wsb + WS_W_IN), (const char*)(wsb + WS_MEMB), (const char*)(wsb + WS_W_KV), G, c};
        EpiP1 E{WSP(bf16, WS_QKVPRE), WSP(bf16, WS_ZB), WSP(bf16, WS_QKVD), WSP(bf16, WS_KMEM), WSP(bf16, WS_VT)};
        pg8::gemm_phase(ring, xch, pg8::Gemm{D, D, D}, S, E); SEAM(1);
    }
    if (IN(2)) { PH_BEGIN(); for (int u = c; u < NB * DNH * NCHUNK; u += G) d1_unit(F, args, u); SEAM(2); }
    if (IN(3)) { PH_BEGIN();
        if (c < 128) scan_wg(F, c);
        for (;;) {
            if (F.tid == 0) MISC[20] = __hip_atomic_fetch_add((unsigned*)(F.ctl + CW_QUEUE), 1u, RLX_AGENT);
            __syncthreads(); const int a = (int)MISC[20]; __syncthreads();
            if (a >= NB * DAH * 96) break;
            attn_unit(F, a);
        }
        SEAM(3);
    }
    if (IN(4)) { PH_BEGIN(); mix_pass(F, args); SEAM(4); }

#pragma unroll
    for (int layer = 0; layer < 2; ++layer) {
        const int pb = layer * 13;
        if (layer == 0) {
            if (IN(5)) { PH_BEGIN(); convert_moe(F, args, 0); __syncthreads();
                SchedDense S{(const char*)(wsb + WS_MIX), (const char*)(wsb + WS_W_ABO), D, D, 64, 4, G, c}; EpiDense E{WSP(bf16, 288 * MiB), D, 1.f};
                pg8::gemm_phase(ring, xch, pg8::Gemm{D, D, D}, S, E); SEAM(5); }
            if (IN(6)) { PH_BEGIN(); ln_pass<0, false, false>(F, args, args.in[0], WSP(bf16, 288 * MiB), 0, WSP(float, WS_H), WSP(bf16, WS_HB), nullptr); SEAM(6); }
        } else {
            if (IN(16)) { PH_BEGIN(); convert_moe(F, args, 1); __syncthreads();
                SchedDense S{HBc, (const char*)(wsb + WS_W_SCI), D, D, 64, 12, G, c}; EpiDense E{WSP(bf16, 192 * MiB), 3 * D, 1.f};
                pg8::gemm_phase(ring, xch, pg8::Gemm{D, D, D}, S, E); SEAM(16); }
            if (IN(17)) { PH_BEGIN(); conv_pass(F, args, WSP(bf16, 192 * MiB), WSP(bf16, 288 * MiB)); SEAM(17); }
            if (IN(18)) { PH_BEGIN(); SchedDense S{(const char*)(wsb + 288 * MiB), (const char*)(wsb + WS_W_SCO), D, D, 64, 4, G, c}; EpiDense E{WSP(bf16, 192 * MiB), D, 1.f};
                pg8::gemm_phase(ring, xch, pg8::Gemm{D, D, D}, S, E); SEAM(18); }
            if (IN(19)) { PH_BEGIN(); ln_pass<0, false, false>(F, args, WSP(float, WS_H), WSP(bf16, 192 * MiB), 3, WSP(float, WS_H), WSP(bf16, WS_HB), nullptr); SEAM(19); }
        }
        const size_t oQ = (layer == 0 ? 192 : 224) * MiB, oP = (layer == 0 ? 224 : 256) * MiB, oO = (layer == 0 ? 256 : 288) * MiB, oY = (layer == 0 ? 288 : 192) * MiB;
        const int p7 = layer == 0 ? 7 : 20;
        if (IN(p7)) { PH_BEGIN(); SchedDense S{HBc, (const char*)(wsb + WS_W_Q + (size_t)layer * D * D * 2), D, D, 64, 4, G, c}; EpiDense E{WSP(bf16, oQ), D, 0.0625f * 1.4426950408889634f};
            pg8::gemm_phase(ring, xch, pg8::Gemm{D, D, D}, S, E); SEAM(p7); }
        if (IN(p7 + 1)) { PH_BEGIN(); SchedXS S{(const char*)(wsb + oQ), (const char*)(wsb + WS_KMEM + (size_t)layer * TM * D * 2), G, c}; EpiSoftmax E{WSP(bf16, oP)};
            pg8::gemm_phase(ring, xch, pg8::Gemm{D, D, XD}, S, E); SEAM(p7 + 1); }
        if (IN(p7 + 2)) { PH_BEGIN(); SchedXP S{(const char*)(wsb + oP), (const char*)(wsb + WS_VT + (size_t)layer * NB * XH * XD * NMEM * 2), G, c};
            EpiDense E{WSP(bf16, oO), D, 1.f};
            pg8::gemm_phase(ring, xch, pg8::Gemm{D, NMEM, NMEM}, S, E); SEAM(p7 + 2); }
        if (IN(p7 + 3)) { PH_BEGIN(); SchedDense S{(const char*)(wsb + oO), (const char*)(wsb + WS_W_O + (size_t)layer * D * D * 2), D, D, 64, 4, G, c}; EpiDense E{WSP(bf16, oY), D, 1.f};
            pg8::gemm_phase(ring, xch, pg8::Gemm{D, D, D}, S, E); SEAM(p7 + 3); }
        unsigned* cnt = (unsigned*)(F.ctl + (layer == 0 ? CW_CNT0 : CW_CNT1));
        if (IN(p7 + 4)) { PH_BEGIN(); ln_pass<0, true, false>(F, args, WSP(float, WS_H), WSP(bf16, oY), layer * 3 + 1, WSP(float, WS_H), WSP(bf16, WS_HB), cnt); SEAM(p7 + 4); }
        if (IN(p7 + 5)) { PH_BEGIN(); moe_table(F, cnt, tab); moe_gather(F, WSP(bf16, WS_HB), WSP(bf16, WS_XG), tab); SEAM(p7 + 5); }
        if (IN(p7 + 6)) { PH_BEGIN(); moe_table(F, cnt, tab);
            SchedMoE S{(const char*)(wsb + WS_XG), (const char*)(wsb + WS_MOEW_GU), tab, D, D, D, G, c}; EpiSwiglu E{WSP(bf16, WS_HACT)};
            pg8::gemm_phase(ring, xch, pg8::Gemm{D, D, D}, S, E); SEAM(p7 + 6); }
        if (IN(p7 + 7)) { PH_BEGIN(); moe_table(F, cnt, tab);
            SchedMoE S{(const char*)(wsb + WS_HACT), (const char*)(wsb + WS_MOEW_D), tab, DE, D, DE, G, c}; EpiDense E{WSP(bf16, WS_XG), D, 1.f};
            pg8::gemm_phase(ring, xch, pg8::Gemm{DE, DE, DE}, S, E); SEAM(p7 + 7); }
        if (IN(p7 + 8)) { PH_BEGIN();
            if (layer == 0) { ln_pass<1, false, false>(F, args, WSP(float, WS_H), WSP(bf16, WS_XG), 2, WSP(float, WS_H), WSP(bf16, WS_HB), nullptr); SEAM(p7 + 8); }
            else ln_pass<1, false, true>(F, args, WSP(float, WS_H), WSP(bf16, WS_XG), 5, args.out, nullptr, nullptr);
        }
        (void)pb;
    }
#undef IN
#undef SEAM
}

extern "C" void kernel_launch(void* const* d_in, const int* in_sizes, int n_in, void* d_out, int out_size, void* d_ws, size_t ws_size, hipStream_t stream) {
    static int grid = 0;
    if (grid == 0) {
        if (n_in != 21 || out_size != T * D || ws_size < WS_END) { fprintf(stderr, "kernel_launch: unexpected problem (n_in %d, out %d, ws %zu < %zu)\n", n_in, out_size, ws_size, (size_t)WS_END); grid = -1; return; }
        int dev = 0, cus = 0, per_cu = 0;
        if (hipGetDevice(&dev) != hipSuccess || hipDeviceGetAttribute(&cus, hipDeviceAttributeMultiprocessorCount, dev) != hipSuccess) { grid = -1; return; }
        if (hipFuncSetAttribute((const void*)fwd_kernel, hipFuncAttributeMaxDynamicSharedMemorySize, LDS_BYTES) != hipSuccess) { fprintf(stderr, "kernel_launch: hipFuncSetAttribute failed\n"); grid = -1; return; }
        if (hipOccupancyMaxActiveBlocksPerMultiprocessor(&per_cu, (const void*)fwd_kernel, 512, LDS_BYTES) != hipSuccess || per_cu < 1) { fprintf(stderr, "kernel_launch: occupancy query says %d blocks per CU\n", per_cu); (void)hipGetLastError(); per_cu = 1; }
        grid = cus;
    }
    if (grid < 0) return;
    (void)hipMemsetAsync((char*)d_ws + WS_CTL, 0, CTL_ZERO_BYTES, stream);
    Args a{};
    for (int i = 0; i < 21; ++i) a.in[i] = (const float*)d_in[i];
    a.out = (float*)d_out; a.ws = (unsigned char*)d_ws;
#if MK_ONE_LAUNCH
    a.ph_lo = 0; a.ph_hi = N_PHASES;
    hipLaunchKernelGGL(fwd_kernel, dim3(grid), dim3(512), LDS_BYTES, stream, a);
#else
    for (int p = 0; p < N_PHASES; ++p) { a.ph_lo = p; a.ph_hi = p + 1; hipLaunchKernelGGL(fwd_kernel, dim3(grid), dim3(512), LDS_BYTES, stream, a); }
#endif
}
```

```cpp
#include <hip/hip_runtime.h>
#include <cstdio>
#include <cstdint>

#ifndef MK_ONE_LAUNCH
#define MK_ONE_LAUNCH 1
#endif

#define LAS __attribute__((address_space(3)))
#define GAS __attribute__((address_space(1)))
typedef unsigned short bf16;
typedef short bf16x8 __attribute__((ext_vector_type(8)));
typedef short s16x4 __attribute__((ext_vector_type(4)));
typedef float f32x4 __attribute__((ext_vector_type(4)));
typedef float f32x2 __attribute__((ext_vector_type(2)));
typedef unsigned u32x4 __attribute__((ext_vector_type(4)));
typedef unsigned u32x2 __attribute__((ext_vector_type(2)));
typedef GAS unsigned gu32;
#define RLX_AGENT __ATOMIC_RELAXED, __HIP_MEMORY_SCOPE_AGENT
#define LDS_WAIT() asm volatile("s_waitcnt lgkmcnt(0)" ::: "memory")
#define VM_WAIT() asm volatile("s_waitcnt vmcnt(0)" ::: "memory")

constexpr int NB = 4, SEQ = 4096, T = NB * SEQ, D = 1024;
constexpr int NMEM = 256, TM = NB * NMEM;
constexpr int DNH = 4, DND = 128, DNW = 512, DNC = 64, NCHUNK = SEQ / DNC;
constexpr int DAH = 8, DAD = 64, DAW = 512;
constexpr int AB_IN = 3592;
constexpr int XH = 4, XD = 256;
constexpr int NE = 16, DE = 512;
constexpr float ALPHA = 1.41421356237f;
constexpr float LN_EPS = 1e-5f, RMS_EPS = 1e-6f;
constexpr int MOE_ROWS = 2 * T + NE * 256;

constexpr size_t MiB = 1u << 20;
constexpr size_t WS_CTL = 0, CTL_ZERO_BYTES = 1 * MiB;
constexpr size_t WS_W_IN = 1 * MiB, WS_W_ABO = 8 * MiB, WS_W_SCI = 10 * MiB, WS_W_SCO = 16 * MiB, WS_W_Q = 18 * MiB, WS_W_KV = 22 * MiB, WS_W_O = 30 * MiB;
constexpr size_t WS_MEMB = 34 * MiB, WS_KMEM = 36 * MiB, WS_VT = 40 * MiB, WS_BETA = 44 * MiB, WS_GG = 45 * MiB, WS_ROUTE = 46 * MiB, WS_GLAST = 47 * MiB;
constexpr size_t WS_HB = 48 * MiB, WS_H = 80 * MiB, WS_ARENA = 144 * MiB, WS_END = 320 * MiB;
constexpr size_t WS_QKVPRE = 144 * MiB, WS_ZB = 192 * MiB, WS_QKVD = 208 * MiB, WS_MNEG = 80 * MiB, WS_BMT = 112 * MiB, WS_QEFF = 256 * MiB, WS_OLOCT = 272 * MiB;
constexpr size_t WS_OUN = 288 * MiB, WS_LSE = 304 * MiB, WS_OPART = 144 * MiB, WS_MIX = 256 * MiB;
constexpr size_t WS_MOEW_GU = 144 * MiB, WS_MOEW_D = 176 * MiB, WS_XG = 192 * MiB, WS_HACT = 264 * MiB;
static_assert((size_t)MOE_ROWS * D * 2 <= 72 * MiB && (size_t)MOE_ROWS * DE * 2 <= 36 * MiB, "moe buffers");
constexpr int CW_TMO = 0, CW_BAR = 4096, CW_QUEUE = 64, CW_CNT0 = 128, CW_CNT1 = 192;

constexpr int LDS_BYTES = 163840, MISC_OFF = 162816, XCH_OFF = 131072;

typedef __bf16 bf16x2_t __attribute__((ext_vector_type(2)));
__device__ __forceinline__ unsigned pk2(float lo, float hi) { const f32x2 v = {lo, hi}; const bf16x2_t b = __builtin_convertvector(v, bf16x2_t); return __builtin_bit_cast(unsigned, b); }
__device__ __forceinline__ unsigned f2bf(float f) { return pk2(f, f) & 0xffffu; }
__device__ __forceinline__ float bf2f(unsigned short b) { return __builtin_bit_cast(float, (unsigned)b << 16); }
__device__ __forceinline__ float bflo(unsigned w) { return __builtin_bit_cast(float, w << 16); }
__device__ __forceinline__ float bfhi(unsigned w) { return __builtin_bit_cast(float, w & 0xffff0000u); }
__device__ __forceinline__ float wave_sum(float v) {
#pragma unroll
    for (int o = 1; o < 64; o <<= 1) v += __shfl_xor(v, o);
    return v;
}
template <class P> __device__ __forceinline__ P opq_v(P p) { asm volatile("" : "+v"(p)); return p; }
template <class P> __device__ __forceinline__ P opq_s(P p) { asm volatile("" : "+s"(p)); return p; }
__device__ __forceinline__ float silu_f(float x) { return x * __builtin_amdgcn_rcpf(1.f + __expf(-x)); }

namespace pg8 {
constexpr int BM = 256, BK = 64, HALF = 128, HTB = HALF * BK * 2, STAGE_BYTES = 8 * HTB;
__host__ __device__ __forceinline__ int lds_byte(int r, int c) { const int st = (r >> 4) * 2 + (c >> 5), rr = r & 15, cc = c & 31, ob = rr * 64 + cc * 2; return st * 1024 + (ob ^ (((ob >> 9) & 1) << 5)); }
__host__ __device__ __forceinline__ void stage_rc(int b, int& R, int& C) { const int st = b / 1024, sb = b % 1024, swz = sb ^ (((sb >> 9) & 1) << 5); R = (st >> 1) * 16 + swz / 64; C = (st & 1) * 32 + (swz % 64) / 2; }
__host__ __device__ __forceinline__ int perm32(int rho) { const int n = rho >> 4, i = rho & 15; return 8 * (i >> 2) + 4 * n + (i & 3); }

struct Unit { int pm, pn, aux; const char* a; const char* b; };
struct Gemm { int lda, ldb, K; };
__device__ __forceinline__ unsigned cvt_pk_bf16(float lo, float hi) { unsigned r; asm volatile("v_cvt_pk_bf16_f32 %0, %1, %2" : "=v"(r) : "v"(lo), "v"(hi)); return r; }

__device__ __forceinline__ void swz_tile(int L, int nM, int nN, int& pm, int& pn) {
    const int nwg = nM * nN; int wgid = L; { const int q = nwg / 8, r = nwg % 8, xcd = wgid % 8, off = wgid / 8; wgid = (xcd < r ? xcd * (q + 1) : r * (q + 1) + (xcd - r) * q) + off; }
    const int nig = 8 * nN, gid = wgid / nig, fm = gid * 8, gsz = (nM - fm) < 8 ? (nM - fm) : 8;
    pm = fm + ((wgid % nig) % gsz); pn = (wgid % nig) / gsz;
}

template <class Epi, class Sched>
__device__ __forceinline__ void gemm_phase(LAS unsigned char* lds, LAS unsigned char* xch, const Gemm g, const Sched& S, const Epi& E) {
    const int tid = opq_v((int)threadIdx.x), wid = __builtin_amdgcn_readfirstlane(tid >> 6), lane = tid & 63, wr = wid >> 2, wc = wid & 3, fr = lane & 15, fq = lane >> 4;
    const int K = g.K, nt = K / BK;
    unsigned voffA[2], voffB[2];
#pragma unroll
    for (int i = 0; i < 2; ++i) { int R, C; stage_rc(tid * 16 + i * 8192, R, C); const int Rb = Epi::PERM ? ((R & ~31) + perm32(R & 31)) : R;
        voffA[i] = (unsigned)(R * g.lda + C) * 2u; voffB[i] = (unsigned)(Rb * g.ldb + C) * 2u; }
    const size_t kstep = (size_t)(BK * 2);
    const size_t hstepA = (size_t)HALF * g.lda * 2, hstepB = (size_t)HALF * g.ldb * 2;
    const unsigned ldsw = (unsigned)wid * 1024u;
    const int aoff = lds_byte(wr * 64 + fr, fq * 8), boff = lds_byte(wc * 32 + fr, fq * 8);
#define PG8_SA(b, h) (((b) * 2 + (h)) * HTB)
#define PG8_SB(b, h) ((4 + (b) * 2 + (h)) * HTB)
#define PG8_STAGE(bufoff, gbase, voff) do { _Pragma("unroll") for (int _i = 0; _i < 2; ++_i) \
        __builtin_amdgcn_global_load_lds((const unsigned*)((const char*)(gbase) + (voff)[_i]), (LAS unsigned*)(lds + (bufoff) + ldsw + _i * 8192), 16, 0, 0); } while (0)
#define PG8_LDA(dst, b, h) do { _Pragma("unroll") for (int m = 0; m < 4; ++m) _Pragma("unroll") for (int k = 0; k < 2; ++k) dst[m][k] = *(const LAS bf16x8*)(lds + PG8_SA(b, h) + aoff + m * 2048 + k * 1024); } while (0)
#define PG8_LDB(dst, b, h) do { _Pragma("unroll") for (int n = 0; n < 2; ++n) _Pragma("unroll") for (int k = 0; k < 2; ++k) dst[n][k] = *(const LAS bf16x8*)(lds + PG8_SB(b, h) + boff + n * 2048 + k * 1024); } while (0)
#define PG8_MMA(ai, bj, At, Bt) do { __builtin_amdgcn_s_setprio(1); _Pragma("unroll") for (int m = 0; m < 4; ++m) _Pragma("unroll") for (int n = 0; n < 2; ++n) _Pragma("unroll") for (int k = 0; k < 2; ++k) \
        acc[ai][bj][m][n] = __builtin_amdgcn_mfma_f32_16x16x32_bf16(Bt[n][k], At[m][k], acc[ai][bj][m][n], 0, 0, 0); __builtin_amdgcn_s_setprio(0); } while (0)
#define PG8_WAIT_V(n) asm volatile("s_waitcnt vmcnt(" #n ")" ::: "memory")
#define PG8_WAIT_L(n) asm volatile("s_waitcnt lgkmcnt(" #n ")" ::: "memory")
#define PG8_BAR __builtin_amdgcn_s_barrier()
#define PG8_SCHED __builtin_amdgcn_sched_barrier(0)
    Unit cur, nxt; int ui = 0;
    if (!S.next(0, cur)) return;
    f32x4 acc[2][2][4][2];
#pragma unroll
    for (int a = 0; a < 2; ++a)
#pragma unroll
        for (int b = 0; b < 2; ++b)
#pragma unroll
            for (int m = 0; m < 4; ++m)
#pragma unroll
                for (int n = 0; n < 2; ++n) acc[a][b][m][n] = (f32x4){0.f, 0.f, 0.f, 0.f};
    bf16x8 At[4][2], B0[2][2], B1[2][2];
    const char* cA = cur.a; const char* cB = cur.b;
    PG8_STAGE(PG8_SB(0, 0), cB, voffB); PG8_STAGE(PG8_SB(0, 1), cB + hstepB, voffB); PG8_STAGE(PG8_SA(0, 0), cA, voffA); PG8_STAGE(PG8_SA(0, 1), cA + hstepA, voffA);
    if (wr == 1) PG8_BAR;
    PG8_WAIT_V(2); PG8_BAR;
    PG8_STAGE(PG8_SB(1, 0), cB + kstep, voffB); PG8_STAGE(PG8_SA(1, 0), cA + kstep, voffA); PG8_STAGE(PG8_SB(1, 1), cB + hstepB + kstep, voffB);
    PG8_WAIT_V(6); PG8_BAR;
#pragma unroll 1
    for (;;) {
        const bool has_next = S.next(ui + 1, nxt);
        const char* nA = has_next ? nxt.a : cA; const char* nB = has_next ? nxt.b : cB;
#pragma unroll 1
        for (int t = 0; t < nt; t += 2) {
            const bool last = (t == nt - 2);
            const char* a1 = cA + (size_t)(t + 1) * kstep;
            const char* a2 = last ? nA : cA + (size_t)(t + 2) * kstep; const char* b2 = last ? nB : cB + (size_t)(t + 2) * kstep;
            const char* a3 = a2 + kstep; const char* b3 = b2 + kstep;
            PG8_LDB(B0, 0, 0); PG8_LDB(B1, 0, 1); PG8_SCHED; PG8_LDA(At, 0, 0); PG8_STAGE(PG8_SA(1, 1), a1 + hstepA, voffA);
            PG8_WAIT_V(8); PG8_WAIT_L(0); PG8_BAR; PG8_MMA(0, 0, At, B0); PG8_MMA(0, 1, At, B1); PG8_BAR; PG8_SCHED;
            PG8_LDA(At, 0, 1); PG8_STAGE(PG8_SB(0, 0), b2, voffB); PG8_STAGE(PG8_SB(0, 1), b2 + hstepB, voffB); PG8_STAGE(PG8_SA(0, 0), a2, voffA);
            PG8_WAIT_V(8); PG8_WAIT_L(0); PG8_BAR; PG8_MMA(1, 0, At, B0); PG8_MMA(1, 1, At, B1); PG8_BAR; PG8_SCHED;
            PG8_LDB(B0, 1, 0); PG8_LDB(B1, 1, 1); PG8_SCHED; PG8_LDA(At, 1, 0); PG8_STAGE(PG8_SA(0, 1), a2 + hstepA, voffA);
            PG8_WAIT_V(8); PG8_WAIT_L(0); PG8_BAR; PG8_MMA(0, 0, At, B0); PG8_MMA(0, 1, At, B1); PG8_BAR; PG8_SCHED;
            PG8_LDA(At, 1, 1); PG8_STAGE(PG8_SB(1, 0), b3, voffB); PG8_STAGE(PG8_SB(1, 1), b3 + hstepB, voffB); PG8_STAGE(PG8_SA(1, 0), a3, voffA);
            PG8_WAIT_V(8); PG8_WAIT_L(0); PG8_BAR; PG8_MMA(1, 0, At, B0); PG8_MMA(1, 1, At, B1); PG8_BAR; PG8_SCHED;
        }
        if (wr == 0) PG8_BAR;
        E(acc, cur, wr, wc, fr, fq, xch);
        if (!has_next) break;
#pragma unroll
        for (int a = 0; a < 2; ++a)
#pragma unroll
            for (int b = 0; b < 2; ++b)
#pragma unroll
                for (int m = 0; m < 4; ++m)
#pragma unroll
                    for (int n = 0; n < 2; ++n) acc[a][b][m][n] = (f32x4){0.f, 0.f, 0.f, 0.f};
        cur = nxt; cA = nA; cB = nB; ++ui;
        if (wr == 1) PG8_BAR;
    }
    PG8_WAIT_V(0);
    PG8_BAR;
#undef PG8_SA
#undef PG8_SB
#undef PG8_STAGE
#undef PG8_LDA
#undef PG8_LDB
#undef PG8_MMA
#undef PG8_WAIT_V
#undef PG8_WAIT_L
#undef PG8_BAR
#undef PG8_SCHED
}

struct Dst { bf16* p; int ld; };
__device__ __forceinline__ void store_tile_bf16(const f32x4 (&acc)[2][2][4][2], const Dst d, float sc, int wr, int wc, int fr, int fq) {
    unsigned lane_off = (unsigned)((wr * 64 + fr) * d.ld + wc * 32 + 8 * fq);
    asm volatile("" : "+v"(lane_off));
#pragma unroll
    for (int ai = 0; ai < 2; ++ai)
#pragma unroll
        for (int m = 0; m < 4; ++m) { bf16* rowp = d.p + (size_t)lane_off + (size_t)((ai * HALF + m * 16) * d.ld);
#pragma unroll
            for (int bj = 0; bj < 2; ++bj) { const f32x4 v0 = acc[ai][bj][m][0] * sc, v1 = acc[ai][bj][m][1] * sc;
                u32x4 w; w.x = cvt_pk_bf16(v0[0], v0[1]); w.y = cvt_pk_bf16(v0[2], v0[3]); w.z = cvt_pk_bf16(v1[0], v1[1]); w.w = cvt_pk_bf16(v1[2], v1[3]);
                *(u32x4*)(rowp + bj * HALF) = w; } }
}
}

#define XB_TMO      128
#define XB_XCNT(j)  (256  + 64 * (j))
#define XB_XSUB(j)  (1280 + 64 * (j))
#define XB_XGEN(j)  (2304 + 64 * (j))
#define XB_TOP      3328
#define XB_TOPGEN   3392
#define XCD_BAR_WORDS 3456
#define XB_SPIN_CAP (1u << 20)
__device__ __forceinline__ unsigned xb_ld(unsigned* p)              { return __hip_atomic_load(p, __ATOMIC_RELAXED, __HIP_MEMORY_SCOPE_AGENT); }
__device__ __forceinline__ unsigned xb_add(unsigned* p, unsigned v) { return __hip_atomic_fetch_add(p, v, __ATOMIC_RELAXED, __HIP_MEMORY_SCOPE_AGENT); }
__device__ __forceinline__ unsigned xb_xcc_id() { return (unsigned)__builtin_amdgcn_s_getreg((3 << 11) | 20) & 0xFu; }
#define XB_SPIN(cond, bar) do { unsigned _sp = 0; while (cond) { __builtin_amdgcn_s_sleep(1); \
    if ((++_sp & 255u) == 0u) { if (xb_ld(&(bar)[XB_TMO])) break; if (_sp > XB_SPIN_CAP) { atomicAdd(&(bar)[XB_TMO], 1u); break; } } } } while (0)
struct XcdBarrier { unsigned* bar; unsigned x; volatile LAS unsigned* st; };
__device__ __forceinline__ XcdBarrier xcd_barrier_post(unsigned* bar, volatile LAS unsigned* st) {
    XcdBarrier b; b.bar = bar; b.x = xb_xcc_id(); b.st = st;
    if (threadIdx.x == 0) (void)xb_add(&bar[XB_XCNT(b.x)], 1u);
    return b;
}
__device__ __forceinline__ void xcd_barrier_complete(unsigned* bar, unsigned x, unsigned& nloc, unsigned& nx) {
    const unsigned G = gridDim.x * gridDim.y * gridDim.z;
    unsigned sum, cnt, mine, sp = 0u;
    for (;;) {
        sum = 0u; cnt = 0u; mine = 0u;
#pragma unroll
        for (unsigned j = 0; j < 16; ++j) { const unsigned c = xb_ld(&bar[XB_XCNT(j)]); sum += c; cnt += (c > 0u) ? 1u : 0u; mine = (j == x) ? c : mine; }
        if (sum == G) break;
        __builtin_amdgcn_s_sleep(1);
        if ((++sp & 255u) == 0u) { if (xb_ld(&bar[XB_TMO])) break; if (sp > XB_SPIN_CAP) { atomicAdd(&bar[XB_TMO], 1u); break; } }
    }
    nloc = mine > 0u ? mine : 1u; nx = cnt > 0u ? cnt : 1u;
}
__device__ __forceinline__ void xcd_barrier(const XcdBarrier& b) {
    asm volatile("s_waitcnt vmcnt(0)" ::: "memory");
    __syncthreads();
    if (threadIdx.x == 0) {
        unsigned* bar = b.bar;
        __builtin_amdgcn_s_waitcnt(0);
        unsigned nloc = b.st[0], nx = b.st[1];
        if (nloc == 0u) { xcd_barrier_complete(bar, b.x, nloc, nx); b.st[0] = nloc; b.st[1] = nx; }
        const unsigned old = xb_add(&bar[XB_XSUB(b.x)], 1u);
        const unsigned gen = old / nloc;
        if (old + 1u == (gen + 1u) * nloc) {
            __builtin_amdgcn_fence(__ATOMIC_RELEASE, "agent");
            asm volatile("s_waitcnt vmcnt(0)" ::: "memory");
            const unsigned og = xb_add(&bar[XB_TOP], 1u);
            const unsigned tg = og / nx;
            if (og + 1u == (tg + 1u) * nx) xb_add(&bar[XB_TOPGEN], 1u);
            else XB_SPIN(xb_ld(&bar[XB_TOPGEN]) == tg, bar);
            __builtin_amdgcn_fence(__ATOMIC_ACQUIRE, "agent");
            xb_add(&bar[XB_XGEN(b.x)], 1u);
            asm volatile("s_waitcnt vmcnt(0)" ::: "memory");
        } else {
            XB_SPIN(xb_ld(&bar[XB_XGEN(b.x)]) == gen, bar);
            __builtin_amdgcn_fence(__ATOMIC_ACQUIRE, "agent");
            asm volatile("s_waitcnt vmcnt(0)" ::: "memory");
        }
    }
    __syncthreads();
}

struct Args { const float* in[21]; float* out; unsigned char* ws; int ph_lo, ph_hi; };
struct Frame {
    LAS unsigned char* lds;
    unsigned char* ws;
    gu32* ctl;
    int tid, lane, wave, G, gw, NGW;
};
#define WSP(T_, off) ((T_*)(F.ws + (off)))

__device__ __forceinline__ void tr_item(const float* W, int ldw, int k0, int c0, bf16* dst, int ldd, LAS float* scr, int lane) {
    const int r8 = lane >> 3, c4 = lane & 7;
#pragma unroll
    for (int it = 0; it < 8; ++it) { const int kk = it * 8 + r8; const f32x4 v = *(const GAS f32x4*)(W + (size_t)(k0 + kk) * ldw + c0 + 4 * c4);
        LAS float* s = scr + kk * 33 + 4 * c4; s[0] = v[0]; s[1] = v[1]; s[2] = v[2]; s[3] = v[3]; }
    LDS_WAIT(); asm volatile("" ::: "memory");
    const int c = lane & 7;
#pragma unroll
    for (int j = 0; j < 4; ++j) { const int n = (lane >> 3) + 8 * j; const LAS float* s = scr + (8 * c) * 33 + n;
        u32x4 o; o.x = pk2(s[0 * 33], s[1 * 33]); o.y = pk2(s[2 * 33], s[3 * 33]); o.z = pk2(s[4 * 33], s[5 * 33]); o.w = pk2(s[6 * 33], s[7 * 33]);
        *(GAS u32x4*)(dst + (size_t)n * ldd + k0 + 8 * c) = o; }
    LDS_WAIT(); asm volatile("" ::: "memory");
}
__device__ __forceinline__ void tr_matrix(Frame& F, const float* W, int K, int N, int ldw, bf16* dst, LAS float* scr, int it) {
    const int nblk = N / 32, kb = it / nblk, nb = it % nblk;
    tr_item(W, ldw, 64 * kb, 32 * nb, dst + (size_t)(32 * nb) * K, K, scr, F.lane);
}
__device__ __forceinline__ void p0_prologue(Frame& F, const Args& A) {
    LAS float* scr = (LAS float*)(F.lds + F.wave * 16384);
    constexpr int I_IN = 16 * 112, I_SQ = 16 * 32, I_SCI = 16 * 96, I_KV = 16 * 64;
    constexpr int NITEMS = I_IN + I_SQ + I_SCI + I_SQ + 2 * I_SQ + 2 * I_KV + 2 * I_SQ;
    for (int it = F.gw; it < NITEMS; it += F.NGW) {
        int r = it;
        if (r < I_IN) { const int kb = r / 112, nb = r % 112;
            tr_item(A.in[2], AB_IN, 64 * kb, 32 * nb + (nb >= 64 ? 8 : 0), WSP(bf16, WS_W_IN) + (size_t)(32 * nb) * D, D, scr, F.lane); continue; } r -= I_IN;
        if (r < I_SQ) { tr_matrix(F, A.in[7], D, D, D, WSP(bf16, WS_W_ABO), scr, r); continue; } r -= I_SQ;
        if (r < I_SCI) { tr_matrix(F, A.in[8], D, 3 * D, 3 * D, WSP(bf16, WS_W_SCI), scr, r); continue; } r -= I_SCI;
        if (r < I_SQ) { tr_matrix(F, A.in[10], D, D, D, WSP(bf16, WS_W_SCO), scr, r); continue; } r -= I_SQ;
        if (r < 2 * I_SQ) { const int l = r / I_SQ; tr_matrix(F, A.in[11] + (size_t)l * D * D, D, D, D, WSP(bf16, WS_W_Q) + (size_t)l * D * D, scr, r % I_SQ); continue; } r -= 2 * I_SQ;
        if (r < 2 * I_KV) { const int l = r / I_KV; tr_matrix(F, A.in[12] + (size_t)l * D * 2 * D, D, 2 * D, 2 * D, WSP(bf16, WS_W_KV) + (size_t)l * 2 * D * D, scr, r % I_KV); continue; } r -= 2 * I_KV;
        { const int l = r / I_SQ; tr_matrix(F, A.in[13] + (size_t)l * D * D, D, D, D, WSP(bf16, WS_W_O) + (size_t)l * D * D, scr, r % I_SQ); }
    }
    __syncthreads();
    LAS float* wt = (LAS float*)F.lds;
    for (int i = F.tid; i < 8 * D; i += 512) { const int k = i >> 3, c = i & 7; wt[c * D + k] = A.in[2][(size_t)k * AB_IN + 2048 + c]; }
    __syncthreads();
    const float* x = A.in[0];
    float alg[4], dtb[4];
#pragma unroll
    for (int h = 0; h < 4; ++h) { alg[h] = -__expf(A.in[4][h]); dtb[h] = A.in[5][h]; }
    for (int m = F.gw; m < T; m += F.NGW) {
        const GAS f32x4* xr = (const GAS f32x4*)(x + (size_t)m * D) + F.lane;
        f32x4 v[4];
#pragma unroll
        for (int j = 0; j < 4; ++j) v[j] = xr[64 * j];
        GAS u32x2* o8 = (GAS u32x2*)(WSP(bf16, WS_HB) + (size_t)m * D) + F.lane;
#pragma unroll
        for (int j = 0; j < 4; ++j) { u32x2 w; w.x = pk2(v[j][0], v[j][1]); w.y = pk2(v[j][2], v[j][3]); o8[64 * j] = w; }
        float dot[8];
#pragma unroll
        for (int c = 0; c < 8; ++c) { float s = 0.f;
#pragma unroll
            for (int j = 0; j < 4; ++j) { const f32x4 w = *(const LAS f32x4*)(wt + c * D + 256 * j + 4 * F.lane); s += v[j][0] * w[0] + v[j][1] * w[1] + v[j][2] * w[2] + v[j][3] * w[3]; }
            dot[c] = wave_sum(s); }
        if (F.lane == 0) {
            f32x4 bo, go;
#pragma unroll
            for (int hq = 0; hq < 4; ++hq) { bo[hq] = 1.f / (1.f + __expf(-dot[hq])); const float xx = dot[4 + hq] + dtb[hq]; const float sp = xx > 20.f ? xx : log1pf(__expf(xx)); go[hq] = alg[hq] * sp; }
            *(GAS f32x4*)(WSP(float, WS_BETA) + (size_t)m * 4) = bo;
            *(GAS f32x4*)(WSP(float, WS_GG) + (size_t)m * 4) = go;
        }
    }
    for (int m = F.gw; m < TM; m += F.NGW) {
        const GAS f32x4* xr = (const GAS f32x4*)(A.in[1] + (size_t)m * D) + F.lane;
        GAS u32x2* o8 = (GAS u32x2*)(WSP(bf16, WS_MEMB) + (size_t)m * D) + F.lane;
#pragma unroll
        for (int j = 0; j < 4; ++j) { const f32x4 v = xr[64 * j]; u32x2 w; w.x = pk2(v[0], v[1]); w.y = pk2(v[2], v[3]); o8[64 * j] = w; }
    }
}
__device__ __forceinline__ void convert_moe(Frame& F, const Args& A, int layer) {
    LAS float* scr = (LAS float*)(F.lds + F.wave * 16384);
    constexpr int I_GU = 16 * 32, I_D = 8 * 32;
    constexpr int NITEMS = NE * (I_GU + I_D);
    for (int it = F.gw; it < NITEMS; it += F.NGW) {
        const int e = it / (I_GU + I_D); int r = it % (I_GU + I_D);
        if (r < I_GU) { const int kb = r / 32, rb = r % 32, pn = rb >> 3, sub = rb & 7;
            const float* src = (sub < 4 ? A.in[16] : A.in[17]) + ((size_t)layer * NE + e) * D * DE;
            tr_item(src, DE, 64 * kb, 128 * pn + 32 * (sub & 3), WSP(bf16, WS_MOEW_GU) + ((size_t)e * D + 32 * rb) * D, D, scr, F.lane);
        } else { r -= I_GU; const int kb = r / 32, nb = r % 32;
            tr_item(A.in[18] + ((size_t)layer * NE + e) * DE * D, D, 64 * kb, 32 * nb, WSP(bf16, WS_MOEW_D) + ((size_t)e * D + 32 * nb) * DE, DE, scr, F.lane); }
    }
}

struct SchedDense {
    const char* A; const char* B; int lda, ldb, nM, nN, G, c;
    __device__ __forceinline__ bool next(int i, pg8::Unit& u) const {
        const int L = i * G + c; if (L >= nM * nN) return false;
        pg8::swz_tile(L, nM, nN, u.pm, u.pn); u.aux = 0;
        u.a = A + (size_t)u.pm * 256 * lda * 2; u.b = B + (size_t)u.pn * 256 * ldb * 2; return true; }
};
struct EpiDense {
    static constexpr bool PERM = true;
    bf16* O; int ld; float sc;
    __device__ __forceinline__ void operator()(const f32x4 (&acc)[2][2][4][2], const pg8::Unit& u, int wr, int wc, int fr, int fq, LAS unsigned char*) const {
        pg8::store_tile_bf16(acc, pg8::Dst{O + (size_t)u.pm * 256 * ld + u.pn * 256, ld}, sc, wr, wc, fr, fq); }
};
struct SchedP1 {
    const char* XB; const char* WIN; const char* MEMB; const char* WKV; int G, c;
    __device__ __forceinline__ bool next(int i, pg8::Unit& u) const {
        const int L = i * G + c; if (L >= 896 + 64) return false;
        if (L < 896) { pg8::swz_tile(L, 64, 14, u.pm, u.pn); u.aux = 0; u.a = XB + (size_t)u.pm * 256 * D * 2; u.b = WIN + (size_t)u.pn * 256 * D * 2; }
        else { const int r = L - 896, l = r >> 5; u.pm = (r & 31) >> 3; u.pn = r & 7; u.aux = 1 + l; u.a = MEMB + (size_t)u.pm * 256 * D * 2; u.b = WKV + ((size_t)l * 2 * D + u.pn * 256) * D * 2; }
        return true; }
};
struct EpiP1 {
    static constexpr bool PERM = true;
    bf16 *QKVPRE, *ZB, *QKVD, *KMEM, *VT;
    __device__ __forceinline__ void operator()(const f32x4 (&acc)[2][2][4][2], const pg8::Unit& u, int wr, int wc, int fr, int fq, LAS unsigned char*) const {
        if (u.aux == 0) {
            pg8::Dst d;
            if (u.pn < 6) d = pg8::Dst{QKVPRE + (size_t)u.pm * 256 * 1536 + u.pn * 256, 1536};
            else if (u.pn < 8) d = pg8::Dst{ZB + (size_t)u.pm * 256 * 512 + (u.pn - 6) * 256, 512};
            else d = pg8::Dst{QKVD + (size_t)u.pm * 256 * 1536 + (u.pn - 8) * 256, 1536};
            pg8::store_tile_bf16(acc, d, 1.f, wr, wc, fr, fq);
        } else {
            const int l = u.aux - 1;
            if (u.pn < 4) pg8::store_tile_bf16(acc, pg8::Dst{KMEM + ((size_t)l * TM + u.pm * 256) * D + u.pn * 256, D}, 1.f, wr, wc, fr, fq);
            else {
                unsigned lane_off = (unsigned)((wc * 32 + 8 * fq) * NMEM + wr * 64 + fr);
                asm volatile("" : "+v"(lane_off));
                bf16* vt = VT + (((size_t)l * NB + u.pm) * XH + (u.pn - 4)) * XD * NMEM + lane_off;
#pragma unroll
                for (int ai = 0; ai < 2; ++ai)
#pragma unroll
                    for (int m = 0; m < 4; ++m)
#pragma unroll
                        for (int bj = 0; bj < 2; ++bj)
#pragma unroll
                            for (int n = 0; n < 2; ++n)
#pragma unroll
                                for (int e = 0; e < 4; ++e) vt[(bj * 128 + 4 * n + e) * NMEM + ai * 128 + m * 16] = (bf16)f2bf(acc[ai][bj][m][n][e]);
            }
        }
    }
};
struct SchedXS {
    const char* QB; const char* KM; int G, c;
    __device__ __forceinline__ bool next(int i, pg8::Unit& u) const {
        const int L = i * G + c; if (L >= 256) return false;
        u.pm = L >> 2; u.pn = L & 3; u.aux = 0;
        u.a = QB + ((size_t)u.pm * 256 * D + u.pn * XD) * 2; u.b = KM + ((size_t)(u.pm >> 4) * NMEM * D + u.pn * XD) * 2; return true; }
};
struct EpiSoftmax {
    static constexpr bool PERM = true;
    bf16* P;
    __device__ __forceinline__ void operator()(f32x4 (&acc)[2][2][4][2], const pg8::Unit& u, int wr, int wc, int fr, int fq, LAS unsigned char* xch) const {
        LAS float* MX = (LAS float*)xch;
        LAS float* SM = (LAS float*)(xch + 4096);
#pragma unroll
        for (int ai = 0; ai < 2; ++ai)
#pragma unroll
            for (int m = 0; m < 4; ++m) { float v = -3.0e38f;
#pragma unroll
                for (int bj = 0; bj < 2; ++bj)
#pragma unroll
                    for (int n = 0; n < 2; ++n) { const f32x4 x = acc[ai][bj][m][n]; v = fmaxf(v, fmaxf(fmaxf(x[0], x[1]), fmaxf(x[2], x[3]))); }
                v = fmaxf(v, __shfl_xor(v, 16)); v = fmaxf(v, __shfl_xor(v, 32));
                if (fq == 0) MX[(ai * 128 + wr * 64 + m * 16 + fr) * 4 + wc] = v; }
        LDS_WAIT(); __builtin_amdgcn_s_barrier(); asm volatile("" ::: "memory");
#pragma unroll
        for (int ai = 0; ai < 2; ++ai)
#pragma unroll
            for (int m = 0; m < 4; ++m) { float s = 0.f; const f32x4 q = *(const LAS f32x4*)(MX + (ai * 128 + wr * 64 + m * 16 + fr) * 4); const float mxr = fmaxf(fmaxf(q[0], q[1]), fmaxf(q[2], q[3]));
#pragma unroll
                for (int bj = 0; bj < 2; ++bj)
#pragma unroll
                    for (int n = 0; n < 2; ++n) { f32x4 x = acc[ai][bj][m][n];
#pragma unroll
                        for (int e = 0; e < 4; ++e) { x[e] = __builtin_amdgcn_exp2f(x[e] - mxr); s += x[e]; }
                        acc[ai][bj][m][n] = x; }
                s += __shfl_xor(s, 16); s += __shfl_xor(s, 32);
                if (fq == 0) SM[(ai * 128 + wr * 64 + m * 16 + fr) * 4 + wc] = s; }
        LDS_WAIT(); __builtin_amdgcn_s_barrier(); asm volatile("" ::: "memory");
        bf16* base = P + (size_t)u.pm * 256 * D + u.pn * XD;
#pragma unroll
        for (int ai = 0; ai < 2; ++ai)
#pragma unroll
            for (int m = 0; m < 4; ++m) { const f32x4 q = *(const LAS f32x4*)(SM + (ai * 128 + wr * 64 + m * 16 + fr) * 4); const float inv = 1.f / ((q[0] + q[1]) + (q[2] + q[3]));
                bf16* rowp = base + (size_t)(ai * 128 + wr * 64 + m * 16 + fr) * D + wc * 32 + 8 * fq;
#pragma unroll
                for (int bj = 0; bj < 2; ++bj) { const f32x4 v0 = acc[ai][bj][m][0] * inv, v1 = acc[ai][bj][m][1] * inv;
                    u32x4 w; w.x = pg8::cvt_pk_bf16(v0[0], v0[1]); w.y = pg8::cvt_pk_bf16(v0[2], v0[3]); w.z = pg8::cvt_pk_bf16(v1[0], v1[1]); w.w = pg8::cvt_pk_bf16(v1[2], v1[3]);
                    *(u32x4*)(rowp + bj * 128) = w; } }
        LDS_WAIT(); __builtin_amdgcn_s_barrier(); asm volatile("" ::: "memory");
    }
};
struct SchedXP {
    const char* PB; const char* VT; int G, c;
    __device__ __forceinline__ bool next(int i, pg8::Unit& u) const {
        const int L = i * G + c; if (L >= 256) return false;
        u.pm = L >> 2; u.pn = L & 3; u.aux = 0;
        u.a = PB + ((size_t)u.pm * 256 * D + u.pn * XD) * 2; u.b = VT + ((size_t)((u.pm >> 4) * XH + u.pn) * XD * NMEM) * 2; return true; }
};
struct SchedMoE {
    const char* Aall; const char* Wall; volatile LAS unsigned* tab; int lda, wrows  , ldb, G, c;
    __device__ __forceinline__ bool next(int i, pg8::Unit& u) const {
        const int L = i * G + c; const int ntile = (int)tab[16]; if (L >= ntile * 4) return false;
        u.pm = L >> 2; u.pn = L & 3; int e = 0;
#pragma unroll
        for (int j = 1; j < 16; ++j) e += ((int)tab[j] <= u.pm) ? 1 : 0;
        u.aux = e; u.a = Aall + (size_t)u.pm * 256 * lda * 2; u.b = Wall + ((size_t)e * wrows + u.pn * 256) * ldb * 2; return true; }
};
struct EpiSwiglu {
    static constexpr bool PERM = true;
    bf16* HACT;
    __device__ __forceinline__ void operator()(const f32x4 (&acc)[2][2][4][2], const pg8::Unit& u, int wr, int wc, int fr, int fq, LAS unsigned char*) const {
#pragma unroll
        for (int ai = 0; ai < 2; ++ai)
#pragma unroll
            for (int m = 0; m < 4; ++m) { bf16* rowp = HACT + (size_t)(u.pm * 256 + ai * 128 + wr * 64 + m * 16 + fr) * DE + u.pn * 128 + wc * 32 + 8 * fq;
                float h[8];
#pragma unroll
                for (int n = 0; n < 2; ++n)
#pragma unroll
                    for (int e = 0; e < 4; ++e) { const float gt = acc[ai][0][m][n][e], up = acc[ai][1][m][n][e]; h[n * 4 + e] = silu_f(gt) * up; }
                u32x4 w; w.x = pg8::cvt_pk_bf16(h[0], h[1]); w.y = pg8::cvt_pk_bf16(h[2], h[3]); w.z = pg8::cvt_pk_bf16(h[4], h[5]); w.w = pg8::cvt_pk_bf16(h[6], h[7]);
                *(u32x4*)rowp = w; }
    }
};

struct Route { int e0, e1, r0, r1; float w0, w1; int s0, s1; };
template <int MODE, bool ROUTER, bool FINAL>
__device__ __forceinline__ void ln_pass(Frame& F, const Args& A, const bf16* hold, const bf16* Y, int li  , float* hnew  , bf16* hb, unsigned* cnt) {
    const float* gam = A.in[19] + (size_t)li * D; const float* bet = A.in[20] + (size_t)li * D;
    f32x4 gv[4], bv[4];
#pragma unroll
    for (int j = 0; j < 4; ++j) { gv[j] = *(const GAS f32x4*)(gam + 256 * j + 4 * F.lane); bv[j] = *(const GAS f32x4*)(bet + 256 * j + 4 * F.lane); }
    LAS float* rw = (LAS float*)F.lds;
    LAS int* sel = (LAS int*)(F.lds + 65536);
    LAS float* selw = (LAS float*)(F.lds + 65536 + 1024);
    if (ROUTER) { for (int i = F.tid; i < NE * D; i += 512) { const int k = i >> 4, e = i & 15; rw[e * D + k] = A.in[14][i]; } __syncthreads(); }
    Route* route = WSP(Route, WS_ROUTE);
    const int nblk = T / 64;
    for (int blk = blockIdx.x; blk < nblk; blk += F.G) {
        u32x2 hn[4]; u32x2 ya[4], yb[4]; float rw0 = 0.f, rw1 = 0.f;
#define LN_LOAD(mrow) do { const int m_ = (mrow); \
            _Pragma("unroll") for (int j = 0; j < 4; ++j) hn[j] = *((const GAS u32x2*)(hold + (size_t)m_ * D) + F.lane + 64 * j); \
            if (MODE == 0) { _Pragma("unroll") for (int j = 0; j < 4; ++j) ya[j] = *((const GAS u32x2*)(Y + (size_t)m_ * D) + F.lane + 64 * j); } \
            else { const Route r_ = route[m_]; rw0 = r_.w0; rw1 = r_.w1; \
                _Pragma("unroll") for (int j = 0; j < 4; ++j) { ya[j] = *((const GAS u32x2*)(Y + (size_t)r_.s0 * D) + F.lane + 64 * j); yb[j] = *((const GAS u32x2*)(Y + (size_t)r_.s1 * D) + F.lane + 64 * j); } } } while (0)
        LN_LOAD(blk * 64 + F.wave * 8);
#pragma unroll 1
        for (int rr = 0; rr < 8; ++rr) {
            const int m = blk * 64 + F.wave * 8 + rr;
            f32x4 v[4];
#pragma unroll
            for (int j = 0; j < 4; ++j) { v[j][0] = bflo(hn[j].x) * ALPHA; v[j][1] = bfhi(hn[j].x) * ALPHA; v[j][2] = bflo(hn[j].y) * ALPHA; v[j][3] = bfhi(hn[j].y) * ALPHA; }
            if (MODE == 0) {
#pragma unroll
                for (int j = 0; j < 4; ++j) { const u32x2 w = ya[j]; v[j][0] += bflo(w.x); v[j][1] += bfhi(w.x); v[j][2] += bflo(w.y); v[j][3] += bfhi(w.y); }
            } else {
#pragma unroll
                for (int j = 0; j < 4; ++j) { const u32x2 w0 = ya[j], w1 = yb[j];
                    v[j][0] += rw0 * bflo(w0.x) + rw1 * bflo(w1.x); v[j][1] += rw0 * bfhi(w0.x) + rw1 * bfhi(w1.x); v[j][2] += rw0 * bflo(w0.y) + rw1 * bflo(w1.y); v[j][3] += rw0 * bfhi(w0.y) + rw1 * bfhi(w1.y); }
            }
            if (rr < 7) LN_LOAD(m + 1);
            float s = 0.f;
#pragma unroll
            for (int j = 0; j < 4; ++j) s += (v[j][0] + v[j][1]) + (v[j][2] + v[j][3]);
            const float mean = wave_sum(s) * (1.f / D); float s2 = 0.f;
#pragma unroll
            for (int j = 0; j < 4; ++j) { v[j] = v[j] - mean; s2 += (v[j][0] * v[j][0] + v[j][1] * v[j][1]) + (v[j][2] * v[j][2] + v[j][3] * v[j][3]); }
            const float rstd = 1.f / sqrtf(wave_sum(s2) * (1.f / D) + LN_EPS);
#pragma unroll
            for (int j = 0; j < 4; ++j) v[j] = v[j] * rstd * gv[j] + bv[j];
            if (FINAL) {
#pragma unroll
                for (int j = 0; j < 4; ++j) *((GAS f32x4*)(hnew + (size_t)m * D) + F.lane + 64 * j) = v[j];
            } else {
#pragma unroll
                for (int j = 0; j < 4; ++j) { u32x2 w; w.x = pk2(v[j][0], v[j][1]); w.y = pk2(v[j][2], v[j][3]); *((GAS u32x2*)(hb + (size_t)m * D) + F.lane + 64 * j) = w; }
            }
            if (ROUTER) {
                float lg[16];
#pragma unroll
                for (int e = 0; e < 16; ++e) { float d = 0.f;
#pragma unroll
                    for (int j = 0; j < 4; ++j) { const f32x4 w = *(const LAS f32x4*)(rw + e * D + 256 * j + 4 * F.lane); d += v[j][0] * w[0] + v[j][1] * w[1] + v[j][2] * w[2] + v[j][3] * w[3]; }
                    lg[e] = wave_sum(d); }
                float mxl = lg[0];
#pragma unroll
                for (int e = 1; e < 16; ++e) mxl = fmaxf(mxl, lg[e]);
                float sc[16], se = 0.f;
#pragma unroll
                for (int e = 0; e < 16; ++e) { sc[e] = __expf(lg[e] - mxl); se += sc[e]; }
                const float inv = 1.f / se; float sl[16];
#pragma unroll
                for (int e = 0; e < 16; ++e) { sc[e] *= inv; sl[e] = sc[e] + A.in[15][e]; }
                int bg = 0; float bgs = -3.0e38f;
#pragma unroll
                for (int g4 = 0; g4 < 4; ++g4) { const float a = sl[4 * g4], b = sl[4 * g4 + 1], c = sl[4 * g4 + 2], d = sl[4 * g4 + 3];
                    const float hi1 = fmaxf(a, b), lo1 = fminf(a, b), hi2 = fmaxf(c, d), lo2 = fminf(c, d);
                    const float top = fmaxf(hi1, hi2), second = fmaxf(fminf(hi1, hi2), fmaxf(lo1, lo2)); const float gs = top + second;
                    if (gs > bgs) { bgs = gs; bg = g4; } }
                float s4[4], c4[4];
#pragma unroll
                for (int q = 0; q < 4; ++q) { s4[q] = bg == 0 ? sl[q] : bg == 1 ? sl[4 + q] : bg == 2 ? sl[8 + q] : sl[12 + q]; c4[q] = bg == 0 ? sc[q] : bg == 1 ? sc[4 + q] : bg == 2 ? sc[8 + q] : sc[12 + q]; }
                int i0 = 0; float b0 = s4[0];
#pragma unroll
                for (int q = 1; q < 4; ++q) if (s4[q] > b0) { b0 = s4[q]; i0 = q; }
                int i1 = -1; float b1 = -3.0e38f;
#pragma unroll
                for (int q = 0; q < 4; ++q) if (q != i0 && s4[q] > b1) { b1 = s4[q]; i1 = q; }
                const float p0 = i0 == 0 ? c4[0] : i0 == 1 ? c4[1] : i0 == 2 ? c4[2] : c4[3];
                const float p1 = i1 == 0 ? c4[0] : i1 == 1 ? c4[1] : i1 == 2 ? c4[2] : c4[3];
                if (F.lane == 0) { const int tk = F.wave * 8 + rr; sel[tk * 4 + 0] = bg * 4 + i0; sel[tk * 4 + 1] = bg * 4 + i1; selw[tk * 2 + 0] = p0 / (p0 + p1); selw[tk * 2 + 1] = p1 / (p0 + p1); }
            }
        }
        if (ROUTER) {
            __syncthreads();
            if (F.tid < 16) {
                const int e = F.tid; int n = 0;
                for (int i = 0; i < 64; ++i) { if (sel[i * 4 + 0] == e) { sel[i * 4 + 2] = n; ++n; } if (sel[i * 4 + 1] == e) { sel[i * 4 + 3] = n; ++n; } }
                const int base = n ? (int)atomicAdd(cnt + e, (unsigned)n) : 0;
                for (int i = 0; i < 64; ++i) { if (sel[i * 4 + 0] == e) sel[i * 4 + 2] += base; if (sel[i * 4 + 1] == e) sel[i * 4 + 3] += base; }
            }
            __syncthreads();
            if (F.tid < 64) { Route r; r.e0 = sel[F.tid * 4 + 0]; r.e1 = sel[F.tid * 4 + 1]; r.r0 = sel[F.tid * 4 + 2]; r.r1 = sel[F.tid * 4 + 3]; r.w0 = selw[F.tid * 2 + 0]; r.w1 = selw[F.tid * 2 + 1]; r.s0 = 0; r.s1 = 0; route[blk * 64 + F.tid] = r; }
            __syncthreads();
        }
    }
}
__device__ __forceinline__ void moe_table(Frame& F, const unsigned* cnt, volatile LAS unsigned* tab) {
    if (F.tid == 0) { unsigned t = 0; for (int e = 0; e < 16; ++e) { tab[e] = t; t += (__hip_atomic_load(cnt + e, RLX_AGENT) + 255u) >> 8; } tab[16] = t; }
    __syncthreads();
}
__device__ __forceinline__ void moe_gather(Frame& F, const bf16* hb, bf16* xg, volatile LAS unsigned* tab) {
    Route* route = WSP(Route, WS_ROUTE);
    for (int m = F.gw; m < T; m += F.NGW) {
        Route r = route[m];
        const int s0 = (int)tab[r.e0] * 256 + r.r0, s1 = (int)tab[r.e1] * 256 + r.r1;
        if (F.lane == 0) { route[m].s0 = s0; route[m].s1 = s1; }
        const GAS u32x4* src = (const GAS u32x4*)(hb + (size_t)m * D) + F.lane;
        const u32x4 a = src[0], b = src[64];
        GAS u32x4* d0 = (GAS u32x4*)(xg + (size_t)s0 * D) + F.lane; GAS u32x4* d1 = (GAS u32x4*)(xg + (size_t)s1 * D) + F.lane;
        d0[0] = a; d0[64] = b; d1[0] = a; d1[64] = b;
    }
}

__device__ __forceinline__ void conv_pass(Frame& F, const Args& A, const bf16* prj, bf16* ub) {
    const float* cw = A.in[9];
    for (int it = F.gw; it < (T / 16) * 2; it += F.NGW) {
        const int tb = it >> 1, c0 = (it & 1) * 512 + F.lane * 8; const int t0 = tb * 16, pos0 = t0 % SEQ;
        float w[3][8];
#pragma unroll
        for (int j = 0; j < 3; ++j) { const f32x4 a = *(const GAS f32x4*)(cw + j * D + c0), b = *(const GAS f32x4*)(cw + j * D + c0 + 4);
#pragma unroll
            for (int e = 0; e < 4; ++e) { w[j][e] = a[e]; w[j][4 + e] = b[e]; } }
        float p2[8], p1[8];
#pragma unroll
        for (int e = 0; e < 8; ++e) { p2[e] = 0.f; p1[e] = 0.f; }
#pragma unroll
        for (int q = 0; q < 2; ++q) { if (pos0 - 2 + q >= 0) { const bf16* r = prj + (size_t)(t0 - 2 + q) * 3072;
                const u32x4 gc = *(const GAS u32x4*)(r + 1024 + c0), hd = *(const GAS u32x4*)(r + 2048 + c0);
#pragma unroll
                for (int e = 0; e < 4; ++e) { const float lo = bflo(gc[e]) * bflo(hd[e]), hi = bfhi(gc[e]) * bfhi(hd[e]); if (q == 0) { p2[2 * e] = lo; p2[2 * e + 1] = hi; } else { p1[2 * e] = lo; p1[2 * e + 1] = hi; } } } }
#pragma unroll 4
        for (int tt = 0; tt < 16; ++tt) { const bf16* r = prj + (size_t)(t0 + tt) * 3072;
            const u32x4 gb = *(const GAS u32x4*)(r + c0), gc = *(const GAS u32x4*)(r + 1024 + c0), hd = *(const GAS u32x4*)(r + 2048 + c0);
            float p0[8], o[8];
#pragma unroll
            for (int e = 0; e < 4; ++e) { p0[2 * e] = bflo(gc[e]) * bflo(hd[e]); p0[2 * e + 1] = bfhi(gc[e]) * bfhi(hd[e]); }
#pragma unroll
            for (int e = 0; e < 8; ++e) { const float cv = w[0][e] * p2[e] + w[1][e] * p1[e] + w[2][e] * p0[e]; const float g = (e & 1) ? bfhi(gb[e >> 1]) : bflo(gb[e >> 1]); o[e] = g * cv; p2[e] = p1[e]; p1[e] = p0[e]; }
            u32x4 wv; wv.x = pk2(o[0], o[1]); wv.y = pk2(o[2], o[3]); wv.z = pk2(o[4], o[5]); wv.w = pk2(o[6], o[7]);
            *(GAS u32x4*)(ub + (size_t)(t0 + tt) * D + c0) = wv; }
    }
}

constexpr int D1_QB = 0, D1_KB = 17408, D1_E = D1_KB, D1_AT = 34816, D1_KT = 44032, D1_RT = 62464, D1_P = 99328, D1_PT = D1_P + 9216, D1_ET = D1_PT + 9216, D1_UW = D1_P, D1_GC = 136192;
constexpr int RSB = 272, RSS = 144;
static_assert(D1_GC + 2 * 256 <= MISC_OFF && D1_UW + 36864 <= D1_GC && D1_RT + 3 * 67 * 272 <= D1_ET, "D1 LDS");
__device__ __forceinline__ f32x4 tile_k64(const LAS unsigned char* xr, const LAS unsigned char* yr, f32x4 acc) {
#pragma unroll
    for (int s = 0; s < 2; ++s) acc = __builtin_amdgcn_mfma_f32_16x16x32_bf16(*(const LAS bf16x8*)(xr + 64 * s), *(const LAS bf16x8*)(yr + 64 * s), acc, 0, 0, 0);
    return acc;
}
template <int VAR> __device__ __forceinline__ void d1_unit(Frame& F, const Args& A, int unit) {
    if (VAR == 4) return;
    const int bh = unit >> 6, n = unit & 63, b = bh >> 2, h = bh & 3;
    const int t0 = b * SEQ + n * 64;
    const int lane = F.lane, wave = F.wave, g = lane >> 4, c = lane & 15;
    LAS unsigned char* L = F.lds;
    LAS unsigned char* L0 = opq_v(L); LAS unsigned char* L1 = opq_v(L + D1_RT); LAS unsigned char* L2 = opq_v(L + D1_P);
    LAS float* gcs = (LAS float*)(L2 + (D1_GC - D1_P)); LAS float* betas = gcs + 64;
    LAS unsigned char* LQB = L0 + D1_QB; LAS unsigned char* LKB = L0 + D1_KB; LAS unsigned char* LAT = L0 + D1_AT; LAS unsigned char* LKT = L0 + D1_KT;
    LAS unsigned char* LRT = L1; LAS unsigned char* LP = L2; LAS unsigned char* LPT = L2 + 9216; LAS unsigned char* LET = L2 + 18432;
    LAS unsigned char* LUW = L2; LAS unsigned char* LE = L0 + D1_E;
    const int i = lane;
    float gc = ((const GAS float*)WSP(float, WS_GG))[(size_t)(t0 + lane) * 4 + h];
    const float bt = ((const GAS float*)WSP(float, WS_BETA))[(size_t)(t0 + lane) * 4 + h];
    int wvb[3];
    LAS unsigned char* RAW = L1;
    {
        const bf16* pre = WSP(bf16, WS_QKVPRE);
        const float* cwp = A.in[3];
#pragma unroll
        for (int x = 0; x < 3; ++x) wvb[x] = __float_as_int(((const GAS float*)cwp)[(lane >> 4) * 1536 + x * 512 + h * 128 + 16 * wave + (lane & 15)]);
        u32x4 rv[7];
#pragma unroll
        for (int k = 0; k < 7; ++k) { int p = F.tid + 512 * k; p = p < 3216 ? p : 3215; const int x = p / 1072, rem = p - x * 1072, row = rem >> 4, pc = rem & 15;
            const bool okr = (n * 64 - 3 + row >= 0); const int rowi = okr ? (t0 - 3 + row) : t0;
            rv[k] = *(const GAS u32x4*)(pre + (size_t)rowi * 1536 + x * 512 + h * 128 + pc * 8); if (!okr) rv[k] = (u32x4){0u, 0u, 0u, 0u}; }
#pragma unroll
        for (int k = 0; k < 7; ++k) { const int p = F.tid + 512 * k; if (p < 3216) { const int x = p / 1072, rem = p - x * 1072, row = rem >> 4, pc = rem & 15; *(LAS u32x4*)(RAW + (x * 67 + row) * RSB + pc * 16) = rv[k]; } }
    }
    __syncthreads();
#pragma unroll
    for (int o = 1; o < 64; o <<= 1) { const float t = __shfl_up(gc, o); if (lane >= o) gc += t; }
    const float gc63 = __shfl(gc, 63);
    if (wave == 0) { gcs[lane] = gc; betas[lane] = bt; }
    {
        float ov[3][16];
#pragma unroll
        for (int x = 0; x < 3; ++x) {
#define RL(k) __int_as_float(__builtin_amdgcn_readlane(wvb[x], (k)))
            float acc[16];
#pragma unroll
            for (int e = 0; e < 16; ++e) acc[e] = 0.f;
#pragma unroll
            for (int j = 0; j < 4; ++j) {
                const u32x4 r0 = *(const LAS u32x4*)(RAW + (x * 67 + i + j) * RSB + 32 * wave), r1 = *(const LAS u32x4*)(RAW + (x * 67 + i + j) * RSB + 32 * wave + 16);
#pragma unroll
                for (int e = 0; e < 4; ++e) { const float w0 = RL(j * 16 + 2 * e), w1 = RL(j * 16 + 2 * e + 1), w2 = RL(j * 16 + 8 + 2 * e), w3 = RL(j * 16 + 8 + 2 * e + 1);
                    acc[2 * e] += w0 * bflo(r0[e]); acc[2 * e + 1] += w1 * bfhi(r0[e]); acc[8 + 2 * e] += w2 * bflo(r1[e]); acc[8 + 2 * e + 1] += w3 * bfhi(r1[e]); }
            }
#pragma unroll
            for (int e = 0; e < 16; ++e) ov[x][e] = silu_f(acc[e]);
#undef RL
        }
        float sq = 0.f, sk = 0.f;
#pragma unroll
        for (int e = 0; e < 16; ++e) { sq += ov[0][e] * ov[0][e]; sk += ov[1][e] * ov[1][e]; }
        LAS float* part = (LAS float*)LET;
        part[wave * 64 + i] = sq; part[512 + wave * 64 + i] = sk;
        __syncthreads();
        float tq = 0.f, tk = 0.f;
#pragma unroll
        for (int w8 = 0; w8 < 8; ++w8) { tq += part[w8 * 64 + i]; tk += part[512 + w8 * 64 + i]; }
        const float rq = rsqrtf(tq + RMS_EPS) * 0.08838834764831845f, rk = rsqrtf(tk + RMS_EPS);
        const float kt = __expf(gc63 - gc), be = bt * __expf(gc);
        u32x4 qw[2], kw[2];
#pragma unroll
        for (int e = 0; e < 8; ++e) { qw[e >> 2][e & 3] = pk2(ov[0][2 * e] * rq, ov[0][2 * e + 1] * rq); kw[e >> 2][e & 3] = pk2(ov[1][2 * e] * rk, ov[1][2 * e + 1] * rk); }
        *(LAS u32x4*)(LQB + i * RSB + 32 * wave) = qw[0]; *(LAS u32x4*)(LQB + i * RSB + 32 * wave + 16) = qw[1];
        *(LAS u32x4*)(LKB + i * RSB + 32 * wave) = kw[0]; *(LAS u32x4*)(LKB + i * RSB + 32 * wave + 16) = kw[1];
#pragma unroll
        for (int e = 0; e < 16; ++e) { const float kv = ov[1][e] * rk; const int d = 16 * wave + e;
            *(LAS unsigned short*)(LKT + d * RSS + 2 * i) = (unsigned short)f2bf(kv * kt);
            *(LAS unsigned short*)(LRT + d * RSS + 2 * i) = (unsigned short)f2bf(ov[2][e] * bt);
            *(LAS unsigned short*)(LRT + (128 + d) * RSS + 2 * i) = (unsigned short)f2bf(kv * be); }
    }
    __syncthreads();
    if (VAR == 1) return;
    f32x4 Er[2];
#pragma unroll
    for (int it = 0; it < 4; ++it) {
        const int id = wave + 8 * (it & 1), isq = it >> 1, mi = id >> 2, nj = id & 3;
        f32x4 acc = {0.f, 0.f, 0.f, 0.f};
        if (mi >= nj) {
            const LAS unsigned char* xr = (isq ? LQB : LKB) + (16 * mi + c) * RSB + 16 * g;
            const LAS unsigned char* yr = LKB + (16 * nj + c) * RSB + 16 * g;
#pragma unroll
            for (int s = 0; s < 4; ++s) acc = __builtin_amdgcn_mfma_f32_16x16x32_bf16(*(const LAS bf16x8*)(xr + 64 * s), *(const LAS bf16x8*)(yr + 64 * s), acc, 0, 0, 0);
        }
        const int j = 16 * nj + c; const float gj = gcs[j];
        f32x4 o;
#pragma unroll
        for (int r = 0; r < 4; ++r) { const int i = 16 * mi + 4 * g + r; const float dec = (i >= j) ? __expf(gcs[i] - gj) : 0.f;
            o[r] = isq ? ((i >= j) ? acc[r] * dec : 0.f) : ((i > j) ? -betas[i] * acc[r] * dec : 0.f); }
        if (!isq) { Er[it & 1] = o;
            u32x2 w; w.x = pk2(o[0], o[1]); w.y = pk2(o[2], o[3]);
            *(LAS u32x2*)(LPT + j * RSS + 2 * (16 * mi + 4 * g)) = w; *(LAS u32x2*)(LET + j * RSS + 2 * (16 * mi + 4 * g)) = w;
#pragma unroll
            for (int r = 0; r < 4; ++r) *(LAS unsigned short*)(LP + (16 * mi + 4 * g + r) * RSS + 2 * j) = (unsigned short)f2bf(o[r]);
        } else {
#pragma unroll
            for (int r = 0; r < 4; ++r) *(LAS unsigned short*)(LAT + (16 * mi + 4 * g + r) * RSS + 2 * j) = (unsigned short)f2bf(o[r]);
        }
    }
#pragma unroll 1
    for (int s5 = 0; s5 < 5; ++s5) {
        __syncthreads();
        f32x4 Pn[2];
#pragma unroll
        for (int tt = 0; tt < 2; ++tt) { const int id = wave + 8 * tt, mi = id >> 2, nj = id & 3;
            Pn[tt] = tile_k64(LP + (16 * mi + c) * RSS + 16 * g, LPT + (16 * nj + c) * RSS + 16 * g, (f32x4){0.f, 0.f, 0.f, 0.f}); }
        __syncthreads();
#pragma unroll
        for (int tt = 0; tt < 2; ++tt) { const int id = wave + 8 * tt, mi = id >> 2, nj = id & 3, j = 16 * nj + c;
            u32x2 w; w.x = pk2(Pn[tt][0], Pn[tt][1]); w.y = pk2(Pn[tt][2], Pn[tt][3]);
            *(LAS u32x2*)(LPT + j * RSS + 2 * (16 * mi + 4 * g)) = w;
#pragma unroll
            for (int r = 0; r < 4; ++r) *(LAS unsigned short*)(LP + (16 * mi + 4 * g + r) * RSS + 2 * j) = (unsigned short)f2bf(Pn[tt][r]); }
        __syncthreads();
        f32x4 En[2];
#pragma unroll
        for (int tt = 0; tt < 2; ++tt) { const int id = wave + 8 * tt, mi = id >> 2, nj = id & 3;
            En[tt] = tile_k64(LP + (16 * mi + c) * RSS + 16 * g, LET + (16 * nj + c) * RSS + 16 * g, Er[tt] + Pn[tt]); }
        __syncthreads();
#pragma unroll
        for (int tt = 0; tt < 2; ++tt) { const int id = wave + 8 * tt, mi = id >> 2, nj = id & 3, j = 16 * nj + c;
            Er[tt] = En[tt];
            u32x2 w; w.x = pk2(En[tt][0], En[tt][1]); w.y = pk2(En[tt][2], En[tt][3]);
            *(LAS u32x2*)(LET + j * RSS + 2 * (16 * mi + 4 * g)) = w; }
    }
    if (VAR == 2) { __syncthreads(); return; }
#pragma unroll
    for (int tt = 0; tt < 2; ++tt) { const int id = wave + 8 * tt, mi = id >> 2, nj = id & 3, j = 16 * nj + c;
#pragma unroll
        for (int r = 0; r < 4; ++r) *(LAS unsigned short*)(LE + (16 * mi + 4 * g + r) * RSS + 2 * j) = (unsigned short)f2bf(Er[tt][r]); }
    __syncthreads();
    {
        f32x4 xo[8];
#pragma unroll
        for (int q = 0; q < 8; ++q) { const int t = wave + 8 * q, mi = t >> 4, ct = t & 15;
            const u32x2 rv = *(const LAS u32x2*)(LRT + (16 * ct + c) * RSS + 2 * (16 * mi + 4 * g));
            xo[q] = tile_k64(LE + (16 * mi + c) * RSS + 16 * g, LRT + (16 * ct + c) * RSS + 16 * g, (f32x4){bflo(rv.x), bfhi(rv.x), bflo(rv.y), bfhi(rv.y)}); }
        __syncthreads();
#pragma unroll
        for (int q = 0; q < 8; ++q) { const int t = wave + 8 * q, mi = t >> 4, ct = t & 15;
            u32x2 w; w.x = pk2(xo[q][0], xo[q][1]); w.y = pk2(xo[q][2], xo[q][3]);
            *(LAS u32x2*)(LUW + (16 * ct + c) * RSS + 2 * (16 * mi + 4 * g)) = w; }
    }
    __syncthreads();
    if (VAR == 3) return;
    const LAS unsigned char* UWr = LUW; const LAS unsigned char* ATr = LAT; const LAS unsigned char* KTr = LKT;
    const size_t cbase = (size_t)unit; const f32x4 z4 = {0.f, 0.f, 0.f, 0.f};
    for (int t = wave; t < 32; t += 8) { const int xi = t >> 3, yj = t & 7;
        const f32x4 d = tile_k64(ATr + (16 * xi + c) * RSS + 16 * g, UWr + (16 * yj + c) * RSS + 16 * g, z4);
        u32x2 w; w.x = pk2(d[0], d[1]); w.y = pk2(d[2], d[3]);
        *(GAS u32x2*)(WSP(bf16, WS_OLOCT) + cbase * 8192 + (size_t)((yj * 4 + xi) * 64 + lane) * 4) = w; }
    for (int t = wave; t < 32; t += 8) { const int xi = t >> 2, yj = t & 3;
        const f32x4 d = tile_k64(UWr + (128 + 16 * xi + c) * RSS + 16 * g, ATr + (16 * yj + c) * RSS + 16 * g, z4);
        const int i2 = 16 * yj + c, dd = 16 * xi + 4 * g; const float eg = __expf(gcs[i2]);
        const u32x2 qv = *(const LAS u32x2*)(LQB + i2 * RSB + 2 * dd);
        u32x2 w; w.x = pk2(bflo(qv.x) * eg - d[0], bfhi(qv.x) * eg - d[1]); w.y = pk2(bflo(qv.y) * eg - d[2], bfhi(qv.y) * eg - d[3]);
        *(GAS u32x2*)(WSP(bf16, WS_QEFF) + cbase * 8192 + (size_t)(((yj * 4 + (xi >> 1)) * 64 + (2 * (xi & 1) + (g >> 1)) * 16 + c) * 8 + 4 * (g & 1))) = w; }
    for (int t = wave; t < 64; t += 8) { const int xi = t >> 3, yj = t & 7;
        const f32x4 d = tile_k64(KTr + (16 * xi + c) * RSS + 16 * g, UWr + (16 * yj + c) * RSS + 16 * g, z4);
        u32x2 w; w.x = pk2(d[0], d[1]); w.y = pk2(d[2], d[3]);
        *(GAS u32x2*)(WSP(bf16, WS_BMT) + cbase * 16384 + (size_t)(((yj * 4 + (xi >> 1)) * 2 + (xi & 1)) * 64 + lane) * 4) = w; }
    for (int t = wave; t < 64; t += 8) { const int xi = t >> 3, yj = t & 7;
        const f32x4 d = tile_k64(UWr + (128 + 16 * xi + c) * RSS + 16 * g, KTr + (16 * yj + c) * RSS + 16 * g, z4);
        u32x2 w; w.x = pk2(-d[0], -d[1]); w.y = pk2(-d[2], -d[3]);
        *(GAS u32x2*)(WSP(bf16, WS_MNEG) + cbase * 16384 + (size_t)(((yj * 4 + (xi >> 1)) * 64 + (2 * (xi & 1) + (g >> 1)) * 16 + c) * 8 + 4 * (g & 1))) = w; }
    if (F.tid == 0) WSP(float, WS_GLAST)[unit] = __expf(gc63);
    __syncthreads();
}

constexpr int SCAN_PF = 4;
__device__ __forceinline__ void scan_wg(Frame& F, int sw) {
    const int bh = sw & 15, slice = sw >> 4, b = bh >> 2, h = bh & 3;
    const int lane = F.lane, wave = F.wave, g = lane >> 4, c = lane & 15;
    LAS unsigned char* ST = opq_v(F.lds);
    LAS unsigned char* OS = ST + 8704;
    for (int i = F.tid; i < 2 * 4352 / 4; i += 512) ((LAS unsigned*)ST)[i] = 0u;
    __syncthreads();
    const GAS bf16* MN = (const GAS bf16*)(WSP(bf16, WS_MNEG) + (size_t)bh * 64 * 16384); const GAS bf16* BM = (const GAS bf16*)(WSP(bf16, WS_BMT) + (size_t)bh * 64 * 16384);
    const GAS bf16* QE = (const GAS bf16*)(WSP(bf16, WS_QEFF) + (size_t)bh * 64 * 8192); const GAS bf16* OL = (const GAS bf16*)(WSP(bf16, WS_OLOCT) + (size_t)bh * 64 * 8192);
    const GAS float* GL = (const GAS float*)(WSP(float, WS_GLAST) + bh * 64);
    (void)b; (void)h;
    if (wave < 4) {
        f32x4 Sreg[2] = {{0.f, 0.f, 0.f, 0.f}, {0.f, 0.f, 0.f, 0.f}};
        bf16x8 Af[SCAN_PF][2][4]; u32x2 bm[SCAN_PF][2]; float gl[SCAN_PF];
#define SCAN_LOAD_REC(j, n) do { const size_t cb_ = (size_t)(n) * 16384; \
        _Pragma("unroll") for (int mt = 0; mt < 2; ++mt) { _Pragma("unroll") for (int s = 0; s < 4; ++s) Af[j][mt][s] = *(const GAS bf16x8*)(MN + cb_ + (size_t)(((wave * 2 + mt) * 4 + s) * 64 + lane) * 8); \
            bm[j][mt] = *(const GAS u32x2*)(BM + cb_ + (size_t)(((slice * 4 + wave) * 2 + mt) * 64 + lane) * 4); } gl[j] = GL[n]; } while (0)
#pragma unroll
        for (int j = 0; j < SCAN_PF; ++j) SCAN_LOAD_REC(j, j);
#pragma unroll 1
        for (int n0 = 0; n0 < 64; n0 += SCAN_PF) {
#pragma unroll
            for (int j = 0; j < SCAN_PF; ++j) {
                const int n = n0 + j; const int cur = n & 1;
                bf16x8 Sb[4];
#pragma unroll
                for (int s = 0; s < 4; ++s) Sb[s] = *(const LAS bf16x8*)(ST + cur * 4352 + c * 272 + 64 * s + 16 * g);
#pragma unroll
                for (int mt = 0; mt < 2; ++mt) {
                    f32x4 acc; acc[0] = gl[j] * Sreg[mt][0] + bflo(bm[j][mt].x); acc[1] = gl[j] * Sreg[mt][1] + bfhi(bm[j][mt].x); acc[2] = gl[j] * Sreg[mt][2] + bflo(bm[j][mt].y); acc[3] = gl[j] * Sreg[mt][3] + bfhi(bm[j][mt].y);
#pragma unroll
                    for (int s = 0; s < 4; ++s) acc = __builtin_amdgcn_mfma_f32_16x16x32_bf16(Af[j][mt][s], Sb[s], acc, 0, 0, 0);
                    Sreg[mt] = acc;
                    u32x2 w; w.x = pk2(acc[0], acc[1]); w.y = pk2(acc[2], acc[3]);
                    *(LAS u32x2*)(ST + (cur ^ 1) * 4352 + c * 272 + 2 * (32 * wave + 16 * mt + 4 * g)) = w;
                }
                if (n + SCAN_PF < 64) SCAN_LOAD_REC(j, n + SCAN_PF);
                __syncthreads();
            }
        }
#undef SCAN_LOAD_REC
        __syncthreads();
    } else {
        const int m = wave - 4;
        bf16x8 Qf[SCAN_PF][4]; u32x2 ol[SCAN_PF];
        GAS bf16* OU = (GAS bf16*)(WSP(bf16, WS_OUN) + ((size_t)(bh * 8 + slice) * SEQ) * 16);
#define SCAN_LOAD_OUT(j, n) do { const size_t cb_ = (size_t)(n) * 8192; \
        _Pragma("unroll") for (int s = 0; s < 4; ++s) Qf[j][s] = *(const GAS bf16x8*)(QE + cb_ + (size_t)((m * 4 + s) * 64 + lane) * 8); \
        ol[j] = *(const GAS u32x2*)(OL + cb_ + (size_t)((slice * 4 + m) * 64 + lane) * 4); } while (0)
#define SCAN_FLUSH(n) do { if (m < 2) { const int q_ = m * 64 + lane; const u32x4 v_ = *(const LAS u32x4*)(OS + ((n) & 1) * 2048 + q_ * 16); *(GAS u32x4*)(OU + (size_t)(n) * 1024 + q_ * 8) = v_; } } while (0)
#pragma unroll
        for (int j = 0; j < SCAN_PF; ++j) SCAN_LOAD_OUT(j, j);
#pragma unroll 1
        for (int n0 = 0; n0 < 64; n0 += SCAN_PF) {
#pragma unroll
            for (int j = 0; j < SCAN_PF; ++j) {
                const int n = n0 + j; const int cur = n & 1;
                if (n > 0) SCAN_FLUSH(n - 1);
                bf16x8 Sb[4];
#pragma unroll
                for (int s = 0; s < 4; ++s) Sb[s] = *(const LAS bf16x8*)(ST + cur * 4352 + c * 272 + 64 * s + 16 * g);
                f32x4 acc; acc[0] = bflo(ol[j].x); acc[1] = bfhi(ol[j].x); acc[2] = bflo(ol[j].y); acc[3] = bfhi(ol[j].y);
#pragma unroll
                for (int s = 0; s < 4; ++s) acc = __builtin_amdgcn_mfma_f32_16x16x32_bf16(Qf[j][s], Sb[s], acc, 0, 0, 0);
#pragma unroll
                for (int r = 0; r < 4; ++r) *(LAS unsigned short*)(OS + cur * 2048 + (16 * m + 4 * g + r) * 32 + 2 * c) = (unsigned short)f2bf(acc[r]);
                if (n + SCAN_PF < 64) SCAN_LOAD_OUT(j, n + SCAN_PF);
                __syncthreads();
            }
        }
        SCAN_FLUSH(63);
        __syncthreads();
#undef SCAN_LOAD_OUT
#undef SCAN_FLUSH
    }
}

constexpr int AT_KS = 0, AT_VS = 36864;
__device__ __forceinline__ s16x4 vtr(const LAS unsigned char* p) { typedef short v4i16_t __attribute__((ext_vector_type(4))); return __builtin_bit_cast(s16x4, __builtin_amdgcn_ds_read_tr16_b64_v4i16((LAS v4i16_t*)p)); }
__device__ __forceinline__ void attn_unit(Frame& F, int a) {
    const int bhh = a / 96, rem = a % 96, br = rem >> 5, idx = rem & 31, b = bhh >> 3, hh = bhh & 7;
    const int dil = br == 0 ? 1 : br == 1 ? 4 : 16, nblk = 32 / dil, res = idx / nblk, n = idx % nblk;
    const int lane = F.lane, wave = F.wave, g = lane >> 4, c = lane & 15;
    LAS unsigned char* L = opq_v(F.lds);
    const bf16* QKVD = WSP(bf16, WS_QKVD);
    {
        const int j = F.tid >> 1, half = F.tid & 1; const int kidx = 128 * (n - 1) + j;
        u32x4 kv[4], vv[4];
        { const bool okk = kidx >= 0; const bf16* src = QKVD + (size_t)(b * SEQ + (okk ? kidx : 0) * dil + res) * 1536 + hh * 64 + half * 32;
#pragma unroll
            for (int q = 0; q < 4; ++q) { kv[q] = *(const GAS u32x4*)(src + 512 + 8 * q); vv[q] = *(const GAS u32x4*)(src + 1024 + 8 * q); }
            if (!okk) {
#pragma unroll
                for (int q = 0; q < 4; ++q) { kv[q] = (u32x4){0u, 0u, 0u, 0u}; vv[q] = (u32x4){0u, 0u, 0u, 0u}; } } }
#pragma unroll
        for (int q = 0; q < 4; ++q) { *(LAS u32x4*)(L + AT_KS + j * RSS + half * 64 + 16 * q) = kv[q]; *(LAS u32x4*)(L + AT_VS + j * RSS + half * 64 + 16 * q) = vv[q]; }
    }
    const int qi = 16 * wave + c;
    const size_t qtok = (size_t)(b * SEQ + (128 * n + qi) * dil + res);
    bf16x8 Bq[2];
#pragma unroll
    for (int s = 0; s < 2; ++s) Bq[s] = *(const GAS bf16x8*)(QKVD + qtok * 1536 + hh * 64 + 32 * s + 8 * g);
    __syncthreads();
    f32x4 sc[9];
    float mx = -1.0e30f;
#pragma unroll
    for (int t = 0; t < 9; ++t) {
        const LAS unsigned char* kr = L + AT_KS + (16 * (wave + t) + c) * RSS + 16 * g;
        f32x4 acc = {0.f, 0.f, 0.f, 0.f};
        acc = __builtin_amdgcn_mfma_f32_16x16x32_bf16(*(const LAS bf16x8*)kr, Bq[0], acc, 0, 0, 0);
        acc = __builtin_amdgcn_mfma_f32_16x16x32_bf16(*(const LAS bf16x8*)(kr + 64), Bq[1], acc, 0, 0, 0);
#pragma unroll
        for (int r = 0; r < 4; ++r) { const int j = 16 * (wave + t) + 4 * g + r; const bool ok = (j >= qi) && (j <= qi + 128) && (n > 0 || j >= 128);
            acc[r] = ok ? acc[r] * (0.125f * 1.4426950408889634f) : -1.0e30f; mx = fmaxf(mx, acc[r]); }
        sc[t] = acc;
    }
    mx = fmaxf(mx, __shfl_xor(mx, 16)); mx = fmaxf(mx, __shfl_xor(mx, 32));
    float lsum = 0.f;
#pragma unroll
    for (int t = 0; t < 9; ++t)
#pragma unroll
        for (int r = 0; r < 4; ++r) { const float p = __builtin_amdgcn_exp2f(sc[t][r] - mx); sc[t][r] = p; lsum += p; }
    lsum += __shfl_xor(lsum, 16); lsum += __shfl_xor(lsum, 32);
    bf16x8 pf[5];
#pragma unroll
    for (int u = 0; u < 5; ++u) { u32x4 w; w.x = pk2(sc[2 * u][0], sc[2 * u][1]); w.y = pk2(sc[2 * u][2], sc[2 * u][3]);
        if (u < 4) { w.z = pk2(sc[2 * u + 1][0], sc[2 * u + 1][1]); w.w = pk2(sc[2 * u + 1][2], sc[2 * u + 1][3]); } else { w.z = 0u; w.w = 0u; }
        pf[u] = __builtin_bit_cast(bf16x8, w); }
    float linv[4];
#pragma unroll
    for (int r = 0; r < 4; ++r) linv[r] = 1.f / __shfl(lsum, 4 * g + r);
    bf16* OP = WSP(bf16, WS_OPART) + (size_t)br * T * 512;
#pragma unroll
    for (int dt = 0; dt < 4; ++dt) {
        f32x4 acc = {0.f, 0.f, 0.f, 0.f};
#pragma unroll
        for (int u = 0; u < 5; ++u) { const int kb = 16 * (wave + 2 * u);
            const LAS unsigned char* vp = L + AT_VS + (kb + 4 * g + (c >> 2)) * RSS + (16 * dt + 4 * (c & 3)) * 2;
            const s16x4 lo = vtr(vp); s16x4 hi = {0, 0, 0, 0}; if (u < 4) hi = vtr(vp + 16 * RSS);
            const bf16x8 bv = {lo[0], lo[1], lo[2], lo[3], hi[0], hi[1], hi[2], hi[3]};
            acc = __builtin_amdgcn_mfma_f32_16x16x32_bf16(pf[u], bv, acc, 0, 0, 0); }
#pragma unroll
        for (int r = 0; r < 4; ++r) { const size_t tok = (size_t)(b * SEQ + (128 * n + 16 * wave + 4 * g + r) * dil + res);
            OP[tok * 512 + hh * 64 + 16 * dt + c] = (bf16)f2bf(acc[r] * linv[r]); }
    }
    if (g == 0) WSP(float, WS_LSE)[((size_t)br * T + qtok) * 8 + hh] = (mx + __log2f(lsum)) * 0.6931471805599453f;
    __syncthreads();
}

__device__ __forceinline__ void mix_pass(Frame& F, const Args& A) {
    const int lane = F.lane;
    float nw[8];
    { const f32x4 a = *(const GAS f32x4*)(A.in[6] + 8 * (lane & 15)), b = *(const GAS f32x4*)(A.in[6] + 8 * (lane & 15) + 4);
#pragma unroll
      for (int e = 0; e < 4; ++e) { nw[e] = a[e]; nw[4 + e] = b[e]; } }
    const bf16* OU = WSP(bf16, WS_OUN); const bf16* ZB = WSP(bf16, WS_ZB); const bf16* OP = WSP(bf16, WS_OPART); const float* LSE = WSP(float, WS_LSE); bf16* MIX = WSP(bf16, WS_MIX);
    for (int t = F.gw; t < T; t += F.NGW) {
        const u32x4 uo = *(const GAS u32x4*)(OU + ((size_t)(((t >> 12) * 4 + (lane >> 4)) * 8 + ((lane & 15) >> 1)) * SEQ + (t & 4095)) * 16 + 8 * (lane & 1)), uz = *(const GAS u32x4*)(ZB + (size_t)t * 512 + 8 * lane);
        float x[8], z[8];
#pragma unroll
        for (int e = 0; e < 4; ++e) { x[2 * e] = bflo(uo[e]); x[2 * e + 1] = bfhi(uo[e]); z[2 * e] = bflo(uz[e]); z[2 * e + 1] = bfhi(uz[e]); }
        float ss = 0.f;
#pragma unroll
        for (int e = 0; e < 8; ++e) ss += x[e] * x[e];
        ss += __shfl_xor(ss, 1); ss += __shfl_xor(ss, 2); ss += __shfl_xor(ss, 4); ss += __shfl_xor(ss, 8);
        const float rstd = rsqrtf(ss * (1.f / 128.f) + RMS_EPS);
        float o[8];
#pragma unroll
        for (int e = 0; e < 8; ++e) o[e] = x[e] * rstd * nw[e] * silu_f(z[e]);
        u32x4 w; w.x = pk2(o[0], o[1]); w.y = pk2(o[2], o[3]); w.z = pk2(o[4], o[5]); w.w = pk2(o[6], o[7]);
        *(GAS u32x4*)(MIX + (size_t)t * D + 8 * lane) = w;
        const int hh = lane >> 3;
        const float l0 = LSE[((size_t)0 * T + t) * 8 + hh], l1 = LSE[((size_t)1 * T + t) * 8 + hh], l2 = LSE[((size_t)2 * T + t) * 8 + hh];
        const float lm = fmaxf(l0, fmaxf(l1, l2)); const float e0 = __expf(l0 - lm), e1 = __expf(l1 - lm), e2 = __expf(l2 - lm); const float inv = 1.f / (e0 + e1 + e2);
        const u32x4 p0 = *(const GAS u32x4*)(OP + ((size_t)0 * T + t) * 512 + 8 * lane), p1 = *(const GAS u32x4*)(OP + ((size_t)1 * T + t) * 512 + 8 * lane), p2 = *(const GAS u32x4*)(OP + ((size_t)2 * T + t) * 512 + 8 * lane);
        const float w0 = e0 * inv, w1 = e1 * inv, w2 = e2 * inv;
        u32x4 wo;
#pragma unroll
        for (int e = 0; e < 4; ++e) wo[e] = pk2(w0 * bflo(p0[e]) + w1 * bflo(p1[e]) + w2 * bflo(p2[e]), w0 * bfhi(p0[e]) + w1 * bfhi(p1[e]) + w2 * bfhi(p2[e]));
        *(GAS u32x4*)(MIX + (size_t)t * D + 512 + 8 * lane) = wo;
    }
}

constexpr int N_PHASES = 29;
#define D1V 0
__global__ void __launch_bounds__(512, 2) fwd_kernel(Args args) {
    extern __shared__ __attribute__((aligned(16))) unsigned char lds_raw[];
    Frame F;
    F.lds = (LAS unsigned char*)lds_raw; F.ws = args.ws; F.ctl = (gu32*)(args.ws + WS_CTL);
    F.tid = threadIdx.x; F.lane = F.tid & 63; F.wave = __builtin_amdgcn_readfirstlane(F.tid >> 6);
    F.G = gridDim.x; F.gw = blockIdx.x * 8 + F.wave; F.NGW = F.G * 8;
    volatile LAS unsigned* MISC = (volatile LAS unsigned*)(F.lds + MISC_OFF); const char* wsb = (const char*)args.ws;
    for (int u = F.tid; u < 256; u += 512) MISC[u] = 0u;
    __syncthreads();
    const int lo = args.ph_lo, hi = args.ph_hi;
    XcdBarrier bar; bar.bar = (unsigned*)(F.ctl + CW_BAR); bar.x = 0; bar.st = MISC + 8;
    if (hi - lo > 1) bar = xcd_barrier_post((unsigned*)(F.ctl + CW_BAR), MISC + 8);
    LAS unsigned char* ring = F.lds; LAS unsigned char* xch = F.lds + XCH_OFF;
    volatile LAS unsigned* tab = MISC + 32;
    const int c = blockIdx.x, G = F.G; int qsel = 0;
#ifndef PHASE_MASK
#define PHASE_MASK 0xFFFFFFFFu
#endif
#define IN(k) ((((PHASE_MASK) >> (k)) & 1u) && lo <= (k) && (k) < hi)
#define SEAM(k) do { if (IN(k) && IN((k) + 1)) xcd_barrier(bar); } while (0)
#define PH_BEGIN() do { const int t_ = opq_v((int)threadIdx.x); F.tid = t_; F.lane = t_ & 63; F.wave = __builtin_amdgcn_readfirstlane(t_ >> 6); F.gw = blockIdx.x * 8 + F.wave; \
        unsigned char* w_ = opq_s(args.ws); F.ws = w_; F.ctl = (gu32*)(w_ + WS_CTL); xch = opq_v(F.lds + XCH_OFF); MISC = (volatile LAS unsigned*)opq_v(F.lds + MISC_OFF); tab = MISC + 32; bar.st = MISC + 8; wsb = (const char*)w_; } while (0)
#define HBc (wsb + WS_HB)

    if (IN(0)) { PH_BEGIN(); p0_prologue(F, args); SEAM(0); }
    if (IN(1)) { PH_BEGIN();
        SchedP1 S{HBc, (const char*)(wsb + WS_W_IN), (const char*)(wsb + WS_MEMB), (const char*)(wsb + WS_W_KV), G, c};
        EpiP1 E{WSP(bf16, WS_QKVPRE), WSP(bf16, WS_ZB), WSP(bf16, WS_QKVD), WSP(bf16, WS_KMEM), WSP(bf16, WS_VT)};
        pg8::gemm_phase(ring, xch, pg8::Gemm{D, D, D}, S, E); SEAM(1);
    }
    if (IN(2)) { PH_BEGIN(); for (int u = c; u < NB * DNH * NCHUNK; u += G) d1_unit<D1V>(F, args, u); SEAM(2); }
    if (IN(3)) { PH_BEGIN();
        if (c < 128) scan_wg(F, c);
        for (;;) {
            if (F.tid == 0) MISC[20] = __hip_atomic_fetch_add((unsigned*)(F.ctl + CW_QUEUE + 16 * qsel), 1u, RLX_AGENT);
            __syncthreads(); const int a = (int)MISC[20]; __syncthreads();
            if (a >= NB * DAH * 96) break;
            attn_unit(F, a);
        }
        ++qsel;
        SEAM(3);
    }
    if (IN(4)) { PH_BEGIN(); mix_pass(F, args); SEAM(4); }

#pragma unroll
    for (int layer = 0; layer < 2; ++layer) {
        const int pb = layer * 13;
        if (layer == 0) {
            if (IN(5)) { PH_BEGIN(); convert_moe(F, args, 0); __syncthreads();
                SchedDense S{(const char*)(wsb + WS_MIX), (const char*)(wsb + WS_W_ABO), D, D, 64, 4, G, c}; EpiDense E{WSP(bf16, 288 * MiB), D, 1.f};
                pg8::gemm_phase(ring, xch, pg8::Gemm{D, D, D}, S, E); SEAM(5); }
            if (IN(6)) { PH_BEGIN(); ln_pass<0, false, false>(F, args, WSP(bf16, WS_HB), WSP(bf16, 288 * MiB), 0, nullptr, WSP(bf16, WS_HB), nullptr); SEAM(6); }
        } else {
            if (IN(16)) { PH_BEGIN(); convert_moe(F, args, 1); __syncthreads();
                SchedDense S{HBc, (const char*)(wsb + WS_W_SCI), D, D, 64, 12, G, c}; EpiDense E{WSP(bf16, 192 * MiB), 3 * D, 1.f};
                pg8::gemm_phase(ring, xch, pg8::Gemm{D, D, D}, S, E); SEAM(16); }
            if (IN(17)) { PH_BEGIN(); conv_pass(F, args, WSP(bf16, 192 * MiB), WSP(bf16, 288 * MiB)); SEAM(17); }
            if (IN(18)) { PH_BEGIN(); SchedDense S{(const char*)(wsb + 288 * MiB), (const char*)(wsb + WS_W_SCO), D, D, 64, 4, G, c}; EpiDense E{WSP(bf16, 192 * MiB), D, 1.f};
                pg8::gemm_phase(ring, xch, pg8::Gemm{D, D, D}, S, E); SEAM(18); }
            if (IN(19)) { PH_BEGIN(); ln_pass<0, false, false>(F, args, WSP(bf16, WS_HB), WSP(bf16, 192 * MiB), 3, nullptr, WSP(bf16, WS_HB), nullptr); SEAM(19); }
        }
        const size_t oQ = (layer == 0 ? 192 : 224) * MiB, oP = (layer == 0 ? 224 : 256) * MiB, oO = (layer == 0 ? 256 : 288) * MiB, oY = (layer == 0 ? 288 : 192) * MiB;
        const int p7 = layer == 0 ? 7 : 20;
        if (IN(p7)) { PH_BEGIN(); SchedDense S{HBc, (const char*)(wsb + WS_W_Q + (size_t)layer * D * D * 2), D, D, 64, 4, G, c}; EpiDense E{WSP(bf16, oQ), D, 0.0625f * 1.4426950408889634f};
            pg8::gemm_phase(ring, xch, pg8::Gemm{D, D, D}, S, E); SEAM(p7); }
        if (IN(p7 + 1)) { PH_BEGIN(); SchedXS S{(const char*)(wsb + oQ), (const char*)(wsb + WS_KMEM + (size_t)layer * TM * D * 2), G, c}; EpiSoftmax E{WSP(bf16, oP)};
            pg8::gemm_phase(ring, xch, pg8::Gemm{D, D, XD}, S, E); SEAM(p7 + 1); }
        if (IN(p7 + 2)) { PH_BEGIN(); SchedXP S{(const char*)(wsb + oP), (const char*)(wsb + WS_VT + (size_t)layer * NB * XH * XD * NMEM * 2), G, c};
            EpiDense E{WSP(bf16, oO), D, 1.f};
            pg8::gemm_phase(ring, xch, pg8::Gemm{D, NMEM, NMEM}, S, E); SEAM(p7 + 2); }
        if (IN(p7 + 3)) { PH_BEGIN(); SchedDense S{(const char*)(wsb + oO), (const char*)(wsb + WS_W_O + (size_t)layer * D * D * 2), D, D, 64, 4, G, c}; EpiDense E{WSP(bf16, oY), D, 1.f};
            pg8::gemm_phase(ring, xch, pg8::Gemm{D, D, D}, S, E); SEAM(p7 + 3); }
        unsigned* cnt = (unsigned*)(F.ctl + (layer == 0 ? CW_CNT0 : CW_CNT1));
        if (IN(p7 + 4)) { PH_BEGIN(); ln_pass<0, true, false>(F, args, WSP(bf16, WS_HB), WSP(bf16, oY), layer * 3 + 1, nullptr, WSP(bf16, WS_HB), cnt); SEAM(p7 + 4); }
        if (IN(p7 + 5)) { PH_BEGIN(); moe_table(F, cnt, tab); moe_gather(F, WSP(bf16, WS_HB), WSP(bf16, WS_XG), tab); SEAM(p7 + 5); }
        if (IN(p7 + 6)) { PH_BEGIN(); moe_table(F, cnt, tab);
            SchedMoE S{(const char*)(wsb + WS_XG), (const char*)(wsb + WS_MOEW_GU), tab, D, D, D, G, c}; EpiSwiglu E{WSP(bf16, WS_HACT)};
            pg8::gemm_phase(ring, xch, pg8::Gemm{D, D, D}, S, E); SEAM(p7 + 6); }
        if (IN(p7 + 7)) { PH_BEGIN(); moe_table(F, cnt, tab);
            SchedMoE S{(const char*)(wsb + WS_HACT), (const char*)(wsb + WS_MOEW_D), tab, DE, D, DE, G, c}; EpiDense E{WSP(bf16, WS_XG), D, 1.f};
            pg8::gemm_phase(ring, xch, pg8::Gemm{DE, DE, DE}, S, E); SEAM(p7 + 7); }
        if (layer == 0) { if (IN(15)) { PH_BEGIN(); ln_pass<1, false, false>(F, args, WSP(bf16, WS_HB), WSP(bf16, WS_XG), 2, nullptr, WSP(bf16, WS_HB), nullptr); SEAM(15); } }
        else { if (IN(28)) { PH_BEGIN(); ln_pass<1, false, true>(F, args, WSP(bf16, WS_HB), WSP(bf16, WS_XG), 5, args.out, nullptr, nullptr); SEAM(28); } }
        (void)pb;
    }
#undef IN
#undef SEAM
}

extern "C" void kernel_launch(void* const* d_in, const int* in_sizes, int n_in, void* d_out, int out_size, void* d_ws, size_t ws_size, hipStream_t stream) {
    static int grid = 0;
    if (grid == 0) {
        if (n_in != 21 || out_size != T * D || ws_size < WS_END) { fprintf(stderr, "kernel_launch: unexpected problem (n_in %d, out %d, ws %zu < %zu)\n", n_in, out_size, ws_size, (size_t)WS_END); grid = -1; return; }
        int dev = 0, cus = 0, per_cu = 0;
        if (hipGetDevice(&dev) != hipSuccess || hipDeviceGetAttribute(&cus, hipDeviceAttributeMultiprocessorCount, dev) != hipSuccess) { grid = -1; return; }
        if (hipFuncSetAttribute((const void*)fwd_kernel, hipFuncAttributeMaxDynamicSharedMemorySize, LDS_BYTES) != hipSuccess) { fprintf(stderr, "kernel_launch: hipFuncSetAttribute failed\n"); grid = -1; return; }
        if (hipOccupancyMaxActiveBlocksPerMultiprocessor(&per_cu, (const void*)fwd_kernel, 512, LDS_BYTES) != hipSuccess || per_cu < 1) { fprintf(stderr, "kernel_launch: occupancy query says %d blocks per CU\n", per_cu); (void)hipGetLastError(); per_cu = 1; }
        grid = cus;
    }
    if (grid < 0) return;
    (void)hipMemsetAsync((char*)d_ws + WS_CTL, 0, CTL_ZERO_BYTES, stream);
    Args a{};
    for (int i = 0; i < 21; ++i) a.in[i] = (const float*)d_in[i];
    a.out = (float*)d_out; a.ws = (unsigned char*)d_ws;
#if MK_ONE_LAUNCH
    a.ph_lo = 0; a.ph_hi = N_PHASES;
    hipLaunchKernelGGL(fwd_kernel, dim3(grid), dim3(512), LDS_BYTES, stream, a);
#else
    for (int p = 0; p < N_PHASES; ++p) { a.ph_lo = p; a.ph_hi = p + 1; hipLaunchKernelGGL(fwd_kernel, dim3(grid), dim3(512), LDS_BYTES, stream, a); }
#endif
}
```

```cpp
#include <hip/hip_runtime.h>
#include <cstdio>
#include <cstdint>

#ifndef MK_ONE_LAUNCH
#define MK_ONE_LAUNCH 1
#endif

#define LAS __attribute__((address_space(3)))
#define GAS __attribute__((address_space(1)))
typedef unsigned short bf16;
typedef short bf16x8 __attribute__((ext_vector_type(8)));
typedef short s16x4 __attribute__((ext_vector_type(4)));
typedef float f32x4 __attribute__((ext_vector_type(4)));
typedef float f32x2 __attribute__((ext_vector_type(2)));
typedef unsigned u32x4 __attribute__((ext_vector_type(4)));
typedef unsigned u32x2 __attribute__((ext_vector_type(2)));
typedef GAS unsigned gu32;
#define RLX_AGENT __ATOMIC_RELAXED, __HIP_MEMORY_SCOPE_AGENT
#define LDS_WAIT() asm volatile("s_waitcnt lgkmcnt(0)" ::: "memory")
#define VM_WAIT() asm volatile("s_waitcnt vmcnt(0)" ::: "memory")

constexpr int NB = 4, SEQ = 4096, T = NB * SEQ, D = 1024;
constexpr int NMEM = 256, TM = NB * NMEM;
constexpr int DNH = 4, DND = 128, DNW = 512, DNC = 64, NCHUNK = SEQ / DNC;
constexpr int DAH = 8, DAD = 64, DAW = 512;
constexpr int AB_IN = 3592;
constexpr int XH = 4, XD = 256;
constexpr int NE = 16, DE = 512;
constexpr float ALPHA = 1.41421356237f;
constexpr float LN_EPS = 1e-5f, RMS_EPS = 1e-6f;
constexpr int MOE_ROWS = 2 * T + NE * 256;

constexpr size_t MiB = 1u << 20;
constexpr size_t WS_CTL = 0, CTL_ZERO_BYTES = 1 * MiB;
constexpr size_t WS_W_IN = 1 * MiB, WS_W_ABO = 8 * MiB, WS_W_SCI = 10 * MiB, WS_W_SCO = 16 * MiB, WS_W_Q = 18 * MiB, WS_W_KV = 22 * MiB, WS_W_O = 30 * MiB;
constexpr size_t WS_MEMB = 34 * MiB, WS_KMEM = 36 * MiB, WS_VT = 40 * MiB, WS_BETA = 44 * MiB, WS_GG = 45 * MiB, WS_ROUTE = 46 * MiB, WS_GLAST = 47 * MiB;
constexpr size_t WS_MT = 80 * MiB, WS_VWT = 96 * MiB;
constexpr size_t WS_HB = 48 * MiB, WS_H = 80 * MiB, WS_ARENA = 144 * MiB, WS_END = 320 * MiB;
constexpr size_t WS_QKVPRE = 144 * MiB, WS_ZB = 192 * MiB, WS_QKVD = 208 * MiB, WS_MNEG = 80 * MiB, WS_BMT = 112 * MiB, WS_QEFF = 256 * MiB, WS_OLOCT = 272 * MiB;
constexpr size_t WS_OUN = 288 * MiB, WS_LSE = 304 * MiB, WS_OPART = 144 * MiB, WS_MIX = 256 * MiB;
constexpr size_t WS_MOEW_GU = 144 * MiB, WS_MOEW_D = 176 * MiB, WS_XG = 192 * MiB, WS_HACT = 264 * MiB;
constexpr size_t WS_MOEW_GU1 = 112 * MiB, WS_MOEW_D1 = 144 * MiB;
static_assert((size_t)MOE_ROWS * D * 2 <= 72 * MiB && (size_t)MOE_ROWS * DE * 2 <= 36 * MiB, "moe buffers");
constexpr int CW_TMO = 0, CW_BAR = 4096, CW_QUEUE = 64, CW_CNT0 = 128, CW_CNT1 = 192, CW_CVQ = 256;

constexpr int LDS_BYTES = 163840, MISC_OFF = 162816, XCH_OFF = 131072;

typedef __bf16 bf16x2_t __attribute__((ext_vector_type(2)));
__device__ __forceinline__ unsigned pk2(float lo, float hi) { const f32x2 v = {lo, hi}; const bf16x2_t b = __builtin_convertvector(v, bf16x2_t); return __builtin_bit_cast(unsigned, b); }
__device__ __forceinline__ unsigned f2bf(float f) { return pk2(f, f) & 0xffffu; }
__device__ __forceinline__ float bf2f(unsigned short b) { return __builtin_bit_cast(float, (unsigned)b << 16); }
__device__ __forceinline__ float bflo(unsigned w) { return __builtin_bit_cast(float, w << 16); }
__device__ __forceinline__ float bfhi(unsigned w) { return __builtin_bit_cast(float, w & 0xffff0000u); }
__device__ __forceinline__ float wave_sum(float v) {
#pragma unroll
    for (int o = 1; o < 64; o <<= 1) v += __shfl_xor(v, o);
    return v;
}
template <class P> __device__ __forceinline__ P opq_v(P p) { asm volatile("" : "+v"(p)); return p; }
template <class P> __device__ __forceinline__ P opq_s(P p) { asm volatile("" : "+s"(p)); return p; }
__device__ __forceinline__ float silu_f(float x) { return x * __builtin_amdgcn_rcpf(1.f + __expf(-x)); }

namespace pg8 {
constexpr int BM = 256, BK = 64, HALF = 128, HTB = HALF * BK * 2, STAGE_BYTES = 8 * HTB;
__host__ __device__ __forceinline__ int lds_byte(int r, int c) { const int st = (r >> 4) * 2 + (c >> 5), rr = r & 15, cc = c & 31, ob = rr * 64 + cc * 2; return st * 1024 + (ob ^ (((ob >> 9) & 1) << 5)); }
__host__ __device__ __forceinline__ void stage_rc(int b, int& R, int& C) { const int st = b / 1024, sb = b % 1024, swz = sb ^ (((sb >> 9) & 1) << 5); R = (st >> 1) * 16 + swz / 64; C = (st & 1) * 32 + (swz % 64) / 2; }
__host__ __device__ __forceinline__ int perm32(int rho) { const int n = rho >> 4, i = rho & 15; return 8 * (i >> 2) + 4 * n + (i & 3); }

struct Unit { int pm, pn, aux; const char* a; const char* b; };
struct Gemm { int lda, ldb, K; };
__device__ __forceinline__ unsigned cvt_pk_bf16(float lo, float hi) { unsigned r; asm volatile("v_cvt_pk_bf16_f32 %0, %1, %2" : "=v"(r) : "v"(lo), "v"(hi)); return r; }

__device__ __forceinline__ void swz_tile(int L, int nM, int nN, int& pm, int& pn) {
    const int nwg = nM * nN; int wgid = L; { const int q = nwg / 8, r = nwg % 8, xcd = wgid % 8, off = wgid / 8; wgid = (xcd < r ? xcd * (q + 1) : r * (q + 1) + (xcd - r) * q) + off; }
    const int nig = 8 * nN, gid = wgid / nig, fm = gid * 8, gsz = (nM - fm) < 8 ? (nM - fm) : 8;
    pm = fm + ((wgid % nig) % gsz); pn = (wgid % nig) / gsz;
}

template <class Epi, class Sched>
__device__ __forceinline__ void gemm_phase(LAS unsigned char* lds, LAS unsigned char* xch, const Gemm g, const Sched& S, const Epi& E) {
    const int tid = opq_v((int)threadIdx.x), wid = __builtin_amdgcn_readfirstlane(tid >> 6), lane = tid & 63, wr = wid >> 2, wc = wid & 3, fr = lane & 15, fq = lane >> 4;
    const int K = g.K, nt = K / BK;
    unsigned voffA[2], voffB[2];
#pragma unroll
    for (int i = 0; i < 2; ++i) { int R, C; stage_rc(tid * 16 + i * 8192, R, C); const int Rb = Epi::PERM ? ((R & ~31) + perm32(R & 31)) : R;
        voffA[i] = (unsigned)(R * g.lda + C) * 2u; voffB[i] = (unsigned)(Rb * g.ldb + C) * 2u; }
    const size_t kstep = (size_t)(BK * 2);
    const size_t hstepA = (size_t)HALF * g.lda * 2, hstepB = (size_t)HALF * g.ldb * 2;
    const unsigned ldsw = (unsigned)wid * 1024u;
    const int aoff = lds_byte(wr * 64 + fr, fq * 8), boff = lds_byte(wc * 32 + fr, fq * 8);
#define PG8_SA(b, h) (((b) * 2 + (h)) * HTB)
#define PG8_SB(b, h) ((4 + (b) * 2 + (h)) * HTB)
#define PG8_STAGE(bufoff, gbase, voff) do { _Pragma("unroll") for (int _i = 0; _i < 2; ++_i) \
        __builtin_amdgcn_global_load_lds((const unsigned*)((const char*)(gbase) + (voff)[_i]), (LAS unsigned*)(lds + (bufoff) + ldsw + _i * 8192), 16, 0, 0); } while (0)
#define PG8_LDA(dst, b, h) do { _Pragma("unroll") for (int m = 0; m < 4; ++m) _Pragma("unroll") for (int k = 0; k < 2; ++k) dst[m][k] = *(const LAS bf16x8*)(lds + PG8_SA(b, h) + aoff + m * 2048 + k * 1024); } while (0)
#define PG8_LDB(dst, b, h) do { _Pragma("unroll") for (int n = 0; n < 2; ++n) _Pragma("unroll") for (int k = 0; k < 2; ++k) dst[n][k] = *(const LAS bf16x8*)(lds + PG8_SB(b, h) + boff + n * 2048 + k * 1024); } while (0)
#define PG8_MMA(ai, bj, At, Bt) do { __builtin_amdgcn_s_setprio(1); _Pragma("unroll") for (int m = 0; m < 4; ++m) _Pragma("unroll") for (int n = 0; n < 2; ++n) _Pragma("unroll") for (int k = 0; k < 2; ++k) \
        acc[ai][bj][m][n] = __builtin_amdgcn_mfma_f32_16x16x32_bf16(Bt[n][k], At[m][k], acc[ai][bj][m][n], 0, 0, 0); __builtin_amdgcn_s_setprio(0); } while (0)
#define PG8_WAIT_V(n) asm volatile("s_waitcnt vmcnt(" #n ")" ::: "memory")
#define PG8_WAIT_L(n) asm volatile("s_waitcnt lgkmcnt(" #n ")" ::: "memory")
#define PG8_BAR __builtin_amdgcn_s_barrier()
#define PG8_SCHED __builtin_amdgcn_sched_barrier(0)
    Unit cur, nxt; int ui = 0;
    if (!S.next(0, cur)) return;
    f32x4 acc[2][2][4][2];
#pragma unroll
    for (int a = 0; a < 2; ++a)
#pragma unroll
        for (int b = 0; b < 2; ++b)
#pragma unroll
            for (int m = 0; m < 4; ++m)
#pragma unroll
                for (int n = 0; n < 2; ++n) acc[a][b][m][n] = (f32x4){0.f, 0.f, 0.f, 0.f};
    bf16x8 At[4][2], B0[2][2], B1[2][2];
    const char* cA = cur.a; const char* cB = cur.b;
    PG8_STAGE(PG8_SB(0, 0), cB, voffB); PG8_STAGE(PG8_SB(0, 1), cB + hstepB, voffB); PG8_STAGE(PG8_SA(0, 0), cA, voffA); PG8_STAGE(PG8_SA(0, 1), cA + hstepA, voffA);
    if (wr == 1) PG8_BAR;
    PG8_WAIT_V(2); PG8_BAR;
    PG8_STAGE(PG8_SB(1, 0), cB + kstep, voffB); PG8_STAGE(PG8_SA(1, 0), cA + kstep, voffA); PG8_STAGE(PG8_SB(1, 1), cB + hstepB + kstep, voffB);
    PG8_WAIT_V(6); PG8_BAR;
#pragma unroll 1
    for (;;) {
        const bool has_next = S.next(ui + 1, nxt);
        const char* nA = has_next ? nxt.a : cA; const char* nB = has_next ? nxt.b : cB;
#pragma unroll 1
        for (int t = 0; t < nt; t += 2) {
            const bool last = (t == nt - 2);
            const char* a1 = cA + (size_t)(t + 1) * kstep;
            const char* a2 = last ? nA : cA + (size_t)(t + 2) * kstep; const char* b2 = last ? nB : cB + (size_t)(t + 2) * kstep;
            const char* a3 = a2 + kstep; const char* b3 = b2 + kstep;
            PG8_LDB(B0, 0, 0); PG8_LDB(B1, 0, 1); PG8_SCHED; PG8_LDA(At, 0, 0); PG8_STAGE(PG8_SA(1, 1), a1 + hstepA, voffA);
            PG8_WAIT_V(8); PG8_WAIT_L(0); PG8_BAR; PG8_MMA(0, 0, At, B0); PG8_MMA(0, 1, At, B1); PG8_BAR; PG8_SCHED;
            PG8_LDA(At, 0, 1); PG8_STAGE(PG8_SB(0, 0), b2, voffB); PG8_STAGE(PG8_SB(0, 1), b2 + hstepB, voffB); PG8_STAGE(PG8_SA(0, 0), a2, voffA);
            PG8_WAIT_V(8); PG8_WAIT_L(0); PG8_BAR; PG8_MMA(1, 0, At, B0); PG8_MMA(1, 1, At, B1); PG8_BAR; PG8_SCHED;
            PG8_LDB(B0, 1, 0); PG8_LDB(B1, 1, 1); PG8_SCHED; PG8_LDA(At, 1, 0); PG8_STAGE(PG8_SA(0, 1), a2 + hstepA, voffA);
            PG8_WAIT_V(8); PG8_WAIT_L(0); PG8_BAR; PG8_MMA(0, 0, At, B0); PG8_MMA(0, 1, At, B1); PG8_BAR; PG8_SCHED;
            PG8_LDA(At, 1, 1); PG8_STAGE(PG8_SB(1, 0), b3, voffB); PG8_STAGE(PG8_SB(1, 1), b3 + hstepB, voffB); PG8_STAGE(PG8_SA(1, 0), a3, voffA);
            PG8_WAIT_V(8); PG8_WAIT_L(0); PG8_BAR; PG8_MMA(1, 0, At, B0); PG8_MMA(1, 1, At, B1); PG8_BAR; PG8_SCHED;
        }
        if (wr == 0) PG8_BAR;
        E(acc, cur, wr, wc, fr, fq, xch);
        if (!has_next) break;
#pragma unroll
        for (int a = 0; a < 2; ++a)
#pragma unroll
            for (int b = 0; b < 2; ++b)
#pragma unroll
                for (int m = 0; m < 4; ++m)
#pragma unroll
                    for (int n = 0; n < 2; ++n) acc[a][b][m][n] = (f32x4){0.f, 0.f, 0.f, 0.f};
        cur = nxt; cA = nA; cB = nB; ++ui;
        if (wr == 1) PG8_BAR;
    }
    PG8_WAIT_V(0);
    PG8_BAR;
#undef PG8_SA
#undef PG8_SB
#undef PG8_STAGE
#undef PG8_LDA
#undef PG8_LDB
#undef PG8_MMA
#undef PG8_WAIT_V
#undef PG8_WAIT_L
#undef PG8_BAR
#undef PG8_SCHED
}

struct Dst { bf16* p; int ld; };
__device__ __forceinline__ void store_tile_bf16(const f32x4 (&acc)[2][2][4][2], const Dst d, float sc, int wr, int wc, int fr, int fq) {
    unsigned lane_off = (unsigned)((wr * 64 + fr) * d.ld + wc * 32 + 8 * fq);
    asm volatile("" : "+v"(lane_off));
#pragma unroll
    for (int ai = 0; ai < 2; ++ai)
#pragma unroll
        for (int m = 0; m < 4; ++m) { bf16* rowp = d.p + (size_t)lane_off + (size_t)((ai * HALF + m * 16) * d.ld);
#pragma unroll
            for (int bj = 0; bj < 2; ++bj) { const f32x4 v0 = acc[ai][bj][m][0] * sc, v1 = acc[ai][bj][m][1] * sc;
                u32x4 w; w.x = cvt_pk_bf16(v0[0], v0[1]); w.y = cvt_pk_bf16(v0[2], v0[3]); w.z = cvt_pk_bf16(v1[0], v1[1]); w.w = cvt_pk_bf16(v1[2], v1[3]);
                *(u32x4*)(rowp + bj * HALF) = w; } }
}
}

#define XB_TMO      128
#define XB_XCNT(j)  (256  + 64 * (j))
#define XB_XSUB(j)  (1280 + 64 * (j))
#define XB_XGEN(j)  (2304 + 64 * (j))
#define XB_TOP      3328
#define XB_TOPGEN   3392
#define XCD_BAR_WORDS 3456
#define XB_SPIN_CAP (1u << 20)
__device__ __forceinline__ unsigned xb_ld(unsigned* p)              { return __hip_atomic_load(p, __ATOMIC_RELAXED, __HIP_MEMORY_SCOPE_AGENT); }
__device__ __forceinline__ unsigned xb_add(unsigned* p, unsigned v) { return __hip_atomic_fetch_add(p, v, __ATOMIC_RELAXED, __HIP_MEMORY_SCOPE_AGENT); }
__device__ __forceinline__ unsigned xb_xcc_id() { return (unsigned)__builtin_amdgcn_s_getreg((3 << 11) | 20) & 0xFu; }
#define XB_SPIN(cond, bar) do { unsigned _sp = 0; while (cond) { __builtin_amdgcn_s_sleep(1); \
    if ((++_sp & 255u) == 0u) { if (xb_ld(&(bar)[XB_TMO])) break; if (_sp > XB_SPIN_CAP) { atomicAdd(&(bar)[XB_TMO], 1u); break; } } } } while (0)
struct XcdBarrier { unsigned* bar; unsigned x; volatile LAS unsigned* st; };
__device__ __forceinline__ XcdBarrier xcd_barrier_post(unsigned* bar, volatile LAS unsigned* st) {
    XcdBarrier b; b.bar = bar; b.x = xb_xcc_id(); b.st = st;
    if (threadIdx.x == 0) (void)xb_add(&bar[XB_XCNT(b.x)], 1u);
    return b;
}
__device__ __forceinline__ void xcd_barrier_complete(unsigned* bar, unsigned x, unsigned& nloc, unsigned& nx) {
    const unsigned G = gridDim.x * gridDim.y * gridDim.z;
    unsigned sum, cnt, mine, sp = 0u;
    for (;;) {
        sum = 0u; cnt = 0u; mine = 0u;
#pragma unroll
        for (unsigned j = 0; j < 16; ++j) { const unsigned c = xb_ld(&bar[XB_XCNT(j)]); sum += c; cnt += (c > 0u) ? 1u : 0u; mine = (j == x) ? c : mine; }
        if (sum == G) break;
        __builtin_amdgcn_s_sleep(1);
        if ((++sp & 255u) == 0u) { if (xb_ld(&bar[XB_TMO])) break; if (sp > XB_SPIN_CAP) { atomicAdd(&bar[XB_TMO], 1u); break; } }
    }
    nloc = mine > 0u ? mine : 1u; nx = cnt > 0u ? cnt : 1u;
}
__device__ __forceinline__ void xcd_barrier(const XcdBarrier& b) {
    asm volatile("s_waitcnt vmcnt(0)" ::: "memory");
    __syncthreads();
    if (threadIdx.x == 0) {
        unsigned* bar = b.bar;
        __builtin_amdgcn_s_waitcnt(0);
        unsigned nloc = b.st[0], nx = b.st[1];
        if (nloc == 0u) { xcd_barrier_complete(bar, b.x, nloc, nx); b.st[0] = nloc; b.st[1] = nx; }
        const unsigned old = xb_add(&bar[XB_XSUB(b.x)], 1u);
        const unsigned gen = old / nloc;
        if (old + 1u == (gen + 1u) * nloc) {
            __builtin_amdgcn_fence(__ATOMIC_RELEASE, "agent");
            asm volatile("s_waitcnt vmcnt(0)" ::: "memory");
            const unsigned og = xb_add(&bar[XB_TOP], 1u);
            const unsigned tg = og / nx;
            if (og + 1u == (tg + 1u) * nx) xb_add(&bar[XB_TOPGEN], 1u);
            else XB_SPIN(xb_ld(&bar[XB_TOPGEN]) == tg, bar);
            __builtin_amdgcn_fence(__ATOMIC_ACQUIRE, "agent");
            xb_add(&bar[XB_XGEN(b.x)], 1u);
            asm volatile("s_waitcnt vmcnt(0)" ::: "memory");
        } else {
            XB_SPIN(xb_ld(&bar[XB_XGEN(b.x)]) == gen, bar);
            __builtin_amdgcn_fence(__ATOMIC_ACQUIRE, "agent");
            asm volatile("s_waitcnt vmcnt(0)" ::: "memory");
        }
    }
    __syncthreads();
}

struct Args { const float* in[21]; float* out; unsigned char* ws; int ph_lo, ph_hi; };
struct Frame {
    LAS unsigned char* lds;
    unsigned char* ws;
    gu32* ctl;
    int tid, lane, wave, G, gw, NGW;
};
#define WSP(T_, off) ((T_*)(F.ws + (off)))

__device__ __forceinline__ void tr_item(const float* W, int ldw, int k0, int c0, bf16* dst, int ldd, LAS float* scr, int lane) {
    const int r8 = lane >> 3, c4 = lane & 7;
#pragma unroll
    for (int it = 0; it < 8; ++it) { const int kk = it * 8 + r8; const f32x4 v = *(const GAS f32x4*)(W + (size_t)(k0 + kk) * ldw + c0 + 4 * c4);
        LAS float* s = scr + kk * 33 + 4 * c4; s[0] = v[0]; s[1] = v[1]; s[2] = v[2]; s[3] = v[3]; }
    LDS_WAIT(); asm volatile("" ::: "memory");
    const int c = lane & 7;
#pragma unroll
    for (int j = 0; j < 4; ++j) { const int n = (lane >> 3) + 8 * j; const LAS float* s = scr + (8 * c) * 33 + n;
        u32x4 o; o.x = pk2(s[0 * 33], s[1 * 33]); o.y = pk2(s[2 * 33], s[3 * 33]); o.z = pk2(s[4 * 33], s[5 * 33]); o.w = pk2(s[6 * 33], s[7 * 33]);
        *(GAS u32x4*)(dst + (size_t)n * ldd + k0 + 8 * c) = o; }
    LDS_WAIT(); asm volatile("" ::: "memory");
}
__device__ __forceinline__ void tr_matrix(Frame& F, const float* W, int K, int N, int ldw, bf16* dst, LAS float* scr, int it) {
    const int nblk = N / 32, kb = it / nblk, nb = it % nblk;
    tr_item(W, ldw, 64 * kb, 32 * nb, dst + (size_t)(32 * nb) * K, K, scr, F.lane);
}
__device__ __forceinline__ void p0_prologue(Frame& F, const Args& A) {
    LAS float* scr = (LAS float*)(F.lds + F.wave * 16384);
    constexpr int I_IN = 16 * 112, I_SQ = 16 * 32, I_SCI = 16 * 96, I_KV = 16 * 64;
    constexpr int NITEMS = I_IN + I_SQ + I_SCI + I_SQ + 2 * I_SQ + 2 * I_KV + 2 * I_SQ;
    for (int it = F.gw; it < NITEMS; it += F.NGW) {
        int r = it;
        if (r < I_IN) { const int kb = r / 112, nb = r % 112;
            tr_item(A.in[2], AB_IN, 64 * kb, 32 * nb + (nb >= 64 ? 8 : 0), WSP(bf16, WS_W_IN) + (size_t)(32 * nb) * D, D, scr, F.lane); continue; } r -= I_IN;
        if (r < I_SQ) { tr_matrix(F, A.in[7], D, D, D, WSP(bf16, WS_W_ABO), scr, r); continue; } r -= I_SQ;
        if (r < I_SCI) { tr_matrix(F, A.in[8], D, 3 * D, 3 * D, WSP(bf16, WS_W_SCI), scr, r); continue; } r -= I_SCI;
        if (r < I_SQ) { tr_matrix(F, A.in[10], D, D, D, WSP(bf16, WS_W_SCO), scr, r); continue; } r -= I_SQ;
        if (r < 2 * I_SQ) { continue; } r -= 2 * I_SQ;
        if (r < 2 * I_KV) { const int l = r / I_KV; tr_matrix(F, A.in[12] + (size_t)l * D * 2 * D, D, 2 * D, 2 * D, WSP(bf16, WS_W_KV) + (size_t)l * 2 * D * D, scr, r % I_KV); continue; } r -= 2 * I_KV;
        { const int l = r / I_SQ; tr_matrix(F, A.in[13] + (size_t)l * D * D, D, D, D, WSP(bf16, WS_W_O) + (size_t)l * D * D, scr, r % I_SQ); }
    }
    __syncthreads();
    LAS float* wt = (LAS float*)F.lds;
    for (int i = F.tid; i < 8 * D; i += 512) { const int k = i >> 3, c = i & 7; wt[c * D + k] = A.in[2][(size_t)k * AB_IN + 2048 + c]; }
    __syncthreads();
    const float* x = A.in[0];
    float alg[4], dtb[4];
#pragma unroll
    for (int h = 0; h < 4; ++h) { alg[h] = -__expf(A.in[4][h]); dtb[h] = A.in[5][h]; }
    for (int m = F.gw; m < T; m += F.NGW) {
        const GAS f32x4* xr = (const GAS f32x4*)(x + (size_t)m * D) + F.lane;
        f32x4 v[4];
#pragma unroll
        for (int j = 0; j < 4; ++j) v[j] = xr[64 * j];
        GAS u32x2* o8 = (GAS u32x2*)(WSP(bf16, WS_HB) + (size_t)m * D) + F.lane;
#pragma unroll
        for (int j = 0; j < 4; ++j) { u32x2 w; w.x = pk2(v[j][0], v[j][1]); w.y = pk2(v[j][2], v[j][3]); o8[64 * j] = w; }
        float dot[8];
#pragma unroll
        for (int c = 0; c < 8; ++c) { float s = 0.f;
#pragma unroll
            for (int j = 0; j < 4; ++j) { const f32x4 w = *(const LAS f32x4*)(wt + c * D + 256 * j + 4 * F.lane); s += v[j][0] * w[0] + v[j][1] * w[1] + v[j][2] * w[2] + v[j][3] * w[3]; }
            dot[c] = wave_sum(s); }
        if (F.lane == 0) {
            f32x4 bo, go;
#pragma unroll
            for (int hq = 0; hq < 4; ++hq) { bo[hq] = 1.f / (1.f + __expf(-dot[hq])); const float xx = dot[4 + hq] + dtb[hq]; const float sp = xx > 20.f ? xx : log1pf(__expf(xx)); go[hq] = alg[hq] * sp; }
            *(GAS f32x4*)(WSP(float, WS_BETA) + (size_t)m * 4) = bo;
            *(GAS f32x4*)(WSP(float, WS_GG) + (size_t)m * 4) = go;
        }
    }
    for (int m = F.gw; m < 2 * D; m += F.NGW) {
        const GAS f32x4* xr = (const GAS f32x4*)(A.in[11] + (size_t)m * D) + F.lane;
        GAS u32x2* o8 = (GAS u32x2*)(WSP(bf16, WS_W_Q) + (size_t)m * D) + F.lane;
#pragma unroll
        for (int j = 0; j < 4; ++j) { const f32x4 v = xr[64 * j]; u32x2 w; w.x = pk2(v[0], v[1]); w.y = pk2(v[2], v[3]); o8[64 * j] = w; }
    }
    for (int m = F.gw; m < TM; m += F.NGW) {
        const GAS f32x4* xr = (const GAS f32x4*)(A.in[1] + (size_t)m * D) + F.lane;
        GAS u32x2* o8 = (GAS u32x2*)(WSP(bf16, WS_MEMB) + (size_t)m * D) + F.lane;
#pragma unroll
        for (int j = 0; j < 4; ++j) { const f32x4 v = xr[64 * j]; u32x2 w; w.x = pk2(v[0], v[1]); w.y = pk2(v[2], v[3]); o8[64 * j] = w; }
    }
}
constexpr int MOE_I_GU = 16 * 32, MOE_I_D = 8 * 32;
__device__ __forceinline__ void convert_moe_q(Frame& F, const Args& A, int layer, int which  , bf16* dst, unsigned* qword, volatile LAS unsigned* MISC) {
    LAS float* scr = (LAS float*)(F.lds + F.wave * 16384);
    const int nitems = NE * (which == 0 ? MOE_I_GU : MOE_I_D);
    for (;;) {
        __syncthreads();
        if (F.tid == 0) MISC[21] = __hip_atomic_fetch_add(qword, 8u, RLX_AGENT);
        __syncthreads();
        const int it = (int)MISC[21] + F.wave;
        if ((int)MISC[21] >= nitems) break;
        if (it < nitems) {
            if (which == 0) { const int e = it / MOE_I_GU, r = it % MOE_I_GU, kb = r / 32, rb = r % 32, pn = rb >> 3, sub = rb & 7;
                const float* src = (sub < 4 ? A.in[16] : A.in[17]) + ((size_t)layer * NE + e) * D * DE;
                tr_item(src, DE, 64 * kb, 128 * pn + 32 * (sub & 3), dst + ((size_t)e * D + 32 * rb) * D, D, scr, F.lane);
            } else { const int e = it / MOE_I_D, r = it % MOE_I_D, kb = r / 32, nb = r % 32;
                tr_item(A.in[18] + ((size_t)layer * NE + e) * DE * D, D, 64 * kb, 32 * nb, dst + ((size_t)e * D + 32 * nb) * DE, DE, scr, F.lane); }
        }
    }
}

struct SchedDense {
    const char* A; const char* B; int lda, ldb, nM, nN, G, c;
    __device__ __forceinline__ bool next(int i, pg8::Unit& u) const {
        const int L = i * G + c; if (L >= nM * nN) return false;
        pg8::swz_tile(L, nM, nN, u.pm, u.pn); u.aux = 0;
        u.a = A + (size_t)u.pm * 256 * lda * 2; u.b = B + (size_t)u.pn * 256 * ldb * 2; return true; }
};
struct EpiDense {
    static constexpr bool PERM = true;
    bf16* O; int ld; float sc;
    __device__ __forceinline__ void operator()(const f32x4 (&acc)[2][2][4][2], const pg8::Unit& u, int wr, int wc, int fr, int fq, LAS unsigned char*) const {
        pg8::store_tile_bf16(acc, pg8::Dst{O + (size_t)u.pm * 256 * ld + u.pn * 256, ld}, sc, wr, wc, fr, fq); }
};
struct SchedP1 {
    const char* XB; const char* WIN; const char* MEMB; const char* WKV; int G, c;
    __device__ __forceinline__ bool next(int i, pg8::Unit& u) const {
        const int L = i * G + c; if (L >= 896 + 64) return false;
        if (L < 896) { pg8::swz_tile(L, 64, 14, u.pm, u.pn); u.aux = 0; u.a = XB + (size_t)u.pm * 256 * D * 2; u.b = WIN + (size_t)u.pn * 256 * D * 2; }
        else { const int r = L - 896, l = r >> 5; u.pm = (r & 31) >> 3; u.pn = r & 7; u.aux = 1 + l; u.a = MEMB + (size_t)u.pm * 256 * D * 2; u.b = WKV + ((size_t)l * 2 * D + u.pn * 256) * D * 2; }
        return true; }
};
struct EpiP1 {
    static constexpr bool PERM = true;
    bf16 *QKVPRE, *ZB, *QKVD, *KMEM, *VT;
    __device__ __forceinline__ void operator()(const f32x4 (&acc)[2][2][4][2], const pg8::Unit& u, int wr, int wc, int fr, int fq, LAS unsigned char*) const {
        if (u.aux == 0) {
            pg8::Dst d;
            if (u.pn < 6) d = pg8::Dst{QKVPRE + (size_t)u.pm * 256 * 1536 + u.pn * 256, 1536};
            else if (u.pn < 8) d = pg8::Dst{ZB + (size_t)u.pm * 256 * 512 + (u.pn - 6) * 256, 512};
            else d = pg8::Dst{QKVD + (size_t)u.pm * 256 * 1536 + (u.pn - 8) * 256, 1536};
            pg8::store_tile_bf16(acc, d, (u.pn == 8 || u.pn == 9) ? 0.125f * 1.4426950408889634f : 1.f, wr, wc, fr, fq);
        } else {
            const int l = u.aux - 1;
            if (u.pn < 4) pg8::store_tile_bf16(acc, pg8::Dst{KMEM + ((size_t)l * TM + u.pm * 256) * D + u.pn * 256, D}, 1.f, wr, wc, fr, fq);
            else pg8::store_tile_bf16(acc, pg8::Dst{VT + ((size_t)l * TM + u.pm * 256) * D + (u.pn - 4) * 256, D}, 1.f, wr, wc, fr, fq);
        }
    }
};
struct SchedPrep {
    const char* KM; const char* WQO; const char* WOT; const char* VM; int G, c;
    __device__ __forceinline__ bool next(int i, pg8::Unit& u) const {
        const int L = i * G + c; if (L >= 256) return false;
        const int l = L >> 7, r = L & 127, kind = r >> 6, q = r & 63, bh = q >> 2, t4 = q & 3, b = bh >> 2, hd = bh & 3;
        u.aux = L; u.pm = 0; u.pn = 0;
        if (kind == 0) { u.a = KM + (((size_t)(l * NB + b) * NMEM) * D + hd * XD) * 2; u.b = WQO + (((size_t)l * D + t4 * 256) * D + hd * XD) * 2; }
        else           { u.a = WOT + (((size_t)l * D + t4 * 256) * D + hd * XD) * 2; u.b = VM + (((size_t)(l * NB + b) * NMEM) * D + hd * XD) * 2; }
        return true; }
};
struct EpiPrep {
    static constexpr bool PERM = true;
    bf16 *MT, *VWT;
    __device__ __forceinline__ void operator()(const f32x4 (&acc)[2][2][4][2], const pg8::Unit& u, int wr, int wc, int fr, int fq, LAS unsigned char*) const {
        const int L = u.aux, l = L >> 7, r = L & 127, kind = r >> 6, q = r & 63, bh = q >> 2, t4 = q & 3, b = bh >> 2, hd = bh & 3;
        if (kind == 0) pg8::store_tile_bf16(acc, pg8::Dst{MT + ((size_t)(l * NB + b) * D + hd * XD) * D + t4 * 256, D}, 0.0625f * 1.4426950408889634f, wr, wc, fr, fq);
        else           pg8::store_tile_bf16(acc, pg8::Dst{VWT + ((size_t)(l * NB + b) * D + t4 * 256) * D + hd * XD, D}, 1.f, wr, wc, fr, fq);
    }
};
struct SchedXB {
    const char* AB; const char* BB; int G, c;
    __device__ __forceinline__ bool next(int i, pg8::Unit& u) const {
        const int L = i * G + c; if (L >= 256) return false;
        u.pm = L >> 2; u.pn = L & 3; u.aux = 0;
        u.a = AB + (size_t)u.pm * 256 * D * 2; u.b = BB + ((size_t)(u.pm >> 4) * D + u.pn * 256) * D * 2; return true; }
};
struct EpiSoftmax {
    static constexpr bool PERM = true;
    bf16* P;
    __device__ __forceinline__ void operator()(f32x4 (&acc)[2][2][4][2], const pg8::Unit& u, int wr, int wc, int fr, int fq, LAS unsigned char* xch) const {
        LAS float* MX = (LAS float*)xch;
        LAS float* SM = (LAS float*)(xch + 4096);
#pragma unroll
        for (int ai = 0; ai < 2; ++ai)
#pragma unroll
            for (int m = 0; m < 4; ++m) { float v = -3.0e38f;
#pragma unroll
                for (int bj = 0; bj < 2; ++bj)
#pragma unroll
                    for (int n = 0; n < 2; ++n) { const f32x4 x = acc[ai][bj][m][n]; v = fmaxf(v, fmaxf(fmaxf(x[0], x[1]), fmaxf(x[2], x[3]))); }
                v = fmaxf(v, __shfl_xor(v, 16)); v = fmaxf(v, __shfl_xor(v, 32));
                if (fq == 0) MX[(ai * 128 + wr * 64 + m * 16 + fr) * 4 + wc] = v; }
        LDS_WAIT(); __builtin_amdgcn_s_barrier(); asm volatile("" ::: "memory");
#pragma unroll
        for (int ai = 0; ai < 2; ++ai)
#pragma unroll
            for (int m = 0; m < 4; ++m) { float s = 0.f; const f32x4 q = *(const LAS f32x4*)(MX + (ai * 128 + wr * 64 + m * 16 + fr) * 4); const float mxr = fmaxf(fmaxf(q[0], q[1]), fmaxf(q[2], q[3]));
#pragma unroll
                for (int bj = 0; bj < 2; ++bj)
#pragma unroll
                    for (int n = 0; n < 2; ++n) { f32x4 x = acc[ai][bj][m][n];
#pragma unroll
                        for (int e = 0; e < 4; ++e) { x[e] = __builtin_amdgcn_exp2f(x[e] - mxr); s += x[e]; }
                        acc[ai][bj][m][n] = x; }
                s += __shfl_xor(s, 16); s += __shfl_xor(s, 32);
                if (fq == 0) SM[(ai * 128 + wr * 64 + m * 16 + fr) * 4 + wc] = s; }
        LDS_WAIT(); __builtin_amdgcn_s_barrier(); asm volatile("" ::: "memory");
        bf16* base = P + (size_t)u.pm * 256 * D + u.pn * XD;
#pragma unroll
        for (int ai = 0; ai < 2; ++ai)
#pragma unroll
            for (int m = 0; m < 4; ++m) { const f32x4 q = *(const LAS f32x4*)(SM + (ai * 128 + wr * 64 + m * 16 + fr) * 4); const float inv = 1.f / ((q[0] + q[1]) + (q[2] + q[3]));
                bf16* rowp = base + (size_t)(ai * 128 + wr * 64 + m * 16 + fr) * D + wc * 32 + 8 * fq;
#pragma unroll
                for (int bj = 0; bj < 2; ++bj) { const f32x4 v0 = acc[ai][bj][m][0] * inv, v1 = acc[ai][bj][m][1] * inv;
                    u32x4 w; w.x = pg8::cvt_pk_bf16(v0[0], v0[1]); w.y = pg8::cvt_pk_bf16(v0[2], v0[3]); w.z = pg8::cvt_pk_bf16(v1[0], v1[1]); w.w = pg8::cvt_pk_bf16(v1[2], v1[3]);
                    *(u32x4*)(rowp + bj * 128) = w; } }
        LDS_WAIT(); __builtin_amdgcn_s_barrier(); asm volatile("" ::: "memory");
    }
};
struct SchedMoE {
    const char* Aall; const char* Wall; volatile LAS unsigned* tab; int lda, wrows  , ldb, G, c;
    __device__ __forceinline__ bool next(int i, pg8::Unit& u) const {
        const int L = i * G + c; const int ntile = (int)tab[16]; if (L >= ntile * 4) return false;
        u.pm = L >> 2; u.pn = L & 3; int e = 0;
#pragma unroll
        for (int j = 1; j < 16; ++j) e += ((int)tab[j] <= u.pm) ? 1 : 0;
        u.aux = e; u.a = Aall + (size_t)u.pm * 256 * lda * 2; u.b = Wall + ((size_t)e * wrows + u.pn * 256) * ldb * 2; return true; }
};
struct EpiSwiglu {
    static constexpr bool PERM = true;
    bf16* HACT;
    __device__ __forceinline__ void operator()(const f32x4 (&acc)[2][2][4][2], const pg8::Unit& u, int wr, int wc, int fr, int fq, LAS unsigned char*) const {
#pragma unroll
        for (int ai = 0; ai < 2; ++ai)
#pragma unroll
            for (int m = 0; m < 4; ++m) { bf16* rowp = HACT + (size_t)(u.pm * 256 + ai * 128 + wr * 64 + m * 16 + fr) * DE + u.pn * 128 + wc * 32 + 8 * fq;
                float h[8];
#pragma unroll
                for (int n = 0; n < 2; ++n)
#pragma unroll
                    for (int e = 0; e < 4; ++e) { const float gt = acc[ai][0][m][n][e], up = acc[ai][1][m][n][e]; h[n * 4 + e] = silu_f(gt) * up; }
                u32x4 w; w.x = pg8::cvt_pk_bf16(h[0], h[1]); w.y = pg8::cvt_pk_bf16(h[2], h[3]); w.z = pg8::cvt_pk_bf16(h[4], h[5]); w.w = pg8::cvt_pk_bf16(h[6], h[7]);
                *(u32x4*)rowp = w; }
    }
};

struct Route { int e0, e1, r0, r1; float w0, w1; int s0, s1; };
template <int MODE, bool ROUTER, bool FINAL>
__device__ __forceinline__ void ln_pass(Frame& F, const Args& A, const bf16* hold, const bf16* Y, int li  , float* hnew  , bf16* hb, unsigned* cnt) {
    const float* gam = A.in[19] + (size_t)li * D; const float* bet = A.in[20] + (size_t)li * D;
    f32x4 gv[4], bv[4];
#pragma unroll
    for (int j = 0; j < 4; ++j) { gv[j] = *(const GAS f32x4*)(gam + 256 * j + 4 * F.lane); bv[j] = *(const GAS f32x4*)(bet + 256 * j + 4 * F.lane); }
    LAS float* rw = (LAS float*)F.lds;
    LAS int* sel = (LAS int*)(F.lds + 65536);
    LAS float* selw = (LAS float*)(F.lds + 65536 + 1024);
    if (ROUTER) { for (int i = F.tid; i < NE * D; i += 512) { const int k = i >> 4, e = i & 15; rw[e * D + k] = A.in[14][i]; } __syncthreads(); }
    Route* route = WSP(Route, WS_ROUTE);
    const int nblk = T / 64;
    for (int blk = blockIdx.x; blk < nblk; blk += F.G) {
        u32x2 hn[4]; u32x2 ya[4], yb[4]; float rw0 = 0.f, rw1 = 0.f;
#define LN_LOAD(mrow) do { const int m_ = (mrow); \
            _Pragma("unroll") for (int j = 0; j < 4; ++j) hn[j] = *((const GAS u32x2*)(hold + (size_t)m_ * D) + F.lane + 64 * j); \
            if (MODE == 0) { _Pragma("unroll") for (int j = 0; j < 4; ++j) ya[j] = *((const GAS u32x2*)(Y + (size_t)m_ * D) + F.lane + 64 * j); } \
            else { const Route r_ = route[m_]; rw0 = r_.w0; rw1 = r_.w1; \
                _Pragma("unroll") for (int j = 0; j < 4; ++j) { ya[j] = *((const GAS u32x2*)(Y + (size_t)r_.s0 * D) + F.lane + 64 * j); yb[j] = *((const GAS u32x2*)(Y + (size_t)r_.s1 * D) + F.lane + 64 * j); } } } while (0)
        LN_LOAD(blk * 64 + F.wave * 8);
#pragma unroll 1
        for (int rr = 0; rr < 8; ++rr) {
            const int m = blk * 64 + F.wave * 8 + rr;
            f32x4 v[4];
#pragma unroll
            for (int j = 0; j < 4; ++j) { v[j][0] = bflo(hn[j].x) * ALPHA; v[j][1] = bfhi(hn[j].x) * ALPHA; v[j][2] = bflo(hn[j].y) * ALPHA; v[j][3] = bfhi(hn[j].y) * ALPHA; }
            if (MODE == 0) {
#pragma unroll
                for (int j = 0; j < 4; ++j) { const u32x2 w = ya[j]; v[j][0] += bflo(w.x); v[j][1] += bfhi(w.x); v[j][2] += bflo(w.y); v[j][3] += bfhi(w.y); }
            } else {
#pragma unroll
                for (int j = 0; j < 4; ++j) { const u32x2 w0 = ya[j], w1 = yb[j];
                    v[j][0] += rw0 * bflo(w0.x) + rw1 * bflo(w1.x); v[j][1] += rw0 * bfhi(w0.x) + rw1 * bfhi(w1.x); v[j][2] += rw0 * bflo(w0.y) + rw1 * bflo(w1.y); v[j][3] += rw0 * bfhi(w0.y) + rw1 * bfhi(w1.y); }
            }
            if (rr < 7) LN_LOAD(m + 1);
            float s = 0.f;
#pragma unroll
            for (int j = 0; j < 4; ++j) s += (v[j][0] + v[j][1]) + (v[j][2] + v[j][3]);
            const float mean = wave_sum(s) * (1.f / D); float s2 = 0.f;
#pragma unroll
            for (int j = 0; j < 4; ++j) { v[j] = v[j] - mean; s2 += (v[j][0] * v[j][0] + v[j][1] * v[j][1]) + (v[j][2] * v[j][2] + v[j][3] * v[j][3]); }
            const float rstd = 1.f / sqrtf(wave_sum(s2) * (1.f / D) + LN_EPS);
#pragma unroll
            for (int j = 0; j < 4; ++j) v[j] = v[j] * rstd * gv[j] + bv[j];
            if (FINAL) {
#pragma unroll
                for (int j = 0; j < 4; ++j) *((GAS f32x4*)(hnew + (size_t)m * D) + F.lane + 64 * j) = v[j];
            } else {
#pragma unroll
                for (int j = 0; j < 4; ++j) { u32x2 w; w.x = pk2(v[j][0], v[j][1]); w.y = pk2(v[j][2], v[j][3]); *((GAS u32x2*)(hb + (size_t)m * D) + F.lane + 64 * j) = w; }
            }
            if (ROUTER) {
                float lg[16];
#pragma unroll
                for (int e = 0; e < 16; ++e) { float d = 0.f;
#pragma unroll
                    for (int j = 0; j < 4; ++j) { const f32x4 w = *(const LAS f32x4*)(rw + e * D + 256 * j + 4 * F.lane); d += v[j][0] * w[0] + v[j][1] * w[1] + v[j][2] * w[2] + v[j][3] * w[3]; }
                    lg[e] = wave_sum(d); }
                float mxl = lg[0];
#pragma unroll
                for (int e = 1; e < 16; ++e) mxl = fmaxf(mxl, lg[e]);
                float sc[16], se = 0.f;
#pragma unroll
                for (int e = 0; e < 16; ++e) { sc[e] = __expf(lg[e] - mxl); se += sc[e]; }
                const float inv = 1.f / se; float sl[16];
#pragma unroll
                for (int e = 0; e < 16; ++e) { sc[e] *= inv; sl[e] = sc[e] + A.in[15][e]; }
                int bg = 0; float bgs = -3.0e38f;
#pragma unroll
                for (int g4 = 0; g4 < 4; ++g4) { const float a = sl[4 * g4], b = sl[4 * g4 + 1], c = sl[4 * g4 + 2], d = sl[4 * g4 + 3];
                    const float hi1 = fmaxf(a, b), lo1 = fminf(a, b), hi2 = fmaxf(c, d), lo2 = fminf(c, d);
                    const float top = fmaxf(hi1, hi2), second = fmaxf(fminf(hi1, hi2), fmaxf(lo1, lo2)); const float gs = top + second;
                    if (gs > bgs) { bgs = gs; bg = g4; } }
                float s4[4], c4[4];
#pragma unroll
                for (int q = 0; q < 4; ++q) { s4[q] = bg == 0 ? sl[q] : bg == 1 ? sl[4 + q] : bg == 2 ? sl[8 + q] : sl[12 + q]; c4[q] = bg == 0 ? sc[q] : bg == 1 ? sc[4 + q] : bg == 2 ? sc[8 + q] : sc[12 + q]; }
                int i0 = 0; float b0 = s4[0];
#pragma unroll
                for (int q = 1; q < 4; ++q) if (s4[q] > b0) { b0 = s4[q]; i0 = q; }
                int i1 = -1; float b1 = -3.0e38f;
#pragma unroll
                for (int q = 0; q < 4; ++q) if (q != i0 && s4[q] > b1) { b1 = s4[q]; i1 = q; }
                const float p0 = i0 == 0 ? c4[0] : i0 == 1 ? c4[1] : i0 == 2 ? c4[2] : c4[3];
                const float p1 = i1 == 0 ? c4[0] : i1 == 1 ? c4[1] : i1 == 2 ? c4[2] : c4[3];
                if (F.lane == 0) { const int tk = F.wave * 8 + rr; sel[tk * 4 + 0] = bg * 4 + i0; sel[tk * 4 + 1] = bg * 4 + i1; selw[tk * 2 + 0] = p0 / (p0 + p1); selw[tk * 2 + 1] = p1 / (p0 + p1); }
            }
        }
        if (ROUTER) {
            __syncthreads();
            if (F.tid < 16) {
                const int e = F.tid; int n = 0;
                for (int i = 0; i < 64; ++i) { if (sel[i * 4 + 0] == e) { sel[i * 4 + 2] = n; ++n; } if (sel[i * 4 + 1] == e) { sel[i * 4 + 3] = n; ++n; } }
                const int base = n ? (int)atomicAdd(cnt + e, (unsigned)n) : 0;
                for (int i = 0; i < 64; ++i) { if (sel[i * 4 + 0] == e) sel[i * 4 + 2] += base; if (sel[i * 4 + 1] == e) sel[i * 4 + 3] += base; }
            }
            __syncthreads();
            if (F.tid < 64) { Route r; r.e0 = sel[F.tid * 4 + 0]; r.e1 = sel[F.tid * 4 + 1]; r.r0 = sel[F.tid * 4 + 2]; r.r1 = sel[F.tid * 4 + 3]; r.w0 = selw[F.tid * 2 + 0]; r.w1 = selw[F.tid * 2 + 1]; r.s0 = 0; r.s1 = 0; route[blk * 64 + F.tid] = r; }
            __syncthreads();
        }
    }
}
__device__ __forceinline__ void moe_table(Frame& F, const unsigned* cnt, volatile LAS unsigned* tab) {
    if (F.tid == 0) { unsigned t = 0; for (int e = 0; e < 16; ++e) { tab[e] = t; t += (__hip_atomic_load(cnt + e, RLX_AGENT) + 255u) >> 8; } tab[16] = t; }
    __syncthreads();
}
__device__ __forceinline__ void moe_gather(Frame& F, const bf16* hb, bf16* xg, volatile LAS unsigned* tab) {
    Route* route = WSP(Route, WS_ROUTE);
    for (int m = F.gw; m < T; m += F.NGW) {
        Route r = route[m];
        const int s0 = (int)tab[r.e0] * 256 + r.r0, s1 = (int)tab[r.e1] * 256 + r.r1;
        if (F.lane == 0) { route[m].s0 = s0; route[m].s1 = s1; }
        const GAS u32x4* src = (const GAS u32x4*)(hb + (size_t)m * D) + F.lane;
        const u32x4 a = src[0], b = src[64];
        GAS u32x4* d0 = (GAS u32x4*)(xg + (size_t)s0 * D) + F.lane; GAS u32x4* d1 = (GAS u32x4*)(xg + (size_t)s1 * D) + F.lane;
        d0[0] = a; d0[64] = b; d1[0] = a; d1[64] = b;
    }
}

__device__ __forceinline__ void conv_pass(Frame& F, const Args& A, const bf16* prj, bf16* ub) {
    const float* cw = A.in[9];
    for (int it = F.gw; it < (T / 16) * 2; it += F.NGW) {
        const int tb = it >> 1, c0 = (it & 1) * 512 + F.lane * 8; const int t0 = tb * 16, pos0 = t0 % SEQ;
        float w[3][8];
#pragma unroll
        for (int j = 0; j < 3; ++j) { const f32x4 a = *(const GAS f32x4*)(cw + j * D + c0), b = *(const GAS f32x4*)(cw + j * D + c0 + 4);
#pragma unroll
            for (int e = 0; e < 4; ++e) { w[j][e] = a[e]; w[j][4 + e] = b[e]; } }
        float p2[8], p1[8];
#pragma unroll
        for (int e = 0; e < 8; ++e) { p2[e] = 0.f; p1[e] = 0.f; }
#pragma unroll
        for (int q = 0; q < 2; ++q) { if (pos0 - 2 + q >= 0) { const bf16* r = prj + (size_t)(t0 - 2 + q) * 3072;
                const u32x4 gc = *(const GAS u32x4*)(r + 1024 + c0), hd = *(const GAS u32x4*)(r + 2048 + c0);
#pragma unroll
                for (int e = 0; e < 4; ++e) { const float lo = bflo(gc[e]) * bflo(hd[e]), hi = bfhi(gc[e]) * bfhi(hd[e]); if (q == 0) { p2[2 * e] = lo; p2[2 * e + 1] = hi; } else { p1[2 * e] = lo; p1[2 * e + 1] = hi; } } } }
#pragma unroll 4
        for (int tt = 0; tt < 16; ++tt) { const bf16* r = prj + (size_t)(t0 + tt) * 3072;
            const u32x4 gb = *(const GAS u32x4*)(r + c0), gc = *(const GAS u32x4*)(r + 1024 + c0), hd = *(const GAS u32x4*)(r + 2048 + c0);
            float p0[8], o[8];
#pragma unroll
            for (int e = 0; e < 4; ++e) { p0[2 * e] = bflo(gc[e]) * bflo(hd[e]); p0[2 * e + 1] = bfhi(gc[e]) * bfhi(hd[e]); }
#pragma unroll
            for (int e = 0; e < 8; ++e) { const float cv = w[0][e] * p2[e] + w[1][e] * p1[e] + w[2][e] * p0[e]; const float g = (e & 1) ? bfhi(gb[e >> 1]) : bflo(gb[e >> 1]); o[e] = g * cv; p2[e] = p1[e]; p1[e] = p0[e]; }
            u32x4 wv; wv.x = pk2(o[0], o[1]); wv.y = pk2(o[2], o[3]); wv.z = pk2(o[4], o[5]); wv.w = pk2(o[6], o[7]);
            *(GAS u32x4*)(ub + (size_t)(t0 + tt) * D + c0) = wv; }
    }
}

constexpr int D1_QB = 0, D1_KB = 17408, D1_E = D1_KB, D1_AT = 34816, D1_KT = 44032, D1_RT = 62464, D1_P = 99328, D1_PT = D1_P + 9216, D1_ET = D1_PT + 9216, D1_UW = D1_P, D1_GC = 136192;
constexpr int RSB = 272, RSS = 144;
static_assert(D1_GC + 2 * 256 <= MISC_OFF && D1_UW + 36864 <= D1_GC && D1_RT + 3 * 67 * 272 <= D1_ET, "D1 LDS");
__device__ __forceinline__ f32x4 tile_k64(const LAS unsigned char* xr, const LAS unsigned char* yr, f32x4 acc) {
#pragma unroll
    for (int s = 0; s < 2; ++s) acc = __builtin_amdgcn_mfma_f32_16x16x32_bf16(*(const LAS bf16x8*)(xr + 64 * s), *(const LAS bf16x8*)(yr + 64 * s), acc, 0, 0, 0);
    return acc;
}
template <int VAR> __device__ __forceinline__ void d1_unit(Frame& F, const Args& A, int unit) {
    if (VAR == 4) return;
    const int bh = unit >> 6, n = unit & 63, b = bh >> 2, h = bh & 3;
    const int t0 = b * SEQ + n * 64;
    const int lane = F.lane, wave = F.wave, g = lane >> 4, c = lane & 15;
    LAS unsigned char* L = F.lds;
    LAS unsigned char* L0 = opq_v(L); LAS unsigned char* L1 = opq_v(L + D1_RT); LAS unsigned char* L2 = opq_v(L + D1_P);
    LAS float* gcs = (LAS float*)(L2 + (D1_GC - D1_P)); LAS float* betas = gcs + 64;
    LAS unsigned char* LQB = L0 + D1_QB; LAS unsigned char* LKB = L0 + D1_KB; LAS unsigned char* LAT = L0 + D1_AT; LAS unsigned char* LKT = L0 + D1_KT;
    LAS unsigned char* LRT = L1; LAS unsigned char* LP = L2; LAS unsigned char* LPT = L2 + 9216; LAS unsigned char* LET = L2 + 18432;
    LAS unsigned char* LUW = L2; LAS unsigned char* LE = L0 + D1_E;
    const int i = lane;
    float gc = ((const GAS float*)WSP(float, WS_GG))[(size_t)(t0 + lane) * 4 + h];
    const float bt = ((const GAS float*)WSP(float, WS_BETA))[(size_t)(t0 + lane) * 4 + h];
    int wvb[3];
    LAS unsigned char* RAW = L1;
    {
        const bf16* pre = WSP(bf16, WS_QKVPRE);
        const float* cwp = A.in[3];
#pragma unroll
        for (int x = 0; x < 3; ++x) wvb[x] = __float_as_int(((const GAS float*)cwp)[(lane >> 4) * 1536 + x * 512 + h * 128 + 16 * wave + (lane & 15)]);
        u32x4 rv[7];
#pragma unroll
        for (int k = 0; k < 7; ++k) { int p = F.tid + 512 * k; p = p < 3216 ? p : 3215; const int x = p / 1072, rem = p - x * 1072, row = rem >> 4, pc = rem & 15;
            const bool okr = (n * 64 - 3 + row >= 0); const int rowi = okr ? (t0 - 3 + row) : t0;
            rv[k] = *(const GAS u32x4*)(pre + (size_t)rowi * 1536 + x * 512 + h * 128 + pc * 8); if (!okr) rv[k] = (u32x4){0u, 0u, 0u, 0u}; }
#pragma unroll
        for (int k = 0; k < 7; ++k) { const int p = F.tid + 512 * k; if (p < 3216) { const int x = p / 1072, rem = p - x * 1072, row = rem >> 4, pc = rem & 15; *(LAS u32x4*)(RAW + (x * 67 + row) * RSB + pc * 16) = rv[k]; } }
    }
    __syncthreads();
#pragma unroll
    for (int o = 1; o < 64; o <<= 1) { const float t = __shfl_up(gc, o); if (lane >= o) gc += t; }
    const float gc63 = __shfl(gc, 63);
    if (wave == 0) { gcs[lane] = gc; betas[lane] = bt; }
    {
        float ov[3][16];
#pragma unroll
        for (int x = 0; x < 3; ++x) {
#define RL(k) __int_as_float(__builtin_amdgcn_readlane(wvb[x], (k)))
            float acc[16];
#pragma unroll
            for (int e = 0; e < 16; ++e) acc[e] = 0.f;
#pragma unroll
            for (int j = 0; j < 4; ++j) {
                const u32x4 r0 = *(const LAS u32x4*)(RAW + (x * 67 + i + j) * RSB + 32 * wave), r1 = *(const LAS u32x4*)(RAW + (x * 67 + i + j) * RSB + 32 * wave + 16);
#pragma unroll
                for (int e = 0; e < 4; ++e) { const float w0 = RL(j * 16 + 2 * e), w1 = RL(j * 16 + 2 * e + 1), w2 = RL(j * 16 + 8 + 2 * e), w3 = RL(j * 16 + 8 + 2 * e + 1);
                    acc[2 * e] += w0 * bflo(r0[e]); acc[2 * e + 1] += w1 * bfhi(r0[e]); acc[8 + 2 * e] += w2 * bflo(r1[e]); acc[8 + 2 * e + 1] += w3 * bfhi(r1[e]); }
            }
#pragma unroll
            for (int e = 0; e < 16; ++e) ov[x][e] = silu_f(acc[e]);
#undef RL
        }
        float sq = 0.f, sk = 0.f;
#pragma unroll
        for (int e = 0; e < 16; ++e) { sq += ov[0][e] * ov[0][e]; sk += ov[1][e] * ov[1][e]; }
        LAS float* part = (LAS float*)LET;
        part[wave * 64 + i] = sq; part[512 + wave * 64 + i] = sk;
        __syncthreads();
        float tq = 0.f, tk = 0.f;
#pragma unroll
        for (int w8 = 0; w8 < 8; ++w8) { tq += part[w8 * 64 + i]; tk += part[512 + w8 * 64 + i]; }
        const float rq = rsqrtf(tq + RMS_EPS) * 0.08838834764831845f, rk = rsqrtf(tk + RMS_EPS);
        const float kt = __expf(gc63 - gc), be = bt * __expf(gc);
        u32x4 qw[2], kw[2];
#pragma unroll
        for (int e = 0; e < 8; ++e) { qw[e >> 2][e & 3] = pk2(ov[0][2 * e] * rq, ov[0][2 * e + 1] * rq); kw[e >> 2][e & 3] = pk2(ov[1][2 * e] * rk, ov[1][2 * e + 1] * rk); }
        *(LAS u32x4*)(LQB + i * RSB + 32 * wave) = qw[0]; *(LAS u32x4*)(LQB + i * RSB + 32 * wave + 16) = qw[1];
        *(LAS u32x4*)(LKB + i * RSB + 32 * wave) = kw[0]; *(LAS u32x4*)(LKB + i * RSB + 32 * wave + 16) = kw[1];
#pragma unroll
        for (int e = 0; e < 16; ++e) { const float kv = ov[1][e] * rk; const int d = 16 * wave + e;
            *(LAS unsigned short*)(LKT + d * RSS + 2 * i) = (unsigned short)f2bf(kv * kt);
            *(LAS unsigned short*)(LRT + d * RSS + 2 * i) = (unsigned short)f2bf(ov[2][e] * bt);
            *(LAS unsigned short*)(LRT + (128 + d) * RSS + 2 * i) = (unsigned short)f2bf(kv * be); }
    }
    __syncthreads();
    if (VAR == 1) return;
    f32x4 Er[2];
#pragma unroll
    for (int it = 0; it < 4; ++it) {
        const int id = wave + 8 * (it & 1), isq = it >> 1, mi = id >> 2, nj = id & 3;
        f32x4 acc = {0.f, 0.f, 0.f, 0.f};
        if (mi >= nj) {
            const LAS unsigned char* xr = (isq ? LQB : LKB) + (16 * mi + c) * RSB + 16 * g;
            const LAS unsigned char* yr = LKB + (16 * nj + c) * RSB + 16 * g;
#pragma unroll
            for (int s = 0; s < 4; ++s) acc = __builtin_amdgcn_mfma_f32_16x16x32_bf16(*(const LAS bf16x8*)(xr + 64 * s), *(const LAS bf16x8*)(yr + 64 * s), acc, 0, 0, 0);
        }
        const int j = 16 * nj + c; const float gj = gcs[j];
        f32x4 o;
#pragma unroll
        for (int r = 0; r < 4; ++r) { const int i = 16 * mi + 4 * g + r; const float dec = (i >= j) ? __expf(gcs[i] - gj) : 0.f;
            o[r] = isq ? ((i >= j) ? acc[r] * dec : 0.f) : ((i > j) ? -betas[i] * acc[r] * dec : 0.f); }
        if (!isq) { Er[it & 1] = o;
            u32x2 w; w.x = pk2(o[0], o[1]); w.y = pk2(o[2], o[3]);
            *(LAS u32x2*)(LPT + j * RSS + 2 * (16 * mi + 4 * g)) = w; *(LAS u32x2*)(LET + j * RSS + 2 * (16 * mi + 4 * g)) = w;
#pragma unroll
            for (int r = 0; r < 4; ++r) *(LAS unsigned short*)(LP + (16 * mi + 4 * g + r) * RSS + 2 * j) = (unsigned short)f2bf(o[r]);
        } else {
#pragma unroll
            for (int r = 0; r < 4; ++r) *(LAS unsigned short*)(LAT + (16 * mi + 4 * g + r) * RSS + 2 * j) = (unsigned short)f2bf(o[r]);
        }
    }
#pragma unroll 1
    for (int s5 = 0; s5 < 5; ++s5) {
        __syncthreads();
        f32x4 Pn[2];
#pragma unroll
        for (int tt = 0; tt < 2; ++tt) { const int id = wave + 8 * tt, mi = id >> 2, nj = id & 3;
            Pn[tt] = tile_k64(LP + (16 * mi + c) * RSS + 16 * g, LPT + (16 * nj + c) * RSS + 16 * g, (f32x4){0.f, 0.f, 0.f, 0.f}); }
        __syncthreads();
#pragma unroll
        for (int tt = 0; tt < 2; ++tt) { const int id = wave + 8 * tt, mi = id >> 2, nj = id & 3, j = 16 * nj + c;
            u32x2 w; w.x = pk2(Pn[tt][0], Pn[tt][1]); w.y = pk2(Pn[tt][2], Pn[tt][3]);
            *(LAS u32x2*)(LPT + j * RSS + 2 * (16 * mi + 4 * g)) = w;
#pragma unroll
            for (int r = 0; r < 4; ++r) *(LAS unsigned short*)(LP + (16 * mi + 4 * g + r) * RSS + 2 * j) = (unsigned short)f2bf(Pn[tt][r]); }
        __syncthreads();
        f32x4 En[2];
#pragma unroll
        for (int tt = 0; tt < 2; ++tt) { const int id = wave + 8 * tt, mi = id >> 2, nj = id & 3;
            En[tt] = tile_k64(LP + (16 * mi + c) * RSS + 16 * g, LET + (16 * nj + c) * RSS + 16 * g, Er[tt] + Pn[tt]); }
        __syncthreads();
#pragma unroll
        for (int tt = 0; tt < 2; ++tt) { const int id = wave + 8 * tt, mi = id >> 2, nj = id & 3, j = 16 * nj + c;
            Er[tt] = En[tt];
            u32x2 w; w.x = pk2(En[tt][0], En[tt][1]); w.y = pk2(En[tt][2], En[tt][3]);
            *(LAS u32x2*)(LET + j * RSS + 2 * (16 * mi + 4 * g)) = w; }
    }
    if (VAR == 2) { __syncthreads(); return; }
#pragma unroll
    for (int tt = 0; tt < 2; ++tt) { const int id = wave + 8 * tt, mi = id >> 2, nj = id & 3, j = 16 * nj + c;
#pragma unroll
        for (int r = 0; r < 4; ++r) *(LAS unsigned short*)(LE + (16 * mi + 4 * g + r) * RSS + 2 * j) = (unsigned short)f2bf(Er[tt][r]); }
    __syncthreads();
    {
        f32x4 xo[8];
#pragma unroll
        for (int q = 0; q < 8; ++q) { const int t = wave + 8 * q, mi = t >> 4, ct = t & 15;
            const u32x2 rv = *(const LAS u32x2*)(LRT + (16 * ct + c) * RSS + 2 * (16 * mi + 4 * g));
            xo[q] = tile_k64(LE + (16 * mi + c) * RSS + 16 * g, LRT + (16 * ct + c) * RSS + 16 * g, (f32x4){bflo(rv.x), bfhi(rv.x), bflo(rv.y), bfhi(rv.y)}); }
        __syncthreads();
#pragma unroll
        for (int q = 0; q < 8; ++q) { const int t = wave + 8 * q, mi = t >> 4, ct = t & 15;
            u32x2 w; w.x = pk2(xo[q][0], xo[q][1]); w.y = pk2(xo[q][2], xo[q][3]);
            *(LAS u32x2*)(LUW + (16 * ct + c) * RSS + 2 * (16 * mi + 4 * g)) = w; }
    }
    __syncthreads();
    if (VAR == 3) return;
    const LAS unsigned char* UWr = LUW; const LAS unsigned char* ATr = LAT; const LAS unsigned char* KTr = LKT;
    const size_t cbase = (size_t)unit; const f32x4 z4 = {0.f, 0.f, 0.f, 0.f};
    for (int t = wave; t < 32; t += 8) { const int xi = t >> 3, yj = t & 7;
        const f32x4 d = tile_k64(ATr + (16 * xi + c) * RSS + 16 * g, UWr + (16 * yj + c) * RSS + 16 * g, z4);
        u32x2 w; w.x = pk2(d[0], d[1]); w.y = pk2(d[2], d[3]);
        *(GAS u32x2*)(WSP(bf16, WS_OLOCT) + cbase * 8192 + (size_t)((yj * 4 + xi) * 64 + lane) * 4) = w; }
    for (int t = wave; t < 32; t += 8) { const int xi = t >> 2, yj = t & 3;
        const f32x4 d = tile_k64(UWr + (128 + 16 * xi + c) * RSS + 16 * g, ATr + (16 * yj + c) * RSS + 16 * g, z4);
        const int i2 = 16 * yj + c, dd = 16 * xi + 4 * g; const float eg = __expf(gcs[i2]);
        const u32x2 qv = *(const LAS u32x2*)(LQB + i2 * RSB + 2 * dd);
        u32x2 w; w.x = pk2(bflo(qv.x) * eg - d[0], bfhi(qv.x) * eg - d[1]); w.y = pk2(bflo(qv.y) * eg - d[2], bfhi(qv.y) * eg - d[3]);
        *(GAS u32x2*)(WSP(bf16, WS_QEFF) + cbase * 8192 + (size_t)(((yj * 4 + (xi >> 1)) * 64 + (2 * (xi & 1) + (g >> 1)) * 16 + c) * 8 + 4 * (g & 1))) = w; }
    for (int t = wave; t < 64; t += 8) { const int xi = t >> 3, yj = t & 7;
        const f32x4 d = tile_k64(KTr + (16 * xi + c) * RSS + 16 * g, UWr + (16 * yj + c) * RSS + 16 * g, z4);
        u32x2 w; w.x = pk2(d[0], d[1]); w.y = pk2(d[2], d[3]);
        *(GAS u32x2*)(WSP(bf16, WS_BMT) + cbase * 16384 + (size_t)(((yj * 4 + (xi >> 1)) * 2 + (xi & 1)) * 64 + lane) * 4) = w; }
    for (int t = wave; t < 64; t += 8) { const int xi = t >> 3, yj = t & 7;
        const f32x4 d = tile_k64(UWr + (128 + 16 * xi + c) * RSS + 16 * g, KTr + (16 * yj + c) * RSS + 16 * g, z4);
        u32x2 w; w.x = pk2(-d[0], -d[1]); w.y = pk2(-d[2], -d[3]);
        *(GAS u32x2*)(WSP(bf16, WS_MNEG) + cbase * 16384 + (size_t)(((yj * 4 + (xi >> 1)) * 64 + (2 * (xi & 1) + (g >> 1)) * 16 + c) * 8 + 4 * (g & 1))) = w; }
    if (F.tid == 0) WSP(float, WS_GLAST)[unit] = __expf(gc63);
    __syncthreads();
}

constexpr int SCAN_PF = 4;
__device__ __forceinline__ void scan_wg(Frame& F, int sw) {
    const int bh = sw & 15, slice = sw >> 4, b = bh >> 2, h = bh & 3;
    const int lane = F.lane, wave = F.wave, g = lane >> 4, c = lane & 15;
    LAS unsigned char* ST = opq_v(F.lds);
    LAS unsigned char* OS = ST + 8704;
    for (int i = F.tid; i < 2 * 4352 / 4; i += 512) ((LAS unsigned*)ST)[i] = 0u;
    __syncthreads();
    const GAS bf16* MN = (const GAS bf16*)(WSP(bf16, WS_MNEG) + (size_t)bh * 64 * 16384); const GAS bf16* BM = (const GAS bf16*)(WSP(bf16, WS_BMT) + (size_t)bh * 64 * 16384);
    const GAS bf16* QE = (const GAS bf16*)(WSP(bf16, WS_QEFF) + (size_t)bh * 64 * 8192); const GAS bf16* OL = (const GAS bf16*)(WSP(bf16, WS_OLOCT) + (size_t)bh * 64 * 8192);
    const GAS float* GL = (const GAS float*)(WSP(float, WS_GLAST) + bh * 64);
    (void)b; (void)h;
    if (wave < 4) {
        f32x4 Sreg[2] = {{0.f, 0.f, 0.f, 0.f}, {0.f, 0.f, 0.f, 0.f}};
        bf16x8 Af[SCAN_PF][2][4]; u32x2 bm[SCAN_PF][2]; float gl[SCAN_PF];
#define SCAN_LOAD_REC(j, n) do { const size_t cb_ = (size_t)(n) * 16384; \
        _Pragma("unroll") for (int mt = 0; mt < 2; ++mt) { _Pragma("unroll") for (int s = 0; s < 4; ++s) Af[j][mt][s] = *(const GAS bf16x8*)(MN + cb_ + (size_t)(((wave * 2 + mt) * 4 + s) * 64 + lane) * 8); \
            bm[j][mt] = *(const GAS u32x2*)(BM + cb_ + (size_t)(((slice * 4 + wave) * 2 + mt) * 64 + lane) * 4); } gl[j] = GL[n]; } while (0)
#pragma unroll
        for (int j = 0; j < SCAN_PF; ++j) SCAN_LOAD_REC(j, j);
#pragma unroll 1
        for (int n0 = 0; n0 < 64; n0 += SCAN_PF) {
#pragma unroll
            for (int j = 0; j < SCAN_PF; ++j) {
                const int n = n0 + j; const int cur = n & 1;
                bf16x8 Sb[4];
#pragma unroll
                for (int s = 0; s < 4; ++s) Sb[s] = *(const LAS bf16x8*)(ST + cur * 4352 + c * 272 + 64 * s + 16 * g);
#pragma unroll
                for (int mt = 0; mt < 2; ++mt) {
                    f32x4 acc; acc[0] = gl[j] * Sreg[mt][0] + bflo(bm[j][mt].x); acc[1] = gl[j] * Sreg[mt][1] + bfhi(bm[j][mt].x); acc[2] = gl[j] * Sreg[mt][2] + bflo(bm[j][mt].y); acc[3] = gl[j] * Sreg[mt][3] + bfhi(bm[j][mt].y);
#pragma unroll
                    for (int s = 0; s < 4; ++s) acc = __builtin_amdgcn_mfma_f32_16x16x32_bf16(Af[j][mt][s], Sb[s], acc, 0, 0, 0);
                    Sreg[mt] = acc;
                    u32x2 w; w.x = pk2(acc[0], acc[1]); w.y = pk2(acc[2], acc[3]);
                    *(LAS u32x2*)(ST + (cur ^ 1) * 4352 + c * 272 + 2 * (32 * wave + 16 * mt + 4 * g)) = w;
                }
                if (n + SCAN_PF < 64) SCAN_LOAD_REC(j, n + SCAN_PF);
                __syncthreads();
            }
        }
#undef SCAN_LOAD_REC
        __syncthreads();
    } else {
        const int m = wave - 4;
        bf16x8 Qf[SCAN_PF][4]; u32x2 ol[SCAN_PF];
        GAS bf16* OU = (GAS bf16*)(WSP(bf16, WS_OUN) + ((size_t)(bh * 8 + slice) * SEQ) * 16);
#define SCAN_LOAD_OUT(j, n) do { const size_t cb_ = (size_t)(n) * 8192; \
        _Pragma("unroll") for (int s = 0; s < 4; ++s) Qf[j][s] = *(const GAS bf16x8*)(QE + cb_ + (size_t)((m * 4 + s) * 64 + lane) * 8); \
        ol[j] = *(const GAS u32x2*)(OL + cb_ + (size_t)((slice * 4 + m) * 64 + lane) * 4); } while (0)
#define SCAN_FLUSH(n) do { if (m < 2) { const int q_ = m * 64 + lane; const u32x4 v_ = *(const LAS u32x4*)(OS + ((n) & 1) * 2048 + q_ * 16); *(GAS u32x4*)(OU + (size_t)(n) * 1024 + q_ * 8) = v_; } } while (0)
#pragma unroll
        for (int j = 0; j < SCAN_PF; ++j) SCAN_LOAD_OUT(j, j);
#pragma unroll 1
        for (int n0 = 0; n0 < 64; n0 += SCAN_PF) {
#pragma unroll
            for (int j = 0; j < SCAN_PF; ++j) {
                const int n = n0 + j; const int cur = n & 1;
                if (n > 0) SCAN_FLUSH(n - 1);
                bf16x8 Sb[4];
#pragma unroll
                for (int s = 0; s < 4; ++s) Sb[s] = *(const LAS bf16x8*)(ST + cur * 4352 + c * 272 + 64 * s + 16 * g);
                f32x4 acc; acc[0] = bflo(ol[j].x); acc[1] = bfhi(ol[j].x); acc[2] = bflo(ol[j].y); acc[3] = bfhi(ol[j].y);
#pragma unroll
                for (int s = 0; s < 4; ++s) acc = __builtin_amdgcn_mfma_f32_16x16x32_bf16(Qf[j][s], Sb[s], acc, 0, 0, 0);
#pragma unroll
                for (int r = 0; r < 4; ++r) *(LAS unsigned short*)(OS + cur * 2048 + (16 * m + 4 * g + r) * 32 + 2 * c) = (unsigned short)f2bf(acc[r]);
                if (n + SCAN_PF < 64) SCAN_LOAD_OUT(j, n + SCAN_PF);
                __syncthreads();
            }
        }
        SCAN_FLUSH(63);
        __syncthreads();
#undef SCAN_LOAD_OUT
#undef SCAN_FLUSH
    }
}

constexpr int AT_KS = 0, AT_VS = 36864, AT_OS = 73728, N_ATT_UNITS = NB * DAH * 96;
__device__ __forceinline__ s16x4 vtr(const LAS unsigned char* p) { typedef short v4i16_t __attribute__((ext_vector_type(4))); return __builtin_bit_cast(s16x4, __builtin_amdgcn_ds_read_tr16_b64_v4i16((LAS v4i16_t*)p)); }
struct AttU { int b, hh, br, dil, res, n; };
__device__ __forceinline__ AttU att_decode(int a) { AttU u; const int bhh = a / 96, rem = a % 96; u.br = rem >> 5; const int idx = rem & 31; u.b = bhh >> 3; u.hh = bhh & 7;
    u.dil = u.br == 0 ? 1 : u.br == 1 ? 4 : 16; const int nblk = 32 / u.dil; u.res = idx / nblk; u.n = idx % nblk; return u; }
__device__ __forceinline__ void att_load(Frame& F, int a, u32x4 (&kv)[4], u32x4 (&vv)[4], bf16x8 (&Bq)[2]) {
    const AttU u = att_decode(a); const bf16* QKVD = WSP(bf16, WS_QKVD);
#pragma unroll
    for (int p = 0; p < 4; ++p) { const int j = (F.tid >> 3) + 64 * p, kidx = 128 * (u.n - 1) + j; const bool ok = kidx >= 0;
        const bf16* src = QKVD + (size_t)(u.b * SEQ + (ok ? kidx : 0) * u.dil + u.res) * 1536 + u.hh * 64 + (F.tid & 7) * 8;
        kv[p] = *(const GAS u32x4*)(src + 512); vv[p] = *(const GAS u32x4*)(src + 1024);
        if (!ok) { kv[p] = (u32x4){0u, 0u, 0u, 0u}; vv[p] = (u32x4){0u, 0u, 0u, 0u}; } }
    const int qi = 16 * F.wave + (F.lane & 15); const size_t qtok = (size_t)(u.b * SEQ + (128 * u.n + qi) * u.dil + u.res);
#pragma unroll
    for (int s = 0; s < 2; ++s) Bq[s] = *(const GAS bf16x8*)(QKVD + qtok * 1536 + u.hh * 64 + 32 * s + 8 * (F.lane >> 4));
}
__device__ __forceinline__ void att_compute(Frame& F, int a, LAS unsigned char* L, const bf16x8 (&Bq)[2]) {
    const AttU u = att_decode(a); const int n = u.n;
    const int lane = F.lane, wave = F.wave, g = lane >> 4, c = lane & 15;
    const int qi = 16 * wave + c;
    f32x4 sc[9];
    float mx = -1.0e30f;
#pragma unroll
    for (int t = 0; t < 9; ++t) {
        const LAS unsigned char* kr = L + AT_KS + (16 * (wave + t) + c) * RSS + 16 * g;
        f32x4 acc = {0.f, 0.f, 0.f, 0.f};
        acc = __builtin_amdgcn_mfma_f32_16x16x32_bf16(*(const LAS bf16x8*)kr, Bq[0], acc, 0, 0, 0);
        acc = __builtin_amdgcn_mfma_f32_16x16x32_bf16(*(const LAS bf16x8*)(kr + 64), Bq[1], acc, 0, 0, 0);
        if (t == 0) {
#pragma unroll
            for (int r = 0; r < 4; ++r) { const int j = 16 * wave + 4 * g + r; if (j < qi) acc[r] = -1.0e30f; } }
        if (t == 8) {
#pragma unroll
            for (int r = 0; r < 4; ++r) { const int j = 16 * (wave + 8) + 4 * g + r; if (j > qi + 128) acc[r] = -1.0e30f; } }
        if (n == 0 && wave + t < 8) acc = (f32x4){-1.0e30f, -1.0e30f, -1.0e30f, -1.0e30f};
        mx = fmaxf(fmaxf(mx, fmaxf(acc[0], acc[1])), fmaxf(acc[2], acc[3]));
        sc[t] = acc;
    }
    mx = fmaxf(mx, __shfl_xor(mx, 16)); mx = fmaxf(mx, __shfl_xor(mx, 32));
    float lsum = 0.f;
#pragma unroll
    for (int t = 0; t < 9; ++t)
#pragma unroll
        for (int r = 0; r < 4; ++r) { const float p = __builtin_amdgcn_exp2f(sc[t][r] - mx); sc[t][r] = p; lsum += p; }
    lsum += __shfl_xor(lsum, 16); lsum += __shfl_xor(lsum, 32);
    bf16x8 pf[5];
#pragma unroll
    for (int q = 0; q < 5; ++q) { u32x4 w; w.x = pk2(sc[2 * q][0], sc[2 * q][1]); w.y = pk2(sc[2 * q][2], sc[2 * q][3]);
        if (q < 4) { w.z = pk2(sc[2 * q + 1][0], sc[2 * q + 1][1]); w.w = pk2(sc[2 * q + 1][2], sc[2 * q + 1][3]); } else { w.z = 0u; w.w = 0u; }
        pf[q] = __builtin_bit_cast(bf16x8, w); }
    float linv[4];
#pragma unroll
    for (int r = 0; r < 4; ++r) linv[r] = 1.f / __shfl(lsum, 4 * g + r);
    LAS unsigned char* OS = L + AT_OS + wave * 2304;
#pragma unroll
    for (int dt = 0; dt < 4; ++dt) {
        f32x4 acc = {0.f, 0.f, 0.f, 0.f};
#pragma unroll
        for (int q = 0; q < 5; ++q) { const int kb = 16 * (wave + 2 * q);
            const LAS unsigned char* vp = L + AT_VS + (kb + 4 * g + (c >> 2)) * RSS + (16 * dt + 4 * (c & 3)) * 2;
            const s16x4 lo = vtr(vp); s16x4 hi = {0, 0, 0, 0}; if (q < 4) hi = vtr(vp + 16 * RSS);
            const bf16x8 bv = {lo[0], lo[1], lo[2], lo[3], hi[0], hi[1], hi[2], hi[3]};
            acc = __builtin_amdgcn_mfma_f32_16x16x32_bf16(pf[q], bv, acc, 0, 0, 0); }
#pragma unroll
        for (int r = 0; r < 4; ++r) *(LAS unsigned short*)(OS + (4 * g + r) * RSS + (16 * dt + c) * 2) = (unsigned short)f2bf(acc[r] * linv[r]);
    }
    const size_t qtok = (size_t)(u.b * SEQ + (128 * n + qi) * u.dil + u.res);
    if (g == 0) ((GAS float*)WSP(float, WS_LSE))[((size_t)u.br * T + qtok) * 8 + u.hh] = (mx + __log2f(lsum)) * 0.6931471805599453f;
    { const int row = lane >> 2, pc = lane & 3; const size_t tok = (size_t)(u.b * SEQ + (128 * n + 16 * wave + row) * u.dil + u.res);
      const u32x4 v0 = *(const LAS u32x4*)(OS + row * RSS + pc * 32), v1 = *(const LAS u32x4*)(OS + row * RSS + pc * 32 + 16);
      GAS u32x4* dst = (GAS u32x4*)(WSP(bf16, WS_OPART) + ((size_t)u.br * T + tok) * 512 + u.hh * 64 + pc * 16); dst[0] = v0; dst[1] = v1; }
}
__device__ __forceinline__ void attn_queue(Frame& F, unsigned* qword, volatile LAS unsigned* MISC) {
    LAS unsigned char* L = opq_v(F.lds);
    u32x4 kv[4], vv[4]; bf16x8 Bq[2], BqN[2];
    if (F.tid == 0) MISC[22] = __hip_atomic_fetch_add(qword, 1u, RLX_AGENT);
    __syncthreads();
    int a = (int)MISC[22];
    if (a < N_ATT_UNITS) att_load(F, a, kv, vv, Bq);
    while (a < N_ATT_UNITS) {
#pragma unroll
        for (int p = 0; p < 4; ++p) { const int j = (F.tid >> 3) + 64 * p; *(LAS u32x4*)(L + AT_KS + j * RSS + (F.tid & 7) * 16) = kv[p]; *(LAS u32x4*)(L + AT_VS + j * RSS + (F.tid & 7) * 16) = vv[p]; }
        if (F.tid == 0) MISC[20] = __hip_atomic_fetch_add(qword, 1u, RLX_AGENT);
        __syncthreads();
        const int an = (int)MISC[20];
        if (an < N_ATT_UNITS) att_load(F, an, kv, vv, BqN);
        att_compute(F, a, L, Bq);
        __syncthreads();
        a = an; Bq[0] = BqN[0]; Bq[1] = BqN[1];
    }
}

__device__ __forceinline__ void mix_pass(Frame& F, const Args& A) {
    const int lane = F.lane;
    float nw[8];
    { const f32x4 a = *(const GAS f32x4*)(A.in[6] + 8 * (lane & 15)), b = *(const GAS f32x4*)(A.in[6] + 8 * (lane & 15) + 4);
#pragma unroll
      for (int e = 0; e < 4; ++e) { nw[e] = a[e]; nw[4 + e] = b[e]; } }
    const bf16* OU = WSP(bf16, WS_OUN); const bf16* ZB = WSP(bf16, WS_ZB); const bf16* OP = WSP(bf16, WS_OPART); const float* LSE = WSP(float, WS_LSE); bf16* MIX = WSP(bf16, WS_MIX);
    for (int t = F.gw; t < T; t += F.NGW) {
        const u32x4 uo = *(const GAS u32x4*)(OU + ((size_t)(((t >> 12) * 4 + (lane >> 4)) * 8 + ((lane & 15) >> 1)) * SEQ + (t & 4095)) * 16 + 8 * (lane & 1)), uz = *(const GAS u32x4*)(ZB + (size_t)t * 512 + 8 * lane);
        float x[8], z[8];
#pragma unroll
        for (int e = 0; e < 4; ++e) { x[2 * e] = bflo(uo[e]); x[2 * e + 1] = bfhi(uo[e]); z[2 * e] = bflo(uz[e]); z[2 * e + 1] = bfhi(uz[e]); }
        float ss = 0.f;
#pragma unroll
        for (int e = 0; e < 8; ++e) ss += x[e] * x[e];
        ss += __shfl_xor(ss, 1); ss += __shfl_xor(ss, 2); ss += __shfl_xor(ss, 4); ss += __shfl_xor(ss, 8);
        const float rstd = rsqrtf(ss * (1.f / 128.f) + RMS_EPS);
        float o[8];
#pragma unroll
        for (int e = 0; e < 8; ++e) o[e] = x[e] * rstd * nw[e] * silu_f(z[e]);
        u32x4 w; w.x = pk2(o[0], o[1]); w.y = pk2(o[2], o[3]); w.z = pk2(o[4], o[5]); w.w = pk2(o[6], o[7]);
        *(GAS u32x4*)(MIX + (size_t)t * D + 8 * lane) = w;
        const int hh = lane >> 3;
        const float l0 = LSE[((size_t)0 * T + t) * 8 + hh], l1 = LSE[((size_t)1 * T + t) * 8 + hh], l2 = LSE[((size_t)2 * T + t) * 8 + hh];
        const float lm = fmaxf(l0, fmaxf(l1, l2)); const float e0 = __expf(l0 - lm), e1 = __expf(l1 - lm), e2 = __expf(l2 - lm); const float inv = 1.f / (e0 + e1 + e2);
        const u32x4 p0 = *(const GAS u32x4*)(OP + ((size_t)0 * T + t) * 512 + 8 * lane), p1 = *(const GAS u32x4*)(OP + ((size_t)1 * T + t) * 512 + 8 * lane), p2 = *(const GAS u32x4*)(OP + ((size_t)2 * T + t) * 512 + 8 * lane);
        const float w0 = e0 * inv, w1 = e1 * inv, w2 = e2 * inv;
        u32x4 wo;
#pragma unroll
        for (int e = 0; e < 4; ++e) wo[e] = pk2(w0 * bflo(p0[e]) + w1 * bflo(p1[e]) + w2 * bflo(p2[e]), w0 * bfhi(p0[e]) + w1 * bfhi(p1[e]) + w2 * bfhi(p2[e]));
        *(GAS u32x4*)(MIX + (size_t)t * D + 512 + 8 * lane) = wo;
    }
}

constexpr int N_PHASES = 29;
#define D1V 0
__global__ void __launch_bounds__(512, 2) fwd_kernel(Args args) {
    extern __shared__ __attribute__((aligned(16))) unsigned char lds_raw[];
    Frame F;
    F.lds = (LAS unsigned char*)lds_raw; F.ws = args.ws; F.ctl = (gu32*)(args.ws + WS_CTL);
    F.tid = threadIdx.x; F.lane = F.tid & 63; F.wave = __builtin_amdgcn_readfirstlane(F.tid >> 6);
    F.G = gridDim.x; F.gw = blockIdx.x * 8 + F.wave; F.NGW = F.G * 8;
    volatile LAS unsigned* MISC = (volatile LAS unsigned*)(F.lds + MISC_OFF); const char* wsb = (const char*)args.ws;
    for (int u = F.tid; u < 256; u += 512) MISC[u] = 0u;
    __syncthreads();
    const int lo = args.ph_lo, hi = args.ph_hi;
    XcdBarrier bar; bar.bar = (unsigned*)(F.ctl + CW_BAR); bar.x = 0; bar.st = MISC + 8;
    if (hi - lo > 1) bar = xcd_barrier_post((unsigned*)(F.ctl + CW_BAR), MISC + 8);
    LAS unsigned char* ring = F.lds; LAS unsigned char* xch = F.lds + XCH_OFF;
    volatile LAS unsigned* tab = MISC + 32;
    const int c = blockIdx.x, G = F.G; int qsel = 0;
#ifndef PHASE_MASK
#define PHASE_MASK 0xFFFFFFFFu
#endif
#define IN(k) ((((PHASE_MASK) >> (k)) & 1u) && lo <= (k) && (k) < hi)
#define SEAM(k) do { if (IN(k) && IN((k) + 1)) xcd_barrier(bar); } while (0)
#define PH_BEGIN() do { const int t_ = opq_v((int)threadIdx.x); F.tid = t_; F.lane = t_ & 63; F.wave = __builtin_amdgcn_readfirstlane(t_ >> 6); F.gw = blockIdx.x * 8 + F.wave; \
        unsigned char* w_ = opq_s(args.ws); F.ws = w_; F.ctl = (gu32*)(w_ + WS_CTL); xch = opq_v(F.lds + XCH_OFF); MISC = (volatile LAS unsigned*)opq_v(F.lds + MISC_OFF); tab = MISC + 32; bar.st = MISC + 8; wsb = (const char*)w_; } while (0)
#define HBc (wsb + WS_HB)

    if (IN(0)) { PH_BEGIN(); p0_prologue(F, args); SEAM(0); }
    if (IN(1)) { PH_BEGIN();
        SchedP1 S{HBc, (const char*)(wsb + WS_W_IN), (const char*)(wsb + WS_MEMB), (const char*)(wsb + WS_W_KV), G, c};
        EpiP1 E{WSP(bf16, WS_QKVPRE), WSP(bf16, WS_ZB), WSP(bf16, WS_QKVD), WSP(bf16, WS_KMEM), WSP(bf16, WS_VT)};
        pg8::gemm_phase(ring, xch, pg8::Gemm{D, D, D}, S, E); SEAM(1);
    }
    if (IN(2)) { PH_BEGIN(); for (int u = c; u < NB * DNH * NCHUNK; u += G) d1_unit<D1V>(F, args, u); SEAM(2); }
    if (IN(3)) { PH_BEGIN();
        if (c < 128) scan_wg(F, c);
        attn_queue(F, (unsigned*)(F.ctl + CW_QUEUE + 16 * qsel), MISC);
        ++qsel;
        SEAM(3);
    }
    if (IN(4)) { PH_BEGIN();
        { SchedPrep S{(const char*)(wsb + WS_KMEM), (const char*)(wsb + WS_W_Q), (const char*)(wsb + WS_W_O), (const char*)(wsb + WS_VT), G, c}; EpiPrep E{WSP(bf16, WS_MT), WSP(bf16, WS_VWT)};
          pg8::gemm_phase(ring, xch, pg8::Gemm{D, D, XD}, S, E); }
        mix_pass(F, args); SEAM(4); }

#pragma unroll
    for (int layer = 0; layer < 2; ++layer) {
        const int pb = layer * 13;
        if (layer == 0) {
            if (IN(5)) { PH_BEGIN(); convert_moe_q(F, args, 0, 0, WSP(bf16, WS_MOEW_GU), (unsigned*)(F.ctl + CW_CVQ), MISC); convert_moe_q(F, args, 0, 1, WSP(bf16, WS_MOEW_D), (unsigned*)(F.ctl + CW_CVQ + 16), MISC); __syncthreads();
                SchedDense S{(const char*)(wsb + WS_MIX), (const char*)(wsb + WS_W_ABO), D, D, 64, 4, G, c}; EpiDense E{WSP(bf16, 288 * MiB), D, 1.f};
                pg8::gemm_phase(ring, xch, pg8::Gemm{D, D, D}, S, E); SEAM(5); }
            if (IN(6)) { PH_BEGIN(); ln_pass<0, false, false>(F, args, WSP(bf16, WS_HB), WSP(bf16, 288 * MiB), 0, nullptr, WSP(bf16, WS_HB), nullptr); SEAM(6); }
        } else {
            if (IN(16)) { PH_BEGIN();
                SchedDense S{HBc, (const char*)(wsb + WS_W_SCI), D, D, 64, 12, G, c}; EpiDense E{WSP(bf16, 192 * MiB), 3 * D, 1.f};
                pg8::gemm_phase(ring, xch, pg8::Gemm{D, D, D}, S, E); SEAM(16); }
            if (IN(17)) { PH_BEGIN(); conv_pass(F, args, WSP(bf16, 192 * MiB), WSP(bf16, 288 * MiB)); SEAM(17); }
            if (IN(18)) { PH_BEGIN(); SchedDense S{(const char*)(wsb + 288 * MiB), (const char*)(wsb + WS_W_SCO), D, D, 64, 4, G, c}; EpiDense E{WSP(bf16, 192 * MiB), D, 1.f};
                pg8::gemm_phase(ring, xch, pg8::Gemm{D, D, D}, S, E); SEAM(18); }
            if (IN(19)) { PH_BEGIN(); ln_pass<0, false, false>(F, args, WSP(bf16, WS_HB), WSP(bf16, 192 * MiB), 3, nullptr, WSP(bf16, WS_HB), nullptr); SEAM(19); }
        }
        const size_t oP = (layer == 0 ? 224 : 256) * MiB, oY = (layer == 0 ? 288 : 192) * MiB;
        const int p7 = layer == 0 ? 7 : 20;
        if (IN(p7)) { PH_BEGIN(); SchedXB S{HBc, (const char*)(wsb + WS_MT + (size_t)layer * NB * D * D * 2), G, c}; EpiSoftmax E{WSP(bf16, oP)};
            pg8::gemm_phase(ring, xch, pg8::Gemm{D, D, D}, S, E); SEAM(p7); }
        if (IN(p7 + 1)) { PH_BEGIN(); SchedXB S{(const char*)(wsb + oP), (const char*)(wsb + WS_VWT + (size_t)layer * NB * D * D * 2), G, c}; EpiDense E{WSP(bf16, oY), D, 1.f};
            pg8::gemm_phase(ring, xch, pg8::Gemm{D, D, D}, S, E); SEAM(p7 + 1); }
        unsigned* cnt = (unsigned*)(F.ctl + (layer == 0 ? CW_CNT0 : CW_CNT1));
        if (IN(p7 + 4)) { PH_BEGIN(); ln_pass<0, true, false>(F, args, WSP(bf16, WS_HB), WSP(bf16, oY), layer * 3 + 1, nullptr, WSP(bf16, WS_HB), cnt); SEAM(p7 + 4); }
        if (IN(p7 + 5)) { PH_BEGIN(); moe_table(F, cnt, tab); moe_gather(F, WSP(bf16, WS_HB), WSP(bf16, WS_XG), tab); SEAM(p7 + 5); }
        if (IN(p7 + 6)) { PH_BEGIN(); moe_table(F, cnt, tab);
            SchedMoE S{(const char*)(wsb + WS_XG), (const char*)(wsb + (layer == 0 ? WS_MOEW_GU : WS_MOEW_GU1)), tab, D, D, D, G, c}; EpiSwiglu E{WSP(bf16, WS_HACT)};
            pg8::gemm_phase(ring, xch, pg8::Gemm{D, D, D}, S, E);
            if (layer == 0) convert_moe_q(F, args, 1, 0, WSP(bf16, WS_MOEW_GU1), (unsigned*)(F.ctl + CW_CVQ + 32), MISC);
            SEAM(p7 + 6); }
        if (IN(p7 + 7)) { PH_BEGIN(); moe_table(F, cnt, tab);
            SchedMoE S{(const char*)(wsb + WS_HACT), (const char*)(wsb + (layer == 0 ? WS_MOEW_D : WS_MOEW_D1)), tab, DE, D, DE, G, c}; EpiDense E{WSP(bf16, WS_XG), D, 1.f};
            pg8::gemm_phase(ring, xch, pg8::Gemm{DE, DE, DE}, S, E);
            if (layer == 0) convert_moe_q(F, args, 1, 1, WSP(bf16, WS_MOEW_D1), (unsigned*)(F.ctl + CW_CVQ + 48), MISC);
            SEAM(p7 + 7); }
        if (layer == 0) { if (IN(15)) { PH_BEGIN(); ln_pass<1, false, false>(F, args, WSP(bf16, WS_HB), WSP(bf16, WS_XG), 2, nullptr, WSP(bf16, WS_HB), nullptr); SEAM(15); } }
        else { if (IN(28)) { PH_BEGIN(); ln_pass<1, false, true>(F, args, WSP(bf16, WS_HB), WSP(bf16, WS_XG), 5, args.out, nullptr, nullptr); SEAM(28); } }
        (void)pb;
    }
#undef IN
#undef SEAM
}

extern "C" void kernel_launch(void* const* d_in, const int* in_sizes, int n_in, void* d_out, int out_size, void* d_ws, size_t ws_size, hipStream_t stream) {
    static int grid = 0;
    if (grid == 0) {
        if (n_in != 21 || out_size != T * D || ws_size < WS_END) { fprintf(stderr, "kernel_launch: unexpected problem (n_in %d, out %d, ws %zu < %zu)\n", n_in, out_size, ws_size, (size_t)WS_END); grid = -1; return; }
        int dev = 0, cus = 0, per_cu = 0;
        if (hipGetDevice(&dev) != hipSuccess || hipDeviceGetAttribute(&cus, hipDeviceAttributeMultiprocessorCount, dev) != hipSuccess) { grid = -1; return; }
        if (hipFuncSetAttribute((const void*)fwd_kernel, hipFuncAttributeMaxDynamicSharedMemorySize, LDS_BYTES) != hipSuccess) { fprintf(stderr, "kernel_launch: hipFuncSetAttribute failed\n"); grid = -1; return; }
        if (hipOccupancyMaxActiveBlocksPerMultiprocessor(&per_cu, (const void*)fwd_kernel, 512, LDS_BYTES) != hipSuccess || per_cu < 1) { fprintf(stderr, "kernel_launch: occupancy query says %d blocks per CU\n", per_cu); (void)hipGetLastError(); per_cu = 1; }
        grid = cus;
    }
    if (grid < 0) return;
    (void)hipMemsetAsync((char*)d_ws + WS_CTL, 0, CTL_ZERO_BYTES, stream);
    Args a{};
    for (int i = 0; i < 21; ++i) a.in[i] = (const float*)d_in[i];
    a.out = (float*)d_out; a.ws = (unsigned char*)d_ws;
#if MK_ONE_LAUNCH
    a.ph_lo = 0; a.ph_hi = N_PHASES;
    hipLaunchKernelGGL(fwd_kernel, dim3(grid), dim3(512), LDS_BYTES, stream, a);
#else
    for (int p = 0; p < N_PHASES; ++p) { a.ph_lo = p; a.ph_hi = p + 1; hipLaunchKernelGGL(fwd_kernel, dim3(grid), dim3(512), LDS_BYTES, stream, a); }
#endif
}
```

```cpp
#include <hip/hip_runtime.h>
#include <cstdio>
#include <cstdint>

#ifndef MK_ONE_LAUNCH
#define MK_ONE_LAUNCH 1
#endif

#define LAS __attribute__((address_space(3)))
#define GAS __attribute__((address_space(1)))
typedef unsigned short bf16;
typedef short bf16x8 __attribute__((ext_vector_type(8)));
typedef short s16x4 __attribute__((ext_vector_type(4)));
typedef float f32x4 __attribute__((ext_vector_type(4)));
typedef float f32x2 __attribute__((ext_vector_type(2)));
typedef unsigned u32x4 __attribute__((ext_vector_type(4)));
typedef unsigned u32x2 __attribute__((ext_vector_type(2)));
typedef GAS unsigned gu32;
#define RLX_AGENT __ATOMIC_RELAXED, __HIP_MEMORY_SCOPE_AGENT
#define LDS_WAIT() asm volatile("s_waitcnt lgkmcnt(0)" ::: "memory")
#define VM_WAIT() asm volatile("s_waitcnt vmcnt(0)" ::: "memory")

constexpr int NB = 4, SEQ = 4096, T = NB * SEQ, D = 1024;
constexpr int NMEM = 256, TM = NB * NMEM;
constexpr int DNH = 4, DND = 128, DNW = 512, DNC = 64, NCHUNK = SEQ / DNC;
constexpr int DAH = 8, DAD = 64, DAW = 512;
constexpr int AB_IN = 3592;
constexpr int XH = 4, XD = 256;
constexpr int NE = 16, DE = 512;
constexpr float ALPHA = 1.41421356237f;
constexpr float LN_EPS = 1e-5f, RMS_EPS = 1e-6f;
constexpr int MOE_ROWS = 2 * T + NE * 256;

constexpr size_t MiB = 1u << 20;
constexpr size_t WS_CTL = 0, CTL_ZERO_BYTES = 1 * MiB;
constexpr size_t WS_W_IN = 1 * MiB, WS_W_ABO = 8 * MiB, WS_W_SCI = 10 * MiB, WS_W_SCO = 16 * MiB, WS_W_Q = 18 * MiB, WS_W_KV = 22 * MiB, WS_W_O = 30 * MiB;
constexpr size_t WS_MEMB = 34 * MiB, WS_KMEM = 36 * MiB, WS_VT = 40 * MiB, WS_BETA = 44 * MiB, WS_GG = 45 * MiB, WS_ROUTE = 46 * MiB, WS_GLAST = 47 * MiB;
constexpr size_t WS_MT = 80 * MiB, WS_VWT = 96 * MiB;
constexpr size_t WS_HB = 48 * MiB, WS_H = 80 * MiB, WS_ARENA = 144 * MiB, WS_END = 320 * MiB;
constexpr size_t WS_QKVPRE = 144 * MiB, WS_ZB = 192 * MiB, WS_QKVD = 208 * MiB, WS_MNEG = 80 * MiB, WS_BMT = 112 * MiB, WS_QEFF = 256 * MiB, WS_OLOCT = 272 * MiB;
constexpr size_t WS_OUN = 288 * MiB, WS_LSE = 304 * MiB, WS_OPART = 144 * MiB, WS_MIX = 256 * MiB;
constexpr size_t WS_MOEW_GU = 144 * MiB, WS_MOEW_D = 176 * MiB, WS_XG = 192 * MiB, WS_HACT = 264 * MiB;
constexpr size_t WS_MOEW_GU1 = 112 * MiB, WS_MOEW_D1 = 144 * MiB;
static_assert((size_t)MOE_ROWS * D * 2 <= 72 * MiB && (size_t)MOE_ROWS * DE * 2 <= 36 * MiB, "moe buffers");
constexpr size_t WS_INV = 256 * 1024;
constexpr int CW_TMO = 0, CW_BAR = 4096, CW_QUEUE = 64, CW_CNT0 = 128, CW_CNT1 = 192, CW_CVQ = 256;

constexpr int LDS_BYTES = 163840, MISC_OFF = 162816, XCH_OFF = 131072;

typedef __bf16 bf16x2_t __attribute__((ext_vector_type(2)));
__device__ __forceinline__ unsigned pk2(float lo, float hi) { const f32x2 v = {lo, hi}; const bf16x2_t b = __builtin_convertvector(v, bf16x2_t); return __builtin_bit_cast(unsigned, b); }
__device__ __forceinline__ unsigned f2bf(float f) { return pk2(f, f) & 0xffffu; }
__device__ __forceinline__ float bf2f(unsigned short b) { return __builtin_bit_cast(float, (unsigned)b << 16); }
__device__ __forceinline__ float bflo(unsigned w) { return __builtin_bit_cast(float, w << 16); }
__device__ __forceinline__ float bfhi(unsigned w) { return __builtin_bit_cast(float, w & 0xffff0000u); }
#define dpp_f(v, ctrl, row_mask) __int_as_float(__builtin_amdgcn_update_dpp(0, __float_as_int(v), (ctrl), (row_mask), 0xf, false))
__device__ __forceinline__ float wave_sum(float v) {
    v += dpp_f(v, 0xB1, 0xf); v += dpp_f(v, 0x4E, 0xf); v += dpp_f(v, 0x141, 0xf); v += dpp_f(v, 0x140, 0xf);
    v += dpp_f(v, 0x142, 0xa); v += dpp_f(v, 0x143, 0xc);
    return __int_as_float(__builtin_amdgcn_readlane(__float_as_int(v), 63));
}
template <class P> __device__ __forceinline__ P opq_v(P p) { asm volatile("" : "+v"(p)); return p; }
template <class P> __device__ __forceinline__ P opq_s(P p) { asm volatile("" : "+s"(p)); return p; }
__device__ __forceinline__ float silu_f(float x) { return x * __builtin_amdgcn_rcpf(1.f + __expf(-x)); }

namespace pg8 {
constexpr int BM = 256, BK = 64, HALF = 128, HTB = HALF * BK * 2, STAGE_BYTES = 8 * HTB;
__host__ __device__ __forceinline__ int lds_byte(int r, int c) { const int st = (r >> 4) * 2 + (c >> 5), rr = r & 15, cc = c & 31, ob = rr * 64 + cc * 2; return st * 1024 + (ob ^ (((ob >> 9) & 1) << 5)); }
__host__ __device__ __forceinline__ void stage_rc(int b, int& R, int& C) { const int st = b / 1024, sb = b % 1024, swz = sb ^ (((sb >> 9) & 1) << 5); R = (st >> 1) * 16 + swz / 64; C = (st & 1) * 32 + (swz % 64) / 2; }
__host__ __device__ __forceinline__ int perm32(int rho) { const int n = rho >> 4, i = rho & 15; return 8 * (i >> 2) + 4 * n + (i & 3); }

struct Unit { int pm, pn, aux; const char* a; const char* b; };
struct Gemm { int lda, ldb, K; };
__device__ __forceinline__ unsigned cvt_pk_bf16(float lo, float hi) { unsigned r; asm volatile("v_cvt_pk_bf16_f32 %0, %1, %2" : "=v"(r) : "v"(lo), "v"(hi)); return r; }

__device__ __forceinline__ void swz_tile(int L, int nM, int nN, int& pm, int& pn) {
    const int nwg = nM * nN; int wgid = L; { const int q = nwg / 8, r = nwg % 8, xcd = wgid % 8, off = wgid / 8; wgid = (xcd < r ? xcd * (q + 1) : r * (q + 1) + (xcd - r) * q) + off; }
    const int nig = 8 * nN, gid = wgid / nig, fm = gid * 8, gsz = (nM - fm) < 8 ? (nM - fm) : 8;
    pm = fm + ((wgid % nig) % gsz); pn = (wgid % nig) / gsz;
}

template <class Epi, class Sched>
__device__ __forceinline__ void gemm_phase(LAS unsigned char* lds, LAS unsigned char* xch, const Gemm g, const Sched& S, const Epi& E) {
    const int tid = opq_v((int)threadIdx.x), wid = __builtin_amdgcn_readfirstlane(tid >> 6), lane = tid & 63, wr = wid >> 2, wc = wid & 3, fr = lane & 15, fq = lane >> 4;
    const int K = g.K, nt = K / BK;
    unsigned voffA[2], voffB[2];
#pragma unroll
    for (int i = 0; i < 2; ++i) { int R, C; stage_rc(tid * 16 + i * 8192, R, C); const int Rb = Epi::PERM ? ((R & ~31) + perm32(R & 31)) : R;
        voffA[i] = (unsigned)(R * g.lda + C) * 2u; voffB[i] = (unsigned)(Rb * g.ldb + C) * 2u; }
    const size_t kstep = (size_t)(BK * 2);
    const size_t hstepA = Sched::GATHER ? (size_t)0 : (size_t)HALF * g.lda * 2, hstepB = (size_t)HALF * g.ldb * 2;
    unsigned vGc[2][2], vGn[2][2];
#pragma unroll
    for (int i = 0; i < 2; ++i) vGc[0][i] = vGc[1][i] = vGn[0][i] = vGn[1][i] = 0u;
#define PG8_GLOAD(dst, u_) do { if (Sched::GATHER) { _Pragma("unroll") for (int hh_ = 0; hh_ < 2; ++hh_) _Pragma("unroll") for (int i_ = 0; i_ < 2; ++i_) { int R_, C_; stage_rc(tid * 16 + i_ * 8192, R_, C_); \
        dst[hh_][i_] = (unsigned)S.row((u_), hh_ * HALF + R_) * (unsigned)(g.lda * 2) + (unsigned)C_ * 2u; } } } while (0)
    const unsigned ldsw = (unsigned)wid * 1024u;
    const int aoff = lds_byte(wr * 64 + fr, fq * 8), boff = lds_byte(wc * 32 + fr, fq * 8);
#define PG8_SA(b, h) (((b) * 2 + (h)) * HTB)
#define PG8_SB(b, h) ((4 + (b) * 2 + (h)) * HTB)
#define PG8_STAGE(bufoff, gbase, voff) do { _Pragma("unroll") for (int _i = 0; _i < 2; ++_i) \
        __builtin_amdgcn_global_load_lds((const unsigned*)((const char*)(gbase) + (voff)[_i]), (LAS unsigned*)(lds + (bufoff) + ldsw + _i * 8192), 16, 0, 0); } while (0)
#define PG8_STAGE_A(bufoff, gbase, hf, vg) do { if (Sched::GATHER) { PG8_STAGE(bufoff, gbase, vg[hf]); } else { PG8_STAGE(bufoff, (gbase) + (hf) * hstepA, voffA); } } while (0)
#define PG8_LDA(dst, b, h) do { _Pragma("unroll") for (int m = 0; m < 4; ++m) _Pragma("unroll") for (int k = 0; k < 2; ++k) dst[m][k] = *(const LAS bf16x8*)(lds + PG8_SA(b, h) + aoff + m * 2048 + k * 1024); } while (0)
#define PG8_LDB(dst, b, h) do { _Pragma("unroll") for (int n = 0; n < 2; ++n) _Pragma("unroll") for (int k = 0; k < 2; ++k) dst[n][k] = *(const LAS bf16x8*)(lds + PG8_SB(b, h) + boff + n * 2048 + k * 1024); } while (0)
#define PG8_MMA(ai, bj, At, Bt) do { __builtin_amdgcn_s_setprio(1); _Pragma("unroll") for (int m = 0; m < 4; ++m) _Pragma("unroll") for (int n = 0; n < 2; ++n) _Pragma("unroll") for (int k = 0; k < 2; ++k) \
        acc[ai][bj][m][n] = __builtin_amdgcn_mfma_f32_16x16x32_bf16(Bt[n][k], At[m][k], acc[ai][bj][m][n], 0, 0, 0); __builtin_amdgcn_s_setprio(0); } while (0)
#define PG8_WAIT_V(n) asm volatile("s_waitcnt vmcnt(" #n ")" ::: "memory")
#define PG8_WAIT_L(n) asm volatile("s_waitcnt lgkmcnt(" #n ")" ::: "memory")
#define PG8_BAR __builtin_amdgcn_s_barrier()
#define PG8_SCHED __builtin_amdgcn_sched_barrier(0)
    Unit cur, nxt; int ui = 0;
    if (!S.next(0, cur)) return;
    f32x4 acc[2][2][4][2];
#pragma unroll
    for (int a = 0; a < 2; ++a)
#pragma unroll
        for (int b = 0; b < 2; ++b)
#pragma unroll
            for (int m = 0; m < 4; ++m)
#pragma unroll
                for (int n = 0; n < 2; ++n) acc[a][b][m][n] = (f32x4){0.f, 0.f, 0.f, 0.f};
    bf16x8 At[4][2], B0[2][2], B1[2][2];
    const char* cA = cur.a; const char* cB = cur.b;
    PG8_GLOAD(vGc, cur);
    PG8_STAGE(PG8_SB(0, 0), cB, voffB); PG8_STAGE(PG8_SB(0, 1), cB + hstepB, voffB); PG8_STAGE_A(PG8_SA(0, 0), cA, 0, vGc); PG8_STAGE_A(PG8_SA(0, 1), cA, 1, vGc);
    if (wr == 1) PG8_BAR;
    PG8_WAIT_V(2); PG8_BAR;
    PG8_STAGE(PG8_SB(1, 0), cB + kstep, voffB); PG8_STAGE_A(PG8_SA(1, 0), cA + kstep, 0, vGc); PG8_STAGE(PG8_SB(1, 1), cB + hstepB + kstep, voffB);
    PG8_WAIT_V(6); PG8_BAR;
#pragma unroll 1
    for (;;) {
        const bool has_next = S.next(ui + 1, nxt);
        const char* nA = has_next ? nxt.a : cA; const char* nB = has_next ? nxt.b : cB;
        if (Sched::GATHER) { if (has_next) { PG8_GLOAD(vGn, nxt); } else {
#pragma unroll
                for (int hh_ = 0; hh_ < 2; ++hh_)
#pragma unroll
                    for (int i_ = 0; i_ < 2; ++i_) vGn[hh_][i_] = vGc[hh_][i_]; } }
#pragma unroll 1
        for (int t = 0; t < nt; t += 2) {
            const bool last = (t == nt - 2);
            const char* a1 = cA + (size_t)(t + 1) * kstep;
            const char* a2 = last ? nA : cA + (size_t)(t + 2) * kstep; const char* b2 = last ? nB : cB + (size_t)(t + 2) * kstep;
            const char* a3 = a2 + kstep; const char* b3 = b2 + kstep;
            unsigned v2[2][2];
#pragma unroll
            for (int hh_ = 0; hh_ < 2; ++hh_)
#pragma unroll
                for (int i_ = 0; i_ < 2; ++i_) v2[hh_][i_] = last ? vGn[hh_][i_] : vGc[hh_][i_];
            PG8_LDB(B0, 0, 0); PG8_LDB(B1, 0, 1); PG8_SCHED; PG8_LDA(At, 0, 0); PG8_STAGE_A(PG8_SA(1, 1), a1, 1, vGc);
            PG8_WAIT_V(8); PG8_WAIT_L(0); PG8_BAR; PG8_MMA(0, 0, At, B0); PG8_MMA(0, 1, At, B1); PG8_BAR; PG8_SCHED;
            PG8_LDA(At, 0, 1); PG8_STAGE(PG8_SB(0, 0), b2, voffB); PG8_STAGE(PG8_SB(0, 1), b2 + hstepB, voffB); PG8_STAGE_A(PG8_SA(0, 0), a2, 0, v2);
            PG8_WAIT_V(8); PG8_WAIT_L(0); PG8_BAR; PG8_MMA(1, 0, At, B0); PG8_MMA(1, 1, At, B1); PG8_BAR; PG8_SCHED;
            PG8_LDB(B0, 1, 0); PG8_LDB(B1, 1, 1); PG8_SCHED; PG8_LDA(At, 1, 0); PG8_STAGE_A(PG8_SA(0, 1), a2, 1, v2);
            PG8_WAIT_V(8); PG8_WAIT_L(0); PG8_BAR; PG8_MMA(0, 0, At, B0); PG8_MMA(0, 1, At, B1); PG8_BAR; PG8_SCHED;
            PG8_LDA(At, 1, 1); PG8_STAGE(PG8_SB(1, 0), b3, voffB); PG8_STAGE(PG8_SB(1, 1), b3 + hstepB, voffB); PG8_STAGE_A(PG8_SA(1, 0), a3, 0, v2);
            PG8_WAIT_V(8); PG8_WAIT_L(0); PG8_BAR; PG8_MMA(1, 0, At, B0); PG8_MMA(1, 1, At, B1); PG8_BAR; PG8_SCHED;
        }
        if (wr == 0) PG8_BAR;
        E(acc, cur, wr, wc, fr, fq, xch);
        if (!has_next) break;
#pragma unroll
        for (int a = 0; a < 2; ++a)
#pragma unroll
            for (int b = 0; b < 2; ++b)
#pragma unroll
                for (int m = 0; m < 4; ++m)
#pragma unroll
                    for (int n = 0; n < 2; ++n) acc[a][b][m][n] = (f32x4){0.f, 0.f, 0.f, 0.f};
        cur = nxt; cA = nA; cB = nB; ++ui;
#pragma unroll
        for (int hh_ = 0; hh_ < 2; ++hh_)
#pragma unroll
            for (int i_ = 0; i_ < 2; ++i_) vGc[hh_][i_] = vGn[hh_][i_];
        if (wr == 1) PG8_BAR;
    }
    PG8_WAIT_V(0);
    PG8_BAR;
#undef PG8_SA
#undef PG8_SB
#undef PG8_STAGE
#undef PG8_LDA
#undef PG8_STAGE_A
#undef PG8_GLOAD
#undef PG8_LDB
#undef PG8_MMA
#undef PG8_WAIT_V
#undef PG8_WAIT_L
#undef PG8_BAR
#undef PG8_SCHED
}

struct Dst { bf16* p; int ld; };
__device__ __forceinline__ void store_tile_bf16(const f32x4 (&acc)[2][2][4][2], const Dst d, float sc, int wr, int wc, int fr, int fq) {
    unsigned lane_off = (unsigned)((wr * 64 + fr) * d.ld + wc * 32 + 8 * fq);
    asm volatile("" : "+v"(lane_off));
#pragma unroll
    for (int ai = 0; ai < 2; ++ai)
#pragma unroll
        for (int m = 0; m < 4; ++m) { bf16* rowp = d.p + (size_t)lane_off + (size_t)((ai * HALF + m * 16) * d.ld);
#pragma unroll
            for (int bj = 0; bj < 2; ++bj) { const f32x4 v0 = acc[ai][bj][m][0] * sc, v1 = acc[ai][bj][m][1] * sc;
                u32x4 w; w.x = cvt_pk_bf16(v0[0], v0[1]); w.y = cvt_pk_bf16(v0[2], v0[3]); w.z = cvt_pk_bf16(v1[0], v1[1]); w.w = cvt_pk_bf16(v1[2], v1[3]);
                *(u32x4*)(rowp + bj * HALF) = w; } }
}
}

#define XB_TMO      128
#define XB_XCNT(j)  (256  + 64 * (j))
#define XB_XSUB(j)  (1280 + 64 * (j))
#define XB_XGEN(j)  (2304 + 64 * (j))
#define XB_TOP      3328
#define XB_TOPGEN   3392
#define XCD_BAR_WORDS 3456
#define XB_SPIN_CAP (1u << 20)
__device__ __forceinline__ unsigned xb_ld(unsigned* p)              { return __hip_atomic_load(p, __ATOMIC_RELAXED, __HIP_MEMORY_SCOPE_AGENT); }
__device__ __forceinline__ unsigned xb_add(unsigned* p, unsigned v) { return __hip_atomic_fetch_add(p, v, __ATOMIC_RELAXED, __HIP_MEMORY_SCOPE_AGENT); }
__device__ __forceinline__ unsigned xb_xcc_id() { return (unsigned)__builtin_amdgcn_s_getreg((3 << 11) | 20) & 0xFu; }
#define XB_SPIN(cond, bar) do { unsigned _sp = 0; while (cond) { __builtin_amdgcn_s_sleep(1); \
    if ((++_sp & 255u) == 0u) { if (xb_ld(&(bar)[XB_TMO])) break; if (_sp > XB_SPIN_CAP) { atomicAdd(&(bar)[XB_TMO], 1u); break; } } } } while (0)
struct XcdBarrier { unsigned* bar; unsigned x; volatile LAS unsigned* st; };
__device__ __forceinline__ XcdBarrier xcd_barrier_post(unsigned* bar, volatile LAS unsigned* st) {
    XcdBarrier b; b.bar = bar; b.x = xb_xcc_id(); b.st = st;
    if (threadIdx.x == 0) (void)xb_add(&bar[XB_XCNT(b.x)], 1u);
    return b;
}
__device__ __forceinline__ void xcd_barrier_complete(unsigned* bar, unsigned x, unsigned& nloc, unsigned& nx) {
    const unsigned G = gridDim.x * gridDim.y * gridDim.z;
    unsigned sum, cnt, mine, sp = 0u;
    for (;;) {
        sum = 0u; cnt = 0u; mine = 0u;
#pragma unroll
        for (unsigned j = 0; j < 16; ++j) { const unsigned c = xb_ld(&bar[XB_XCNT(j)]); sum += c; cnt += (c > 0u) ? 1u : 0u; mine = (j == x) ? c : mine; }
        if (sum == G) break;
        __builtin_amdgcn_s_sleep(1);
        if ((++sp & 255u) == 0u) { if (xb_ld(&bar[XB_TMO])) break; if (sp > XB_SPIN_CAP) { atomicAdd(&bar[XB_TMO], 1u); break; } }
    }
    nloc = mine > 0u ? mine : 1u; nx = cnt > 0u ? cnt : 1u;
}
__device__ __forceinline__ void xcd_barrier(const XcdBarrier& b) {
    asm volatile("s_waitcnt vmcnt(0)" ::: "memory");
    __syncthreads();
    if (threadIdx.x == 0) {
        unsigned* bar = b.bar;
        __builtin_amdgcn_s_waitcnt(0);
        unsigned nloc = b.st[0], nx = b.st[1];
        if (nloc == 0u) { xcd_barrier_complete(bar, b.x, nloc, nx); b.st[0] = nloc; b.st[1] = nx; }
        const unsigned old = xb_add(&bar[XB_XSUB(b.x)], 1u);
        const unsigned gen = old / nloc;
        if (old + 1u == (gen + 1u) * nloc) {
            __builtin_amdgcn_fence(__ATOMIC_RELEASE, "agent");
            asm volatile("s_waitcnt vmcnt(0)" ::: "memory");
            const unsigned og = xb_add(&bar[XB_TOP], 1u);
            const unsigned tg = og / nx;
            if (og + 1u == (tg + 1u) * nx) xb_add(&bar[XB_TOPGEN], 1u);
            else XB_SPIN(xb_ld(&bar[XB_TOPGEN]) == tg, bar);
            __builtin_amdgcn_fence(__ATOMIC_ACQUIRE, "agent");
            xb_add(&bar[XB_XGEN(b.x)], 1u);
            asm volatile("s_waitcnt vmcnt(0)" ::: "memory");
        } else {
            XB_SPIN(xb_ld(&bar[XB_XGEN(b.x)]) == gen, bar);
            __builtin_amdgcn_fence(__ATOMIC_ACQUIRE, "agent");
            asm volatile("s_waitcnt vmcnt(0)" ::: "memory");
        }
    }
    __syncthreads();
}

struct Args { const float* in[21]; float* out; unsigned char* ws; int ph_lo, ph_hi; };
struct Frame {
    LAS unsigned char* lds;
    unsigned char* ws;
    gu32* ctl;
    int tid, lane, wave, G, gw, NGW;
};
#define WSP(T_, off) ((T_*)(F.ws + (off)))

__device__ __forceinline__ void tr_item(const float* W, int ldw, int k0, int c0, bf16* dst, int ldd, LAS float* scr, int lane) {
    const int r8 = lane >> 3, c4 = lane & 7;
#pragma unroll
    for (int it = 0; it < 8; ++it) { const int kk = it * 8 + r8; const f32x4 v = *(const GAS f32x4*)(W + (size_t)(k0 + kk) * ldw + c0 + 4 * c4);
        LAS float* s = scr + kk * 33 + 4 * c4; s[0] = v[0]; s[1] = v[1]; s[2] = v[2]; s[3] = v[3]; }
    LDS_WAIT(); asm volatile("" ::: "memory");
    const int c = lane & 7;
#pragma unroll
    for (int j = 0; j < 4; ++j) { const int n = (lane >> 3) + 8 * j; const LAS float* s = scr + (8 * c) * 33 + n;
        u32x4 o; o.x = pk2(s[0 * 33], s[1 * 33]); o.y = pk2(s[2 * 33], s[3 * 33]); o.z = pk2(s[4 * 33], s[5 * 33]); o.w = pk2(s[6 * 33], s[7 * 33]);
        *(GAS u32x4*)(dst + (size_t)n * ldd + k0 + 8 * c) = o; }
    LDS_WAIT(); asm volatile("" ::: "memory");
}
__device__ __forceinline__ void tr_matrix(Frame& F, const float* W, int K, int N, int ldw, bf16* dst, LAS float* scr, int it) {
    const int nblk = N / 32, kb = it / nblk, nb = it % nblk;
    tr_item(W, ldw, 64 * kb, 32 * nb, dst + (size_t)(32 * nb) * K, K, scr, F.lane);
}
__device__ __forceinline__ void p0_prologue(Frame& F, const Args& A) {
    LAS float* scr = (LAS float*)(F.lds + F.wave * 16384);
    constexpr int I_IN = 16 * 112, I_SQ = 16 * 32, I_SCI = 16 * 96, I_KV = 16 * 64;
    constexpr int NITEMS = I_IN + I_SQ + I_SCI + I_SQ + 2 * I_SQ + 2 * I_KV + 2 * I_SQ;
    for (int it = F.gw; it < NITEMS; it += F.NGW) {
        int r = it;
        if (r < I_IN) { const int kb = r / 112, nb = r % 112;
            tr_item(A.in[2], AB_IN, 64 * kb, 32 * nb + (nb >= 64 ? 8 : 0), WSP(bf16, WS_W_IN) + (size_t)(32 * nb) * D, D, scr, F.lane); continue; } r -= I_IN;
        if (r < I_SQ) { tr_matrix(F, A.in[7], D, D, D, WSP(bf16, WS_W_ABO), scr, r); continue; } r -= I_SQ;
        if (r < I_SCI) { tr_matrix(F, A.in[8], D, 3 * D, 3 * D, WSP(bf16, WS_W_SCI), scr, r); continue; } r -= I_SCI;
        if (r < I_SQ) { tr_matrix(F, A.in[10], D, D, D, WSP(bf16, WS_W_SCO), scr, r); continue; } r -= I_SQ;
        if (r < 2 * I_SQ) { continue; } r -= 2 * I_SQ;
        if (r < 2 * I_KV) { const int l = r / I_KV; tr_matrix(F, A.in[12] + (size_t)l * D * 2 * D, D, 2 * D, 2 * D, WSP(bf16, WS_W_KV) + (size_t)l * 2 * D * D, scr, r % I_KV); continue; } r -= 2 * I_KV;
        { const int l = r / I_SQ; tr_matrix(F, A.in[13] + (size_t)l * D * D, D, D, D, WSP(bf16, WS_W_O) + (size_t)l * D * D, scr, r % I_SQ); }
    }
    __syncthreads();
    LAS float* wt = (LAS float*)F.lds;
    for (int i = F.tid; i < 8 * D; i += 512) { const int k = i >> 3, c = i & 7; wt[c * D + k] = A.in[2][(size_t)k * AB_IN + 2048 + c]; }
    __syncthreads();
    const float* x = A.in[0];
    float alg[4], dtb[4];
#pragma unroll
    for (int h = 0; h < 4; ++h) { alg[h] = -__expf(A.in[4][h]); dtb[h] = A.in[5][h]; }
    for (int m = F.gw; m < T; m += F.NGW) {
        const GAS f32x4* xr = (const GAS f32x4*)(x + (size_t)m * D) + F.lane;
        f32x4 v[4];
#pragma unroll
        for (int j = 0; j < 4; ++j) v[j] = xr[64 * j];
        GAS u32x2* o8 = (GAS u32x2*)(WSP(bf16, WS_HB) + (size_t)m * D) + F.lane;
#pragma unroll
        for (int j = 0; j < 4; ++j) { u32x2 w; w.x = pk2(v[j][0], v[j][1]); w.y = pk2(v[j][2], v[j][3]); o8[64 * j] = w; }
        float dot[8];
#pragma unroll
        for (int c = 0; c < 8; ++c) { float s = 0.f;
#pragma unroll
            for (int j = 0; j < 4; ++j) { const f32x4 w = *(const LAS f32x4*)(wt + c * D + 256 * j + 4 * F.lane); s += v[j][0] * w[0] + v[j][1] * w[1] + v[j][2] * w[2] + v[j][3] * w[3]; }
            dot[c] = wave_sum(s); }
        if (F.lane == 0) {
            f32x4 bo, go;
#pragma unroll
            for (int hq = 0; hq < 4; ++hq) { bo[hq] = 1.f / (1.f + __expf(-dot[hq])); const float xx = dot[4 + hq] + dtb[hq]; const float sp = xx > 20.f ? xx : log1pf(__expf(xx)); go[hq] = alg[hq] * sp; }
            *(GAS f32x4*)(WSP(float, WS_BETA) + (size_t)m * 4) = bo;
            *(GAS f32x4*)(WSP(float, WS_GG) + (size_t)m * 4) = go;
        }
    }
    for (int m = F.gw; m < 2 * D; m += F.NGW) {
        const GAS f32x4* xr = (const GAS f32x4*)(A.in[11] + (size_t)m * D) + F.lane;
        GAS u32x2* o8 = (GAS u32x2*)(WSP(bf16, WS_W_Q) + (size_t)m * D) + F.lane;
#pragma unroll
        for (int j = 0; j < 4; ++j) { const f32x4 v = xr[64 * j]; u32x2 w; w.x = pk2(v[0], v[1]); w.y = pk2(v[2], v[3]); o8[64 * j] = w; }
    }
    for (int m = F.gw; m < TM; m += F.NGW) {
        const GAS f32x4* xr = (const GAS f32x4*)(A.in[1] + (size_t)m * D) + F.lane;
        GAS u32x2* o8 = (GAS u32x2*)(WSP(bf16, WS_MEMB) + (size_t)m * D) + F.lane;
#pragma unroll
        for (int j = 0; j < 4; ++j) { const f32x4 v = xr[64 * j]; u32x2 w; w.x = pk2(v[0], v[1]); w.y = pk2(v[2], v[3]); o8[64 * j] = w; }
    }
}
constexpr int MOE_I_GU = 16 * 32, MOE_I_D = 8 * 32;
__device__ __forceinline__ void convert_moe_q(Frame& F, const Args& A, int layer, int which  , bf16* dst, unsigned* qword, volatile LAS unsigned* MISC) {
    LAS float* scr = (LAS float*)(F.lds + F.wave * 16384);
    const int nitems = NE * (which == 0 ? MOE_I_GU : MOE_I_D);
    for (;;) {
        __syncthreads();
        if (F.tid == 0) MISC[21] = __hip_atomic_fetch_add(qword, 8u, RLX_AGENT);
        __syncthreads();
        const int it = (int)MISC[21] + F.wave;
        if ((int)MISC[21] >= nitems) break;
        if (it < nitems) {
            if (which == 0) { const int e = it / MOE_I_GU, r = it % MOE_I_GU, kb = r / 32, rb = r % 32, pn = rb >> 3, sub = rb & 7;
                const float* src = (sub < 4 ? A.in[16] : A.in[17]) + ((size_t)layer * NE + e) * D * DE;
                tr_item(src, DE, 64 * kb, 128 * pn + 32 * (sub & 3), dst + ((size_t)e * D + 32 * rb) * D, D, scr, F.lane);
            } else { const int e = it / MOE_I_D, r = it % MOE_I_D, kb = r / 32, nb = r % 32;
                tr_item(A.in[18] + ((size_t)layer * NE + e) * DE * D, D, 64 * kb, 32 * nb, dst + ((size_t)e * D + 32 * nb) * DE, DE, scr, F.lane); }
        }
    }
}

struct SchedDense {
    static constexpr bool GATHER = false; __device__ __forceinline__ int row(const pg8::Unit&, int) const { return 0; }
    const char* A; const char* B; int lda, ldb, nM, nN, G, c;
    __device__ __forceinline__ bool next(int i, pg8::Unit& u) const {
        const int L = i * G + c; if (L >= nM * nN) return false;
        pg8::swz_tile(L, nM, nN, u.pm, u.pn); u.aux = 0;
        u.a = A + (size_t)u.pm * 256 * lda * 2; u.b = B + (size_t)u.pn * 256 * ldb * 2; return true; }
};
struct EpiDense {
    static constexpr bool PERM = true;
    bf16* O; int ld; float sc;
    __device__ __forceinline__ void operator()(const f32x4 (&acc)[2][2][4][2], const pg8::Unit& u, int wr, int wc, int fr, int fq, LAS unsigned char*) const {
        pg8::store_tile_bf16(acc, pg8::Dst{O + (size_t)u.pm * 256 * ld + u.pn * 256, ld}, sc, wr, wc, fr, fq); }
};
struct SchedP1 {
    static constexpr bool GATHER = false; __device__ __forceinline__ int row(const pg8::Unit&, int) const { return 0; }
    const char* XB; const char* WIN; const char* MEMB; const char* WKV; int G, c;
    __device__ __forceinline__ bool next(int i, pg8::Unit& u) const {
        const int L = i * G + c; if (L >= 896 + 64) return false;
        if (L < 896) { pg8::swz_tile(L, 64, 14, u.pm, u.pn); u.aux = 0; u.a = XB + (size_t)u.pm * 256 * D * 2; u.b = WIN + (size_t)u.pn * 256 * D * 2; }
        else { const int r = L - 896, l = r >> 5; u.pm = (r & 31) >> 3; u.pn = r & 7; u.aux = 1 + l; u.a = MEMB + (size_t)u.pm * 256 * D * 2; u.b = WKV + ((size_t)l * 2 * D + u.pn * 256) * D * 2; }
        return true; }
};
struct EpiP1 {
    static constexpr bool PERM = true;
    bf16 *QKVPRE, *ZB, *QKVD, *KMEM, *VT;
    __device__ __forceinline__ void operator()(const f32x4 (&acc)[2][2][4][2], const pg8::Unit& u, int wr, int wc, int fr, int fq, LAS unsigned char*) const {
        if (u.aux == 0) {
            pg8::Dst d;
            if (u.pn < 6) d = pg8::Dst{QKVPRE + (size_t)u.pm * 256 * 1536 + u.pn * 256, 1536};
            else if (u.pn < 8) d = pg8::Dst{ZB + (size_t)u.pm * 256 * 512 + (u.pn - 6) * 256, 512};
            else d = pg8::Dst{QKVD + (size_t)u.pm * 256 * 1536 + (u.pn - 8) * 256, 1536};
            pg8::store_tile_bf16(acc, d, (u.pn == 8 || u.pn == 9) ? 0.125f * 1.4426950408889634f : 1.f, wr, wc, fr, fq);
        } else {
            const int l = u.aux - 1;
            if (u.pn < 4) pg8::store_tile_bf16(acc, pg8::Dst{KMEM + ((size_t)l * TM + u.pm * 256) * D + u.pn * 256, D}, 1.f, wr, wc, fr, fq);
            else pg8::store_tile_bf16(acc, pg8::Dst{VT + ((size_t)l * TM + u.pm * 256) * D + (u.pn - 4) * 256, D}, 1.f, wr, wc, fr, fq);
        }
    }
};
struct SchedPrep {
    static constexpr bool GATHER = false; __device__ __forceinline__ int row(const pg8::Unit&, int) const { return 0; }
    const char* KM; const char* WQO; const char* WOT; const char* VM; int G, c;
    __device__ __forceinline__ bool next(int i, pg8::Unit& u) const {
        const int L = i * G + c; if (L >= 256) return false;
        const int l = L >> 7, r = L & 127, kind = r >> 6, q = r & 63, bh = q >> 2, t4 = q & 3, b = bh >> 2, hd = bh & 3;
        u.aux = L; u.pm = 0; u.pn = 0;
        if (kind == 0) { u.a = KM + (((size_t)(l * NB + b) * NMEM) * D + hd * XD) * 2; u.b = WQO + (((size_t)l * D + t4 * 256) * D + hd * XD) * 2; }
        else           { u.a = WOT + (((size_t)l * D + t4 * 256) * D + hd * XD) * 2; u.b = VM + (((size_t)(l * NB + b) * NMEM) * D + hd * XD) * 2; }
        return true; }
};
struct EpiPrep {
    static constexpr bool PERM = true;
    bf16 *MT, *VWT;
    __device__ __forceinline__ void operator()(const f32x4 (&acc)[2][2][4][2], const pg8::Unit& u, int wr, int wc, int fr, int fq, LAS unsigned char*) const {
        const int L = u.aux, l = L >> 7, r = L & 127, kind = r >> 6, q = r & 63, bh = q >> 2, t4 = q & 3, b = bh >> 2, hd = bh & 3;
        if (kind == 0) pg8::store_tile_bf16(acc, pg8::Dst{MT + ((size_t)(l * NB + b) * D + hd * XD) * D + t4 * 256, D}, 0.0625f * 1.4426950408889634f, wr, wc, fr, fq);
        else           pg8::store_tile_bf16(acc, pg8::Dst{VWT + ((size_t)(l * NB + b) * D + t4 * 256) * D + hd * XD, D}, 1.f, wr, wc, fr, fq);
    }
};
struct SchedXB {
    static constexpr bool GATHER = false; __device__ __forceinline__ int row(const pg8::Unit&, int) const { return 0; }
    const char* AB; const char* BB; int G, c;
    __device__ __forceinline__ bool next(int i, pg8::Unit& u) const {
        const int L = i * G + c; if (L >= 256) return false;
        u.pm = L >> 2; u.pn = L & 3; u.aux = 0;
        u.a = AB + (size_t)u.pm * 256 * D * 2; u.b = BB + ((size_t)(u.pm >> 4) * D + u.pn * 256) * D * 2; return true; }
};
struct EpiSoftmax {
    static constexpr bool PERM = true;
    bf16* P;
    __device__ __forceinline__ void operator()(f32x4 (&acc)[2][2][4][2], const pg8::Unit& u, int wr, int wc, int fr, int fq, LAS unsigned char* xch) const {
        LAS float* MX = opq_v((LAS float*)xch + (wr * 64 + fr) * 4);
        LAS float* SM = MX + 1024;
#pragma unroll
        for (int ai = 0; ai < 2; ++ai)
#pragma unroll
            for (int m = 0; m < 4; ++m) { float v = -3.0e38f;
#pragma unroll
                for (int bj = 0; bj < 2; ++bj)
#pragma unroll
                    for (int n = 0; n < 2; ++n) { const f32x4 x = acc[ai][bj][m][n]; v = fmaxf(v, fmaxf(fmaxf(x[0], x[1]), fmaxf(x[2], x[3]))); }
                v = fmaxf(v, __shfl_xor(v, 16)); v = fmaxf(v, __shfl_xor(v, 32));
                if (fq == 0) MX[(ai * 128 + m * 16) * 4 + wc] = v; }
        LDS_WAIT(); __builtin_amdgcn_s_barrier(); asm volatile("" ::: "memory");
#pragma unroll
        for (int ai = 0; ai < 2; ++ai)
#pragma unroll
            for (int m = 0; m < 4; ++m) { float s = 0.f; const f32x4 q = *(const LAS f32x4*)(MX + (ai * 128 + m * 16) * 4); const float mxr = fmaxf(fmaxf(q[0], q[1]), fmaxf(q[2], q[3]));
#pragma unroll
                for (int bj = 0; bj < 2; ++bj)
#pragma unroll
                    for (int n = 0; n < 2; ++n) { f32x4 x = acc[ai][bj][m][n];
#pragma unroll
                        for (int e = 0; e < 4; ++e) { x[e] = __builtin_amdgcn_exp2f(x[e] - mxr); s += x[e]; }
                        acc[ai][bj][m][n] = x; }
                s += __shfl_xor(s, 16); s += __shfl_xor(s, 32);
                if (fq == 0) SM[(ai * 128 + m * 16) * 4 + wc] = s; asm volatile("" ::: "memory"); }
        LDS_WAIT(); __builtin_amdgcn_s_barrier(); asm volatile("" ::: "memory");
        unsigned lane_off = (unsigned)((wr * 64 + fr) * D + wc * 32 + 8 * fq);
        asm volatile("" : "+v"(lane_off));
        bf16* base = P + (size_t)u.pm * 256 * D + u.pn * XD + lane_off;
#pragma unroll
        for (int ai = 0; ai < 2; ++ai)
#pragma unroll
            for (int m = 0; m < 4; ++m) { const f32x4 q = *(const LAS f32x4*)(SM + (ai * 128 + m * 16) * 4); const float inv = 1.f / ((q[0] + q[1]) + (q[2] + q[3]));
                bf16* rowp = base + (size_t)((ai * 128 + m * 16) * D);
#pragma unroll
                for (int bj = 0; bj < 2; ++bj) { const f32x4 v0 = acc[ai][bj][m][0] * inv, v1 = acc[ai][bj][m][1] * inv;
                    u32x4 w; w.x = pg8::cvt_pk_bf16(v0[0], v0[1]); w.y = pg8::cvt_pk_bf16(v0[2], v0[3]); w.z = pg8::cvt_pk_bf16(v1[0], v1[1]); w.w = pg8::cvt_pk_bf16(v1[2], v1[3]);
                    *(u32x4*)(rowp + bj * 128) = w; } asm volatile("" ::: "memory"); }
        LDS_WAIT(); __builtin_amdgcn_s_barrier(); asm volatile("" ::: "memory");
    }
};
template <bool G_> struct SchedMoE {
    static constexpr bool GATHER = G_;
    const char* Aall; const char* Wall; volatile LAS unsigned* tab; const int* rowmap; int lda, wrows  , ldb, G, c;
    __device__ __forceinline__ int row(const pg8::Unit& u, int r) const { return ((const GAS int*)rowmap)[u.pm * 256 + r]; }
    __device__ __forceinline__ bool next(int i, pg8::Unit& u) const {
        const int L = i * G + c; const int ntile = __builtin_amdgcn_readfirstlane((int)tab[16]); if (L >= ntile * 4) return false;
        u.pm = L >> 2; u.pn = L & 3; const int e = __builtin_amdgcn_readfirstlane((int)tab[32 + u.pm]);
        u.aux = e; u.a = G_ ? Aall : Aall + (size_t)u.pm * 256 * lda * 2; u.b = Wall + ((size_t)e * wrows + u.pn * 256) * ldb * 2; return true; }
};
struct EpiSwiglu {
    static constexpr bool PERM = true;
    bf16* HACT;
    __device__ __forceinline__ void operator()(const f32x4 (&acc)[2][2][4][2], const pg8::Unit& u, int wr, int wc, int fr, int fq, LAS unsigned char*) const {
#pragma unroll
        for (int ai = 0; ai < 2; ++ai)
#pragma unroll
            for (int m = 0; m < 4; ++m) { bf16* rowp = HACT + (size_t)(u.pm * 256 + ai * 128 + wr * 64 + m * 16 + fr) * DE + u.pn * 128 + wc * 32 + 8 * fq;
                float h[8];
#pragma unroll
                for (int n = 0; n < 2; ++n)
#pragma unroll
                    for (int e = 0; e < 4; ++e) { const float gt = acc[ai][0][m][n][e], up = acc[ai][1][m][n][e]; h[n * 4 + e] = silu_f(gt) * up; }
                u32x4 w; w.x = pg8::cvt_pk_bf16(h[0], h[1]); w.y = pg8::cvt_pk_bf16(h[2], h[3]); w.z = pg8::cvt_pk_bf16(h[4], h[5]); w.w = pg8::cvt_pk_bf16(h[6], h[7]);
                *(u32x4*)rowp = w; }
    }
};

struct Route { int e0, e1, r0, r1; float w0, w1; int s0, s1; };
template <int MODE, bool ROUTER, bool FINAL, bool DRY = false>
__device__ __forceinline__ void ln_pass(Frame& F, const Args& A, const bf16* hold, const bf16* Y, int li  , float* hnew  , bf16* hb, unsigned* cnt) {
    const float* gam = A.in[19] + (size_t)li * D; const float* bet = A.in[20] + (size_t)li * D;
    f32x4 gv[4], bv[4];
#pragma unroll
    for (int j = 0; j < 4; ++j) { gv[j] = *(const GAS f32x4*)(gam + 256 * j + 4 * F.lane); bv[j] = *(const GAS f32x4*)(bet + 256 * j + 4 * F.lane); }
    LAS float* rw = (LAS float*)F.lds;
    LAS int* sel = (LAS int*)(F.lds + 65536);
    LAS float* selw = (LAS float*)(F.lds + 65536 + 1024);
    if (ROUTER) { for (int i = F.tid; i < NE * D; i += 512) { const int k = i >> 4, e = i & 15; rw[e * D + k] = A.in[14][i]; } __syncthreads(); }
    Route* route = WSP(Route, WS_ROUTE);
    const int nblk = T / 64;
    for (int blk = blockIdx.x; blk < nblk; blk += F.G) {
        u32x2 hn[4]; u32x2 ya[4], yb[4]; float rw0 = 0.f, rw1 = 0.f;
#define LN_LOAD(mrow) do { const int m_ = (mrow); \
            _Pragma("unroll") for (int j = 0; j < 4; ++j) hn[j] = *((const GAS u32x2*)(hold + (size_t)m_ * D) + F.lane + 64 * j); \
            if (MODE == 0) { _Pragma("unroll") for (int j = 0; j < 4; ++j) ya[j] = *((const GAS u32x2*)(Y + (size_t)m_ * D) + F.lane + 64 * j); } \
            else { const Route r_ = route[m_]; rw0 = r_.w0; rw1 = r_.w1; \
                _Pragma("unroll") for (int j = 0; j < 4; ++j) { ya[j] = *((const GAS u32x2*)(Y + (size_t)r_.s0 * D) + F.lane + 64 * j); yb[j] = *((const GAS u32x2*)(Y + (size_t)r_.s1 * D) + F.lane + 64 * j); } } } while (0)
        LN_LOAD(blk * 64 + F.wave * 8);
#pragma unroll 1
        for (int rr = 0; rr < 8; ++rr) {
            const int m = blk * 64 + F.wave * 8 + rr;
            f32x4 v[4];
#pragma unroll
            for (int j = 0; j < 4; ++j) { v[j][0] = bflo(hn[j].x) * ALPHA; v[j][1] = bfhi(hn[j].x) * ALPHA; v[j][2] = bflo(hn[j].y) * ALPHA; v[j][3] = bfhi(hn[j].y) * ALPHA; }
            if (MODE == 0) {
#pragma unroll
                for (int j = 0; j < 4; ++j) { const u32x2 w = ya[j]; v[j][0] += bflo(w.x); v[j][1] += bfhi(w.x); v[j][2] += bflo(w.y); v[j][3] += bfhi(w.y); }
            } else {
#pragma unroll
                for (int j = 0; j < 4; ++j) { const u32x2 w0 = ya[j], w1 = yb[j];
                    v[j][0] += rw0 * bflo(w0.x) + rw1 * bflo(w1.x); v[j][1] += rw0 * bfhi(w0.x) + rw1 * bfhi(w1.x); v[j][2] += rw0 * bflo(w0.y) + rw1 * bflo(w1.y); v[j][3] += rw0 * bfhi(w0.y) + rw1 * bfhi(w1.y); }
            }
            if (rr < 7) LN_LOAD(m + 1);
            float s = 0.f;
#pragma unroll
            for (int j = 0; j < 4; ++j) s += (v[j][0] + v[j][1]) + (v[j][2] + v[j][3]);
            const float mean = wave_sum(s) * (1.f / D); float s2 = 0.f;
#pragma unroll
            for (int j = 0; j < 4; ++j) { v[j] = v[j] - mean; s2 += (v[j][0] * v[j][0] + v[j][1] * v[j][1]) + (v[j][2] * v[j][2] + v[j][3] * v[j][3]); }
            const float rstd = 1.f / sqrtf(wave_sum(s2) * (1.f / D) + LN_EPS);
#pragma unroll
            for (int j = 0; j < 4; ++j) v[j] = v[j] * rstd * gv[j] + bv[j];
            if (FINAL) {
#pragma unroll
                for (int j = 0; j < 4; ++j) *((GAS f32x4*)(hnew + (size_t)m * D) + F.lane + 64 * j) = v[j];
            } else {
#pragma unroll
                for (int j = 0; j < 4; ++j) { u32x2 w; w.x = pk2(v[j][0], v[j][1]); w.y = pk2(v[j][2], v[j][3]); *((GAS u32x2*)(hb + (size_t)m * D) + F.lane + 64 * j) = w; }
            }
            if (ROUTER) {
                float lg[16];
#pragma unroll
                for (int e = 0; e < 16; ++e) { float d = 0.f;
#pragma unroll
                    for (int j = 0; j < 4; ++j) { const f32x4 w = *(const LAS f32x4*)(rw + e * D + 256 * j + 4 * F.lane); d += v[j][0] * w[0] + v[j][1] * w[1] + v[j][2] * w[2] + v[j][3] * w[3]; }
                    lg[e] = wave_sum(d); }
                float mxl = lg[0];
#pragma unroll
                for (int e = 1; e < 16; ++e) mxl = fmaxf(mxl, lg[e]);
                float sc[16], se = 0.f;
#pragma unroll
                for (int e = 0; e < 16; ++e) { sc[e] = __expf(lg[e] - mxl); se += sc[e]; }
                const float inv = 1.f / se; float sl[16];
#pragma unroll
                for (int e = 0; e < 16; ++e) { sc[e] *= inv; sl[e] = sc[e] + A.in[15][e]; }
                int bg = 0; float bgs = -3.0e38f;
#pragma unroll
                for (int g4 = 0; g4 < 4; ++g4) { const float a = sl[4 * g4], b = sl[4 * g4 + 1], c = sl[4 * g4 + 2], d = sl[4 * g4 + 3];
                    const float hi1 = fmaxf(a, b), lo1 = fminf(a, b), hi2 = fmaxf(c, d), lo2 = fminf(c, d);
                    const float top = fmaxf(hi1, hi2), second = fmaxf(fminf(hi1, hi2), fmaxf(lo1, lo2)); const float gs = top + second;
                    if (gs > bgs) { bgs = gs; bg = g4; } }
                float s4[4], c4[4];
#pragma unroll
                for (int q = 0; q < 4; ++q) { s4[q] = bg == 0 ? sl[q] : bg == 1 ? sl[4 + q] : bg == 2 ? sl[8 + q] : sl[12 + q]; c4[q] = bg == 0 ? sc[q] : bg == 1 ? sc[4 + q] : bg == 2 ? sc[8 + q] : sc[12 + q]; }
                int i0 = 0; float b0 = s4[0];
#pragma unroll
                for (int q = 1; q < 4; ++q) if (s4[q] > b0) { b0 = s4[q]; i0 = q; }
                int i1 = -1; float b1 = -3.0e38f;
#pragma unroll
                for (int q = 0; q < 4; ++q) if (q != i0 && s4[q] > b1) { b1 = s4[q]; i1 = q; }
                const float p0 = i0 == 0 ? c4[0] : i0 == 1 ? c4[1] : i0 == 2 ? c4[2] : c4[3];
                const float p1 = i1 == 0 ? c4[0] : i1 == 1 ? c4[1] : i1 == 2 ? c4[2] : c4[3];
                if (F.lane == 0) { const int tk = F.wave * 8 + rr; sel[tk * 4 + 0] = bg * 4 + i0; sel[tk * 4 + 1] = bg * 4 + i1; selw[tk * 2 + 0] = p0 / (p0 + p1); selw[tk * 2 + 1] = p1 / (p0 + p1); }
            }
        }
        if (ROUTER) {
            __syncthreads();
            if (F.wave == 0) {
                const int e0 = sel[F.lane * 4 + 0], e1 = sel[F.lane * 4 + 1];
                const unsigned long long lt = (1ull << F.lane) - 1ull;
                int r0 = 0, r1 = 0, mycount = 0;
#pragma unroll
                for (int e = 0; e < 16; ++e) { const unsigned long long m0 = __ballot(e0 == e), m1 = __ballot(e1 == e);
                    const int before = __popcll(m0 & lt) + __popcll(m1 & lt);
                    if (e0 == e) r0 = before; if (e1 == e) r1 = before;
                    if (F.lane == e) mycount = __popcll(m0) + __popcll(m1); }
                int base = 0; if (F.lane < 16 && mycount > 0 && !DRY) base = (int)atomicAdd(cnt + F.lane, (unsigned)mycount);
                sel[F.lane * 4 + 2] = r0 + __shfl(base, e0); sel[F.lane * 4 + 3] = r1 + __shfl(base, e1);
            }
            __syncthreads();
            if (F.tid < 64) { Route r; r.e0 = sel[F.tid * 4 + 0]; r.e1 = sel[F.tid * 4 + 1]; r.r0 = sel[F.tid * 4 + 2]; r.r1 = sel[F.tid * 4 + 3]; r.w0 = selw[F.tid * 2 + 0]; r.w1 = selw[F.tid * 2 + 1]; r.s0 = 0; r.s1 = 0; if (!DRY) route[blk * 64 + F.tid] = r; }
            __syncthreads();
        }
    }
}
__device__ __forceinline__ void moe_table(Frame& F, const unsigned* cnt, volatile LAS unsigned* tab) {
    if (F.tid == 0) { unsigned t = 0; for (int e = 0; e < 16; ++e) { tab[e] = t; t += (__hip_atomic_load(cnt + e, RLX_AGENT) + 255u) >> 8; } tab[16] = t; }
    __syncthreads();
    if (F.tid < 144) { unsigned e = 0; for (int j = 1; j < 16; ++j) e += (tab[j] <= (unsigned)F.tid) ? 1u : 0u; tab[32 + F.tid] = e; }
    __syncthreads();
}
__device__ __forceinline__ void moe_slots(Frame& F, volatile LAS unsigned* tab, int* inv) {
    Route* route = WSP(Route, WS_ROUTE);
    for (int m = blockIdx.x * 512 + F.tid; m < T; m += F.G * 512) {
        const Route r = route[m];
        const int s0 = (int)tab[r.e0] * 256 + r.r0, s1 = (int)tab[r.e1] * 256 + r.r1;
        route[m].s0 = s0; route[m].s1 = s1; inv[s0] = m; inv[s1] = m;
    }
}

__device__ __forceinline__ void conv_pass(Frame& F, const Args& A, const bf16* prj, bf16* ub) {
    const float* cw = A.in[9];
    for (int it = F.gw; it < (T / 16) * 2; it += F.NGW) {
        const int tb = it >> 1, c0 = (it & 1) * 512 + F.lane * 8; const int t0 = tb * 16, pos0 = t0 % SEQ;
        float w[3][8];
#pragma unroll
        for (int j = 0; j < 3; ++j) { const f32x4 a = *(const GAS f32x4*)(cw + j * D + c0), b = *(const GAS f32x4*)(cw + j * D + c0 + 4);
#pragma unroll
            for (int e = 0; e < 4; ++e) { w[j][e] = a[e]; w[j][4 + e] = b[e]; } }
        float p2[8], p1[8];
#pragma unroll
        for (int e = 0; e < 8; ++e) { p2[e] = 0.f; p1[e] = 0.f; }
#pragma unroll
        for (int q = 0; q < 2; ++q) { if (pos0 - 2 + q >= 0) { const bf16* r = prj + (size_t)(t0 - 2 + q) * 3072;
                const u32x4 gc = *(const GAS u32x4*)(r + 1024 + c0), hd = *(const GAS u32x4*)(r + 2048 + c0);
#pragma unroll
                for (int e = 0; e < 4; ++e) { const float lo = bflo(gc[e]) * bflo(hd[e]), hi = bfhi(gc[e]) * bfhi(hd[e]); if (q == 0) { p2[2 * e] = lo; p2[2 * e + 1] = hi; } else { p1[2 * e] = lo; p1[2 * e + 1] = hi; } } } }
#pragma unroll 4
        for (int tt = 0; tt < 16; ++tt) { const bf16* r = prj + (size_t)(t0 + tt) * 3072;
            const u32x4 gb = *(const GAS u32x4*)(r + c0), gc = *(const GAS u32x4*)(r + 1024 + c0), hd = *(const GAS u32x4*)(r + 2048 + c0);
            float p0[8], o[8];
#pragma unroll
            for (int e = 0; e < 4; ++e) { p0[2 * e] = bflo(gc[e]) * bflo(hd[e]); p0[2 * e + 1] = bfhi(gc[e]) * bfhi(hd[e]); }
#pragma unroll
            for (int e = 0; e < 8; ++e) { const float cv = w[0][e] * p2[e] + w[1][e] * p1[e] + w[2][e] * p0[e]; const float g = (e & 1) ? bfhi(gb[e >> 1]) : bflo(gb[e >> 1]); o[e] = g * cv; p2[e] = p1[e]; p1[e] = p0[e]; }
            u32x4 wv; wv.x = pk2(o[0], o[1]); wv.y = pk2(o[2], o[3]); wv.z = pk2(o[4], o[5]); wv.w = pk2(o[6], o[7]);
            *(GAS u32x4*)(ub + (size_t)(t0 + tt) * D + c0) = wv; }
    }
}

constexpr int D1_QB = 0, D1_KB = 17408, D1_E = D1_KB, D1_AT = 34816, D1_KT = 44032, D1_RT = 62464, D1_P = 99328, D1_PT = D1_P + 9216, D1_ET = D1_PT + 9216, D1_UW = D1_P, D1_GC = 136192;
constexpr int RSB = 272, RSS = 144;
static_assert(D1_GC + 2 * 256 <= MISC_OFF && D1_UW + 36864 <= D1_GC && D1_RT + 3 * 67 * 272 <= D1_ET, "D1 LDS");
__device__ __forceinline__ f32x4 tile_k64(const LAS unsigned char* xr, const LAS unsigned char* yr, f32x4 acc) {
#pragma unroll
    for (int s = 0; s < 2; ++s) acc = __builtin_amdgcn_mfma_f32_16x16x32_bf16(*(const LAS bf16x8*)(xr + 64 * s), *(const LAS bf16x8*)(yr + 64 * s), acc, 0, 0, 0);
    return acc;
}
template <int VAR> __device__ __forceinline__ void d1_unit(Frame& F, const Args& A, int unit) {
    if (VAR == 4) return;
    const int bh = unit >> 6, n = unit & 63, b = bh >> 2, h = bh & 3;
    const int t0 = b * SEQ + n * 64;
    const int lane = F.lane, wave = F.wave, g = lane >> 4, c = lane & 15;
    LAS unsigned char* L = F.lds;
    LAS unsigned char* L0 = opq_v(L); LAS unsigned char* L1 = opq_v(L + D1_RT); LAS unsigned char* L2 = opq_v(L + D1_P);
    LAS float* gcs = (LAS float*)(L2 + (D1_GC - D1_P)); LAS float* betas = gcs + 64;
    LAS unsigned char* LQB = L0 + D1_QB; LAS unsigned char* LKB = L0 + D1_KB; LAS unsigned char* LAT = L0 + D1_AT; LAS unsigned char* LKT = L0 + D1_KT;
    LAS unsigned char* LRT = L1; LAS unsigned char* LP = L2; LAS unsigned char* LPT = L2 + 9216; LAS unsigned char* LET = L2 + 18432;
    LAS unsigned char* LUW = L2; LAS unsigned char* LE = L0 + D1_E;
    const int i = lane;
    float gc = ((const GAS float*)WSP(float, WS_GG))[(size_t)(t0 + lane) * 4 + h];
    const float bt = ((const GAS float*)WSP(float, WS_BETA))[(size_t)(t0 + lane) * 4 + h];
    int wvb[3];
    LAS unsigned char* RAW = L1;
    {
        const bf16* pre = WSP(bf16, WS_QKVPRE);
        const float* cwp = A.in[3];
#pragma unroll
        for (int x = 0; x < 3; ++x) wvb[x] = __float_as_int(((const GAS float*)cwp)[(lane >> 4) * 1536 + x * 512 + h * 128 + 16 * wave + (lane & 15)]);
        u32x4 rv[7];
#pragma unroll
        for (int k = 0; k < 7; ++k) { int p = F.tid + 512 * k; p = p < 3216 ? p : 3215; const int x = p / 1072, rem = p - x * 1072, row = rem >> 4, pc = rem & 15;
            const bool okr = (n * 64 - 3 + row >= 0); const int rowi = okr ? (t0 - 3 + row) : t0;
            rv[k] = *(const GAS u32x4*)(pre + (size_t)rowi * 1536 + x * 512 + h * 128 + pc * 8); if (!okr) rv[k] = (u32x4){0u, 0u, 0u, 0u}; }
#pragma unroll
        for (int k = 0; k < 7; ++k) { const int p = F.tid + 512 * k; if (p < 3216) { const int x = p / 1072, rem = p - x * 1072, row = rem >> 4, pc = rem & 15; *(LAS u32x4*)(RAW + (x * 67 + row) * RSB + pc * 16) = rv[k]; } }
    }
    __syncthreads();
#pragma unroll
    for (int o = 1; o < 64; o <<= 1) { const float t = __shfl_up(gc, o); if (lane >= o) gc += t; }
    const float gc63 = __shfl(gc, 63);
    if (wave == 0) { gcs[lane] = gc; betas[lane] = bt; }
    {
        float ov[3][16];
#pragma unroll
        for (int x = 0; x < 3; ++x) {
#define RL(k) __int_as_float(__builtin_amdgcn_readlane(wvb[x], (k)))
            float acc[16];
#pragma unroll
            for (int e = 0; e < 16; ++e) acc[e] = 0.f;
#pragma unroll
            for (int j = 0; j < 4; ++j) {
                const u32x4 r0 = *(const LAS u32x4*)(RAW + (x * 67 + i + j) * RSB + 32 * wave), r1 = *(const LAS u32x4*)(RAW + (x * 67 + i + j) * RSB + 32 * wave + 16);
#pragma unroll
                for (int e = 0; e < 4; ++e) { const float w0 = RL(j * 16 + 2 * e), w1 = RL(j * 16 + 2 * e + 1), w2 = RL(j * 16 + 8 + 2 * e), w3 = RL(j * 16 + 8 + 2 * e + 1);
                    acc[2 * e] += w0 * bflo(r0[e]); acc[2 * e + 1] += w1 * bfhi(r0[e]); acc[8 + 2 * e] += w2 * bflo(r1[e]); acc[8 + 2 * e + 1] += w3 * bfhi(r1[e]); }
            }
#pragma unroll
            for (int e = 0; e < 16; ++e) ov[x][e] = silu_f(acc[e]);
#undef RL
        }
        float sq = 0.f, sk = 0.f;
#pragma unroll
        for (int e = 0; e < 16; ++e) { sq += ov[0][e] * ov[0][e]; sk += ov[1][e] * ov[1][e]; }
        LAS float* part = (LAS float*)LET;
        part[wave * 64 + i] = sq; part[512 + wave * 64 + i] = sk;
        __syncthreads();
        float tq = 0.f, tk = 0.f;
#pragma unroll
        for (int w8 = 0; w8 < 8; ++w8) { tq += part[w8 * 64 + i]; tk += part[512 + w8 * 64 + i]; }
        const float rq = rsqrtf(tq + RMS_EPS) * 0.08838834764831845f, rk = rsqrtf(tk + RMS_EPS);
        const float kt = __expf(gc63 - gc), be = bt * __expf(gc);
        u32x4 qw[2], kw[2];
#pragma unroll
        for (int e = 0; e < 8; ++e) { qw[e >> 2][e & 3] = pk2(ov[0][2 * e] * rq, ov[0][2 * e + 1] * rq); kw[e >> 2][e & 3] = pk2(ov[1][2 * e] * rk, ov[1][2 * e + 1] * rk); }
        *(LAS u32x4*)(LQB + i * RSB + 32 * wave) = qw[0]; *(LAS u32x4*)(LQB + i * RSB + 32 * wave + 16) = qw[1];
        *(LAS u32x4*)(LKB + i * RSB + 32 * wave) = kw[0]; *(LAS u32x4*)(LKB + i * RSB + 32 * wave + 16) = kw[1];
#pragma unroll
        for (int e = 0; e < 16; ++e) { const float kv = ov[1][e] * rk; const int d = 16 * wave + e;
            *(LAS unsigned short*)(LKT + d * RSS + 2 * i) = (unsigned short)f2bf(kv * kt);
            *(LAS unsigned short*)(LRT + d * RSS + 2 * i) = (unsigned short)f2bf(ov[2][e] * bt);
            *(LAS unsigned short*)(LRT + (128 + d) * RSS + 2 * i) = (unsigned short)f2bf(kv * be); }
    }
    __syncthreads();
    if (VAR == 1) return;
    f32x4 Er[2];
#pragma unroll
    for (int it = 0; it < 4; ++it) {
        const int id = wave + 8 * (it & 1), isq = it >> 1, mi = id >> 2, nj = id & 3;
        f32x4 acc = {0.f, 0.f, 0.f, 0.f};
        if (mi >= nj) {
            const LAS unsigned char* xr = (isq ? LQB : LKB) + (16 * mi + c) * RSB + 16 * g;
            const LAS unsigned char* yr = LKB + (16 * nj + c) * RSB + 16 * g;
#pragma unroll
            for (int s = 0; s < 4; ++s) acc = __builtin_amdgcn_mfma_f32_16x16x32_bf16(*(const LAS bf16x8*)(xr + 64 * s), *(const LAS bf16x8*)(yr + 64 * s), acc, 0, 0, 0);
        }
        const int j = 16 * nj + c; const float gj = gcs[j];
        f32x4 o;
#pragma unroll
        for (int r = 0; r < 4; ++r) { const int i = 16 * mi + 4 * g + r; const float dec = (i >= j) ? __expf(gcs[i] - gj) : 0.f;
            o[r] = isq ? ((i >= j) ? acc[r] * dec : 0.f) : ((i > j) ? -betas[i] * acc[r] * dec : 0.f); }
        if (!isq) { Er[it & 1] = o;
            u32x2 w; w.x = pk2(o[0], o[1]); w.y = pk2(o[2], o[3]);
            *(LAS u32x2*)(LPT + j * RSS + 2 * (16 * mi + 4 * g)) = w; *(LAS u32x2*)(LET + j * RSS + 2 * (16 * mi + 4 * g)) = w;
#pragma unroll
            for (int r = 0; r < 4; ++r) *(LAS unsigned short*)(LP + (16 * mi + 4 * g + r) * RSS + 2 * j) = (unsigned short)f2bf(o[r]);
        } else {
#pragma unroll
            for (int r = 0; r < 4; ++r) *(LAS unsigned short*)(LAT + (16 * mi + 4 * g + r) * RSS + 2 * j) = (unsigned short)f2bf(o[r]);
        }
    }
#pragma unroll 1
    for (int s5 = 0; s5 < 5; ++s5) {
        __syncthreads();
        f32x4 Pn[2];
#pragma unroll
        for (int tt = 0; tt < 2; ++tt) { const int id = wave + 8 * tt, mi = id >> 2, nj = id & 3;
            Pn[tt] = tile_k64(LP + (16 * mi + c) * RSS + 16 * g, LPT + (16 * nj + c) * RSS + 16 * g, (f32x4){0.f, 0.f, 0.f, 0.f}); }
        __syncthreads();
#pragma unroll
        for (int tt = 0; tt < 2; ++tt) { const int id = wave + 8 * tt, mi = id >> 2, nj = id & 3, j = 16 * nj + c;
            u32x2 w; w.x = pk2(Pn[tt][0], Pn[tt][1]); w.y = pk2(Pn[tt][2], Pn[tt][3]);
            *(LAS u32x2*)(LPT + j * RSS + 2 * (16 * mi + 4 * g)) = w;
#pragma unroll
            for (int r = 0; r < 4; ++r) *(LAS unsigned short*)(LP + (16 * mi + 4 * g + r) * RSS + 2 * j) = (unsigned short)f2bf(Pn[tt][r]); }
        __syncthreads();
        f32x4 En[2];
#pragma unroll
        for (int tt = 0; tt < 2; ++tt) { const int id = wave + 8 * tt, mi = id >> 2, nj = id & 3;
            En[tt] = tile_k64(LP + (16 * mi + c) * RSS + 16 * g, LET + (16 * nj + c) * RSS + 16 * g, Er[tt] + Pn[tt]); }
        __syncthreads();
#pragma unroll
        for (int tt = 0; tt < 2; ++tt) { const int id = wave + 8 * tt, mi = id >> 2, nj = id & 3, j = 16 * nj + c;
            Er[tt] = En[tt];
            u32x2 w; w.x = pk2(En[tt][0], En[tt][1]); w.y = pk2(En[tt][2], En[tt][3]);
            *(LAS u32x2*)(LET + j * RSS + 2 * (16 * mi + 4 * g)) = w; }
    }
    if (VAR == 2) { __syncthreads(); return; }
#pragma unroll
    for (int tt = 0; tt < 2; ++tt) { const int id = wave + 8 * tt, mi = id >> 2, nj = id & 3, j = 16 * nj + c;
#pragma unroll
        for (int r = 0; r < 4; ++r) *(LAS unsigned short*)(LE + (16 * mi + 4 * g + r) * RSS + 2 * j) = (unsigned short)f2bf(Er[tt][r]); }
    __syncthreads();
    {
        f32x4 xo[8];
#pragma unroll
        for (int q = 0; q < 8; ++q) { const int t = wave + 8 * q, mi = t >> 4, ct = t & 15;
            const u32x2 rv = *(const LAS u32x2*)(LRT + (16 * ct + c) * RSS + 2 * (16 * mi + 4 * g));
            xo[q] = tile_k64(LE + (16 * mi + c) * RSS + 16 * g, LRT + (16 * ct + c) * RSS + 16 * g, (f32x4){bflo(rv.x), bfhi(rv.x), bflo(rv.y), bfhi(rv.y)}); }
        __syncthreads();
#pragma unroll
        for (int q = 0; q < 8; ++q) { const int t = wave + 8 * q, mi = t >> 4, ct = t & 15;
            u32x2 w; w.x = pk2(xo[q][0], xo[q][1]); w.y = pk2(xo[q][2], xo[q][3]);
            *(LAS u32x2*)(LUW + (16 * ct + c) * RSS + 2 * (16 * mi + 4 * g)) = w; }
    }
    __syncthreads();
    if (VAR == 3) return;
    const LAS unsigned char* UWr = LUW; const LAS unsigned char* ATr = LAT; const LAS unsigned char* KTr = LKT;
    const size_t cbase = (size_t)unit; const f32x4 z4 = {0.f, 0.f, 0.f, 0.f};
    for (int t = wave; t < 32; t += 8) { const int xi = t >> 3, yj = t & 7;
        const f32x4 d = tile_k64(ATr + (16 * xi + c) * RSS + 16 * g, UWr + (16 * yj + c) * RSS + 16 * g, z4);
        u32x2 w; w.x = pk2(d[0], d[1]); w.y = pk2(d[2], d[3]);
        *(GAS u32x2*)(WSP(bf16, WS_OLOCT) + cbase * 8192 + (size_t)((yj * 4 + xi) * 64 + lane) * 4) = w; }
    for (int t = wave; t < 32; t += 8) { const int xi = t >> 2, yj = t & 3;
        const f32x4 d = tile_k64(UWr + (128 + 16 * xi + c) * RSS + 16 * g, ATr + (16 * yj + c) * RSS + 16 * g, z4);
        const int i2 = 16 * yj + c, dd = 16 * xi + 4 * g; const float eg = __expf(gcs[i2]);
        const u32x2 qv = *(const LAS u32x2*)(LQB + i2 * RSB + 2 * dd);
        u32x2 w; w.x = pk2(bflo(qv.x) * eg - d[0], bfhi(qv.x) * eg - d[1]); w.y = pk2(bflo(qv.y) * eg - d[2], bfhi(qv.y) * eg - d[3]);
        *(GAS u32x2*)(WSP(bf16, WS_QEFF) + cbase * 8192 + (size_t)(((yj * 4 + (xi >> 1)) * 64 + (2 * (xi & 1) + (g >> 1)) * 16 + c) * 8 + 4 * (g & 1))) = w; }
    for (int t = wave; t < 64; t += 8) { const int xi = t >> 3, yj = t & 7;
        const f32x4 d = tile_k64(KTr + (16 * xi + c) * RSS + 16 * g, UWr + (16 * yj + c) * RSS + 16 * g, z4);
        u32x2 w; w.x = pk2(d[0], d[1]); w.y = pk2(d[2], d[3]);
        *(GAS u32x2*)(WSP(bf16, WS_BMT) + cbase * 16384 + (size_t)(((yj * 4 + (xi >> 1)) * 2 + (xi & 1)) * 64 + lane) * 4) = w; }
    for (int t = wave; t < 64; t += 8) { const int xi = t >> 3, yj = t & 7;
        const f32x4 d = tile_k64(UWr + (128 + 16 * xi + c) * RSS + 16 * g, KTr + (16 * yj + c) * RSS + 16 * g, z4);
        u32x2 w; w.x = pk2(-d[0], -d[1]); w.y = pk2(-d[2], -d[3]);
        *(GAS u32x2*)(WSP(bf16, WS_MNEG) + cbase * 16384 + (size_t)(((yj * 4 + (xi >> 1)) * 64 + (2 * (xi & 1) + (g >> 1)) * 16 + c) * 8 + 4 * (g & 1))) = w; }
    if (F.tid == 0) WSP(float, WS_GLAST)[unit] = __expf(gc63);
    __syncthreads();
}

constexpr int SCAN_PF = 4;
__device__ __forceinline__ void scan_wg(Frame& F, int sw) {
    const int bh = sw & 15, slice = sw >> 4, b = bh >> 2, h = bh & 3;
    const int lane = F.lane, wave = F.wave, g = lane >> 4, c = lane & 15;
    LAS unsigned char* ST = opq_v(F.lds);
    LAS unsigned char* OS = ST + 8704;
    for (int i = F.tid; i < 2 * 4352 / 4; i += 512) ((LAS unsigned*)ST)[i] = 0u;
    __syncthreads();
    const GAS bf16* MN = (const GAS bf16*)(WSP(bf16, WS_MNEG) + (size_t)bh * 64 * 16384); const GAS bf16* BM = (const GAS bf16*)(WSP(bf16, WS_BMT) + (size_t)bh * 64 * 16384);
    const GAS bf16* QE = (const GAS bf16*)(WSP(bf16, WS_QEFF) + (size_t)bh * 64 * 8192); const GAS bf16* OL = (const GAS bf16*)(WSP(bf16, WS_OLOCT) + (size_t)bh * 64 * 8192);
    const GAS float* GL = (const GAS float*)(WSP(float, WS_GLAST) + bh * 64);
    (void)b; (void)h;
    if (wave < 4) {
        f32x4 Sreg[2] = {{0.f, 0.f, 0.f, 0.f}, {0.f, 0.f, 0.f, 0.f}};
        bf16x8 Af[SCAN_PF][2][4]; u32x2 bm[SCAN_PF][2]; float gl[SCAN_PF];
#define SCAN_LOAD_REC(j, n) do { const size_t cb_ = (size_t)(n) * 16384; \
        _Pragma("unroll") for (int mt = 0; mt < 2; ++mt) { _Pragma("unroll") for (int s = 0; s < 4; ++s) Af[j][mt][s] = *(const GAS bf16x8*)(MN + cb_ + (size_t)(((wave * 2 + mt) * 4 + s) * 64 + lane) * 8); \
            bm[j][mt] = *(const GAS u32x2*)(BM + cb_ + (size_t)(((slice * 4 + wave) * 2 + mt) * 64 + lane) * 4); } gl[j] = GL[n]; } while (0)
#pragma unroll
        for (int j = 0; j < SCAN_PF; ++j) SCAN_LOAD_REC(j, j);
#pragma unroll 1
        for (int n0 = 0; n0 < 64; n0 += SCAN_PF) {
#pragma unroll
            for (int j = 0; j < SCAN_PF; ++j) {
                const int n = n0 + j; const int cur = n & 1;
                bf16x8 Sb[4];
#pragma unroll
                for (int s = 0; s < 4; ++s) Sb[s] = *(const LAS bf16x8*)(ST + cur * 4352 + c * 272 + 64 * s + 16 * g);
#pragma unroll
                for (int mt = 0; mt < 2; ++mt) {
                    f32x4 acc; acc[0] = gl[j] * Sreg[mt][0] + bflo(bm[j][mt].x); acc[1] = gl[j] * Sreg[mt][1] + bfhi(bm[j][mt].x); acc[2] = gl[j] * Sreg[mt][2] + bflo(bm[j][mt].y); acc[3] = gl[j] * Sreg[mt][3] + bfhi(bm[j][mt].y);
#pragma unroll
                    for (int s = 0; s < 4; ++s) acc = __builtin_amdgcn_mfma_f32_16x16x32_bf16(Af[j][mt][s], Sb[s], acc, 0, 0, 0);
                    Sreg[mt] = acc;
                    u32x2 w; w.x = pk2(acc[0], acc[1]); w.y = pk2(acc[2], acc[3]);
                    *(LAS u32x2*)(ST + (cur ^ 1) * 4352 + c * 272 + 2 * (32 * wave + 16 * mt + 4 * g)) = w;
                }
                if (n + SCAN_PF < 64) SCAN_LOAD_REC(j, n + SCAN_PF);
                __syncthreads();
            }
        }
#undef SCAN_LOAD_REC
        __syncthreads();
    } else {
        const int m = wave - 4;
        bf16x8 Qf[SCAN_PF][4]; u32x2 ol[SCAN_PF];
        GAS bf16* OU = (GAS bf16*)(WSP(bf16, WS_OUN) + ((size_t)(bh * 8 + slice) * SEQ) * 16);
#define SCAN_LOAD_OUT(j, n) do { const size_t cb_ = (size_t)(n) * 8192; \
        _Pragma("unroll") for (int s = 0; s < 4; ++s) Qf[j][s] = *(const GAS bf16x8*)(QE + cb_ + (size_t)((m * 4 + s) * 64 + lane) * 8); \
        ol[j] = *(const GAS u32x2*)(OL + cb_ + (size_t)((slice * 4 + m) * 64 + lane) * 4); } while (0)
#define SCAN_FLUSH(n) do { if (m < 2) { const int q_ = m * 64 + lane; const u32x4 v_ = *(const LAS u32x4*)(OS + ((n) & 1) * 2048 + q_ * 16); *(GAS u32x4*)(OU + (size_t)(n) * 1024 + q_ * 8) = v_; } } while (0)
#pragma unroll
        for (int j = 0; j < SCAN_PF; ++j) SCAN_LOAD_OUT(j, j);
#pragma unroll 1
        for (int n0 = 0; n0 < 64; n0 += SCAN_PF) {
#pragma unroll
            for (int j = 0; j < SCAN_PF; ++j) {
                const int n = n0 + j; const int cur = n & 1;
                if (n > 0) SCAN_FLUSH(n - 1);
                bf16x8 Sb[4];
#pragma unroll
                for (int s = 0; s < 4; ++s) Sb[s] = *(const LAS bf16x8*)(ST + cur * 4352 + c * 272 + 64 * s + 16 * g);
                f32x4 acc; acc[0] = bflo(ol[j].x); acc[1] = bfhi(ol[j].x); acc[2] = bflo(ol[j].y); acc[3] = bfhi(ol[j].y);
#pragma unroll
                for (int s = 0; s < 4; ++s) acc = __builtin_amdgcn_mfma_f32_16x16x32_bf16(Qf[j][s], Sb[s], acc, 0, 0, 0);
#pragma unroll
                for (int r = 0; r < 4; ++r) *(LAS unsigned short*)(OS + cur * 2048 + (16 * m + 4 * g + r) * 32 + 2 * c) = (unsigned short)f2bf(acc[r]);
                if (n + SCAN_PF < 64) SCAN_LOAD_OUT(j, n + SCAN_PF);
                __syncthreads();
            }
        }
        SCAN_FLUSH(63);
        __syncthreads();
#undef SCAN_LOAD_OUT
#undef SCAN_FLUSH
    }
}

constexpr int AT_KS = 0, AT_VS = 36864, AT_OS = 73728, N_ATT_UNITS = NB * DAH * 96;
__device__ __forceinline__ s16x4 vtr(const LAS unsigned char* p) { typedef short v4i16_t __attribute__((ext_vector_type(4))); return __builtin_bit_cast(s16x4, __builtin_amdgcn_ds_read_tr16_b64_v4i16((LAS v4i16_t*)p)); }
struct AttU { int b, hh, br, dil, res, n; };
__device__ __forceinline__ AttU att_decode(int a) { AttU u; const int bhh = a / 96, rem = a % 96; u.br = rem >> 5; const int idx = rem & 31; u.b = bhh >> 3; u.hh = bhh & 7;
    u.dil = u.br == 0 ? 1 : u.br == 1 ? 4 : 16; const int nblk = 32 / u.dil; u.res = idx / nblk; u.n = idx % nblk; return u; }
__device__ __forceinline__ void att_load(Frame& F, int a, u32x4 (&kv)[4], u32x4 (&vv)[4], bf16x8 (&Bq)[2]) {
    const AttU u = att_decode(a); const bf16* QKVD = WSP(bf16, WS_QKVD);
#pragma unroll
    for (int p = 0; p < 4; ++p) { const int j = (F.tid >> 3) + 64 * p, kidx = 128 * (u.n - 1) + j; const bool ok = kidx >= 0;
        const bf16* src = QKVD + (size_t)(u.b * SEQ + (ok ? kidx : 0) * u.dil + u.res) * 1536 + u.hh * 64 + (F.tid & 7) * 8;
        kv[p] = *(const GAS u32x4*)(src + 512); vv[p] = *(const GAS u32x4*)(src + 1024);
        if (!ok) { kv[p] = (u32x4){0u, 0u, 0u, 0u}; vv[p] = (u32x4){0u, 0u, 0u, 0u}; } }
    const int qi = 16 * F.wave + (F.lane & 15); const size_t qtok = (size_t)(u.b * SEQ + (128 * u.n + qi) * u.dil + u.res);
#pragma unroll
    for (int s = 0; s < 2; ++s) Bq[s] = *(const GAS bf16x8*)(QKVD + qtok * 1536 + u.hh * 64 + 32 * s + 8 * (F.lane >> 4));
}
__device__ __forceinline__ void att_compute(Frame& F, int a, LAS unsigned char* L, const bf16x8 (&Bq)[2]) {
    const AttU u = att_decode(a); const int n = u.n;
    const int lane = F.lane, wave = F.wave, g = lane >> 4, c = lane & 15;
    const int qi = 16 * wave + c;
    f32x4 sc[9];
    float mx = -1.0e30f;
#pragma unroll
    for (int t = 0; t < 9; ++t) {
        const LAS unsigned char* kr = L + AT_KS + (16 * (wave + t) + c) * RSS + 16 * g;
        f32x4 acc = {0.f, 0.f, 0.f, 0.f};
        acc = __builtin_amdgcn_mfma_f32_16x16x32_bf16(*(const LAS bf16x8*)kr, Bq[0], acc, 0, 0, 0);
        acc = __builtin_amdgcn_mfma_f32_16x16x32_bf16(*(const LAS bf16x8*)(kr + 64), Bq[1], acc, 0, 0, 0);
        if (t == 0) {
#pragma unroll
            for (int r = 0; r < 4; ++r) { const int j = 16 * wave + 4 * g + r; if (j < qi) acc[r] = -1.0e30f; } }
        if (t == 8) {
#pragma unroll
            for (int r = 0; r < 4; ++r) { const int j = 16 * (wave + 8) + 4 * g + r; if (j > qi + 128) acc[r] = -1.0e30f; } }
        if (n == 0 && wave + t < 8) acc = (f32x4){-1.0e30f, -1.0e30f, -1.0e30f, -1.0e30f};
        mx = fmaxf(fmaxf(mx, fmaxf(acc[0], acc[1])), fmaxf(acc[2], acc[3]));
        sc[t] = acc;
    }
    mx = fmaxf(mx, __shfl_xor(mx, 16)); mx = fmaxf(mx, __shfl_xor(mx, 32));
    float lsum = 0.f;
#pragma unroll
    for (int t = 0; t < 9; ++t)
#pragma unroll
        for (int r = 0; r < 4; ++r) { const float p = __builtin_amdgcn_exp2f(sc[t][r] - mx); sc[t][r] = p; lsum += p; }
    lsum += __shfl_xor(lsum, 16); lsum += __shfl_xor(lsum, 32);
    bf16x8 pf[5];
#pragma unroll
    for (int q = 0; q < 5; ++q) { u32x4 w; w.x = pk2(sc[2 * q][0], sc[2 * q][1]); w.y = pk2(sc[2 * q][2], sc[2 * q][3]);
        if (q < 4) { w.z = pk2(sc[2 * q + 1][0], sc[2 * q + 1][1]); w.w = pk2(sc[2 * q + 1][2], sc[2 * q + 1][3]); } else { w.z = 0u; w.w = 0u; }
        pf[q] = __builtin_bit_cast(bf16x8, w); }
    float linv[4];
#pragma unroll
    for (int r = 0; r < 4; ++r) linv[r] = 1.f / __shfl(lsum, 4 * g + r);
    LAS unsigned char* OS = L + AT_OS + wave * 2304;
#pragma unroll
    for (int dt = 0; dt < 4; ++dt) {
        f32x4 acc = {0.f, 0.f, 0.f, 0.f};
#pragma unroll
        for (int q = 0; q < 5; ++q) { const int kb = 16 * (wave + 2 * q);
            const LAS unsigned char* vp = L + AT_VS + (kb + 4 * g + (c >> 2)) * RSS + (16 * dt + 4 * (c & 3)) * 2;
            const s16x4 lo = vtr(vp); s16x4 hi = {0, 0, 0, 0}; if (q < 4) hi = vtr(vp + 16 * RSS);
            const bf16x8 bv = {lo[0], lo[1], lo[2], lo[3], hi[0], hi[1], hi[2], hi[3]};
            acc = __builtin_amdgcn_mfma_f32_16x16x32_bf16(pf[q], bv, acc, 0, 0, 0); }
#pragma unroll
        for (int r = 0; r < 4; ++r) *(LAS unsigned short*)(OS + (4 * g + r) * RSS + (16 * dt + c) * 2) = (unsigned short)f2bf(acc[r] * linv[r]);
    }
    const size_t qtok = (size_t)(u.b * SEQ + (128 * n + qi) * u.dil + u.res);
    if (g == 0) ((GAS float*)WSP(float, WS_LSE))[((size_t)u.br * T + qtok) * 8 + u.hh] = (mx + __log2f(lsum)) * 0.6931471805599453f;
    { const int row = lane >> 2, pc = lane & 3; const size_t tok = (size_t)(u.b * SEQ + (128 * n + 16 * wave + row) * u.dil + u.res);
      const u32x4 v0 = *(const LAS u32x4*)(OS + row * RSS + pc * 32), v1 = *(const LAS u32x4*)(OS + row * RSS + pc * 32 + 16);
      GAS u32x4* dst = (GAS u32x4*)(WSP(bf16, WS_OPART) + ((size_t)u.br * T + tok) * 512 + u.hh * 64 + pc * 16); dst[0] = v0; dst[1] = v1; }
}
__device__ __forceinline__ void attn_queue(Frame& F, unsigned* qword, volatile LAS unsigned* MISC) {
    LAS unsigned char* L = opq_v(F.lds);
    u32x4 kv[4], vv[4]; bf16x8 Bq[2], BqN[2];
    if (F.tid == 0) MISC[22] = __hip_atomic_fetch_add(qword, 1u, RLX_AGENT);
    __syncthreads();
    int a = (int)MISC[22];
    if (a < N_ATT_UNITS) att_load(F, a, kv, vv, Bq);
    while (a < N_ATT_UNITS) {
#pragma unroll
        for (int p = 0; p < 4; ++p) { const int j = (F.tid >> 3) + 64 * p; *(LAS u32x4*)(L + AT_KS + j * RSS + (F.tid & 7) * 16) = kv[p]; *(LAS u32x4*)(L + AT_VS + j * RSS + (F.tid & 7) * 16) = vv[p]; }
        if (F.tid == 0) MISC[20] = __hip_atomic_fetch_add(qword, 1u, RLX_AGENT);
        __syncthreads();
        const int an = (int)MISC[20];
        if (an < N_ATT_UNITS) att_load(F, an, kv, vv, BqN);
        att_compute(F, a, L, Bq);
        __syncthreads();
        a = an; Bq[0] = BqN[0]; Bq[1] = BqN[1];
    }
}

__device__ __forceinline__ void mix_pass(Frame& F, const Args& A) {
    const int lane = F.lane;
    float nw[8];
    { const f32x4 a = *(const GAS f32x4*)(A.in[6] + 8 * (lane & 15)), b = *(const GAS f32x4*)(A.in[6] + 8 * (lane & 15) + 4);
#pragma unroll
      for (int e = 0; e < 4; ++e) { nw[e] = a[e]; nw[4 + e] = b[e]; } }
    const bf16* OU = WSP(bf16, WS_OUN); const bf16* ZB = WSP(bf16, WS_ZB); const bf16* OP = WSP(bf16, WS_OPART); const float* LSE = WSP(float, WS_LSE); bf16* MIX = WSP(bf16, WS_MIX);
    for (int t = F.gw; t < T; t += F.NGW) {
        const u32x4 uo = *(const GAS u32x4*)(OU + ((size_t)(((t >> 12) * 4 + (lane >> 4)) * 8 + ((lane & 15) >> 1)) * SEQ + (t & 4095)) * 16 + 8 * (lane & 1)), uz = *(const GAS u32x4*)(ZB + (size_t)t * 512 + 8 * lane);
        float x[8], z[8];
#pragma unroll
        for (int e = 0; e < 4; ++e) { x[2 * e] = bflo(uo[e]); x[2 * e + 1] = bfhi(uo[e]); z[2 * e] = bflo(uz[e]); z[2 * e + 1] = bfhi(uz[e]); }
        float ss = 0.f;
#pragma unroll
        for (int e = 0; e < 8; ++e) ss += x[e] * x[e];
        ss += __shfl_xor(ss, 1); ss += __shfl_xor(ss, 2); ss += __shfl_xor(ss, 4); ss += __shfl_xor(ss, 8);
        const float rstd = rsqrtf(ss * (1.f / 128.f) + RMS_EPS);
        float o[8];
#pragma unroll
        for (int e = 0; e < 8; ++e) o[e] = x[e] * rstd * nw[e] * silu_f(z[e]);
        u32x4 w; w.x = pk2(o[0], o[1]); w.y = pk2(o[2], o[3]); w.z = pk2(o[4], o[5]); w.w = pk2(o[6], o[7]);
        *(GAS u32x4*)(MIX + (size_t)t * D + 8 * lane) = w;
        const int hh = lane >> 3;
        const float l0 = LSE[((size_t)0 * T + t) * 8 + hh], l1 = LSE[((size_t)1 * T + t) * 8 + hh], l2 = LSE[((size_t)2 * T + t) * 8 + hh];
        const float lm = fmaxf(l0, fmaxf(l1, l2)); const float e0 = __expf(l0 - lm), e1 = __expf(l1 - lm), e2 = __expf(l2 - lm); const float inv = 1.f / (e0 + e1 + e2);
        const u32x4 p0 = *(const GAS u32x4*)(OP + ((size_t)0 * T + t) * 512 + 8 * lane), p1 = *(const GAS u32x4*)(OP + ((size_t)1 * T + t) * 512 + 8 * lane), p2 = *(const GAS u32x4*)(OP + ((size_t)2 * T + t) * 512 + 8 * lane);
        const float w0 = e0 * inv, w1 = e1 * inv, w2 = e2 * inv;
        u32x4 wo;
#pragma unroll
        for (int e = 0; e < 4; ++e) wo[e] = pk2(w0 * bflo(p0[e]) + w1 * bflo(p1[e]) + w2 * bflo(p2[e]), w0 * bfhi(p0[e]) + w1 * bfhi(p1[e]) + w2 * bfhi(p2[e]));
        *(GAS u32x4*)(MIX + (size_t)t * D + 512 + 8 * lane) = wo;
    }
}

constexpr int N_PHASES = 29;
#define D1V 0
#define DRYV 0
__global__ void __launch_bounds__(512, 2) fwd_kernel(Args args) {
    extern __shared__ __attribute__((aligned(16))) unsigned char lds_raw[];
    Frame F;
    F.lds = (LAS unsigned char*)lds_raw; F.ws = args.ws; F.ctl = (gu32*)(args.ws + WS_CTL);
    F.tid = threadIdx.x; F.lane = F.tid & 63; F.wave = __builtin_amdgcn_readfirstlane(F.tid >> 6);
    F.G = gridDim.x; F.gw = blockIdx.x * 8 + F.wave; F.NGW = F.G * 8;
    volatile LAS unsigned* MISC = (volatile LAS unsigned*)(F.lds + MISC_OFF); const char* wsb = (const char*)args.ws;
    for (int u = F.tid; u < 256; u += 512) MISC[u] = 0u;
    __syncthreads();
    const int lo = args.ph_lo, hi = args.ph_hi;
    XcdBarrier bar; bar.bar = (unsigned*)(F.ctl + CW_BAR); bar.x = 0; bar.st = MISC + 8;
    if (hi - lo > 1) bar = xcd_barrier_post((unsigned*)(F.ctl + CW_BAR), MISC + 8);
    LAS unsigned char* ring = F.lds; LAS unsigned char* xch = F.lds + XCH_OFF;
    volatile LAS unsigned* tab = MISC + 32;
    const int c = blockIdx.x, G = F.G; int qsel = 0;
#ifndef PHASE_MASK
#define PHASE_MASK 0xFFFFFFFFu
#endif
#define IN(k) ((((PHASE_MASK) >> (k)) & 1u) && lo <= (k) && (k) < hi)
#define SEAM(k) do { if (IN(k) && IN((k) + 1)) xcd_barrier(bar); } while (0)
#define PH_BEGIN() do { const int t_ = opq_v((int)threadIdx.x); F.tid = t_; F.lane = t_ & 63; F.wave = __builtin_amdgcn_readfirstlane(t_ >> 6); F.gw = blockIdx.x * 8 + F.wave; \
        unsigned char* w_ = opq_s(args.ws); F.ws = w_; F.ctl = (gu32*)(w_ + WS_CTL); xch = opq_v(F.lds + XCH_OFF); MISC = (volatile LAS unsigned*)opq_v(F.lds + MISC_OFF); tab = MISC + 32; bar.st = MISC + 8; wsb = (const char*)w_; } while (0)
#define HBc (wsb + WS_HB)

    if (IN(0)) { PH_BEGIN(); p0_prologue(F, args); SEAM(0); }
    if (IN(1)) { PH_BEGIN();
        SchedP1 S{HBc, (const char*)(wsb + WS_W_IN), (const char*)(wsb + WS_MEMB), (const char*)(wsb + WS_W_KV), G, c};
        EpiP1 E{WSP(bf16, WS_QKVPRE), WSP(bf16, WS_ZB), WSP(bf16, WS_QKVD), WSP(bf16, WS_KMEM), WSP(bf16, WS_VT)};
        pg8::gemm_phase(ring, xch, pg8::Gemm{D, D, D}, S, E); SEAM(1);
    }
    if (IN(2)) { PH_BEGIN(); for (int u = c; u < NB * DNH * NCHUNK; u += G) d1_unit<D1V>(F, args, u); SEAM(2); }
    if (IN(3)) { PH_BEGIN();
        if (c < 128) scan_wg(F, c);
        attn_queue(F, (unsigned*)(F.ctl + CW_QUEUE + 16 * qsel), MISC);
        ++qsel;
        SEAM(3);
    }
    if (IN(4)) { PH_BEGIN();
        { SchedPrep S{(const char*)(wsb + WS_KMEM), (const char*)(wsb + WS_W_Q), (const char*)(wsb + WS_W_O), (const char*)(wsb + WS_VT), G, c}; EpiPrep E{WSP(bf16, WS_MT), WSP(bf16, WS_VWT)};
          pg8::gemm_phase(ring, xch, pg8::Gemm{D, D, XD}, S, E); }
        mix_pass(F, args); SEAM(4); }

#pragma unroll
    for (int layer = 0; layer < 2; ++layer) {
        const int pb = layer * 13;
        if (layer == 0) {
            if (IN(5)) { PH_BEGIN(); convert_moe_q(F, args, 0, 0, WSP(bf16, WS_MOEW_GU), (unsigned*)(F.ctl + CW_CVQ), MISC); convert_moe_q(F, args, 0, 1, WSP(bf16, WS_MOEW_D), (unsigned*)(F.ctl + CW_CVQ + 16), MISC); __syncthreads();
                SchedDense S{(const char*)(wsb + WS_MIX), (const char*)(wsb + WS_W_ABO), D, D, 64, 4, G, c}; EpiDense E{WSP(bf16, 288 * MiB), D, 1.f};
                pg8::gemm_phase(ring, xch, pg8::Gemm{D, D, D}, S, E); SEAM(5); }
            if (IN(6)) { PH_BEGIN(); ln_pass<0, false, false, (DRYV != 0)>(F, args, WSP(bf16, WS_HB), WSP(bf16, 288 * MiB), 0, nullptr, DRYV ? WSP(bf16, 112 * MiB) : WSP(bf16, WS_HB), nullptr); SEAM(6); }
        } else {
            if (IN(16)) { PH_BEGIN();
                SchedDense S{HBc, (const char*)(wsb + WS_W_SCI), D, D, 64, 12, G, c}; EpiDense E{WSP(bf16, 192 * MiB), 3 * D, 1.f};
                pg8::gemm_phase(ring, xch, pg8::Gemm{D, D, D}, S, E); SEAM(16); }
            if (IN(17)) { PH_BEGIN(); conv_pass(F, args, WSP(bf16, 192 * MiB), WSP(bf16, 288 * MiB)); SEAM(17); }
            if (IN(18)) { PH_BEGIN(); SchedDense S{(const char*)(wsb + 288 * MiB), (const char*)(wsb + WS_W_SCO), D, D, 64, 4, G, c}; EpiDense E{WSP(bf16, 192 * MiB), D, 1.f};
                pg8::gemm_phase(ring, xch, pg8::Gemm{D, D, D}, S, E); SEAM(18); }
            if (IN(19)) { PH_BEGIN(); ln_pass<0, false, false>(F, args, WSP(bf16, WS_HB), WSP(bf16, 192 * MiB), 3, nullptr, WSP(bf16, WS_HB), nullptr); SEAM(19); }
        }
        const size_t oP = (layer == 0 ? 224 : 256) * MiB, oY = (layer == 0 ? 288 : 192) * MiB;
        const int p7 = layer == 0 ? 7 : 20;
        if (IN(p7)) { PH_BEGIN(); SchedXB S{HBc, (const char*)(wsb + WS_MT + (size_t)layer * NB * D * D * 2), G, c}; EpiSoftmax E{WSP(bf16, oP)};
            pg8::gemm_phase(ring, xch, pg8::Gemm{D, D, D}, S, E); SEAM(p7); }
        if (IN(p7 + 1)) { PH_BEGIN(); SchedXB S{(const char*)(wsb + oP), (const char*)(wsb + WS_VWT + (size_t)layer * NB * D * D * 2), G, c}; EpiDense E{WSP(bf16, oY), D, 1.f};
            pg8::gemm_phase(ring, xch, pg8::Gemm{D, D, D}, S, E); SEAM(p7 + 1); }
        unsigned* cnt = (unsigned*)(F.ctl + (layer == 0 ? CW_CNT0 : CW_CNT1));
        if (IN(p7 + 4)) { PH_BEGIN(); ln_pass<0, true, false, (DRYV != 0)>(F, args, WSP(bf16, WS_HB), WSP(bf16, oY), layer * 3 + 1, nullptr, DRYV ? WSP(bf16, 112 * MiB) : WSP(bf16, WS_HB), cnt); SEAM(p7 + 4); }
        if (IN(p7 + 5)) { PH_BEGIN(); moe_table(F, cnt, tab); moe_slots(F, tab, WSP(int, WS_INV + (size_t)layer * MOE_ROWS * 4)); SEAM(p7 + 5); }
        if (IN(p7 + 6)) { PH_BEGIN(); moe_table(F, cnt, tab);
            SchedMoE<true> S{HBc, (const char*)(wsb + (layer == 0 ? WS_MOEW_GU : WS_MOEW_GU1)), tab, WSP(int, WS_INV + (size_t)layer * MOE_ROWS * 4), D, D, D, G, c}; EpiSwiglu E{WSP(bf16, WS_HACT)};
            pg8::gemm_phase(ring, xch, pg8::Gemm{D, D, D}, S, E);
            if (layer == 0) convert_moe_q(F, args, 1, 0, WSP(bf16, WS_MOEW_GU1), (unsigned*)(F.ctl + CW_CVQ + 32), MISC);
            SEAM(p7 + 6); }
        if (IN(p7 + 7)) { PH_BEGIN(); moe_table(F, cnt, tab);
            SchedMoE<false> S{(const char*)(wsb + WS_HACT), (const char*)(wsb + (layer == 0 ? WS_MOEW_D : WS_MOEW_D1)), tab, nullptr, DE, D, DE, G, c}; EpiDense E{WSP(bf16, WS_XG), D, 1.f};
            pg8::gemm_phase(ring, xch, pg8::Gemm{DE, DE, DE}, S, E);
            if (layer == 0) convert_moe_q(F, args, 1, 1, WSP(bf16, WS_MOEW_D1), (unsigned*)(F.ctl + CW_CVQ + 48), MISC);
            SEAM(p7 + 7); }
        if (layer == 0) { if (IN(15)) { PH_BEGIN(); ln_pass<1, false, false>(F, args, WSP(bf16, WS_HB), WSP(bf16, WS_XG), 2, nullptr, WSP(bf16, WS_HB), nullptr); SEAM(15); } }
        else { if (IN(28)) { PH_BEGIN(); ln_pass<1, false, true>(F, args, WSP(bf16, WS_HB), WSP(bf16, WS_XG), 5, args.out, nullptr, nullptr); SEAM(28); } }
        (void)pb;
    }
#undef IN
#undef SEAM
}

extern "C" void kernel_launch(void* const* d_in, const int* in_sizes, int n_in, void* d_out, int out_size, void* d_ws, size_t ws_size, hipStream_t stream) {
    static int grid = 0;
    if (grid == 0) {
        if (n_in != 21 || out_size != T * D || ws_size < WS_END) { fprintf(stderr, "kernel_launch: unexpected problem (n_in %d, out %d, ws %zu < %zu)\n", n_in, out_size, ws_size, (size_t)WS_END); grid = -1; return; }
        int dev = 0, cus = 0, per_cu = 0;
        if (hipGetDevice(&dev) != hipSuccess || hipDeviceGetAttribute(&cus, hipDeviceAttributeMultiprocessorCount, dev) != hipSuccess) { grid = -1; return; }
        if (hipFuncSetAttribute((const void*)fwd_kernel, hipFuncAttributeMaxDynamicSharedMemorySize, LDS_BYTES) != hipSuccess) { fprintf(stderr, "kernel_launch: hipFuncSetAttribute failed\n"); grid = -1; return; }
        if (hipOccupancyMaxActiveBlocksPerMultiprocessor(&per_cu, (const void*)fwd_kernel, 512, LDS_BYTES) != hipSuccess || per_cu < 1) { fprintf(stderr, "kernel_launch: occupancy query says %d blocks per CU\n", per_cu); (void)hipGetLastError(); per_cu = 1; }
        grid = cus;
    }
    if (grid < 0) return;
    (void)hipMemsetAsync((char*)d_ws + WS_CTL, 0, CTL_ZERO_BYTES, stream);
    Args a{};
    for (int i = 0; i < 21; ++i) a.in[i] = (const float*)d_in[i];
    a.out = (float*)d_out; a.ws = (unsigned char*)d_ws;
#if MK_ONE_LAUNCH
    a.ph_lo = 0; a.ph_hi = N_PHASES;
    hipLaunchKernelGGL(fwd_kernel, dim3(grid), dim3(512), LDS_BYTES, stream, a);
#else
    for (int p = 0; p < N_PHASES; ++p) { a.ph_lo = p; a.ph_hi = p + 1; hipLaunchKernelGGL(fwd_kernel, dim3(grid), dim3(512), LDS_BYTES, stream, a); }
#endif
}
```

```cpp
#include <hip/hip_runtime.h>
#include <cstdio>
#include <cstdint>

#ifndef MK_ONE_LAUNCH
#define MK_ONE_LAUNCH 1
#endif

#define LAS __attribute__((address_space(3)))
#define GAS __attribute__((address_space(1)))
typedef unsigned short bf16;
typedef short bf16x8 __attribute__((ext_vector_type(8)));
typedef short s16x4 __attribute__((ext_vector_type(4)));
typedef float f32x4 __attribute__((ext_vector_type(4)));
typedef float f32x2 __attribute__((ext_vector_type(2)));
typedef unsigned u32x4 __attribute__((ext_vector_type(4)));
typedef unsigned u32x2 __attribute__((ext_vector_type(2)));
typedef GAS unsigned gu32;
#define RLX_AGENT __ATOMIC_RELAXED, __HIP_MEMORY_SCOPE_AGENT
#define LDS_WAIT() asm volatile("s_waitcnt lgkmcnt(0)" ::: "memory")
#define VM_WAIT() asm volatile("s_waitcnt vmcnt(0)" ::: "memory")

constexpr int NB = 4, SEQ = 4096, T = NB * SEQ, D = 1024;
constexpr int NMEM = 256, TM = NB * NMEM;
constexpr int DNH = 4, DND = 128, DNW = 512, DNC = 64, NCHUNK = SEQ / DNC;
constexpr int DAH = 8, DAD = 64, DAW = 512;
constexpr int AB_IN = 3592;
constexpr int XH = 4, XD = 256;
constexpr int NE = 16, DE = 512;
constexpr float ALPHA = 1.41421356237f;
constexpr float LN_EPS = 1e-5f, RMS_EPS = 1e-6f;
constexpr int MOE_ROWS = 2 * T + NE * 256;

constexpr size_t MiB = 1u << 20;
constexpr size_t WS_CTL = 0, CTL_ZERO_BYTES = 1 * MiB;
constexpr size_t WS_W_IN = 1 * MiB, WS_W_ABO = 8 * MiB, WS_W_SCI = 10 * MiB, WS_W_SCO = 16 * MiB, WS_W_Q = 18 * MiB, WS_W_KV = 22 * MiB, WS_W_O = 30 * MiB;
constexpr size_t WS_MEMB = 34 * MiB, WS_KMEM = 36 * MiB, WS_VT = 40 * MiB, WS_BETA = 44 * MiB, WS_GG = 45 * MiB, WS_ROUTE = 46 * MiB, WS_GLAST = 47 * MiB;
constexpr size_t WS_MT = 80 * MiB, WS_VWT = 96 * MiB;
constexpr size_t WS_HB = 48 * MiB, WS_H = 80 * MiB, WS_ARENA = 144 * MiB, WS_END = 320 * MiB;
constexpr size_t WS_QKVPRE = 144 * MiB, WS_ZB = 192 * MiB, WS_QKVD = 208 * MiB, WS_MNEG = 80 * MiB, WS_BMT = 112 * MiB, WS_QEFF = 256 * MiB, WS_OLOCT = 272 * MiB;
constexpr size_t WS_OUN = 288 * MiB, WS_LSE = 304 * MiB, WS_OPART = 144 * MiB, WS_MIX = 256 * MiB;
constexpr size_t WS_MOEW_GU = 144 * MiB, WS_MOEW_D = 176 * MiB, WS_XG = 192 * MiB, WS_HACT = 264 * MiB;
constexpr size_t WS_MOEW_GU1 = 112 * MiB, WS_MOEW_D1 = 144 * MiB;
static_assert((size_t)MOE_ROWS * D * 2 <= 72 * MiB && (size_t)MOE_ROWS * DE * 2 <= 36 * MiB, "moe buffers");
constexpr size_t WS_INV = 256 * 1024;
constexpr int CW_TMO = 0, CW_BAR = 4096, CW_QUEUE = 64, CW_CNT0 = 128, CW_CNT1 = 192, CW_CVQ = 256, CW_G1DONE = 512;

constexpr int LDS_BYTES = 163840, MISC_OFF = 162816, XCH_OFF = 131072;

typedef __bf16 bf16x2_t __attribute__((ext_vector_type(2)));
__device__ __forceinline__ unsigned pk2(float lo, float hi) { const f32x2 v = {lo, hi}; const bf16x2_t b = __builtin_convertvector(v, bf16x2_t); return __builtin_bit_cast(unsigned, b); }
__device__ __forceinline__ unsigned f2bf(float f) { return pk2(f, f) & 0xffffu; }
__device__ __forceinline__ float bf2f(unsigned short b) { return __builtin_bit_cast(float, (unsigned)b << 16); }
__device__ __forceinline__ float bflo(unsigned w) { return __builtin_bit_cast(float, w << 16); }
__device__ __forceinline__ float bfhi(unsigned w) { return __builtin_bit_cast(float, w & 0xffff0000u); }
#define dpp_f(v, ctrl, row_mask) __int_as_float(__builtin_amdgcn_update_dpp(0, __float_as_int(v), (ctrl), (row_mask), 0xf, false))
__device__ __forceinline__ float wave_sum(float v) {
    v += dpp_f(v, 0xB1, 0xf); v += dpp_f(v, 0x4E, 0xf); v += dpp_f(v, 0x141, 0xf); v += dpp_f(v, 0x140, 0xf);
    v += dpp_f(v, 0x142, 0xa); v += dpp_f(v, 0x143, 0xc);
    return __int_as_float(__builtin_amdgcn_readlane(__float_as_int(v), 63));
}
template <class P> __device__ __forceinline__ P opq_v(P p) { asm volatile("" : "+v"(p)); return p; }
template <class P> __device__ __forceinline__ P opq_s(P p) { asm volatile("" : "+s"(p)); return p; }
__device__ __forceinline__ float silu_f(float x) { return x * __builtin_amdgcn_rcpf(1.f + __expf(-x)); }

namespace pg8 {
constexpr int BM = 256, BK = 64, HALF = 128, HTB = HALF * BK * 2, STAGE_BYTES = 8 * HTB;
__host__ __device__ __forceinline__ int lds_byte(int r, int c) { const int st = (r >> 4) * 2 + (c >> 5), rr = r & 15, cc = c & 31, ob = rr * 64 + cc * 2; return st * 1024 + (ob ^ (((ob >> 9) & 1) << 5)); }
__host__ __device__ __forceinline__ void stage_rc(int b, int& R, int& C) { const int st = b / 1024, sb = b % 1024, swz = sb ^ (((sb >> 9) & 1) << 5); R = (st >> 1) * 16 + swz / 64; C = (st & 1) * 32 + (swz % 64) / 2; }
__host__ __device__ __forceinline__ int perm32(int rho) { const int n = rho >> 4, i = rho & 15; return 8 * (i >> 2) + 4 * n + (i & 3); }

struct Unit { int pm, pn, aux; const char* a; const char* b; };
struct Gemm { int lda, ldb, K; };
__device__ __forceinline__ unsigned cvt_pk_bf16(float lo, float hi) { unsigned r; asm volatile("v_cvt_pk_bf16_f32 %0, %1, %2" : "=v"(r) : "v"(lo), "v"(hi)); return r; }

__device__ __forceinline__ void swz_tile(int L, int nM, int nN, int& pm, int& pn) {
    const int nwg = nM * nN; int wgid = L; { const int q = nwg / 8, r = nwg % 8, xcd = wgid % 8, off = wgid / 8; wgid = (xcd < r ? xcd * (q + 1) : r * (q + 1) + (xcd - r) * q) + off; }
    const int nig = 8 * nN, gid = wgid / nig, fm = gid * 8, gsz = (nM - fm) < 8 ? (nM - fm) : 8;
    pm = fm + ((wgid % nig) % gsz); pn = (wgid % nig) / gsz;
}

template <class Epi, class Sched>
__device__ __forceinline__ void gemm_phase(LAS unsigned char* lds, LAS unsigned char* xch, const Gemm g, const Sched& S, const Epi& E) {
    const int tid = opq_v((int)threadIdx.x), wid = __builtin_amdgcn_readfirstlane(tid >> 6), lane = tid & 63, wr = wid >> 2, wc = wid & 3, fr = lane & 15, fq = lane >> 4;
    const int K = g.K, nt = K / BK;
    unsigned voffA[2], voffB[2];
#pragma unroll
    for (int i = 0; i < 2; ++i) { int R, C; stage_rc(tid * 16 + i * 8192, R, C); const int Rb = Epi::PERM ? ((R & ~31) + perm32(R & 31)) : R;
        voffA[i] = (unsigned)(R * g.lda + C) * 2u; voffB[i] = (unsigned)(Rb * g.ldb + C) * 2u; }
    const size_t kstep = (size_t)(BK * 2);
    const size_t hstepA = Sched::GATHER ? (size_t)0 : (size_t)HALF * g.lda * 2, hstepB = (size_t)HALF * g.ldb * 2;
    unsigned vGc[2][2], vGn[2][2];
#pragma unroll
    for (int i = 0; i < 2; ++i) vGc[0][i] = vGc[1][i] = vGn[0][i] = vGn[1][i] = 0u;
#define PG8_GLOAD(dst, u_) do { if (Sched::GATHER) { _Pragma("unroll") for (int hh_ = 0; hh_ < 2; ++hh_) _Pragma("unroll") for (int i_ = 0; i_ < 2; ++i_) { int R_, C_; stage_rc(tid * 16 + i_ * 8192, R_, C_); \
        dst[hh_][i_] = (unsigned)S.row((u_), hh_ * HALF + R_) * (unsigned)(g.lda * 2) + (unsigned)C_ * 2u; } } } while (0)
    const unsigned ldsw = (unsigned)wid * 1024u;
    const int aoff = lds_byte(wr * 64 + fr, fq * 8), boff = lds_byte(wc * 32 + fr, fq * 8);
#define PG8_SA(b, h) (((b) * 2 + (h)) * HTB)
#define PG8_SB(b, h) ((4 + (b) * 2 + (h)) * HTB)
#define PG8_STAGE(bufoff, gbase, voff) do { _Pragma("unroll") for (int _i = 0; _i < 2; ++_i) \
        __builtin_amdgcn_global_load_lds((const unsigned*)((const char*)(gbase) + (voff)[_i]), (LAS unsigned*)(lds + (bufoff) + ldsw + _i * 8192), 16, 0, 0); } while (0)
#define PG8_STAGE_A(bufoff, gbase, hf, vg) do { if (Sched::GATHER) { PG8_STAGE(bufoff, gbase, vg[hf]); } else { PG8_STAGE(bufoff, (gbase) + (hf) * hstepA, voffA); } } while (0)
#define PG8_LDA(dst, b, h) do { _Pragma("unroll") for (int m = 0; m < 4; ++m) _Pragma("unroll") for (int k = 0; k < 2; ++k) dst[m][k] = *(const LAS bf16x8*)(lds + PG8_SA(b, h) + aoff + m * 2048 + k * 1024); } while (0)
#define PG8_LDB(dst, b, h) do { _Pragma("unroll") for (int n = 0; n < 2; ++n) _Pragma("unroll") for (int k = 0; k < 2; ++k) dst[n][k] = *(const LAS bf16x8*)(lds + PG8_SB(b, h) + boff + n * 2048 + k * 1024); } while (0)
#define PG8_MMA(ai, bj, At, Bt) do { __builtin_amdgcn_s_setprio(1); _Pragma("unroll") for (int m = 0; m < 4; ++m) _Pragma("unroll") for (int n = 0; n < 2; ++n) _Pragma("unroll") for (int k = 0; k < 2; ++k) \
        acc[ai][bj][m][n] = __builtin_amdgcn_mfma_f32_16x16x32_bf16(Bt[n][k], At[m][k], acc[ai][bj][m][n], 0, 0, 0); __builtin_amdgcn_s_setprio(0); } while (0)
#define PG8_WAIT_V(n) asm volatile("s_waitcnt vmcnt(" #n ")" ::: "memory")
#define PG8_WAIT_L(n) asm volatile("s_waitcnt lgkmcnt(" #n ")" ::: "memory")
#define PG8_BAR __builtin_amdgcn_s_barrier()
#define PG8_SCHED __builtin_amdgcn_sched_barrier(0)
    Unit cur, nxt; int ui = 0;
    if (!S.next(0, cur)) return;
    f32x4 acc[2][2][4][2];
#pragma unroll
    for (int a = 0; a < 2; ++a)
#pragma unroll
        for (int b = 0; b < 2; ++b)
#pragma unroll
            for (int m = 0; m < 4; ++m)
#pragma unroll
                for (int n = 0; n < 2; ++n) acc[a][b][m][n] = (f32x4){0.f, 0.f, 0.f, 0.f};
    bf16x8 At[4][2], B0[2][2], B1[2][2];
    const char* cA = cur.a; const char* cB = cur.b;
    PG8_GLOAD(vGc, cur);
    PG8_STAGE(PG8_SB(0, 0), cB, voffB); PG8_STAGE(PG8_SB(0, 1), cB + hstepB, voffB); PG8_STAGE_A(PG8_SA(0, 0), cA, 0, vGc); PG8_STAGE_A(PG8_SA(0, 1), cA, 1, vGc);
    if (wr == 1) PG8_BAR;
    PG8_WAIT_V(2); PG8_BAR;
    PG8_STAGE(PG8_SB(1, 0), cB + kstep, voffB); PG8_STAGE_A(PG8_SA(1, 0), cA + kstep, 0, vGc); PG8_STAGE(PG8_SB(1, 1), cB + hstepB + kstep, voffB);
    PG8_WAIT_V(6); PG8_BAR;
#pragma unroll 1
    for (;;) {
        const bool has_next = S.next(ui + 1, nxt);
        const char* nA = has_next ? nxt.a : cA; const char* nB = has_next ? nxt.b : cB;
        if (Sched::GATHER) { if (has_next) { PG8_GLOAD(vGn, nxt); } else {
#pragma unroll
                for (int hh_ = 0; hh_ < 2; ++hh_)
#pragma unroll
                    for (int i_ = 0; i_ < 2; ++i_) vGn[hh_][i_] = vGc[hh_][i_]; } }
#pragma unroll 1
        for (int t = 0; t < nt; t += 2) {
            const bool last = (t == nt - 2);
            const char* a1 = cA + (size_t)(t + 1) * kstep;
            const char* a2 = last ? nA : cA + (size_t)(t + 2) * kstep; const char* b2 = last ? nB : cB + (size_t)(t + 2) * kstep;
            const char* a3 = a2 + kstep; const char* b3 = b2 + kstep;
            unsigned v2[2][2];
#pragma unroll
            for (int hh_ = 0; hh_ < 2; ++hh_)
#pragma unroll
                for (int i_ = 0; i_ < 2; ++i_) v2[hh_][i_] = last ? vGn[hh_][i_] : vGc[hh_][i_];
            PG8_LDB(B0, 0, 0); PG8_LDB(B1, 0, 1); PG8_SCHED; PG8_LDA(At, 0, 0); PG8_STAGE_A(PG8_SA(1, 1), a1, 1, vGc);
            PG8_WAIT_V(8); PG8_WAIT_L(0); PG8_BAR; PG8_MMA(0, 0, At, B0); PG8_MMA(0, 1, At, B1); PG8_BAR; PG8_SCHED;
            PG8_LDA(At, 0, 1); PG8_STAGE(PG8_SB(0, 0), b2, voffB); PG8_STAGE(PG8_SB(0, 1), b2 + hstepB, voffB); PG8_STAGE_A(PG8_SA(0, 0), a2, 0, v2);
            PG8_WAIT_V(8); PG8_WAIT_L(0); PG8_BAR; PG8_MMA(1, 0, At, B0); PG8_MMA(1, 1, At, B1); PG8_BAR; PG8_SCHED;
            PG8_LDB(B0, 1, 0); PG8_LDB(B1, 1, 1); PG8_SCHED; PG8_LDA(At, 1, 0); PG8_STAGE_A(PG8_SA(0, 1), a2, 1, v2);
            PG8_WAIT_V(8); PG8_WAIT_L(0); PG8_BAR; PG8_MMA(0, 0, At, B0); PG8_MMA(0, 1, At, B1); PG8_BAR; PG8_SCHED;
            PG8_LDA(At, 1, 1); PG8_STAGE(PG8_SB(1, 0), b3, voffB); PG8_STAGE(PG8_SB(1, 1), b3 + hstepB, voffB); PG8_STAGE_A(PG8_SA(1, 0), a3, 0, v2);
            PG8_WAIT_V(8); PG8_WAIT_L(0); PG8_BAR; PG8_MMA(1, 0, At, B0); PG8_MMA(1, 1, At, B1); PG8_BAR; PG8_SCHED;
        }
        if (wr == 0) PG8_BAR;
        E(acc, cur, wr, wc, fr, fq, xch);
        if (!has_next) break;
#pragma unroll
        for (int a = 0; a < 2; ++a)
#pragma unroll
            for (int b = 0; b < 2; ++b)
#pragma unroll
                for (int m = 0; m < 4; ++m)
#pragma unroll
                    for (int n = 0; n < 2; ++n) acc[a][b][m][n] = (f32x4){0.f, 0.f, 0.f, 0.f};
        cur = nxt; cA = nA; cB = nB; ++ui;
#pragma unroll
        for (int hh_ = 0; hh_ < 2; ++hh_)
#pragma unroll
            for (int i_ = 0; i_ < 2; ++i_) vGc[hh_][i_] = vGn[hh_][i_];
        if (wr == 1) PG8_BAR;
    }
    PG8_WAIT_V(0);
    PG8_BAR;
#undef PG8_SA
#undef PG8_SB
#undef PG8_STAGE
#undef PG8_LDA
#undef PG8_STAGE_A
#undef PG8_GLOAD
#undef PG8_LDB
#undef PG8_MMA
#undef PG8_WAIT_V
#undef PG8_WAIT_L
#undef PG8_BAR
#undef PG8_SCHED
}

struct Dst { bf16* p; int ld; };
__device__ __forceinline__ void store_tile_bf16(const f32x4 (&acc)[2][2][4][2], const Dst d, float sc, int wr, int wc, int fr, int fq) {
    unsigned lane_off = (unsigned)((wr * 64 + fr) * d.ld + wc * 32 + 8 * fq);
    asm volatile("" : "+v"(lane_off));
#pragma unroll
    for (int ai = 0; ai < 2; ++ai)
#pragma unroll
        for (int m = 0; m < 4; ++m) { bf16* rowp = d.p + (size_t)lane_off + (size_t)((ai * HALF + m * 16) * d.ld);
#pragma unroll
            for (int bj = 0; bj < 2; ++bj) { const f32x4 v0 = acc[ai][bj][m][0] * sc, v1 = acc[ai][bj][m][1] * sc;
                u32x4 w; w.x = cvt_pk_bf16(v0[0], v0[1]); w.y = cvt_pk_bf16(v0[2], v0[3]); w.z = cvt_pk_bf16(v1[0], v1[1]); w.w = cvt_pk_bf16(v1[2], v1[3]);
                *(GAS u32x4*)(rowp + bj * HALF) = w; } }
}
}

#define XB_TMO      128
#define XB_XCNT(j)  (256  + 64 * (j))
#define XB_XSUB(j)  (1280 + 64 * (j))
#define XB_XGEN(j)  (2304 + 64 * (j))
#define XB_TOP      3328
#define XB_TOPGEN   3392
#define XCD_BAR_WORDS 3456
#define XB_SPIN_CAP (1u << 20)
__device__ __forceinline__ unsigned xb_ld(unsigned* p)              { return __hip_atomic_load(p, __ATOMIC_RELAXED, __HIP_MEMORY_SCOPE_AGENT); }
__device__ __forceinline__ unsigned xb_add(unsigned* p, unsigned v) { return __hip_atomic_fetch_add(p, v, __ATOMIC_RELAXED, __HIP_MEMORY_SCOPE_AGENT); }
__device__ __forceinline__ unsigned xb_xcc_id() { return (unsigned)__builtin_amdgcn_s_getreg((3 << 11) | 20) & 0xFu; }
#define XB_SPIN(cond, bar) do { unsigned _sp = 0; while (cond) { __builtin_amdgcn_s_sleep(1); \
    if ((++_sp & 255u) == 0u) { if (xb_ld(&(bar)[XB_TMO])) break; if (_sp > XB_SPIN_CAP) { atomicAdd(&(bar)[XB_TMO], 1u); break; } } } } while (0)
struct XcdBarrier { unsigned* bar; unsigned x; volatile LAS unsigned* st; };
__device__ __forceinline__ XcdBarrier xcd_barrier_post(unsigned* bar, volatile LAS unsigned* st) {
    XcdBarrier b; b.bar = bar; b.x = xb_xcc_id(); b.st = st;
    if (threadIdx.x == 0) (void)xb_add(&bar[XB_XCNT(b.x)], 1u);
    return b;
}
__device__ __forceinline__ void xcd_barrier_complete(unsigned* bar, unsigned x, unsigned& nloc, unsigned& nx) {
    const unsigned G = gridDim.x * gridDim.y * gridDim.z;
    unsigned sum, cnt, mine, sp = 0u;
    for (;;) {
        sum = 0u; cnt = 0u; mine = 0u;
#pragma unroll
        for (unsigned j = 0; j < 16; ++j) { const unsigned c = xb_ld(&bar[XB_XCNT(j)]); sum += c; cnt += (c > 0u) ? 1u : 0u; mine = (j == x) ? c : mine; }
        if (sum == G) break;
        __builtin_amdgcn_s_sleep(1);
        if ((++sp & 255u) == 0u) { if (xb_ld(&bar[XB_TMO])) break; if (sp > XB_SPIN_CAP) { atomicAdd(&bar[XB_TMO], 1u); break; } }
    }
    nloc = mine > 0u ? mine : 1u; nx = cnt > 0u ? cnt : 1u;
}
__device__ __forceinline__ void xcd_barrier(const XcdBarrier& b) {
    asm volatile("s_waitcnt vmcnt(0)" ::: "memory");
    __syncthreads();
    if (threadIdx.x == 0) {
        unsigned* bar = b.bar;
        __builtin_amdgcn_s_waitcnt(0);
        unsigned nloc = b.st[0], nx = b.st[1];
        if (nloc == 0u) { xcd_barrier_complete(bar, b.x, nloc, nx); b.st[0] = nloc; b.st[1] = nx; }
        const unsigned old = xb_add(&bar[XB_XSUB(b.x)], 1u);
        const unsigned gen = old / nloc;
        if (old + 1u == (gen + 1u) * nloc) {
            __builtin_amdgcn_fence(__ATOMIC_RELEASE, "agent");
            asm volatile("s_waitcnt vmcnt(0)" ::: "memory");
            const unsigned og = xb_add(&bar[XB_TOP], 1u);
            const unsigned tg = og / nx;
            if (og + 1u == (tg + 1u) * nx) xb_add(&bar[XB_TOPGEN], 1u);
            else XB_SPIN(xb_ld(&bar[XB_TOPGEN]) == tg, bar);
            __builtin_amdgcn_fence(__ATOMIC_ACQUIRE, "agent");
            xb_add(&bar[XB_XGEN(b.x)], 1u);
            asm volatile("s_waitcnt vmcnt(0)" ::: "memory");
        } else {
            XB_SPIN(xb_ld(&bar[XB_XGEN(b.x)]) == gen, bar);
            __builtin_amdgcn_fence(__ATOMIC_ACQUIRE, "agent");
            asm volatile("s_waitcnt vmcnt(0)" ::: "memory");
        }
    }
    __syncthreads();
}

struct Args { const float* in[21]; float* out; unsigned char* ws; int ph_lo, ph_hi; };
struct Frame {
    LAS unsigned char* lds;
    unsigned char* ws;
    gu32* ctl;
    int tid, lane, wave, G, gw, NGW;
};
#define WSP(T_, off) ((T_*)(F.ws + (off)))

__device__ __forceinline__ void tr_item(const float* W, int ldw, int k0, int c0, bf16* dst, int ldd, LAS float* scr, int lane) {
    const int r8 = lane >> 3, c4 = lane & 7;
#pragma unroll
    for (int it = 0; it < 8; ++it) { const int kk = it * 8 + r8; const f32x4 v = *(const GAS f32x4*)(W + (size_t)(k0 + kk) * ldw + c0 + 4 * c4);
        LAS float* s = scr + kk * 33 + 4 * c4; s[0] = v[0]; s[1] = v[1]; s[2] = v[2]; s[3] = v[3]; }
    LDS_WAIT(); asm volatile("" ::: "memory");
    const int c = lane & 7;
#pragma unroll
    for (int j = 0; j < 4; ++j) { const int n = (lane >> 3) + 8 * j; const LAS float* s = scr + (8 * c) * 33 + n;
        u32x4 o; o.x = pk2(s[0 * 33], s[1 * 33]); o.y = pk2(s[2 * 33], s[3 * 33]); o.z = pk2(s[4 * 33], s[5 * 33]); o.w = pk2(s[6 * 33], s[7 * 33]);
        *(GAS u32x4*)(dst + (size_t)n * ldd + k0 + 8 * c) = o; }
    LDS_WAIT(); asm volatile("" ::: "memory");
}
__device__ __forceinline__ void tr_matrix(Frame& F, const float* W, int K, int N, int ldw, bf16* dst, LAS float* scr, int it) {
    const int nblk = N / 32, kb = it / nblk, nb = it % nblk;
    tr_item(W, ldw, 64 * kb, 32 * nb, dst + (size_t)(32 * nb) * K, K, scr, F.lane);
}
__device__ __forceinline__ void p0_prologue(Frame& F, const Args& A) {
    LAS float* scr = (LAS float*)(F.lds + F.wave * 16384);
    constexpr int I_IN = 16 * 112, I_KV = 16 * 64;
    for (int it = F.gw; it < I_IN + 2 * I_KV; it += F.NGW) {
        int r = it;
        if (r < I_IN) { const int kb = r / 112, nb = r % 112;
            tr_item(A.in[2], AB_IN, 64 * kb, 32 * nb + (nb >= 64 ? 8 : 0), WSP(bf16, WS_W_IN) + (size_t)(32 * nb) * D, D, scr, F.lane); continue; } r -= I_IN;
        { const int l = r / I_KV; tr_matrix(F, A.in[12] + (size_t)l * D * 2 * D, D, 2 * D, 2 * D, WSP(bf16, WS_W_KV) + (size_t)l * 2 * D * D, scr, r % I_KV); }
    }
    __syncthreads();
    LAS float* wt = (LAS float*)F.lds;
    for (int i = F.tid; i < 8 * D; i += 512) { const int k = i >> 3, c = i & 7; wt[c * D + k] = A.in[2][(size_t)k * AB_IN + 2048 + c]; }
    __syncthreads();
    const float* x = A.in[0];
    float alg[4], dtb[4];
#pragma unroll
    for (int h = 0; h < 4; ++h) { alg[h] = -__expf(A.in[4][h]); dtb[h] = A.in[5][h]; }
    for (int m = F.gw; m < T; m += F.NGW) {
        const GAS f32x4* xr = (const GAS f32x4*)(x + (size_t)m * D) + F.lane;
        f32x4 v[4];
#pragma unroll
        for (int j = 0; j < 4; ++j) v[j] = xr[64 * j];
        GAS u32x2* o8 = (GAS u32x2*)(WSP(bf16, WS_HB) + (size_t)m * D) + F.lane;
#pragma unroll
        for (int j = 0; j < 4; ++j) { u32x2 w; w.x = pk2(v[j][0], v[j][1]); w.y = pk2(v[j][2], v[j][3]); o8[64 * j] = w; }
        float dot[8];
#pragma unroll
        for (int c = 0; c < 8; ++c) { float s = 0.f;
#pragma unroll
            for (int j = 0; j < 4; ++j) { const f32x4 w = *(const LAS f32x4*)(wt + c * D + 256 * j + 4 * F.lane); s += v[j][0] * w[0] + v[j][1] * w[1] + v[j][2] * w[2] + v[j][3] * w[3]; }
            dot[c] = wave_sum(s); }
        if (F.lane == 0) {
            f32x4 bo, go;
#pragma unroll
            for (int hq = 0; hq < 4; ++hq) { bo[hq] = 1.f / (1.f + __expf(-dot[hq])); const float xx = dot[4 + hq] + dtb[hq]; const float sp = xx > 20.f ? xx : log1pf(__expf(xx)); go[hq] = alg[hq] * sp; }
            *(GAS f32x4*)(WSP(float, WS_BETA) + (size_t)m * 4) = bo;
            *(GAS f32x4*)(WSP(float, WS_GG) + (size_t)m * 4) = go;
        }
    }
    for (int m = F.gw; m < TM; m += F.NGW) {
        const GAS f32x4* xr = (const GAS f32x4*)(A.in[1] + (size_t)m * D) + F.lane;
        GAS u32x2* o8 = (GAS u32x2*)(WSP(bf16, WS_MEMB) + (size_t)m * D) + F.lane;
#pragma unroll
        for (int j = 0; j < 4; ++j) { const f32x4 v = xr[64 * j]; u32x2 w; w.x = pk2(v[0], v[1]); w.y = pk2(v[2], v[3]); o8[64 * j] = w; }
    }
}
constexpr int MOE_I_GU = 16 * 32, MOE_I_D = 8 * 32;
__device__ __forceinline__ void convert_moe_q(Frame& F, const Args& A, int layer, int which  , bf16* dst, unsigned* qword, volatile LAS unsigned* MISC) {
    LAS float* scr = (LAS float*)(F.lds + F.wave * 16384);
    const int nitems = NE * (which == 0 ? MOE_I_GU : MOE_I_D);
    for (;;) {
        __syncthreads();
        if (F.tid == 0) MISC[21] = __hip_atomic_fetch_add(qword, 8u, RLX_AGENT);
        __syncthreads();
        const int it = (int)MISC[21] + F.wave;
        if ((int)MISC[21] >= nitems) break;
        if (it < nitems) {
            if (which == 0) { const int e = it / MOE_I_GU, r = it % MOE_I_GU, kb = r / 32, rb = r % 32, pn = rb >> 3, sub = rb & 7;
                const float* src = (sub < 4 ? A.in[16] : A.in[17]) + ((size_t)layer * NE + e) * D * DE;
                tr_item(src, DE, 64 * kb, 128 * pn + 32 * (sub & 3), dst + ((size_t)e * D + 32 * rb) * D, D, scr, F.lane);
            } else { const int e = it / MOE_I_D, r = it % MOE_I_D, kb = r / 32, nb = r % 32;
                tr_item(A.in[18] + ((size_t)layer * NE + e) * DE * D, D, 64 * kb, 32 * nb, dst + ((size_t)e * D + 32 * nb) * DE, DE, scr, F.lane); }
        }
    }
}

__device__ __forceinline__ void deferred_weights_q(Frame& F, const Args& A, unsigned* qword, volatile LAS unsigned* MISC) {
    LAS float* scr = (LAS float*)(F.lds + F.wave * 16384);
    constexpr int I_SQ = 16 * 32, I_SCI = 16 * 96, I_WQ = 2 * D / 4;
    constexpr int NITEMS = I_SQ + I_SCI + I_SQ + 2 * I_SQ + I_WQ;
    for (;;) {
        __syncthreads();
        if (F.tid == 0) MISC[21] = __hip_atomic_fetch_add(qword, 8u, RLX_AGENT);
        __syncthreads();
        if ((int)MISC[21] >= NITEMS) break;
        int r = (int)MISC[21] + F.wave;
        if (r >= NITEMS) continue;
        if (r < I_SQ) { tr_matrix(F, A.in[7], D, D, D, WSP(bf16, WS_W_ABO), scr, r); continue; } r -= I_SQ;
        if (r < I_SCI) { tr_matrix(F, A.in[8], D, 3 * D, 3 * D, WSP(bf16, WS_W_SCI), scr, r); continue; } r -= I_SCI;
        if (r < I_SQ) { tr_matrix(F, A.in[10], D, D, D, WSP(bf16, WS_W_SCO), scr, r); continue; } r -= I_SQ;
        if (r < 2 * I_SQ) { const int l = r / I_SQ; tr_matrix(F, A.in[13] + (size_t)l * D * D, D, D, D, WSP(bf16, WS_W_O) + (size_t)l * D * D, scr, r % I_SQ); continue; } r -= 2 * I_SQ;
        for (int q = 0; q < 4; ++q) { const int m = r * 4 + q;
            const GAS f32x4* xr = (const GAS f32x4*)(A.in[11] + (size_t)m * D) + F.lane; GAS u32x2* o8 = (GAS u32x2*)(WSP(bf16, WS_W_Q) + (size_t)m * D) + F.lane;
#pragma unroll
            for (int j = 0; j < 4; ++j) { const f32x4 v = xr[64 * j]; u32x2 w; w.x = pk2(v[0], v[1]); w.y = pk2(v[2], v[3]); o8[64 * j] = w; } }
    }
}

struct SchedDense {
    static constexpr bool GATHER = false; __device__ __forceinline__ int row(const pg8::Unit&, int) const { return 0; }
    const char* A; const char* B; int lda, ldb, nM, nN, G, c;
    __device__ __forceinline__ bool next(int i, pg8::Unit& u) const {
        const int L = i * G + c; if (L >= nM * nN) return false;
        pg8::swz_tile(L, nM, nN, u.pm, u.pn); u.aux = 0;
        u.a = A + (size_t)u.pm * 256 * lda * 2; u.b = B + (size_t)u.pn * 256 * ldb * 2; return true; }
};
struct EpiDense {
    static constexpr bool PERM = true;
    bf16* O; int ld; float sc;
    __device__ __forceinline__ void operator()(const f32x4 (&acc)[2][2][4][2], const pg8::Unit& u, int wr, int wc, int fr, int fq, LAS unsigned char*) const {
        pg8::store_tile_bf16(acc, pg8::Dst{O + (size_t)u.pm * 256 * ld + u.pn * 256, ld}, sc, wr, wc, fr, fq); }
};
struct SchedP1 {
    static constexpr bool GATHER = false; __device__ __forceinline__ int row(const pg8::Unit&, int) const { return 0; }
    const char* XB; const char* WIN; const char* MEMB; const char* WKV; int G, c;
    __device__ __forceinline__ bool next(int i, pg8::Unit& u) const {
        const int L = i * G + c; if (L >= 896 + 64) return false;
        if (L < 896) { pg8::swz_tile(L, 64, 14, u.pm, u.pn); u.aux = 0; u.a = XB + (size_t)u.pm * 256 * D * 2; u.b = WIN + (size_t)u.pn * 256 * D * 2; }
        else { const int r = L - 896, l = r >> 5; u.pm = (r & 31) >> 3; u.pn = r & 7; u.aux = 1 + l; u.a = MEMB + (size_t)u.pm * 256 * D * 2; u.b = WKV + ((size_t)l * 2 * D + u.pn * 256) * D * 2; }
        return true; }
};
struct EpiP1 {
    static constexpr bool PERM = true;
    bf16 *QKVPRE, *ZB, *QKVD, *KMEM, *VT;
    __device__ __forceinline__ void operator()(const f32x4 (&acc)[2][2][4][2], const pg8::Unit& u, int wr, int wc, int fr, int fq, LAS unsigned char*) const {
        if (u.aux == 0) {
            pg8::Dst d;
            if (u.pn < 6) d = pg8::Dst{QKVPRE + (size_t)u.pm * 256 * 1536 + u.pn * 256, 1536};
            else if (u.pn < 8) d = pg8::Dst{ZB + (size_t)u.pm * 256 * 512 + (u.pn - 6) * 256, 512};
            else d = pg8::Dst{QKVD + (size_t)u.pm * 256 * 1536 + (u.pn - 8) * 256, 1536};
            pg8::store_tile_bf16(acc, d, (u.pn == 8 || u.pn == 9) ? 0.125f * 1.4426950408889634f : 1.f, wr, wc, fr, fq);
        } else {
            const int l = u.aux - 1;
            if (u.pn < 4) pg8::store_tile_bf16(acc, pg8::Dst{KMEM + ((size_t)l * TM + u.pm * 256) * D + u.pn * 256, D}, 1.f, wr, wc, fr, fq);
            else pg8::store_tile_bf16(acc, pg8::Dst{VT + ((size_t)l * TM + u.pm * 256) * D + (u.pn - 4) * 256, D}, 1.f, wr, wc, fr, fq);
        }
    }
};
struct SchedPrep {
    static constexpr bool GATHER = false; __device__ __forceinline__ int row(const pg8::Unit&, int) const { return 0; }
    const char* KM; const char* WQO; const char* WOT; const char* VM; int G, c;
    __device__ __forceinline__ bool next(int i, pg8::Unit& u) const {
        const int L = i * G + c; if (L >= 256) return false;
        const int l = L >> 7, r = L & 127, kind = r >> 6, q = r & 63, bh = q >> 2, t4 = q & 3, b = bh >> 2, hd = bh & 3;
        u.aux = L; u.pm = 0; u.pn = 0;
        if (kind == 0) { u.a = KM + (((size_t)(l * NB + b) * NMEM) * D + hd * XD) * 2; u.b = WQO + (((size_t)l * D + t4 * 256) * D + hd * XD) * 2; }
        else           { u.a = WOT + (((size_t)l * D + t4 * 256) * D + hd * XD) * 2; u.b = VM + (((size_t)(l * NB + b) * NMEM) * D + hd * XD) * 2; }
        return true; }
};
struct EpiPrep {
    static constexpr bool PERM = true;
    bf16 *MT, *VWT;
    __device__ __forceinline__ void operator()(const f32x4 (&acc)[2][2][4][2], const pg8::Unit& u, int wr, int wc, int fr, int fq, LAS unsigned char*) const {
        const int L = u.aux, l = L >> 7, r = L & 127, kind = r >> 6, q = r & 63, bh = q >> 2, t4 = q & 3, b = bh >> 2, hd = bh & 3;
        if (kind == 0) pg8::store_tile_bf16(acc, pg8::Dst{MT + ((size_t)(l * NB + b) * D + hd * XD) * D + t4 * 256, D}, 0.0625f * 1.4426950408889634f, wr, wc, fr, fq);
        else           pg8::store_tile_bf16(acc, pg8::Dst{VWT + ((size_t)(l * NB + b) * D + t4 * 256) * D + hd * XD, D}, 1.f, wr, wc, fr, fq);
    }
};
struct SchedXB {
    static constexpr bool GATHER = false; __device__ __forceinline__ int row(const pg8::Unit&, int) const { return 0; }
    const char* AB; const char* BB; int G, c;
    __device__ __forceinline__ bool next(int i, pg8::Unit& u) const {
        const int L = i * G + c; if (L >= 256) return false;
        u.pm = L >> 2; u.pn = L & 3; u.aux = 0;
        u.a = AB + (size_t)u.pm * 256 * D * 2; u.b = BB + ((size_t)(u.pm >> 4) * D + u.pn * 256) * D * 2; return true; }
};
struct EpiSoftmax {
    static constexpr bool PERM = true;
    bf16* P;
    __device__ __forceinline__ void operator()(f32x4 (&acc)[2][2][4][2], const pg8::Unit& u, int wr, int wc, int fr, int fq, LAS unsigned char* xch) const {
        LAS float* MX = opq_v((LAS float*)xch + (wr * 64 + fr) * 4);
        LAS float* SM = MX + 1024;
#pragma unroll
        for (int ai = 0; ai < 2; ++ai)
#pragma unroll
            for (int m = 0; m < 4; ++m) { float v = -3.0e38f;
#pragma unroll
                for (int bj = 0; bj < 2; ++bj)
#pragma unroll
                    for (int n = 0; n < 2; ++n) { const f32x4 x = acc[ai][bj][m][n]; v = fmaxf(v, fmaxf(fmaxf(x[0], x[1]), fmaxf(x[2], x[3]))); }
                v = fmaxf(v, __shfl_xor(v, 16)); v = fmaxf(v, __shfl_xor(v, 32));
                if (fq == 0) MX[(ai * 128 + m * 16) * 4 + wc] = v; }
        LDS_WAIT(); __builtin_amdgcn_s_barrier(); asm volatile("" ::: "memory");
#pragma unroll
        for (int ai = 0; ai < 2; ++ai)
#pragma unroll
            for (int m = 0; m < 4; ++m) { float s = 0.f; const f32x4 q = *(const LAS f32x4*)(MX + (ai * 128 + m * 16) * 4); const float mxr = fmaxf(fmaxf(q[0], q[1]), fmaxf(q[2], q[3]));
#pragma unroll
                for (int bj = 0; bj < 2; ++bj)
#pragma unroll
                    for (int n = 0; n < 2; ++n) { f32x4 x = acc[ai][bj][m][n];
#pragma unroll
                        for (int e = 0; e < 4; ++e) { x[e] = __builtin_amdgcn_exp2f(x[e] - mxr); s += x[e]; }
                        acc[ai][bj][m][n] = x; }
                s += __shfl_xor(s, 16); s += __shfl_xor(s, 32);
                if (fq == 0) SM[(ai * 128 + m * 16) * 4 + wc] = s; asm volatile("" ::: "memory"); }
        LDS_WAIT(); __builtin_amdgcn_s_barrier(); asm volatile("" ::: "memory");
        unsigned lane_off = (unsigned)((wr * 64 + fr) * D + wc * 32 + 8 * fq);
        asm volatile("" : "+v"(lane_off));
        bf16* base = P + (size_t)u.pm * 256 * D + u.pn * XD + lane_off;
#pragma unroll
        for (int ai = 0; ai < 2; ++ai)
#pragma unroll
            for (int m = 0; m < 4; ++m) { const f32x4 q = *(const LAS f32x4*)(SM + (ai * 128 + m * 16) * 4); const float inv = 1.f / ((q[0] + q[1]) + (q[2] + q[3]));
                bf16* rowp = base + (size_t)((ai * 128 + m * 16) * D);
#pragma unroll
                for (int bj = 0; bj < 2; ++bj) { const f32x4 v0 = acc[ai][bj][m][0] * inv, v1 = acc[ai][bj][m][1] * inv;
                    u32x4 w; w.x = pg8::cvt_pk_bf16(v0[0], v0[1]); w.y = pg8::cvt_pk_bf16(v0[2], v0[3]); w.z = pg8::cvt_pk_bf16(v1[0], v1[1]); w.w = pg8::cvt_pk_bf16(v1[2], v1[3]);
                    *(GAS u32x4*)(rowp + bj * 128) = w; } asm volatile("" ::: "memory"); }
        LDS_WAIT(); __builtin_amdgcn_s_barrier(); asm volatile("" ::: "memory");
    }
};
template <bool G_> struct SchedMoE {
    static constexpr bool GATHER = G_;
    const char* Aall; const char* Wall; volatile LAS unsigned* tab; const int* rowmap; int lda, wrows  , ldb, G, c;
    __device__ __forceinline__ int row(const pg8::Unit& u, int r) const { return ((const GAS int*)rowmap)[u.pm * 256 + r]; }
    __device__ __forceinline__ bool next(int i, pg8::Unit& u) const {
        const int L = i * G + c; const int ntile = __builtin_amdgcn_readfirstlane((int)tab[16]); if (L >= ntile * 4) return false;
        u.pm = L >> 2; u.pn = L & 3; const int e = __builtin_amdgcn_readfirstlane((int)tab[32 + u.pm]);
        u.aux = e; u.a = G_ ? Aall : Aall + (size_t)u.pm * 256 * lda * 2; u.b = Wall + ((size_t)e * wrows + u.pn * 256) * ldb * 2; return true; }
};
struct EpiSwiglu {
    static constexpr bool PERM = true;
    bf16* HACT; unsigned* done; int twoG;
    __device__ __forceinline__ void operator()(const f32x4 (&acc)[2][2][4][2], const pg8::Unit& u, int wr, int wc, int fr, int fq, LAS unsigned char*) const {
#pragma unroll
        for (int ai = 0; ai < 2; ++ai)
#pragma unroll
            for (int m = 0; m < 4; ++m) { bf16* rowp = HACT + (size_t)(u.pm * 256 + ai * 128 + wr * 64 + m * 16 + fr) * DE + u.pn * 128 + wc * 32 + 8 * fq;
                float h[8];
#pragma unroll
                for (int n = 0; n < 2; ++n)
#pragma unroll
                    for (int e = 0; e < 4; ++e) { const float gt = acc[ai][0][m][n][e], up = acc[ai][1][m][n][e]; h[n * 4 + e] = silu_f(gt) * up; }
                u32x4 w; w.x = pg8::cvt_pk_bf16(h[0], h[1]); w.y = pg8::cvt_pk_bf16(h[2], h[3]); w.z = pg8::cvt_pk_bf16(h[4], h[5]); w.w = pg8::cvt_pk_bf16(h[6], h[7]);
                if (done) asm volatile("global_store_dwordx4 %0, %1, off sc1\n\ts_nop 1" :: "v"((GAS u32x4*)rowp), "v"(w) : "memory");
                else *(GAS u32x4*)rowp = w; }
        if (done) {
            asm volatile("s_waitcnt vmcnt(0)" ::: "memory"); __builtin_amdgcn_s_barrier(); asm volatile("" ::: "memory");
            if (threadIdx.x == 0) __hip_atomic_fetch_add(done + ((u.pm * 4 + u.pn) < twoG ? 0 : 64), 1u, __ATOMIC_RELAXED, __HIP_MEMORY_SCOPE_AGENT);
        }
    }
};
struct SchedMoE2 {
    static constexpr bool GATHER = false; __device__ __forceinline__ int row(const pg8::Unit&, int) const { return 0; }
    const char* Aall; const char* Wall; volatile LAS unsigned* tab; int G, c;
    __device__ __forceinline__ bool next(int i, pg8::Unit& u) const {
        const int n = 4 * __builtin_amdgcn_readfirstlane((int)tab[16]), G2 = 2 * G, H = n > G2 ? n - G2 : 0; int L;
        if (c < H) { if (i > 0) return false; L = G2 + c; } else { L = (c - H) + i * (G - H); if (L >= (n < G2 ? n : G2)) return false; }
        u.pm = L >> 2; u.pn = L & 3; const int e = __builtin_amdgcn_readfirstlane((int)tab[32 + u.pm]);
        u.aux = e; u.a = Aall + (size_t)u.pm * 256 * DE * 2; u.b = Wall + ((size_t)e * D + u.pn * 256) * DE * 2; return true; }
};
__device__ __forceinline__ void moe_wait_gemm1(Frame& F, unsigned* done, volatile LAS unsigned* tab, int G, int c) {
    if (F.tid == 0) {
        const unsigned n = 4u * tab[16], G2 = 2u * (unsigned)G, needA = n < G2 ? n : G2, H = n > G2 ? n - G2 : 0u; const bool heavy = (unsigned)c < H;
        unsigned sp = 0;
        while (__hip_atomic_load(done, RLX_AGENT) < needA || (heavy && __hip_atomic_load(done + 64, RLX_AGENT) < H)) { __builtin_amdgcn_s_sleep(2); if (++sp > (1u << 22)) break; }
        __builtin_amdgcn_fence(__ATOMIC_ACQUIRE, "agent");
        asm volatile("s_waitcnt vmcnt(0)" ::: "memory");
    }
    __syncthreads();
}


struct Route { int e0, e1, r0, r1; float w0, w1; int s0, s1; };
template <int MODE, bool ROUTER, bool FINAL, bool DRY = false>
__device__ __forceinline__ void ln_pass(Frame& F, const Args& A, const bf16* hold, const bf16* Y, int li  , float* hnew  , bf16* hb, unsigned* cnt) {
    const float* gam = A.in[19] + (size_t)li * D; const float* bet = A.in[20] + (size_t)li * D;
    f32x4 gv[4], bv[4];
#pragma unroll
    for (int j = 0; j < 4; ++j) { gv[j] = *(const GAS f32x4*)(gam + 256 * j + 4 * F.lane); bv[j] = *(const GAS f32x4*)(bet + 256 * j + 4 * F.lane); }
    LAS float* rw = (LAS float*)F.lds;
    LAS int* sel = (LAS int*)(F.lds + 65536);
    LAS float* selw = (LAS float*)(F.lds + 65536 + 1024);
    if (ROUTER) { for (int i = F.tid; i < NE * D; i += 512) { const int k = i >> 4, e = i & 15; rw[e * D + k] = A.in[14][i]; } __syncthreads(); }
    Route* route = WSP(Route, WS_ROUTE);
    const int nblk = T / 64;
    for (int blk = blockIdx.x; blk < nblk; blk += F.G) {
        u32x2 hn[4]; u32x2 ya[4], yb[4]; float rw0 = 0.f, rw1 = 0.f;
#define LN_LOAD(mrow) do { const int m_ = (mrow); \
            _Pragma("unroll") for (int j = 0; j < 4; ++j) hn[j] = *((const GAS u32x2*)(hold + (size_t)m_ * D) + F.lane + 64 * j); \
            if (MODE == 0) { _Pragma("unroll") for (int j = 0; j < 4; ++j) ya[j] = *((const GAS u32x2*)(Y + (size_t)m_ * D) + F.lane + 64 * j); } \
            else { const Route r_ = route[m_]; rw0 = r_.w0; rw1 = r_.w1; \
                _Pragma("unroll") for (int j = 0; j < 4; ++j) { ya[j] = *((const GAS u32x2*)(Y + (size_t)r_.s0 * D) + F.lane + 64 * j); yb[j] = *((const GAS u32x2*)(Y + (size_t)r_.s1 * D) + F.lane + 64 * j); } } } while (0)
        LN_LOAD(blk * 64 + F.wave * 8);
#pragma unroll 1
        for (int rr = 0; rr < 8; ++rr) {
            const int m = blk * 64 + F.wave * 8 + rr;
            f32x4 v[4];
#pragma unroll
            for (int j = 0; j < 4; ++j) { v[j][0] = bflo(hn[j].x) * ALPHA; v[j][1] = bfhi(hn[j].x) * ALPHA; v[j][2] = bflo(hn[j].y) * ALPHA; v[j][3] = bfhi(hn[j].y) * ALPHA; }
            if (MODE == 0) {
#pragma unroll
                for (int j = 0; j < 4; ++j) { const u32x2 w = ya[j]; v[j][0] += bflo(w.x); v[j][1] += bfhi(w.x); v[j][2] += bflo(w.y); v[j][3] += bfhi(w.y); }
            } else {
#pragma unroll
                for (int j = 0; j < 4; ++j) { const u32x2 w0 = ya[j], w1 = yb[j];
                    v[j][0] += rw0 * bflo(w0.x) + rw1 * bflo(w1.x); v[j][1] += rw0 * bfhi(w0.x) + rw1 * bfhi(w1.x); v[j][2] += rw0 * bflo(w0.y) + rw1 * bflo(w1.y); v[j][3] += rw0 * bfhi(w0.y) + rw1 * bfhi(w1.y); }
            }
            if (rr < 7) LN_LOAD(m + 1);
            float s = 0.f;
#pragma unroll
            for (int j = 0; j < 4; ++j) s += (v[j][0] + v[j][1]) + (v[j][2] + v[j][3]);
            const float mean = wave_sum(s) * (1.f / D); float s2 = 0.f;
#pragma unroll
            for (int j = 0; j < 4; ++j) { v[j] = v[j] - mean; s2 += (v[j][0] * v[j][0] + v[j][1] * v[j][1]) + (v[j][2] * v[j][2] + v[j][3] * v[j][3]); }
            const float rstd = 1.f / sqrtf(wave_sum(s2) * (1.f / D) + LN_EPS);
#pragma unroll
            for (int j = 0; j < 4; ++j) v[j] = v[j] * rstd * gv[j] + bv[j];
            if (FINAL) {
#pragma unroll
                for (int j = 0; j < 4; ++j) *((GAS f32x4*)(hnew + (size_t)m * D) + F.lane + 64 * j) = v[j];
            } else {
#pragma unroll
                for (int j = 0; j < 4; ++j) { u32x2 w; w.x = pk2(v[j][0], v[j][1]); w.y = pk2(v[j][2], v[j][3]); *((GAS u32x2*)(hb + (size_t)m * D) + F.lane + 64 * j) = w; }
            }
            if (ROUTER) {
                float lg[16];
#pragma unroll
                for (int e = 0; e < 16; ++e) { float d = 0.f;
#pragma unroll
                    for (int j = 0; j < 4; ++j) { const f32x4 w = *(const LAS f32x4*)(rw + e * D + 256 * j + 4 * F.lane); d += v[j][0] * w[0] + v[j][1] * w[1] + v[j][2] * w[2] + v[j][3] * w[3]; }
                    lg[e] = wave_sum(d); }
                float mxl = lg[0];
#pragma unroll
                for (int e = 1; e < 16; ++e) mxl = fmaxf(mxl, lg[e]);
                float sc[16], se = 0.f;
#pragma unroll
                for (int e = 0; e < 16; ++e) { sc[e] = __expf(lg[e] - mxl); se += sc[e]; }
                const float inv = 1.f / se; float sl[16];
#pragma unroll
                for (int e = 0; e < 16; ++e) { sc[e] *= inv; sl[e] = sc[e] + A.in[15][e]; }
                int bg = 0; float bgs = -3.0e38f;
#pragma unroll
                for (int g4 = 0; g4 < 4; ++g4) { const float a = sl[4 * g4], b = sl[4 * g4 + 1], c = sl[4 * g4 + 2], d = sl[4 * g4 + 3];
                    const float hi1 = fmaxf(a, b), lo1 = fminf(a, b), hi2 = fmaxf(c, d), lo2 = fminf(c, d);
                    const float top = fmaxf(hi1, hi2), second = fmaxf(fminf(hi1, hi2), fmaxf(lo1, lo2)); const float gs = top + second;
                    if (gs > bgs) { bgs = gs; bg = g4; } }
                float s4[4], c4[4];
#pragma unroll
                for (int q = 0; q < 4; ++q) { s4[q] = bg == 0 ? sl[q] : bg == 1 ? sl[4 + q] : bg == 2 ? sl[8 + q] : sl[12 + q]; c4[q] = bg == 0 ? sc[q] : bg == 1 ? sc[4 + q] : bg == 2 ? sc[8 + q] : sc[12 + q]; }
                int i0 = 0; float b0 = s4[0];
#pragma unroll
                for (int q = 1; q < 4; ++q) if (s4[q] > b0) { b0 = s4[q]; i0 = q; }
                int i1 = -1; float b1 = -3.0e38f;
#pragma unroll
                for (int q = 0; q < 4; ++q) if (q != i0 && s4[q] > b1) { b1 = s4[q]; i1 = q; }
                const float p0 = i0 == 0 ? c4[0] : i0 == 1 ? c4[1] : i0 == 2 ? c4[2] : c4[3];
                const float p1 = i1 == 0 ? c4[0] : i1 == 1 ? c4[1] : i1 == 2 ? c4[2] : c4[3];
                if (F.lane == 0) { const int tk = F.wave * 8 + rr; sel[tk * 4 + 0] = bg * 4 + i0; sel[tk * 4 + 1] = bg * 4 + i1; selw[tk * 2 + 0] = p0 / (p0 + p1); selw[tk * 2 + 1] = p1 / (p0 + p1); }
            }
        }
        if (ROUTER) {
            __syncthreads();
            if (F.wave == 0) {
                const int e0 = sel[F.lane * 4 + 0], e1 = sel[F.lane * 4 + 1];
                const unsigned long long lt = (1ull << F.lane) - 1ull;
                int r0 = 0, r1 = 0, mycount = 0;
#pragma unroll
                for (int e = 0; e < 16; ++e) { const unsigned long long m0 = __ballot(e0 == e), m1 = __ballot(e1 == e);
                    const int before = __popcll(m0 & lt) + __popcll(m1 & lt);
                    if (e0 == e) r0 = before; if (e1 == e) r1 = before;
                    if (F.lane == e) mycount = __popcll(m0) + __popcll(m1); }
                int base = 0; if (F.lane < 16 && mycount > 0 && !DRY) base = (int)atomicAdd(cnt + F.lane, (unsigned)mycount);
                sel[F.lane * 4 + 2] = r0 + __shfl(base, e0); sel[F.lane * 4 + 3] = r1 + __shfl(base, e1);
            }
            __syncthreads();
            if (F.tid < 64) { Route r; r.e0 = sel[F.tid * 4 + 0]; r.e1 = sel[F.tid * 4 + 1]; r.r0 = sel[F.tid * 4 + 2]; r.r1 = sel[F.tid * 4 + 3]; r.w0 = selw[F.tid * 2 + 0]; r.w1 = selw[F.tid * 2 + 1]; r.s0 = 0; r.s1 = 0; if (!DRY) route[blk * 64 + F.tid] = r; }
            __syncthreads();
        }
    }
}
__device__ __forceinline__ void moe_table(Frame& F, const unsigned* cnt, volatile LAS unsigned* tab) {
    if (F.tid == 0) { unsigned t = 0; for (int e = 0; e < 16; ++e) { tab[e] = t; t += (__hip_atomic_load(cnt + e, RLX_AGENT) + 255u) >> 8; } tab[16] = t; }
    __syncthreads();
    if (F.tid < 144) { unsigned e = 0; for (int j = 1; j < 16; ++j) e += (tab[j] <= (unsigned)F.tid) ? 1u : 0u; tab[32 + F.tid] = e; }
    __syncthreads();
}
__device__ __forceinline__ void moe_slots(Frame& F, volatile LAS unsigned* tab, int* inv) {
    Route* route = WSP(Route, WS_ROUTE);
    for (int m = blockIdx.x * 512 + F.tid; m < T; m += F.G * 512) {
        const Route r = route[m];
        const int s0 = (int)tab[r.e0] * 256 + r.r0, s1 = (int)tab[r.e1] * 256 + r.r1;
        route[m].s0 = s0; route[m].s1 = s1; inv[s0] = m; inv[s1] = m;
    }
}

__device__ __forceinline__ void conv_pass(Frame& F, const Args& A, const bf16* prj, bf16* ub) {
    const float* cw = A.in[9];
    for (int it = F.gw; it < (T / 16) * 2; it += F.NGW) {
        const int tb = it >> 1, c0 = (it & 1) * 512 + F.lane * 8; const int t0 = tb * 16, pos0 = t0 % SEQ;
        float w[3][8];
#pragma unroll
        for (int j = 0; j < 3; ++j) { const f32x4 a = *(const GAS f32x4*)(cw + j * D + c0), b = *(const GAS f32x4*)(cw + j * D + c0 + 4);
#pragma unroll
            for (int e = 0; e < 4; ++e) { w[j][e] = a[e]; w[j][4 + e] = b[e]; } }
        float p2[8], p1[8];
#pragma unroll
        for (int e = 0; e < 8; ++e) { p2[e] = 0.f; p1[e] = 0.f; }
#pragma unroll
        for (int q = 0; q < 2; ++q) { if (pos0 - 2 + q >= 0) { const bf16* r = prj + (size_t)(t0 - 2 + q) * 3072;
                const u32x4 gc = *(const GAS u32x4*)(r + 1024 + c0), hd = *(const GAS u32x4*)(r + 2048 + c0);
#pragma unroll
                for (int e = 0; e < 4; ++e) { const float lo = bflo(gc[e]) * bflo(hd[e]), hi = bfhi(gc[e]) * bfhi(hd[e]); if (q == 0) { p2[2 * e] = lo; p2[2 * e + 1] = hi; } else { p1[2 * e] = lo; p1[2 * e + 1] = hi; } } } }
#pragma unroll 4
        for (int tt = 0; tt < 16; ++tt) { const bf16* r = prj + (size_t)(t0 + tt) * 3072;
            const u32x4 gb = *(const GAS u32x4*)(r + c0), gc = *(const GAS u32x4*)(r + 1024 + c0), hd = *(const GAS u32x4*)(r + 2048 + c0);
            float p0[8], o[8];
#pragma unroll
            for (int e = 0; e < 4; ++e) { p0[2 * e] = bflo(gc[e]) * bflo(hd[e]); p0[2 * e + 1] = bfhi(gc[e]) * bfhi(hd[e]); }
#pragma unroll
            for (int e = 0; e < 8; ++e) { const float cv = w[0][e] * p2[e] + w[1][e] * p1[e] + w[2][e] * p0[e]; const float g = (e & 1) ? bfhi(gb[e >> 1]) : bflo(gb[e >> 1]); o[e] = g * cv; p2[e] = p1[e]; p1[e] = p0[e]; }
            u32x4 wv; wv.x = pk2(o[0], o[1]); wv.y = pk2(o[2], o[3]); wv.z = pk2(o[4], o[5]); wv.w = pk2(o[6], o[7]);
            *(GAS u32x4*)(ub + (size_t)(t0 + tt) * D + c0) = wv; }
    }
}

constexpr int D1_QB = 0, D1_KB = 17408, D1_E = D1_KB, D1_AT = 34816, D1_KT = 44032, D1_RT = 62464, D1_P = 99328, D1_PT = D1_P + 9216, D1_ET = D1_PT + 9216, D1_UW = D1_P, D1_GC = 136192;
constexpr int RSB = 272, RSS = 144;
static_assert(D1_GC + 2 * 256 <= MISC_OFF && D1_UW + 36864 <= D1_GC && D1_RT + 3 * 67 * 272 <= D1_ET, "D1 LDS");
__device__ __forceinline__ f32x4 tile_k64(const LAS unsigned char* xr, const LAS unsigned char* yr, f32x4 acc) {
#pragma unroll
    for (int s = 0; s < 2; ++s) acc = __builtin_amdgcn_mfma_f32_16x16x32_bf16(*(const LAS bf16x8*)(xr + 64 * s), *(const LAS bf16x8*)(yr + 64 * s), acc, 0, 0, 0);
    return acc;
}
template <int VAR> __device__ __forceinline__ void d1_unit(Frame& F, const Args& A, int unit) {
    if (VAR == 4) return;
    const int bh = unit >> 6, n = unit & 63, b = bh >> 2, h = bh & 3;
    const int t0 = b * SEQ + n * 64;
    const int lane = F.lane, wave = F.wave, g = lane >> 4, c = lane & 15;
    LAS unsigned char* L = F.lds;
    LAS unsigned char* L0 = opq_v(L); LAS unsigned char* L1 = opq_v(L + D1_RT); LAS unsigned char* L2 = opq_v(L + D1_P);
    LAS float* gcs = (LAS float*)(L2 + (D1_GC - D1_P)); LAS float* betas = gcs + 64;
    LAS unsigned char* LQB = L0 + D1_QB; LAS unsigned char* LKB = L0 + D1_KB; LAS unsigned char* LAT = L0 + D1_AT; LAS unsigned char* LKT = L0 + D1_KT;
    LAS unsigned char* LRT = L1; LAS unsigned char* LP = L2; LAS unsigned char* LPT = L2 + 9216; LAS unsigned char* LET = L2 + 18432;
    LAS unsigned char* LUW = L2; LAS unsigned char* LE = L0 + D1_E;
    const int i = lane;
    float gc = ((const GAS float*)WSP(float, WS_GG))[(size_t)(t0 + lane) * 4 + h];
    const float bt = ((const GAS float*)WSP(float, WS_BETA))[(size_t)(t0 + lane) * 4 + h];
    int wvb[3];
    LAS unsigned char* RAW = L1;
    {
        const bf16* pre = WSP(bf16, WS_QKVPRE);
        const float* cwp = A.in[3];
#pragma unroll
        for (int x = 0; x < 3; ++x) wvb[x] = __float_as_int(((const GAS float*)cwp)[(lane >> 4) * 1536 + x * 512 + h * 128 + 16 * wave + (lane & 15)]);
        u32x4 rv[7];
#pragma unroll
        for (int k = 0; k < 7; ++k) { int p = F.tid + 512 * k; p = p < 3216 ? p : 3215; const int x = p / 1072, rem = p - x * 1072, row = rem >> 4, pc = rem & 15;
            const bool okr = (n * 64 - 3 + row >= 0); const int rowi = okr ? (t0 - 3 + row) : t0;
            rv[k] = *(const GAS u32x4*)(pre + (size_t)rowi * 1536 + x * 512 + h * 128 + pc * 8); if (!okr) rv[k] = (u32x4){0u, 0u, 0u, 0u}; }
#pragma unroll
        for (int k = 0; k < 7; ++k) { const int p = F.tid + 512 * k; if (p < 3216) { const int x = p / 1072, rem = p - x * 1072, row = rem >> 4, pc = rem & 15; *(LAS u32x4*)(RAW + (x * 67 + row) * RSB + pc * 16) = rv[k]; } }
    }
    __syncthreads();
#pragma unroll
    for (int o = 1; o < 64; o <<= 1) { const float t = __shfl_up(gc, o); if (lane >= o) gc += t; }
    const float gc63 = __shfl(gc, 63);
    if (wave == 0) { gcs[lane] = gc; betas[lane] = bt; }
    {
        float ov[3][16];
#pragma unroll
        for (int x = 0; x < 3; ++x) {
#define RL(k) __int_as_float(__builtin_amdgcn_readlane(wvb[x], (k)))
            float acc[16];
#pragma unroll
            for (int e = 0; e < 16; ++e) acc[e] = 0.f;
#pragma unroll
            for (int j = 0; j < 4; ++j) {
                const u32x4 r0 = *(const LAS u32x4*)(RAW + (x * 67 + i + j) * RSB + 32 * wave), r1 = *(const LAS u32x4*)(RAW + (x * 67 + i + j) * RSB + 32 * wave + 16);
#pragma unroll
                for (int e = 0; e < 4; ++e) { const float w0 = RL(j * 16 + 2 * e), w1 = RL(j * 16 + 2 * e + 1), w2 = RL(j * 16 + 8 + 2 * e), w3 = RL(j * 16 + 8 + 2 * e + 1);
                    acc[2 * e] += w0 * bflo(r0[e]); acc[2 * e + 1] += w1 * bfhi(r0[e]); acc[8 + 2 * e] += w2 * bflo(r1[e]); acc[8 + 2 * e + 1] += w3 * bfhi(r1[e]); }
            }
#pragma unroll
            for (int e = 0; e < 16; ++e) ov[x][e] = silu_f(acc[e]);
#undef RL
        }
        float sq = 0.f, sk = 0.f;
#pragma unroll
        for (int e = 0; e < 16; ++e) { sq += ov[0][e] * ov[0][e]; sk += ov[1][e] * ov[1][e]; }
        LAS float* part = (LAS float*)LET;
        part[wave * 64 + i] = sq; part[512 + wave * 64 + i] = sk;
        __syncthreads();
        float tq = 0.f, tk = 0.f;
#pragma unroll
        for (int w8 = 0; w8 < 8; ++w8) { tq += part[w8 * 64 + i]; tk += part[512 + w8 * 64 + i]; }
        const float rq = rsqrtf(tq + RMS_EPS) * 0.08838834764831845f, rk = rsqrtf(tk + RMS_EPS);
        const float kt = __expf(gc63 - gc), be = bt * __expf(gc);
        u32x4 qw[2], kw[2];
#pragma unroll
        for (int e = 0; e < 8; ++e) { qw[e >> 2][e & 3] = pk2(ov[0][2 * e] * rq, ov[0][2 * e + 1] * rq); kw[e >> 2][e & 3] = pk2(ov[1][2 * e] * rk, ov[1][2 * e + 1] * rk); }
        *(LAS u32x4*)(LQB + i * RSB + 32 * wave) = qw[0]; *(LAS u32x4*)(LQB + i * RSB + 32 * wave + 16) = qw[1];
        *(LAS u32x4*)(LKB + i * RSB + 32 * wave) = kw[0]; *(LAS u32x4*)(LKB + i * RSB + 32 * wave + 16) = kw[1];
#pragma unroll
        for (int e = 0; e < 16; ++e) { const float kv = ov[1][e] * rk; const int d = 16 * wave + e;
            *(LAS unsigned short*)(LKT + d * RSS + 2 * i) = (unsigned short)f2bf(kv * kt);
            *(LAS unsigned short*)(LRT + d * RSS + 2 * i) = (unsigned short)f2bf(ov[2][e] * bt);
            *(LAS unsigned short*)(LRT + (128 + d) * RSS + 2 * i) = (unsigned short)f2bf(kv * be); }
    }
    __syncthreads();
    if (VAR == 1) return;
    f32x4 Er[2], Pcur[2];
#pragma unroll
    for (int it = 0; it < 4; ++it) {
        const int id = wave + 8 * (it & 1), isq = it >> 1, mi = id >> 2, nj = id & 3;
        f32x4 acc = {0.f, 0.f, 0.f, 0.f};
        if (mi >= nj) {
            const LAS unsigned char* xr = (isq ? LQB : LKB) + (16 * mi + c) * RSB + 16 * g;
            const LAS unsigned char* yr = LKB + (16 * nj + c) * RSB + 16 * g;
#pragma unroll
            for (int s = 0; s < 4; ++s) acc = __builtin_amdgcn_mfma_f32_16x16x32_bf16(*(const LAS bf16x8*)(xr + 64 * s), *(const LAS bf16x8*)(yr + 64 * s), acc, 0, 0, 0);
        }
        const int j = 16 * nj + c; const float gj = gcs[j];
        f32x4 o;
#pragma unroll
        for (int r = 0; r < 4; ++r) { const int i = 16 * mi + 4 * g + r; const float dec = (i >= j) ? __expf(gcs[i] - gj) : 0.f;
            o[r] = isq ? ((i >= j) ? acc[r] * dec : 0.f) : ((i > j) ? -betas[i] * acc[r] * dec : 0.f); }
        if (!isq) { Er[it & 1] = o; Pcur[it & 1] = o;
            u32x2 w; w.x = pk2(o[0], o[1]); w.y = pk2(o[2], o[3]);
            *(LAS u32x2*)(LPT + j * RSS + 2 * (16 * mi + 4 * g)) = w; *(LAS u32x2*)(LET + j * RSS + 2 * (16 * mi + 4 * g)) = w;
#pragma unroll
            for (int r = 0; r < 4; ++r) *(LAS unsigned short*)(LP + (16 * mi + 4 * g + r) * RSS + 2 * j) = (unsigned short)f2bf(o[r]);
        } else {
#pragma unroll
            for (int r = 0; r < 4; ++r) *(LAS unsigned short*)(LAT + (16 * mi + 4 * g + r) * RSS + 2 * j) = (unsigned short)f2bf(o[r]);
        }
    }
#pragma unroll 1
    for (int s6 = 0; s6 < 6; ++s6) {
        __syncthreads();
        f32x4 Pn[2], En[2];
#pragma unroll
        for (int tt = 0; tt < 2; ++tt) { const int id = wave + 8 * tt, mi = id >> 2, nj = id & 3;
            const LAS unsigned char* pr = LP + (16 * mi + c) * RSS + 16 * g;
            if (s6 < 5) Pn[tt] = tile_k64(pr, LPT + (16 * nj + c) * RSS + 16 * g, (f32x4){0.f, 0.f, 0.f, 0.f});
            if (s6 > 0) En[tt] = tile_k64(pr, LET + (16 * nj + c) * RSS + 16 * g, Er[tt] + Pcur[tt]); }
        __syncthreads();
#pragma unroll
        for (int tt = 0; tt < 2; ++tt) { const int id = wave + 8 * tt, mi = id >> 2, nj = id & 3, j = 16 * nj + c;
            if (s6 > 0) { Er[tt] = En[tt]; u32x2 w; w.x = pk2(En[tt][0], En[tt][1]); w.y = pk2(En[tt][2], En[tt][3]); *(LAS u32x2*)(LET + j * RSS + 2 * (16 * mi + 4 * g)) = w; }
            if (s6 < 5) { Pcur[tt] = Pn[tt]; u32x2 w; w.x = pk2(Pn[tt][0], Pn[tt][1]); w.y = pk2(Pn[tt][2], Pn[tt][3]); *(LAS u32x2*)(LPT + j * RSS + 2 * (16 * mi + 4 * g)) = w;
#pragma unroll
                for (int r = 0; r < 4; ++r) *(LAS unsigned short*)(LP + (16 * mi + 4 * g + r) * RSS + 2 * j) = (unsigned short)f2bf(Pn[tt][r]); } }
    }
    if (VAR == 2) { __syncthreads(); return; }
#pragma unroll
    for (int tt = 0; tt < 2; ++tt) { const int id = wave + 8 * tt, mi = id >> 2, nj = id & 3, j = 16 * nj + c;
#pragma unroll
        for (int r = 0; r < 4; ++r) *(LAS unsigned short*)(LE + (16 * mi + 4 * g + r) * RSS + 2 * j) = (unsigned short)f2bf(Er[tt][r]); }
    __syncthreads();
    {
        f32x4 xo[8];
#pragma unroll
        for (int q = 0; q < 8; ++q) { const int t = wave + 8 * q, mi = t >> 4, ct = t & 15;
            const u32x2 rv = *(const LAS u32x2*)(LRT + (16 * ct + c) * RSS + 2 * (16 * mi + 4 * g));
            xo[q] = tile_k64(LE + (16 * mi + c) * RSS + 16 * g, LRT + (16 * ct + c) * RSS + 16 * g, (f32x4){bflo(rv.x), bfhi(rv.x), bflo(rv.y), bfhi(rv.y)}); }
        __syncthreads();
#pragma unroll
        for (int q = 0; q < 8; ++q) { const int t = wave + 8 * q, mi = t >> 4, ct = t & 15;
            u32x2 w; w.x = pk2(xo[q][0], xo[q][1]); w.y = pk2(xo[q][2], xo[q][3]);
            *(LAS u32x2*)(LUW + (16 * ct + c) * RSS + 2 * (16 * mi + 4 * g)) = w; }
    }
    __syncthreads();
    if (VAR == 3) return;
    const LAS unsigned char* UWr = LUW; const LAS unsigned char* ATr = LAT; const LAS unsigned char* KTr = LKT;
    const size_t cbase = (size_t)unit; const f32x4 z4 = {0.f, 0.f, 0.f, 0.f};
#pragma unroll 2
    for (int q_ = 0; q_ < 4; ++q_) { const int t = wave + 8 * q_; const int xi = t >> 3, yj = t & 7;
        const f32x4 d = tile_k64(ATr + (16 * xi + c) * RSS + 16 * g, UWr + (16 * yj + c) * RSS + 16 * g, z4);
        u32x2 w; w.x = pk2(d[0], d[1]); w.y = pk2(d[2], d[3]);
        *(GAS u32x2*)(WSP(bf16, WS_OLOCT) + cbase * 8192 + (size_t)((yj * 4 + xi) * 64 + lane) * 4) = w; }
#pragma unroll 2
    for (int q_ = 0; q_ < 4; ++q_) { const int t = wave + 8 * q_; const int xi = t >> 2, yj = t & 3;
        const f32x4 d = tile_k64(UWr + (128 + 16 * xi + c) * RSS + 16 * g, ATr + (16 * yj + c) * RSS + 16 * g, z4);
        const int i2 = 16 * yj + c, dd = 16 * xi + 4 * g; const float eg = __expf(gcs[i2]);
        const u32x2 qv = *(const LAS u32x2*)(LQB + i2 * RSB + 2 * dd);
        u32x2 w; w.x = pk2(bflo(qv.x) * eg - d[0], bfhi(qv.x) * eg - d[1]); w.y = pk2(bflo(qv.y) * eg - d[2], bfhi(qv.y) * eg - d[3]);
        *(GAS u32x2*)(WSP(bf16, WS_QEFF) + cbase * 8192 + (size_t)(((yj * 4 + (xi >> 1)) * 64 + (2 * (xi & 1) + (g >> 1)) * 16 + c) * 8 + 4 * (g & 1))) = w; }
#pragma unroll 2
    for (int q_ = 0; q_ < 8; ++q_) { const int t = wave + 8 * q_; const int xi = t >> 3, yj = t & 7;
        const f32x4 d = tile_k64(KTr + (16 * xi + c) * RSS + 16 * g, UWr + (16 * yj + c) * RSS + 16 * g, z4);
        u32x2 w; w.x = pk2(d[0], d[1]); w.y = pk2(d[2], d[3]);
        *(GAS u32x2*)(WSP(bf16, WS_BMT) + cbase * 16384 + (size_t)(((yj * 4 + (xi >> 1)) * 2 + (xi & 1)) * 64 + lane) * 4) = w; }
#pragma unroll 2
    for (int q_ = 0; q_ < 8; ++q_) { const int t = wave + 8 * q_; const int xi = t >> 3, yj = t & 7;
        const f32x4 d = tile_k64(UWr + (128 + 16 * xi + c) * RSS + 16 * g, KTr + (16 * yj + c) * RSS + 16 * g, z4);
        u32x2 w; w.x = pk2(-d[0], -d[1]); w.y = pk2(-d[2], -d[3]);
        *(GAS u32x2*)(WSP(bf16, WS_MNEG) + cbase * 16384 + (size_t)(((yj * 4 + (xi >> 1)) * 64 + (2 * (xi & 1) + (g >> 1)) * 16 + c) * 8 + 4 * (g & 1))) = w; }
    if (F.tid == 0) WSP(float, WS_GLAST)[unit] = __expf(gc63);
    __syncthreads();
}

constexpr int SCAN_PF = 4;
__device__ __forceinline__ void scan_wg(Frame& F, int sw) {
    const int bh = sw & 15, slice = sw >> 4, b = bh >> 2, h = bh & 3;
    const int lane = F.lane, wave = F.wave, g = lane >> 4, c = lane & 15;
    LAS unsigned char* ST = opq_v(F.lds);
    LAS unsigned char* OS = ST + 8704;
    for (int i = F.tid; i < 2 * 4352 / 4; i += 512) ((LAS unsigned*)ST)[i] = 0u;
    __syncthreads();
    const GAS bf16* MN = (const GAS bf16*)(WSP(bf16, WS_MNEG) + (size_t)bh * 64 * 16384); const GAS bf16* BM = (const GAS bf16*)(WSP(bf16, WS_BMT) + (size_t)bh * 64 * 16384);
    const GAS bf16* QE = (const GAS bf16*)(WSP(bf16, WS_QEFF) + (size_t)bh * 64 * 8192); const GAS bf16* OL = (const GAS bf16*)(WSP(bf16, WS_OLOCT) + (size_t)bh * 64 * 8192);
    const GAS float* GL = (const GAS float*)(WSP(float, WS_GLAST) + bh * 64);
    (void)b; (void)h;
    if (wave < 4) {
        f32x4 Sreg[2] = {{0.f, 0.f, 0.f, 0.f}, {0.f, 0.f, 0.f, 0.f}};
        bf16x8 Af[SCAN_PF][2][4]; u32x2 bm[SCAN_PF][2]; float gl[SCAN_PF];
#define SCAN_LOAD_REC(j, n) do { const size_t cb_ = (size_t)(n) * 16384; \
        _Pragma("unroll") for (int mt = 0; mt < 2; ++mt) { _Pragma("unroll") for (int s = 0; s < 4; ++s) Af[j][mt][s] = *(const GAS bf16x8*)(MN + cb_ + (size_t)(((wave * 2 + mt) * 4 + s) * 64 + lane) * 8); \
            bm[j][mt] = *(const GAS u32x2*)(BM + cb_ + (size_t)(((slice * 4 + wave) * 2 + mt) * 64 + lane) * 4); } gl[j] = GL[n]; } while (0)
#pragma unroll
        for (int j = 0; j < SCAN_PF; ++j) SCAN_LOAD_REC(j, j);
#pragma unroll 1
        for (int n0 = 0; n0 < 64; n0 += SCAN_PF) {
#pragma unroll
            for (int j = 0; j < SCAN_PF; ++j) {
                const int n = n0 + j; const int cur = n & 1;
                bf16x8 Sb[4];
#pragma unroll
                for (int s = 0; s < 4; ++s) Sb[s] = *(const LAS bf16x8*)(ST + cur * 4352 + c * 272 + 64 * s + 16 * g);
#pragma unroll
                for (int mt = 0; mt < 2; ++mt) {
                    f32x4 acc; acc[0] = gl[j] * Sreg[mt][0] + bflo(bm[j][mt].x); acc[1] = gl[j] * Sreg[mt][1] + bfhi(bm[j][mt].x); acc[2] = gl[j] * Sreg[mt][2] + bflo(bm[j][mt].y); acc[3] = gl[j] * Sreg[mt][3] + bfhi(bm[j][mt].y);
#pragma unroll
                    for (int s = 0; s < 4; ++s) acc = __builtin_amdgcn_mfma_f32_16x16x32_bf16(Af[j][mt][s], Sb[s], acc, 0, 0, 0);
                    Sreg[mt] = acc;
                    u32x2 w; w.x = pk2(acc[0], acc[1]); w.y = pk2(acc[2], acc[3]);
                    *(LAS u32x2*)(ST + (cur ^ 1) * 4352 + c * 272 + 2 * (32 * wave + 16 * mt + 4 * g)) = w;
                }
                if (n + SCAN_PF < 64) SCAN_LOAD_REC(j, n + SCAN_PF);
                __syncthreads();
            }
        }
#undef SCAN_LOAD_REC
        __syncthreads();
    } else {
        const int m = wave - 4;
        bf16x8 Qf[SCAN_PF][4]; u32x2 ol[SCAN_PF];
        GAS bf16* OU = (GAS bf16*)(WSP(bf16, WS_OUN) + ((size_t)(bh * 8 + slice) * SEQ) * 16);
#define SCAN_LOAD_OUT(j, n) do { const size_t cb_ = (size_t)(n) * 8192; \
        _Pragma("unroll") for (int s = 0; s < 4; ++s) Qf[j][s] = *(const GAS bf16x8*)(QE + cb_ + (size_t)((m * 4 + s) * 64 + lane) * 8); \
        ol[j] = *(const GAS u32x2*)(OL + cb_ + (size_t)((slice * 4 + m) * 64 + lane) * 4); } while (0)
#define SCAN_FLUSH(n) do { if (m < 2) { const int q_ = m * 64 + lane; const u32x4 v_ = *(const LAS u32x4*)(OS + ((n) & 1) * 2048 + q_ * 16); *(GAS u32x4*)(OU + (size_t)(n) * 1024 + q_ * 8) = v_; } } while (0)
#pragma unroll
        for (int j = 0; j < SCAN_PF; ++j) SCAN_LOAD_OUT(j, j);
#pragma unroll 1
        for (int n0 = 0; n0 < 64; n0 += SCAN_PF) {
#pragma unroll
            for (int j = 0; j < SCAN_PF; ++j) {
                const int n = n0 + j; const int cur = n & 1;
                if (n > 0) SCAN_FLUSH(n - 1);
                bf16x8 Sb[4];
#pragma unroll
                for (int s = 0; s < 4; ++s) Sb[s] = *(const LAS bf16x8*)(ST + cur * 4352 + c * 272 + 64 * s + 16 * g);
                f32x4 acc; acc[0] = bflo(ol[j].x); acc[1] = bfhi(ol[j].x); acc[2] = bflo(ol[j].y); acc[3] = bfhi(ol[j].y);
#pragma unroll
                for (int s = 0; s < 4; ++s) acc = __builtin_amdgcn_mfma_f32_16x16x32_bf16(Qf[j][s], Sb[s], acc, 0, 0, 0);
#pragma unroll
                for (int r = 0; r < 4; ++r) *(LAS unsigned short*)(OS + cur * 2048 + (16 * m + 4 * g + r) * 32 + 2 * c) = (unsigned short)f2bf(acc[r]);
                if (n + SCAN_PF < 64) SCAN_LOAD_OUT(j, n + SCAN_PF);
                __syncthreads();
            }
        }
        SCAN_FLUSH(63);
        __syncthreads();
#undef SCAN_LOAD_OUT
#undef SCAN_FLUSH
    }
}

constexpr int AT_KS = 0, AT_VS = 36864, AT_OS = 73728, N_ATT_UNITS = NB * DAH * 96;
__device__ __forceinline__ s16x4 vtr(const LAS unsigned char* p) { typedef short v4i16_t __attribute__((ext_vector_type(4))); return __builtin_bit_cast(s16x4, __builtin_amdgcn_ds_read_tr16_b64_v4i16((LAS v4i16_t*)p)); }
struct AttU { int b, hh, br, dil, res, n; };
__device__ __forceinline__ AttU att_decode(int a) { AttU u; const int bhh = a / 96, rem = a % 96; u.br = rem >> 5; const int idx = rem & 31; u.b = bhh >> 3; u.hh = bhh & 7;
    u.dil = u.br == 0 ? 1 : u.br == 1 ? 4 : 16; const int nblk = 32 / u.dil; u.res = idx / nblk; u.n = idx % nblk; return u; }
__device__ __forceinline__ void att_load(Frame& F, int a, u32x4 (&kv)[4], u32x4 (&vv)[4], bf16x8 (&Bq)[2]) {
    const AttU u = att_decode(a); const bf16* QKVD = WSP(bf16, WS_QKVD);
#pragma unroll
    for (int p = 0; p < 4; ++p) { const int j = (F.tid >> 3) + 64 * p, kidx = 128 * (u.n - 1) + j; const bool ok = kidx >= 0;
        const bf16* src = QKVD + (size_t)(u.b * SEQ + (ok ? kidx : 0) * u.dil + u.res) * 1536 + u.hh * 64 + (F.tid & 7) * 8;
        kv[p] = *(const GAS u32x4*)(src + 512); vv[p] = *(const GAS u32x4*)(src + 1024);
        if (!ok) { kv[p] = (u32x4){0u, 0u, 0u, 0u}; vv[p] = (u32x4){0u, 0u, 0u, 0u}; } }
    const int qi = 16 * F.wave + (F.lane & 15); const size_t qtok = (size_t)(u.b * SEQ + (128 * u.n + qi) * u.dil + u.res);
#pragma unroll
    for (int s = 0; s < 2; ++s) Bq[s] = *(const GAS bf16x8*)(QKVD + qtok * 1536 + u.hh * 64 + 32 * s + 8 * (F.lane >> 4));
}
__device__ __forceinline__ void att_compute(Frame& F, int a, LAS unsigned char* L, const bf16x8 (&Bq)[2]) {
    const AttU u = att_decode(a); const int n = u.n;
    const int lane = F.lane, wave = F.wave, g = lane >> 4, c = lane & 15;
    const int qi = 16 * wave + c;
    f32x4 sc[9];
    float mx = -1.0e30f;
#pragma unroll
    for (int t = 0; t < 9; ++t) {
        const LAS unsigned char* kr = L + AT_KS + (16 * (wave + t) + c) * RSS + 16 * g;
        f32x4 acc = {0.f, 0.f, 0.f, 0.f};
        acc = __builtin_amdgcn_mfma_f32_16x16x32_bf16(*(const LAS bf16x8*)kr, Bq[0], acc, 0, 0, 0);
        acc = __builtin_amdgcn_mfma_f32_16x16x32_bf16(*(const LAS bf16x8*)(kr + 64), Bq[1], acc, 0, 0, 0);
        if (t == 0) {
#pragma unroll
            for (int r = 0; r < 4; ++r) { const int j = 16 * wave + 4 * g + r; if (j < qi) acc[r] = -1.0e30f; } }
        if (t == 8) {
#pragma unroll
            for (int r = 0; r < 4; ++r) { const int j = 16 * (wave + 8) + 4 * g + r; if (j > qi + 128) acc[r] = -1.0e30f; } }
        if (n == 0 && wave + t < 8) acc = (f32x4){-1.0e30f, -1.0e30f, -1.0e30f, -1.0e30f};
        mx = fmaxf(fmaxf(mx, fmaxf(acc[0], acc[1])), fmaxf(acc[2], acc[3]));
        sc[t] = acc;
    }
    mx = fmaxf(mx, __shfl_xor(mx, 16)); mx = fmaxf(mx, __shfl_xor(mx, 32));
    float lsum = 0.f;
#pragma unroll
    for (int t = 0; t < 9; ++t)
#pragma unroll
        for (int r = 0; r < 4; ++r) { const float p = __builtin_amdgcn_exp2f(sc[t][r] - mx); sc[t][r] = p; lsum += p; }
    lsum += __shfl_xor(lsum, 16); lsum += __shfl_xor(lsum, 32);
    bf16x8 pf[5];
#pragma unroll
    for (int q = 0; q < 5; ++q) { u32x4 w; w.x = pk2(sc[2 * q][0], sc[2 * q][1]); w.y = pk2(sc[2 * q][2], sc[2 * q][3]);
        if (q < 4) { w.z = pk2(sc[2 * q + 1][0], sc[2 * q + 1][1]); w.w = pk2(sc[2 * q + 1][2], sc[2 * q + 1][3]); } else { w.z = 0u; w.w = 0u; }
        pf[q] = __builtin_bit_cast(bf16x8, w); }
    float linv[4];
#pragma unroll
    for (int r = 0; r < 4; ++r) linv[r] = 1.f / __shfl(lsum, 4 * g + r);
    LAS unsigned char* OS = L + AT_OS + wave * 2304;
#pragma unroll
    for (int dt = 0; dt < 4; ++dt) {
        f32x4 acc = {0.f, 0.f, 0.f, 0.f};
#pragma unroll
        for (int q = 0; q < 5; ++q) { const int kb = 16 * (wave + 2 * q);
            const LAS unsigned char* vp = L + AT_VS + (kb + 4 * g + (c >> 2)) * RSS + (16 * dt + 4 * (c & 3)) * 2;
            const s16x4 lo = vtr(vp); s16x4 hi = {0, 0, 0, 0}; if (q < 4) hi = vtr(vp + 16 * RSS);
            const bf16x8 bv = {lo[0], lo[1], lo[2], lo[3], hi[0], hi[1], hi[2], hi[3]};
            acc = __builtin_amdgcn_mfma_f32_16x16x32_bf16(pf[q], bv, acc, 0, 0, 0); }
#pragma unroll
        for (int r = 0; r < 4; ++r) *(LAS unsigned short*)(OS + (4 * g + r) * RSS + (16 * dt + c) * 2) = (unsigned short)f2bf(acc[r] * linv[r]);
    }
    const size_t qtok = (size_t)(u.b * SEQ + (128 * n + qi) * u.dil + u.res);
    if (g == 0) ((GAS float*)WSP(float, WS_LSE))[((size_t)u.br * T + qtok) * 8 + u.hh] = (mx + __log2f(lsum)) * 0.6931471805599453f;
    { const int row = lane >> 2, pc = lane & 3; const size_t tok = (size_t)(u.b * SEQ + (128 * n + 16 * wave + row) * u.dil + u.res);
      const u32x4 v0 = *(const LAS u32x4*)(OS + row * RSS + pc * 32), v1 = *(const LAS u32x4*)(OS + row * RSS + pc * 32 + 16);
      GAS u32x4* dst = (GAS u32x4*)(WSP(bf16, WS_OPART) + ((size_t)u.br * T + tok) * 512 + u.hh * 64 + pc * 16); dst[0] = v0; dst[1] = v1; }
}
__device__ __forceinline__ void attn_queue(Frame& F, unsigned* qword, volatile LAS unsigned* MISC) {
    LAS unsigned char* L = opq_v(F.lds);
    u32x4 kv[4], vv[4]; bf16x8 Bq[2], BqN[2];
    unsigned pend = 0u;
    if (F.tid == 0) { MISC[22] = __hip_atomic_fetch_add(qword, 1u, RLX_AGENT); pend = __hip_atomic_fetch_add(qword, 1u, RLX_AGENT); }
    __syncthreads();
    int a = (int)MISC[22];
    if (a < N_ATT_UNITS) att_load(F, a, kv, vv, Bq);
    while (a < N_ATT_UNITS) {
#pragma unroll
        for (int p = 0; p < 4; ++p) { const int j = (F.tid >> 3) + 64 * p; *(LAS u32x4*)(L + AT_KS + j * RSS + (F.tid & 7) * 16) = kv[p]; *(LAS u32x4*)(L + AT_VS + j * RSS + (F.tid & 7) * 16) = vv[p]; }
        if (F.tid == 0) { MISC[20] = pend; pend = __hip_atomic_fetch_add(qword, 1u, RLX_AGENT); }
        __syncthreads();
        const int an = (int)MISC[20];
        if (an < N_ATT_UNITS) att_load(F, an, kv, vv, BqN);
        att_compute(F, a, L, Bq);
        __syncthreads();
        a = an; Bq[0] = BqN[0]; Bq[1] = BqN[1];
    }
}

__device__ __forceinline__ void mix_pass(Frame& F, const Args& A) {
    const int lane = F.lane;
    float nw[8];
    { const f32x4 a = *(const GAS f32x4*)(A.in[6] + 8 * (lane & 15)), b = *(const GAS f32x4*)(A.in[6] + 8 * (lane & 15) + 4);
#pragma unroll
      for (int e = 0; e < 4; ++e) { nw[e] = a[e]; nw[4 + e] = b[e]; } }
    const bf16* OU = WSP(bf16, WS_OUN); const bf16* ZB = WSP(bf16, WS_ZB); const bf16* OP = WSP(bf16, WS_OPART); const float* LSE = WSP(float, WS_LSE); bf16* MIX = WSP(bf16, WS_MIX);
    for (int t = F.gw; t < T; t += F.NGW) {
        const u32x4 uo = *(const GAS u32x4*)(OU + ((size_t)(((t >> 12) * 4 + (lane >> 4)) * 8 + ((lane & 15) >> 1)) * SEQ + (t & 4095)) * 16 + 8 * (lane & 1)), uz = *(const GAS u32x4*)(ZB + (size_t)t * 512 + 8 * lane);
        float x[8], z[8];
#pragma unroll
        for (int e = 0; e < 4; ++e) { x[2 * e] = bflo(uo[e]); x[2 * e + 1] = bfhi(uo[e]); z[2 * e] = bflo(uz[e]); z[2 * e + 1] = bfhi(uz[e]); }
        float ss = 0.f;
#pragma unroll
        for (int e = 0; e < 8; ++e) ss += x[e] * x[e];
        ss += dpp_f(ss, 0xB1, 0xf); ss += dpp_f(ss, 0x4E, 0xf); ss += dpp_f(ss, 0x141, 0xf); ss += dpp_f(ss, 0x140, 0xf);
        const float rstd = rsqrtf(ss * (1.f / 128.f) + RMS_EPS);
        float o[8];
#pragma unroll
        for (int e = 0; e < 8; ++e) o[e] = x[e] * rstd * nw[e] * silu_f(z[e]);
        u32x4 w; w.x = pk2(o[0], o[1]); w.y = pk2(o[2], o[3]); w.z = pk2(o[4], o[5]); w.w = pk2(o[6], o[7]);
        *(GAS u32x4*)(MIX + (size_t)t * D + 8 * lane) = w;
        const int hh = lane >> 3;
        const float l0 = LSE[((size_t)0 * T + t) * 8 + hh], l1 = LSE[((size_t)1 * T + t) * 8 + hh], l2 = LSE[((size_t)2 * T + t) * 8 + hh];
        const float lm = fmaxf(l0, fmaxf(l1, l2)); const float e0 = __expf(l0 - lm), e1 = __expf(l1 - lm), e2 = __expf(l2 - lm); const float inv = 1.f / (e0 + e1 + e2);
        const u32x4 p0 = *(const GAS u32x4*)(OP + ((size_t)0 * T + t) * 512 + 8 * lane), p1 = *(const GAS u32x4*)(OP + ((size_t)1 * T + t) * 512 + 8 * lane), p2 = *(const GAS u32x4*)(OP + ((size_t)2 * T + t) * 512 + 8 * lane);
        const float w0 = e0 * inv, w1 = e1 * inv, w2 = e2 * inv;
        u32x4 wo;
#pragma unroll
        for (int e = 0; e < 4; ++e) wo[e] = pk2(w0 * bflo(p0[e]) + w1 * bflo(p1[e]) + w2 * bflo(p2[e]), w0 * bfhi(p0[e]) + w1 * bfhi(p1[e]) + w2 * bfhi(p2[e]));
        *(GAS u32x4*)(MIX + (size_t)t * D + 512 + 8 * lane) = wo;
    }
}

constexpr int N_PHASES = 29;
#define D1V 0
#define DRYV 0
__global__ void __launch_bounds__(512, 2) fwd_kernel(Args args) {
    extern __shared__ __attribute__((aligned(16))) unsigned char lds_raw[];
    Frame F;
    F.lds = (LAS unsigned char*)lds_raw; F.ws = args.ws; F.ctl = (gu32*)(args.ws + WS_CTL);
    F.tid = threadIdx.x; F.lane = F.tid & 63; F.wave = __builtin_amdgcn_readfirstlane(F.tid >> 6);
    F.G = gridDim.x; F.gw = blockIdx.x * 8 + F.wave; F.NGW = F.G * 8;
    volatile LAS unsigned* MISC = (volatile LAS unsigned*)(F.lds + MISC_OFF); const char* wsb = (const char*)args.ws;
    for (int u = F.tid; u < 256; u += 512) MISC[u] = 0u;
    __syncthreads();
    const int lo = args.ph_lo, hi = args.ph_hi;
    XcdBarrier bar; bar.bar = (unsigned*)(F.ctl + CW_BAR); bar.x = 0; bar.st = MISC + 8;
    if (hi - lo > 1) bar = xcd_barrier_post((unsigned*)(F.ctl + CW_BAR), MISC + 8);
    LAS unsigned char* ring = F.lds; LAS unsigned char* xch = F.lds + XCH_OFF;
    volatile LAS unsigned* tab = MISC + 32;
    const int c = blockIdx.x, G = F.G; int qsel = 0;
#ifndef PHASE_MASK
#define PHASE_MASK 0xFFFFFFFFu
#endif
#define IN(k) ((((PHASE_MASK) >> (k)) & 1u) && lo <= (k) && (k) < hi)
#define SEAM(k) do { if (IN(k) && IN((k) + 1)) xcd_barrier(bar); } while (0)
#define PH_BEGIN() do { const int t_ = opq_v((int)threadIdx.x); F.tid = t_; F.lane = t_ & 63; F.wave = __builtin_amdgcn_readfirstlane(t_ >> 6); F.gw = blockIdx.x * 8 + F.wave; \
        unsigned char* w_ = opq_s(args.ws); F.ws = w_; F.ctl = (gu32*)(w_ + WS_CTL); xch = opq_v(F.lds + XCH_OFF); MISC = (volatile LAS unsigned*)opq_v(F.lds + MISC_OFF); tab = MISC + 32; bar.st = MISC + 8; wsb = (const char*)w_; } while (0)
#define HBc (wsb + WS_HB)

    if (IN(0)) { PH_BEGIN(); p0_prologue(F, args); SEAM(0); }
    if (IN(1)) { PH_BEGIN();
        SchedP1 S{HBc, (const char*)(wsb + WS_W_IN), (const char*)(wsb + WS_MEMB), (const char*)(wsb + WS_W_KV), G, c};
        EpiP1 E{WSP(bf16, WS_QKVPRE), WSP(bf16, WS_ZB), WSP(bf16, WS_QKVD), WSP(bf16, WS_KMEM), WSP(bf16, WS_VT)};
        pg8::gemm_phase(ring, xch, pg8::Gemm{D, D, D}, S, E);
        deferred_weights_q(F, args, (unsigned*)(F.ctl + CW_CVQ + 64), MISC);
        SEAM(1);
    }
    if (IN(2)) { PH_BEGIN(); for (int u = c; u < NB * DNH * NCHUNK; u += G) d1_unit<D1V>(F, args, u); SEAM(2); }
    if (IN(3)) { PH_BEGIN();
        if (c < 128) scan_wg(F, c);
        attn_queue(F, (unsigned*)(F.ctl + CW_QUEUE + 16 * qsel), MISC);
        ++qsel;
        SEAM(3);
    }
    if (IN(4)) { PH_BEGIN();
        { SchedPrep S{(const char*)(wsb + WS_KMEM), (const char*)(wsb + WS_W_Q), (const char*)(wsb + WS_W_O), (const char*)(wsb + WS_VT), G, c}; EpiPrep E{WSP(bf16, WS_MT), WSP(bf16, WS_VWT)};
          pg8::gemm_phase(ring, xch, pg8::Gemm{D, D, XD}, S, E); }
        mix_pass(F, args); SEAM(4); }

#pragma unroll
    for (int layer = 0; layer < 2; ++layer) {
        const int pb = layer * 13;
        if (layer == 0) {
            if (IN(5)) { PH_BEGIN(); convert_moe_q(F, args, 0, 0, WSP(bf16, WS_MOEW_GU), (unsigned*)(F.ctl + CW_CVQ), MISC); convert_moe_q(F, args, 0, 1, WSP(bf16, WS_MOEW_D), (unsigned*)(F.ctl + CW_CVQ + 16), MISC); __syncthreads();
                SchedDense S{(const char*)(wsb + WS_MIX), (const char*)(wsb + WS_W_ABO), D, D, 64, 4, G, c}; EpiDense E{WSP(bf16, 288 * MiB), D, 1.f};
                pg8::gemm_phase(ring, xch, pg8::Gemm{D, D, D}, S, E); SEAM(5); }
            if (IN(6)) { PH_BEGIN(); ln_pass<0, false, false, (DRYV != 0)>(F, args, WSP(bf16, WS_HB), WSP(bf16, 288 * MiB), 0, nullptr, DRYV ? WSP(bf16, 112 * MiB) : WSP(bf16, WS_HB), nullptr); SEAM(6); }
        } else {
            if (IN(16)) { PH_BEGIN();
                SchedDense S{HBc, (const char*)(wsb + WS_W_SCI), D, D, 64, 12, G, c}; EpiDense E{WSP(bf16, 192 * MiB), 3 * D, 1.f};
                pg8::gemm_phase(ring, xch, pg8::Gemm{D, D, D}, S, E); SEAM(16); }
            if (IN(17)) { PH_BEGIN(); conv_pass(F, args, WSP(bf16, 192 * MiB), WSP(bf16, 288 * MiB)); SEAM(17); }
            if (IN(18)) { PH_BEGIN(); SchedDense S{(const char*)(wsb + 288 * MiB), (const char*)(wsb + WS_W_SCO), D, D, 64, 4, G, c}; EpiDense E{WSP(bf16, 192 * MiB), D, 1.f};
                pg8::gemm_phase(ring, xch, pg8::Gemm{D, D, D}, S, E); SEAM(18); }
            if (IN(19)) { PH_BEGIN(); ln_pass<0, false, false>(F, args, WSP(bf16, WS_HB), WSP(bf16, 192 * MiB), 3, nullptr, WSP(bf16, WS_HB), nullptr); SEAM(19); }
        }
        const size_t oP = (layer == 0 ? 224 : 256) * MiB, oY = (layer == 0 ? 288 : 192) * MiB;
        const int p7 = layer == 0 ? 7 : 20;
        if (IN(p7)) { PH_BEGIN(); SchedXB S{HBc, (const char*)(wsb + WS_MT + (size_t)layer * NB * D * D * 2), G, c}; EpiSoftmax E{WSP(bf16, oP)};
            pg8::gemm_phase(ring, xch, pg8::Gemm{D, D, D}, S, E); SEAM(p7); }
        if (IN(p7 + 1)) { PH_BEGIN(); SchedXB S{(const char*)(wsb + oP), (const char*)(wsb + WS_VWT + (size_t)layer * NB * D * D * 2), G, c}; EpiDense E{WSP(bf16, oY), D, 1.f};
            pg8::gemm_phase(ring, xch, pg8::Gemm{D, D, D}, S, E); SEAM(p7 + 1); }
        unsigned* cnt = (unsigned*)(F.ctl + (layer == 0 ? CW_CNT0 : CW_CNT1));
        if (IN(p7 + 4)) { PH_BEGIN(); ln_pass<0, true, false, (DRYV != 0)>(F, args, WSP(bf16, WS_HB), WSP(bf16, oY), layer * 3 + 1, nullptr, DRYV ? WSP(bf16, 112 * MiB) : WSP(bf16, WS_HB), cnt); SEAM(p7 + 4); }
        if (IN(p7 + 5)) { PH_BEGIN(); moe_table(F, cnt, tab); moe_slots(F, tab, WSP(int, WS_INV + (size_t)layer * MOE_ROWS * 4)); SEAM(p7 + 5); }
        if (IN(p7 + 6)) { PH_BEGIN(); moe_table(F, cnt, tab);
            SchedMoE<true> S{HBc, (const char*)(wsb + (layer == 0 ? WS_MOEW_GU : WS_MOEW_GU1)), tab, WSP(int, WS_INV + (size_t)layer * MOE_ROWS * 4), D, D, D, G, c}; EpiSwiglu E{WSP(bf16, WS_HACT), (layer == 1 && MK_ONE_LAUNCH) ? (unsigned*)(F.ctl + CW_G1DONE) : nullptr, 2 * G};
            pg8::gemm_phase(ring, xch, pg8::Gemm{D, D, D}, S, E);
            if (layer == 0) convert_moe_q(F, args, 1, 0, WSP(bf16, WS_MOEW_GU1), (unsigned*)(F.ctl + CW_CVQ + 32), MISC);
            if (!(layer == 1 && MK_ONE_LAUNCH)) SEAM(p7 + 6); }
        if (IN(p7 + 7)) { PH_BEGIN(); moe_table(F, cnt, tab);
            EpiDense E{WSP(bf16, WS_XG), D, 1.f};
            if (layer == 1 && MK_ONE_LAUNCH) { moe_wait_gemm1(F, (unsigned*)(F.ctl + CW_G1DONE), tab, G, c);
                SchedMoE2 S{(const char*)(wsb + WS_HACT), (const char*)(wsb + WS_MOEW_D1), tab, G, c}; pg8::gemm_phase(ring, xch, pg8::Gemm{DE, DE, DE}, S, E); }
            else { SchedMoE<false> S{(const char*)(wsb + WS_HACT), (const char*)(wsb + (layer == 0 ? WS_MOEW_D : WS_MOEW_D1)), tab, nullptr, DE, D, DE, G, c}; pg8::gemm_phase(ring, xch, pg8::Gemm{DE, DE, DE}, S, E); }
            if (layer == 0) convert_moe_q(F, args, 1, 1, WSP(bf16, WS_MOEW_D1), (unsigned*)(F.ctl + CW_CVQ + 48), MISC);
            SEAM(p7 + 7); }
        if (layer == 0) { if (IN(15)) { PH_BEGIN(); ln_pass<1, false, false>(F, args, WSP(bf16, WS_HB), WSP(bf16, WS_XG), 2, nullptr, WSP(bf16, WS_HB), nullptr); SEAM(15); } }
        else { if (IN(28)) { PH_BEGIN(); ln_pass<1, false, true>(F, args, WSP(bf16, WS_HB), WSP(bf16, WS_XG), 5, args.out, nullptr, nullptr); SEAM(28); } }
        (void)pb;
    }
#undef IN
#undef SEAM
}

extern "C" void kernel_launch(void* const* d_in, const int* in_sizes, int n_in, void* d_out, int out_size, void* d_ws, size_t ws_size, hipStream_t stream) {
    static int grid = 0;
    if (grid == 0) {
        if (n_in != 21 || out_size != T * D || ws_size < WS_END) { fprintf(stderr, "kernel_launch: unexpected problem (n_in %d, out %d, ws %zu < %zu)\n", n_in, out_size, ws_size, (size_t)WS_END); grid = -1; return; }
        int dev = 0, cus = 0, per_cu = 0;
        if (hipGetDevice(&dev) != hipSuccess || hipDeviceGetAttribute(&cus, hipDeviceAttributeMultiprocessorCount, dev) != hipSuccess) { grid = -1; return; }
        if (hipFuncSetAttribute((const void*)fwd_kernel, hipFuncAttributeMaxDynamicSharedMemorySize, LDS_BYTES) != hipSuccess) { fprintf(stderr, "kernel_launch: hipFuncSetAttribute failed\n"); grid = -1; return; }
        if (hipOccupancyMaxActiveBlocksPerMultiprocessor(&per_cu, (const void*)fwd_kernel, 512, LDS_BYTES) != hipSuccess || per_cu < 1) { fprintf(stderr, "kernel_launch: occupancy query says %d blocks per CU\n", per_cu); (void)hipGetLastError(); per_cu = 1; }
        grid = cus;
    }
    if (grid < 0) return;
    (void)hipMemsetAsync((char*)d_ws + WS_CTL, 0, CTL_ZERO_BYTES, stream);
    Args a{};
    for (int i = 0; i < 21; ++i) a.in[i] = (const float*)d_in[i];
    a.out = (float*)d_out; a.ws = (unsigned char*)d_ws;
#if MK_ONE_LAUNCH
    a.ph_lo = 0; a.ph_hi = N_PHASES;
    hipLaunchKernelGGL(fwd_kernel, dim3(grid), dim3(512), LDS_BYTES, stream, a);
#else
    for (int p = 0; p < N_PHASES; ++p) { a.ph_lo = p; a.ph_hi = p + 1; hipLaunchKernelGGL(fwd_kernel, dim3(grid), dim3(512), LDS_BYTES, stream, a); }
#endif
}
```

```cpp
#include <hip/hip_runtime.h>
#include <cstdio>
#include <cstdint>

#ifndef MK_ONE_LAUNCH
#define MK_ONE_LAUNCH 1
#endif

#define LAS __attribute__((address_space(3)))
#define GAS __attribute__((address_space(1)))
typedef unsigned short bf16;
typedef short bf16x8 __attribute__((ext_vector_type(8)));
typedef short s16x4 __attribute__((ext_vector_type(4)));
typedef float f32x4 __attribute__((ext_vector_type(4)));
typedef float f32x2 __attribute__((ext_vector_type(2)));
typedef unsigned u32x4 __attribute__((ext_vector_type(4)));
typedef unsigned u32x2 __attribute__((ext_vector_type(2)));
typedef GAS unsigned gu32;
#define RLX_AGENT __ATOMIC_RELAXED, __HIP_MEMORY_SCOPE_AGENT
#define LDS_WAIT() asm volatile("s_waitcnt lgkmcnt(0)" ::: "memory")
#define VM_WAIT() asm volatile("s_waitcnt vmcnt(0)" ::: "memory")

constexpr int NB = 4, SEQ = 4096, T = NB * SEQ, D = 1024;
constexpr int NMEM = 256, TM = NB * NMEM;
constexpr int DNH = 4, DND = 128, DNW = 512, DNC = 64, NCHUNK = SEQ / DNC;
constexpr int DAH = 8, DAD = 64, DAW = 512;
constexpr int AB_IN = 3592;
constexpr int XH = 4, XD = 256;
constexpr int NE = 16, DE = 512;
constexpr float ALPHA = 1.41421356237f;
constexpr float LN_EPS = 1e-5f, RMS_EPS = 1e-6f;
constexpr int MOE_ROWS = 2 * T + NE * 256;

constexpr size_t MiB = 1u << 20;
constexpr size_t WS_CTL = 0, CTL_ZERO_BYTES = 1 * MiB;
constexpr size_t WS_W_IN = 1 * MiB, WS_W_ABO = 8 * MiB, WS_W_SCI = 10 * MiB, WS_W_SCO = 16 * MiB, WS_W_Q = 18 * MiB, WS_W_KV = 22 * MiB, WS_W_O = 30 * MiB;
constexpr size_t WS_MEMB = 34 * MiB, WS_KMEM = 36 * MiB, WS_VT = 40 * MiB, WS_BETA = 44 * MiB, WS_GG = 45 * MiB, WS_ROUTE = 46 * MiB, WS_GLAST = 47 * MiB;
constexpr size_t WS_MT = 80 * MiB, WS_VWT = 96 * MiB;
constexpr size_t WS_HB = 48 * MiB, WS_H = 80 * MiB, WS_ARENA = 144 * MiB, WS_END = 320 * MiB;
constexpr size_t WS_QKVPRE = 144 * MiB, WS_ZB = 192 * MiB, WS_QKVD = 208 * MiB, WS_MNEG = 80 * MiB, WS_BMT = 112 * MiB, WS_QEFF = 256 * MiB, WS_OLOCT = 272 * MiB;
constexpr size_t WS_OUN = 288 * MiB, WS_LSE = 304 * MiB, WS_OPART = 144 * MiB, WS_MIX = 256 * MiB;
constexpr size_t WS_MOEW_GU = 144 * MiB, WS_MOEW_D = 176 * MiB, WS_XG = 192 * MiB, WS_HACT = 264 * MiB;
constexpr size_t WS_MOEW_GU1 = 112 * MiB, WS_MOEW_D1 = 144 * MiB;
static_assert((size_t)MOE_ROWS * D * 2 <= 72 * MiB && (size_t)MOE_ROWS * DE * 2 <= 36 * MiB, "moe buffers");
constexpr size_t WS_INV = 256 * 1024;
constexpr int CW_TMO = 0, CW_BAR = 4096, CW_QUEUE = 64, CW_CNT0 = 128, CW_CNT1 = 192, CW_CVQ = 256, CW_G1DONE = 512;

constexpr int LDS_BYTES = 163840, MISC_OFF = 162816, XCH_OFF = 131072;

typedef __bf16 bf16x2_t __attribute__((ext_vector_type(2)));
__device__ __forceinline__ unsigned pk2(float lo, float hi) { const f32x2 v = {lo, hi}; const bf16x2_t b = __builtin_convertvector(v, bf16x2_t); return __builtin_bit_cast(unsigned, b); }
__device__ __forceinline__ unsigned f2bf(float f) { return pk2(f, f) & 0xffffu; }
__device__ __forceinline__ float bf2f(unsigned short b) { return __builtin_bit_cast(float, (unsigned)b << 16); }
__device__ __forceinline__ float bflo(unsigned w) { return __builtin_bit_cast(float, w << 16); }
__device__ __forceinline__ float bfhi(unsigned w) { return __builtin_bit_cast(float, w & 0xffff0000u); }
#define dpp_f(v, ctrl, row_mask) __int_as_float(__builtin_amdgcn_update_dpp(0, __float_as_int(v), (ctrl), (row_mask), 0xf, false))
__device__ __forceinline__ float wave_sum(float v) {
    v += dpp_f(v, 0xB1, 0xf); v += dpp_f(v, 0x4E, 0xf); v += dpp_f(v, 0x141, 0xf); v += dpp_f(v, 0x140, 0xf);
    v += dpp_f(v, 0x142, 0xa); v += dpp_f(v, 0x143, 0xc);
    return __int_as_float(__builtin_amdgcn_readlane(__float_as_int(v), 63));
}
__device__ __forceinline__ float xrow_max(float v) {
    const auto a = __builtin_amdgcn_permlane16_swap(__float_as_uint(v), __float_as_uint(v), false, false); v = fmaxf(__uint_as_float(a[0]), __uint_as_float(a[1]));
    const auto b = __builtin_amdgcn_permlane32_swap(__float_as_uint(v), __float_as_uint(v), false, false); return fmaxf(__uint_as_float(b[0]), __uint_as_float(b[1])); }
__device__ __forceinline__ float xrow_sum(float v) {
    const auto a = __builtin_amdgcn_permlane16_swap(__float_as_uint(v), __float_as_uint(v), false, false); v = __uint_as_float(a[0]) + __uint_as_float(a[1]);
    const auto b = __builtin_amdgcn_permlane32_swap(__float_as_uint(v), __float_as_uint(v), false, false); return __uint_as_float(b[0]) + __uint_as_float(b[1]); }
template <class P> __device__ __forceinline__ P opq_v(P p) { asm volatile("" : "+v"(p)); return p; }
template <class P> __device__ __forceinline__ P opq_s(P p) { asm volatile("" : "+s"(p)); return p; }
__device__ __forceinline__ float silu_f(float x) { return x * __builtin_amdgcn_rcpf(1.f + __expf(-x)); }

namespace pg8 {
constexpr int BM = 256, BK = 64, HALF = 128, HTB = HALF * BK * 2, STAGE_BYTES = 8 * HTB;
__host__ __device__ __forceinline__ int lds_byte(int r, int c) { const int st = (r >> 4) * 2 + (c >> 5), rr = r & 15, cc = c & 31, ob = rr * 64 + cc * 2; return st * 1024 + (ob ^ (((ob >> 9) & 1) << 5)); }
__host__ __device__ __forceinline__ void stage_rc(int b, int& R, int& C) { const int st = b / 1024, sb = b % 1024, swz = sb ^ (((sb >> 9) & 1) << 5); R = (st >> 1) * 16 + swz / 64; C = (st & 1) * 32 + (swz % 64) / 2; }
__host__ __device__ __forceinline__ int perm32(int rho) { const int n = rho >> 4, i = rho & 15; return 8 * (i >> 2) + 4 * n + (i & 3); }

struct Unit { int pm, pn, aux; const char* a; const char* b; };
struct Gemm { int lda, ldb, K; };
__device__ __forceinline__ unsigned cvt_pk_bf16(float lo, float hi) { unsigned r; asm volatile("v_cvt_pk_bf16_f32 %0, %1, %2" : "=v"(r) : "v"(lo), "v"(hi)); return r; }

__device__ __forceinline__ void swz_tile(int L, int nM, int nN, int& pm, int& pn) {
    const int nwg = nM * nN; int wgid = L; { const int q = nwg / 8, r = nwg % 8, xcd = wgid % 8, off = wgid / 8; wgid = (xcd < r ? xcd * (q + 1) : r * (q + 1) + (xcd - r) * q) + off; }
    const int nig = 8 * nN, gid = wgid / nig, fm = gid * 8, gsz = (nM - fm) < 8 ? (nM - fm) : 8;
    pm = fm + ((wgid % nig) % gsz); pn = (wgid % nig) / gsz;
}

template <class Epi, class Sched>
__device__ __forceinline__ void gemm_phase(LAS unsigned char* lds, LAS unsigned char* xch, const Gemm g, const Sched& S, const Epi& E) {
    const int tid = opq_v((int)threadIdx.x), wid = __builtin_amdgcn_readfirstlane(tid >> 6), lane = tid & 63, wr = wid >> 2, wc = wid & 3, fr = lane & 15, fq = lane >> 4;
    const int K = g.K, nt = K / BK;
    unsigned voffA[2], voffB[2];
#pragma unroll
    for (int i = 0; i < 2; ++i) { int R, C; stage_rc(tid * 16 + i * 8192, R, C); const int Rb = Epi::PERM ? ((R & ~31) + perm32(R & 31)) : R;
        voffA[i] = (unsigned)(R * g.lda + C) * 2u; voffB[i] = (unsigned)(Rb * g.ldb + C) * 2u; }
    const size_t kstep = (size_t)(BK * 2);
    const size_t hstepA = Sched::GATHER ? (size_t)0 : (size_t)HALF * g.lda * 2, hstepB = (size_t)HALF * g.ldb * 2;
    unsigned vGc[2][2], vGn[2][2];
#pragma unroll
    for (int i = 0; i < 2; ++i) vGc[0][i] = vGc[1][i] = vGn[0][i] = vGn[1][i] = 0u;
#define PG8_GLOAD(dst, u_) do { if (Sched::GATHER) { _Pragma("unroll") for (int hh_ = 0; hh_ < 2; ++hh_) _Pragma("unroll") for (int i_ = 0; i_ < 2; ++i_) { int R_, C_; stage_rc(tid * 16 + i_ * 8192, R_, C_); \
        dst[hh_][i_] = (unsigned)S.row((u_), hh_ * HALF + R_) * (unsigned)(g.lda * 2) + (unsigned)C_ * 2u; } } } while (0)
    const unsigned ldsw = (unsigned)wid * 1024u;
    const int aoff = lds_byte(wr * 64 + fr, fq * 8), boff = lds_byte(wc * 32 + fr, fq * 8);
#define PG8_SA(b, h) (((b) * 2 + (h)) * HTB)
#define PG8_SB(b, h) ((4 + (b) * 2 + (h)) * HTB)
#define PG8_STAGE(bufoff, gbase, voff) do { _Pragma("unroll") for (int _i = 0; _i < 2; ++_i) \
        __builtin_amdgcn_global_load_lds((const unsigned*)((const char*)(gbase) + (voff)[_i]), (LAS unsigned*)(lds + (bufoff) + ldsw + _i * 8192), 16, 0, 0); } while (0)
#define PG8_STAGE_A(bufoff, gbase, hf, vg) do { if (Sched::GATHER) { PG8_STAGE(bufoff, gbase, vg[hf]); } else { PG8_STAGE(bufoff, (gbase) + (hf) * hstepA, voffA); } } while (0)
#define PG8_LDA(dst, b, h) do { _Pragma("unroll") for (int m = 0; m < 4; ++m) _Pragma("unroll") for (int k = 0; k < 2; ++k) dst[m][k] = *(const LAS bf16x8*)(lds + PG8_SA(b, h) + aoff + m * 2048 + k * 1024); } while (0)
#define PG8_LDB(dst, b, h) do { _Pragma("unroll") for (int n = 0; n < 2; ++n) _Pragma("unroll") for (int k = 0; k < 2; ++k) dst[n][k] = *(const LAS bf16x8*)(lds + PG8_SB(b, h) + boff + n * 2048 + k * 1024); } while (0)
#define PG8_MMA(ai, bj, At, Bt) do { __builtin_amdgcn_s_setprio(1); _Pragma("unroll") for (int m = 0; m < 4; ++m) _Pragma("unroll") for (int n = 0; n < 2; ++n) _Pragma("unroll") for (int k = 0; k < 2; ++k) \
        acc[ai][bj][m][n] = __builtin_amdgcn_mfma_f32_16x16x32_bf16(Bt[n][k], At[m][k], acc[ai][bj][m][n], 0, 0, 0); __builtin_amdgcn_s_setprio(0); } while (0)
#define PG8_WAIT_V(n) asm volatile("s_waitcnt vmcnt(" #n ")" ::: "memory")
#define PG8_WAIT_L(n) asm volatile("s_waitcnt lgkmcnt(" #n ")" ::: "memory")
#define PG8_BAR __builtin_amdgcn_s_barrier()
#define PG8_SCHED __builtin_amdgcn_sched_barrier(0)
    Unit cur, nxt; int ui = 0;
    if (!S.next(0, cur)) return;
    f32x4 acc[2][2][4][2];
#pragma unroll
    for (int a = 0; a < 2; ++a)
#pragma unroll
        for (int b = 0; b < 2; ++b)
#pragma unroll
            for (int m = 0; m < 4; ++m)
#pragma unroll
                for (int n = 0; n < 2; ++n) acc[a][b][m][n] = (f32x4){0.f, 0.f, 0.f, 0.f};
    bf16x8 At[4][2], B0[2][2], B1[2][2];
    const char* cA = cur.a; const char* cB = cur.b;
    PG8_GLOAD(vGc, cur);
    PG8_STAGE(PG8_SB(0, 0), cB, voffB); PG8_STAGE(PG8_SB(0, 1), cB + hstepB, voffB); PG8_STAGE_A(PG8_SA(0, 0), cA, 0, vGc); PG8_STAGE_A(PG8_SA(0, 1), cA, 1, vGc);
    if (wr == 1) PG8_BAR;
    PG8_WAIT_V(2); PG8_BAR;
    PG8_STAGE(PG8_SB(1, 0), cB + kstep, voffB); PG8_STAGE_A(PG8_SA(1, 0), cA + kstep, 0, vGc); PG8_STAGE(PG8_SB(1, 1), cB + hstepB + kstep, voffB);
    PG8_WAIT_V(6); PG8_BAR;
#pragma unroll 1
    for (;;) {
        const bool has_next = S.next(ui + 1, nxt);
        const char* nA = has_next ? nxt.a : cA; const char* nB = has_next ? nxt.b : cB;
        if (Sched::GATHER) { if (has_next) { PG8_GLOAD(vGn, nxt); } else {
#pragma unroll
                for (int hh_ = 0; hh_ < 2; ++hh_)
#pragma unroll
                    for (int i_ = 0; i_ < 2; ++i_) vGn[hh_][i_] = vGc[hh_][i_]; } }
#pragma unroll 1
        for (int t = 0; t < nt; t += 2) {
            const bool last = (t == nt - 2);
            const char* a1 = cA + (size_t)(t + 1) * kstep;
            const char* a2 = last ? nA : cA + (size_t)(t + 2) * kstep; const char* b2 = last ? nB : cB + (size_t)(t + 2) * kstep;
            const char* a3 = a2 + kstep; const char* b3 = b2 + kstep;
            unsigned v2[2][2];
#pragma unroll
            for (int hh_ = 0; hh_ < 2; ++hh_)
#pragma unroll
                for (int i_ = 0; i_ < 2; ++i_) v2[hh_][i_] = last ? vGn[hh_][i_] : vGc[hh_][i_];
            PG8_LDB(B0, 0, 0); PG8_LDB(B1, 0, 1); PG8_SCHED; PG8_LDA(At, 0, 0); PG8_STAGE_A(PG8_SA(1, 1), a1, 1, vGc);
            PG8_WAIT_V(8); PG8_WAIT_L(0); PG8_BAR; PG8_MMA(0, 0, At, B0); PG8_MMA(0, 1, At, B1); PG8_BAR; PG8_SCHED;
            PG8_LDA(At, 0, 1); PG8_STAGE(PG8_SB(0, 0), b2, voffB); PG8_STAGE(PG8_SB(0, 1), b2 + hstepB, voffB); PG8_STAGE_A(PG8_SA(0, 0), a2, 0, v2);
            PG8_WAIT_V(8); PG8_WAIT_L(0); PG8_BAR; PG8_MMA(1, 0, At, B0); PG8_MMA(1, 1, At, B1); PG8_BAR; PG8_SCHED;
            PG8_LDB(B0, 1, 0); PG8_LDB(B1, 1, 1); PG8_SCHED; PG8_LDA(At, 1, 0); PG8_STAGE_A(PG8_SA(0, 1), a2, 1, v2);
            PG8_WAIT_V(8); PG8_WAIT_L(0); PG8_BAR; PG8_MMA(0, 0, At, B0); PG8_MMA(0, 1, At, B1); PG8_BAR; PG8_SCHED;
            PG8_LDA(At, 1, 1); PG8_STAGE(PG8_SB(1, 0), b3, voffB); PG8_STAGE(PG8_SB(1, 1), b3 + hstepB, voffB); PG8_STAGE_A(PG8_SA(1, 0), a3, 0, v2);
            PG8_WAIT_V(8); PG8_WAIT_L(0); PG8_BAR; PG8_MMA(1, 0, At, B0); PG8_MMA(1, 1, At, B1); PG8_BAR; PG8_SCHED;
        }
        if (wr == 0) PG8_BAR;
        E(acc, cur, wr, wc, fr, fq, xch);
        if (!has_next) break;
#pragma unroll
        for (int a = 0; a < 2; ++a)
#pragma unroll
            for (int b = 0; b < 2; ++b)
#pragma unroll
                for (int m = 0; m < 4; ++m)
#pragma unroll
                    for (int n = 0; n < 2; ++n) acc[a][b][m][n] = (f32x4){0.f, 0.f, 0.f, 0.f};
        cur = nxt; cA = nA; cB = nB; ++ui;
#pragma unroll
        for (int hh_ = 0; hh_ < 2; ++hh_)
#pragma unroll
            for (int i_ = 0; i_ < 2; ++i_) vGc[hh_][i_] = vGn[hh_][i_];
        if (wr == 1) PG8_BAR;
    }
    PG8_WAIT_V(0);
    PG8_BAR;
#undef PG8_SA
#undef PG8_SB
#undef PG8_STAGE
#undef PG8_LDA
#undef PG8_STAGE_A
#undef PG8_GLOAD
#undef PG8_LDB
#undef PG8_MMA
#undef PG8_WAIT_V
#undef PG8_WAIT_L
#undef PG8_BAR
#undef PG8_SCHED
}

struct Dst { bf16* p; int ld; };
__device__ __forceinline__ void store_tile_bf16(const f32x4 (&acc)[2][2][4][2], const Dst d, float sc, int wr, int wc, int fr, int fq) {
    unsigned lane_off = (unsigned)((wr * 64 + fr) * d.ld + wc * 32 + 8 * fq);
    asm volatile("" : "+v"(lane_off));
#pragma unroll
    for (int ai = 0; ai < 2; ++ai)
#pragma unroll
        for (int m = 0; m < 4; ++m) { bf16* rowp = d.p + (size_t)lane_off + (size_t)((ai * HALF + m * 16) * d.ld);
#pragma unroll
            for (int bj = 0; bj < 2; ++bj) { const f32x4 v0 = acc[ai][bj][m][0] * sc, v1 = acc[ai][bj][m][1] * sc;
                u32x4 w; w.x = cvt_pk_bf16(v0[0], v0[1]); w.y = cvt_pk_bf16(v0[2], v0[3]); w.z = cvt_pk_bf16(v1[0], v1[1]); w.w = cvt_pk_bf16(v1[2], v1[3]);
                *(GAS u32x4*)(rowp + bj * HALF) = w; } }
}
}

#define XB_TMO      128
#define XB_XCNT(j)  (256  + 64 * (j))
#define XB_XSUB(j)  (1280 + 64 * (j))
#define XB_XGEN(j)  (2304 + 64 * (j))
#define XB_TOP      3328
#define XB_TOPGEN   3392
#define XCD_BAR_WORDS 3456
#define XB_SPIN_CAP (1u << 20)
__device__ __forceinline__ unsigned xb_ld(unsigned* p)              { return __hip_atomic_load(p, __ATOMIC_RELAXED, __HIP_MEMORY_SCOPE_AGENT); }
__device__ __forceinline__ unsigned xb_add(unsigned* p, unsigned v) { return __hip_atomic_fetch_add(p, v, __ATOMIC_RELAXED, __HIP_MEMORY_SCOPE_AGENT); }
__device__ __forceinline__ unsigned xb_xcc_id() { return (unsigned)__builtin_amdgcn_s_getreg((3 << 11) | 20) & 0xFu; }
#define XB_SPIN(cond, bar) do { unsigned _sp = 0; while (cond) { __builtin_amdgcn_s_sleep(1); \
    if ((++_sp & 255u) == 0u) { if (xb_ld(&(bar)[XB_TMO])) break; if (_sp > XB_SPIN_CAP) { atomicAdd(&(bar)[XB_TMO], 1u); break; } } } } while (0)
struct XcdBarrier { unsigned* bar; unsigned x; volatile LAS unsigned* st; };
__device__ __forceinline__ XcdBarrier xcd_barrier_post(unsigned* bar, volatile LAS unsigned* st) {
    XcdBarrier b; b.bar = bar; b.x = xb_xcc_id(); b.st = st;
    if (threadIdx.x == 0) (void)xb_add(&bar[XB_XCNT(b.x)], 1u);
    return b;
}
__device__ __forceinline__ void xcd_barrier_complete(unsigned* bar, unsigned x, unsigned& nloc, unsigned& nx) {
    const unsigned G = gridDim.x * gridDim.y * gridDim.z;
    unsigned sum, cnt, mine, sp = 0u;
    for (;;) {
        sum = 0u; cnt = 0u; mine = 0u;
#pragma unroll
        for (unsigned j = 0; j < 16; ++j) { const unsigned c = xb_ld(&bar[XB_XCNT(j)]); sum += c; cnt += (c > 0u) ? 1u : 0u; mine = (j == x) ? c : mine; }
        if (sum == G) break;
        __builtin_amdgcn_s_sleep(1);
        if ((++sp & 255u) == 0u) { if (xb_ld(&bar[XB_TMO])) break; if (sp > XB_SPIN_CAP) { atomicAdd(&bar[XB_TMO], 1u); break; } }
    }
    nloc = mine > 0u ? mine : 1u; nx = cnt > 0u ? cnt : 1u;
}
__device__ __forceinline__ void xcd_barrier(const XcdBarrier& b) {
    asm volatile("s_waitcnt vmcnt(0)" ::: "memory");
    __syncthreads();
    if (threadIdx.x == 0) {
        unsigned* bar = b.bar;
        __builtin_amdgcn_s_waitcnt(0);
        unsigned nloc = b.st[0], nx = b.st[1];
        if (nloc == 0u) { xcd_barrier_complete(bar, b.x, nloc, nx); b.st[0] = nloc; b.st[1] = nx; }
        const unsigned old = xb_add(&bar[XB_XSUB(b.x)], 1u);
        const unsigned gen = old / nloc;
        if (old + 1u == (gen + 1u) * nloc) {
            __builtin_amdgcn_fence(__ATOMIC_RELEASE, "agent");
            asm volatile("s_waitcnt vmcnt(0)" ::: "memory");
            const unsigned og = xb_add(&bar[XB_TOP], 1u);
            const unsigned tg = og / nx;
            if (og + 1u == (tg + 1u) * nx) xb_add(&bar[XB_TOPGEN], 1u);
            else XB_SPIN(xb_ld(&bar[XB_TOPGEN]) == tg, bar);
            __builtin_amdgcn_fence(__ATOMIC_ACQUIRE, "agent");
            xb_add(&bar[XB_XGEN(b.x)], 1u);
            asm volatile("s_waitcnt vmcnt(0)" ::: "memory");
        } else {
            XB_SPIN(xb_ld(&bar[XB_XGEN(b.x)]) == gen, bar);
            __builtin_amdgcn_fence(__ATOMIC_ACQUIRE, "agent");
            asm volatile("s_waitcnt vmcnt(0)" ::: "memory");
        }
    }
    __syncthreads();
}

struct Args { const float* in[21]; float* out; unsigned char* ws; int ph_lo, ph_hi; };
struct Frame {
    LAS unsigned char* lds;
    unsigned char* ws;
    gu32* ctl;
    int tid, lane, wave, G, gw, NGW;
};
#define WSP(T_, off) ((T_*)(F.ws + (off)))

__device__ __forceinline__ void tr_item(const float* W, int ldw, int k0, int c0, bf16* dst, int ldd, LAS float* scr, int lane) {
    const int r8 = lane >> 3, c4 = lane & 7;
#pragma unroll
    for (int it = 0; it < 8; ++it) { const int kk = it * 8 + r8; const f32x4 v = *(const GAS f32x4*)(W + (size_t)(k0 + kk) * ldw + c0 + 4 * c4);
        LAS float* s = scr + kk * 33 + 4 * c4; s[0] = v[0]; s[1] = v[1]; s[2] = v[2]; s[3] = v[3]; }
    LDS_WAIT(); asm volatile("" ::: "memory");
    const int c = lane & 7;
#pragma unroll
    for (int j = 0; j < 4; ++j) { const int n = (lane >> 3) + 8 * j; const LAS float* s = scr + (8 * c) * 33 + n;
        u32x4 o; o.x = pk2(s[0 * 33], s[1 * 33]); o.y = pk2(s[2 * 33], s[3 * 33]); o.z = pk2(s[4 * 33], s[5 * 33]); o.w = pk2(s[6 * 33], s[7 * 33]);
        *(GAS u32x4*)(dst + (size_t)n * ldd + k0 + 8 * c) = o; }
    LDS_WAIT(); asm volatile("" ::: "memory");
}
__device__ __forceinline__ void tr_matrix(Frame& F, const float* W, int K, int N, int ldw, bf16* dst, LAS float* scr, int it) {
    const int nblk = N / 32, kb = it / nblk, nb = it % nblk;
    tr_item(W, ldw, 64 * kb, 32 * nb, dst + (size_t)(32 * nb) * K, K, scr, F.lane);
}
__device__ __forceinline__ void p0_prologue(Frame& F, const Args& A) {
    LAS float* scr = (LAS float*)(F.lds + F.wave * 16384);
    constexpr int I_IN = 16 * 112, I_KV = 16 * 64;
    for (int it = F.gw; it < I_IN + 2 * I_KV; it += F.NGW) {
        int r = it;
        if (r < I_IN) { const int kb = r / 112, nb = r % 112;
            tr_item(A.in[2], AB_IN, 64 * kb, 32 * nb + (nb >= 64 ? 8 : 0), WSP(bf16, WS_W_IN) + (size_t)(32 * nb) * D, D, scr, F.lane); continue; } r -= I_IN;
        { const int l = r / I_KV; tr_matrix(F, A.in[12] + (size_t)l * D * 2 * D, D, 2 * D, 2 * D, WSP(bf16, WS_W_KV) + (size_t)l * 2 * D * D, scr, r % I_KV); }
    }
    __syncthreads();
    LAS float* wt = (LAS float*)F.lds;
    for (int i = F.tid; i < 8 * D; i += 512) { const int k = i >> 3, c = i & 7; wt[c * D + k] = A.in[2][(size_t)k * AB_IN + 2048 + c]; }
    __syncthreads();
    const float* x = A.in[0];
    float alg[4], dtb[4];
#pragma unroll
    for (int h = 0; h < 4; ++h) { alg[h] = -__expf(A.in[4][h]); dtb[h] = A.in[5][h]; }
    for (int m = F.gw; m < T; m += F.NGW) {
        const GAS f32x4* xr = (const GAS f32x4*)(x + (size_t)m * D) + F.lane;
        f32x4 v[4];
#pragma unroll
        for (int j = 0; j < 4; ++j) v[j] = xr[64 * j];
        GAS u32x2* o8 = (GAS u32x2*)(WSP(bf16, WS_HB) + (size_t)m * D) + F.lane;
#pragma unroll
        for (int j = 0; j < 4; ++j) { u32x2 w; w.x = pk2(v[j][0], v[j][1]); w.y = pk2(v[j][2], v[j][3]); o8[64 * j] = w; }
        float dot[8];
#pragma unroll
        for (int c = 0; c < 8; ++c) { float s = 0.f;
#pragma unroll
            for (int j = 0; j < 4; ++j) { const f32x4 w = *(const LAS f32x4*)(wt + c * D + 256 * j + 4 * F.lane); s += v[j][0] * w[0] + v[j][1] * w[1] + v[j][2] * w[2] + v[j][3] * w[3]; }
            dot[c] = wave_sum(s); }
        if (F.lane == 0) {
            f32x4 bo, go;
#pragma unroll
            for (int hq = 0; hq < 4; ++hq) { bo[hq] = 1.f / (1.f + __expf(-dot[hq])); const float xx = dot[4 + hq] + dtb[hq]; const float sp = xx > 20.f ? xx : log1pf(__expf(xx)); go[hq] = alg[hq] * sp; }
            *(GAS f32x4*)(WSP(float, WS_BETA) + (size_t)m * 4) = bo;
            *(GAS f32x4*)(WSP(float, WS_GG) + (size_t)m * 4) = go;
        }
    }
    for (int m = F.gw; m < TM; m += F.NGW) {
        const GAS f32x4* xr = (const GAS f32x4*)(A.in[1] + (size_t)m * D) + F.lane;
        GAS u32x2* o8 = (GAS u32x2*)(WSP(bf16, WS_MEMB) + (size_t)m * D) + F.lane;
#pragma unroll
        for (int j = 0; j < 4; ++j) { const f32x4 v = xr[64 * j]; u32x2 w; w.x = pk2(v[0], v[1]); w.y = pk2(v[2], v[3]); o8[64 * j] = w; }
    }
}
constexpr int MOE_I_GU = 16 * 32, MOE_I_D = 8 * 32;
__device__ __forceinline__ void convert_moe_q(Frame& F, const Args& A, int layer, int which  , bf16* dst, unsigned* qword, volatile LAS unsigned* MISC) {
    LAS float* scr = (LAS float*)(F.lds + F.wave * 16384);
    const int nitems = NE * (which == 0 ? MOE_I_GU : MOE_I_D);
    for (;;) {
        __syncthreads();
        if (F.tid == 0) MISC[21] = __hip_atomic_fetch_add(qword, 8u, RLX_AGENT);
        __syncthreads();
        const int it = (int)MISC[21] + F.wave;
        if ((int)MISC[21] >= nitems) break;
        if (it < nitems) {
            if (which == 0) { const int e = it / MOE_I_GU, r = it % MOE_I_GU, kb = r / 32, rb = r % 32, pn = rb >> 3, sub = rb & 7;
                const float* src = (sub < 4 ? A.in[16] : A.in[17]) + ((size_t)layer * NE + e) * D * DE;
                tr_item(src, DE, 64 * kb, 128 * pn + 32 * (sub & 3), dst + ((size_t)e * D + 32 * rb) * D, D, scr, F.lane);
            } else { const int e = it / MOE_I_D, r = it % MOE_I_D, kb = r / 32, nb = r % 32;
                tr_item(A.in[18] + ((size_t)layer * NE + e) * DE * D, D, 64 * kb, 32 * nb, dst + ((size_t)e * D + 32 * nb) * DE, DE, scr, F.lane); }
        }
    }
}

__device__ __forceinline__ void deferred_weights_q(Frame& F, const Args& A, unsigned* qword, volatile LAS unsigned* MISC) {
    LAS float* scr = (LAS float*)(F.lds + F.wave * 16384);
    constexpr int I_SQ = 16 * 32, I_SCI = 16 * 96, I_WQ = 2 * D / 4;
    constexpr int NITEMS = I_SQ + I_SCI + I_SQ + 2 * I_SQ + I_WQ;
    for (;;) {
        __syncthreads();
        if (F.tid == 0) MISC[21] = __hip_atomic_fetch_add(qword, 8u, RLX_AGENT);
        __syncthreads();
        if ((int)MISC[21] >= NITEMS) break;
        int r = (int)MISC[21] + F.wave;
        if (r >= NITEMS) continue;
        if (r < I_SQ) { tr_matrix(F, A.in[7], D, D, D, WSP(bf16, WS_W_ABO), scr, r); continue; } r -= I_SQ;
        if (r < I_SCI) { tr_matrix(F, A.in[8], D, 3 * D, 3 * D, WSP(bf16, WS_W_SCI), scr, r); continue; } r -= I_SCI;
        if (r < I_SQ) { tr_matrix(F, A.in[10], D, D, D, WSP(bf16, WS_W_SCO), scr, r); continue; } r -= I_SQ;
        if (r < 2 * I_SQ) { const int l = r / I_SQ; tr_matrix(F, A.in[13] + (size_t)l * D * D, D, D, D, WSP(bf16, WS_W_O) + (size_t)l * D * D, scr, r % I_SQ); continue; } r -= 2 * I_SQ;
        for (int q = 0; q < 4; ++q) { const int m = r * 4 + q;
            const GAS f32x4* xr = (const GAS f32x4*)(A.in[11] + (size_t)m * D) + F.lane; GAS u32x2* o8 = (GAS u32x2*)(WSP(bf16, WS_W_Q) + (size_t)m * D) + F.lane;
#pragma unroll
            for (int j = 0; j < 4; ++j) { const f32x4 v = xr[64 * j]; u32x2 w; w.x = pk2(v[0], v[1]); w.y = pk2(v[2], v[3]); o8[64 * j] = w; } }
    }
}

struct SchedDense {
    static constexpr bool GATHER = false; __device__ __forceinline__ int row(const pg8::Unit&, int) const { return 0; }
    const char* A; const char* B; int lda, ldb, nM, nN, G, c;
    __device__ __forceinline__ bool next(int i, pg8::Unit& u) const {
        const int L = i * G + c; if (L >= nM * nN) return false;
        pg8::swz_tile(L, nM, nN, u.pm, u.pn); u.aux = 0;
        u.a = A + (size_t)u.pm * 256 * lda * 2; u.b = B + (size_t)u.pn * 256 * ldb * 2; return true; }
};
struct EpiDense {
    static constexpr bool PERM = true;
    bf16* O; int ld; float sc;
    __device__ __forceinline__ void operator()(const f32x4 (&acc)[2][2][4][2], const pg8::Unit& u, int wr, int wc, int fr, int fq, LAS unsigned char*) const {
        pg8::store_tile_bf16(acc, pg8::Dst{O + (size_t)u.pm * 256 * ld + u.pn * 256, ld}, sc, wr, wc, fr, fq); }
};
struct SchedP1 {
    static constexpr bool GATHER = false; __device__ __forceinline__ int row(const pg8::Unit&, int) const { return 0; }
    const char* XB; const char* WIN; const char* MEMB; const char* WKV; int G, c;
    __device__ __forceinline__ bool next(int i, pg8::Unit& u) const {
        const int L = i * G + c; if (L >= 896 + 64) return false;
        if (L < 896) { pg8::swz_tile(L, 64, 14, u.pm, u.pn); u.aux = 0; u.a = XB + (size_t)u.pm * 256 * D * 2; u.b = WIN + (size_t)u.pn * 256 * D * 2; }
        else { const int r = L - 896, l = r >> 5; u.pm = (r & 31) >> 3; u.pn = r & 7; u.aux = 1 + l; u.a = MEMB + (size_t)u.pm * 256 * D * 2; u.b = WKV + ((size_t)l * 2 * D + u.pn * 256) * D * 2; }
        return true; }
};
struct EpiP1 {
    static constexpr bool PERM = true;
    bf16 *QKVPRE, *ZB, *QKVD, *KMEM, *VT;
    __device__ __forceinline__ void operator()(const f32x4 (&acc)[2][2][4][2], const pg8::Unit& u, int wr, int wc, int fr, int fq, LAS unsigned char*) const {
        if (u.aux == 0) {
            pg8::Dst d;
            if (u.pn < 6) d = pg8::Dst{QKVPRE + (size_t)u.pm * 256 * 1536 + u.pn * 256, 1536};
            else if (u.pn < 8) d = pg8::Dst{ZB + (size_t)u.pm * 256 * 512 + (u.pn - 6) * 256, 512};
            else d = pg8::Dst{QKVD + (size_t)u.pm * 256 * 1536 + (u.pn - 8) * 256, 1536};
            pg8::store_tile_bf16(acc, d, (u.pn == 8 || u.pn == 9) ? 0.125f * 1.4426950408889634f : 1.f, wr, wc, fr, fq);
        } else {
            const int l = u.aux - 1;
            if (u.pn < 4) pg8::store_tile_bf16(acc, pg8::Dst{KMEM + ((size_t)l * TM + u.pm * 256) * D + u.pn * 256, D}, 1.f, wr, wc, fr, fq);
            else pg8::store_tile_bf16(acc, pg8::Dst{VT + ((size_t)l * TM + u.pm * 256) * D + (u.pn - 4) * 256, D}, 1.f, wr, wc, fr, fq);
        }
    }
};
struct SchedPrep {
    static constexpr bool GATHER = false; __device__ __forceinline__ int row(const pg8::Unit&, int) const { return 0; }
    const char* KM; const char* WQO; const char* WOT; const char* VM; int G, c;
    __device__ __forceinline__ bool next(int i, pg8::Unit& u) const {
        const int L = i * G + c; if (L >= 256) return false;
        const int l = L >> 7, r = L & 127, kind = r >> 6, q = r & 63, bh = q >> 2, t4 = q & 3, b = bh >> 2, hd = bh & 3;
        u.aux = L; u.pm = 0; u.pn = 0;
        if (kind == 0) { u.a = KM + (((size_t)(l * NB + b) * NMEM) * D + hd * XD) * 2; u.b = WQO + (((size_t)l * D + t4 * 256) * D + hd * XD) * 2; }
        else           { u.a = WOT + (((size_t)l * D + t4 * 256) * D + hd * XD) * 2; u.b = VM + (((size_t)(l * NB + b) * NMEM) * D + hd * XD) * 2; }
        return true; }
};
struct EpiPrep {
    static constexpr bool PERM = true;
    bf16 *MT, *VWT;
    __device__ __forceinline__ void operator()(const f32x4 (&acc)[2][2][4][2], const pg8::Unit& u, int wr, int wc, int fr, int fq, LAS unsigned char*) const {
        const int L = u.aux, l = L >> 7, r = L & 127, kind = r >> 6, q = r & 63, bh = q >> 2, t4 = q & 3, b = bh >> 2, hd = bh & 3;
        if (kind == 0) pg8::store_tile_bf16(acc, pg8::Dst{MT + ((size_t)(l * NB + b) * D + hd * XD) * D + t4 * 256, D}, 0.0625f * 1.4426950408889634f, wr, wc, fr, fq);
        else           pg8::store_tile_bf16(acc, pg8::Dst{VWT + ((size_t)(l * NB + b) * D + t4 * 256) * D + hd * XD, D}, 1.f, wr, wc, fr, fq);
    }
};
struct SchedXB {
    static constexpr bool GATHER = false; __device__ __forceinline__ int row(const pg8::Unit&, int) const { return 0; }
    const char* AB; const char* BB; int G, c;
    __device__ __forceinline__ bool next(int i, pg8::Unit& u) const {
        const int L = i * G + c; if (L >= 256) return false;
        u.pm = L >> 2; u.pn = L & 3; u.aux = 0;
        u.a = AB + (size_t)u.pm * 256 * D * 2; u.b = BB + ((size_t)(u.pm >> 4) * D + u.pn * 256) * D * 2; return true; }
};
struct EpiSoftmax {
    static constexpr bool PERM = true;
    bf16* P;
    __device__ __forceinline__ void operator()(f32x4 (&acc)[2][2][4][2], const pg8::Unit& u, int wr, int wc, int fr, int fq, LAS unsigned char* xch) const {
        LAS float* MX = opq_v((LAS float*)xch + (wr * 64 + fr) * 4);
        LAS float* SM = MX + 1024;
#pragma unroll
        for (int ai = 0; ai < 2; ++ai)
#pragma unroll
            for (int m = 0; m < 4; ++m) { float v = -3.0e38f;
#pragma unroll
                for (int bj = 0; bj < 2; ++bj)
#pragma unroll
                    for (int n = 0; n < 2; ++n) { const f32x4 x = acc[ai][bj][m][n]; v = fmaxf(v, fmaxf(fmaxf(x[0], x[1]), fmaxf(x[2], x[3]))); }
                v = xrow_max(v);
                if (fq == 0) MX[(ai * 128 + m * 16) * 4 + wc] = v; }
        LDS_WAIT(); __builtin_amdgcn_s_barrier(); asm volatile("" ::: "memory");
#pragma unroll
        for (int ai = 0; ai < 2; ++ai)
#pragma unroll
            for (int m = 0; m < 4; ++m) { float s = 0.f; const f32x4 q = *(const LAS f32x4*)(MX + (ai * 128 + m * 16) * 4); const float mxr = fmaxf(fmaxf(q[0], q[1]), fmaxf(q[2], q[3]));
#pragma unroll
                for (int bj = 0; bj < 2; ++bj)
#pragma unroll
                    for (int n = 0; n < 2; ++n) { f32x4 x = acc[ai][bj][m][n];
#pragma unroll
                        for (int e = 0; e < 4; ++e) { x[e] = __builtin_amdgcn_exp2f(x[e] - mxr); s += x[e]; }
                        acc[ai][bj][m][n] = x; }
                s = xrow_sum(s);
                if (fq == 0) SM[(ai * 128 + m * 16) * 4 + wc] = s; asm volatile("" ::: "memory"); }
        LDS_WAIT(); __builtin_amdgcn_s_barrier(); asm volatile("" ::: "memory");
        unsigned lane_off = (unsigned)((wr * 64 + fr) * D + wc * 32 + 8 * fq);
        asm volatile("" : "+v"(lane_off));
        bf16* base = P + (size_t)u.pm * 256 * D + u.pn * XD + lane_off;
#pragma unroll
        for (int ai = 0; ai < 2; ++ai)
#pragma unroll
            for (int m = 0; m < 4; ++m) { const f32x4 q = *(const LAS f32x4*)(SM + (ai * 128 + m * 16) * 4); const float inv = 1.f / ((q[0] + q[1]) + (q[2] + q[3]));
                bf16* rowp = base + (size_t)((ai * 128 + m * 16) * D);
#pragma unroll
                for (int bj = 0; bj < 2; ++bj) { const f32x4 v0 = acc[ai][bj][m][0] * inv, v1 = acc[ai][bj][m][1] * inv;
                    u32x4 w; w.x = pg8::cvt_pk_bf16(v0[0], v0[1]); w.y = pg8::cvt_pk_bf16(v0[2], v0[3]); w.z = pg8::cvt_pk_bf16(v1[0], v1[1]); w.w = pg8::cvt_pk_bf16(v1[2], v1[3]);
                    *(GAS u32x4*)(rowp + bj * 128) = w; } asm volatile("" ::: "memory"); }
        LDS_WAIT(); __builtin_amdgcn_s_barrier(); asm volatile("" ::: "memory");
    }
};
template <bool G_> struct SchedMoE {
    static constexpr bool GATHER = G_;
    const char* Aall; const char* Wall; volatile LAS unsigned* tab; const int* rowmap; int lda, wrows  , ldb, G, c;
    __device__ __forceinline__ int row(const pg8::Unit& u, int r) const { return ((const GAS int*)rowmap)[u.pm * 256 + r]; }
    __device__ __forceinline__ bool next(int i, pg8::Unit& u) const {
        const int L = i * G + c; const int ntile = __builtin_amdgcn_readfirstlane((int)tab[16]); if (L >= ntile * 4) return false;
        u.pm = L >> 2; u.pn = L & 3; const int e = __builtin_amdgcn_readfirstlane((int)tab[32 + u.pm]);
        u.aux = e; u.a = G_ ? Aall : Aall + (size_t)u.pm * 256 * lda * 2; u.b = Wall + ((size_t)e * wrows + u.pn * 256) * ldb * 2; return true; }
};
struct EpiSwiglu {
    static constexpr bool PERM = true;
    bf16* HACT; unsigned* done; int twoG;
    __device__ __forceinline__ void operator()(const f32x4 (&acc)[2][2][4][2], const pg8::Unit& u, int wr, int wc, int fr, int fq, LAS unsigned char*) const {
#pragma unroll
        for (int ai = 0; ai < 2; ++ai)
#pragma unroll
            for (int m = 0; m < 4; ++m) { bf16* rowp = HACT + (size_t)(u.pm * 256 + ai * 128 + wr * 64 + m * 16 + fr) * DE + u.pn * 128 + wc * 32 + 8 * fq;
                float h[8];
#pragma unroll
                for (int n = 0; n < 2; ++n)
#pragma unroll
                    for (int e = 0; e < 4; ++e) { const float gt = acc[ai][0][m][n][e], up = acc[ai][1][m][n][e]; h[n * 4 + e] = silu_f(gt) * up; }
                u32x4 w; w.x = pg8::cvt_pk_bf16(h[0], h[1]); w.y = pg8::cvt_pk_bf16(h[2], h[3]); w.z = pg8::cvt_pk_bf16(h[4], h[5]); w.w = pg8::cvt_pk_bf16(h[6], h[7]);
                if (done) asm volatile("global_store_dwordx4 %0, %1, off sc1\n\ts_nop 1" :: "v"((GAS u32x4*)rowp), "v"(w) : "memory");
                else *(GAS u32x4*)rowp = w; }
        if (done) {
            asm volatile("s_waitcnt vmcnt(0)" ::: "memory"); __builtin_amdgcn_s_barrier(); asm volatile("" ::: "memory");
            if (threadIdx.x == 0) __hip_atomic_fetch_add(done + ((u.pm * 4 + u.pn) < twoG ? 0 : 64), 1u, __ATOMIC_RELAXED, __HIP_MEMORY_SCOPE_AGENT);
        }
    }
};
struct SchedMoE2 {
    static constexpr bool GATHER = false; __device__ __forceinline__ int row(const pg8::Unit&, int) const { return 0; }
    const char* Aall; const char* Wall; volatile LAS unsigned* tab; int G, c;
    __device__ __forceinline__ bool next(int i, pg8::Unit& u) const {
        const int n = 4 * __builtin_amdgcn_readfirstlane((int)tab[16]), G2 = 2 * G, H = n > G2 ? n - G2 : 0; int L;
        if (c < H) { if (i > 0) return false; L = G2 + c; } else { L = (c - H) + i * (G - H); if (L >= (n < G2 ? n : G2)) return false; }
        u.pm = L >> 2; u.pn = L & 3; const int e = __builtin_amdgcn_readfirstlane((int)tab[32 + u.pm]);
        u.aux = e; u.a = Aall + (size_t)u.pm * 256 * DE * 2; u.b = Wall + ((size_t)e * D + u.pn * 256) * DE * 2; return true; }
};
__device__ __forceinline__ void moe_wait_gemm1(Frame& F, unsigned* done, volatile LAS unsigned* tab, int G, int c) {
    if (F.tid == 0) {
        const unsigned n = 4u * tab[16], G2 = 2u * (unsigned)G, needA = n < G2 ? n : G2, H = n > G2 ? n - G2 : 0u; const bool heavy = (unsigned)c < H;
        unsigned sp = 0;
        while (__hip_atomic_load(done, RLX_AGENT) < needA || (heavy && __hip_atomic_load(done + 64, RLX_AGENT) < H)) { __builtin_amdgcn_s_sleep(2); if (++sp > (1u << 22)) break; }
        __builtin_amdgcn_fence(__ATOMIC_ACQUIRE, "agent");
        asm volatile("s_waitcnt vmcnt(0)" ::: "memory");
    }
    __syncthreads();
}


struct Route { int e0, e1, r0, r1; float w0, w1; int s0, s1; };
template <int MODE, bool ROUTER, bool FINAL, bool DRY = false>
__device__ __forceinline__ void ln_pass(Frame& F, const Args& A, const bf16* hold, const bf16* Y, int li  , float* hnew  , bf16* hb, unsigned* cnt) {
    const float* gam = A.in[19] + (size_t)li * D; const float* bet = A.in[20] + (size_t)li * D;
    f32x4 gv[4], bv[4];
#pragma unroll
    for (int j = 0; j < 4; ++j) { gv[j] = *(const GAS f32x4*)(gam + 256 * j + 4 * F.lane); bv[j] = *(const GAS f32x4*)(bet + 256 * j + 4 * F.lane); }
    LAS float* rw = (LAS float*)F.lds;
    LAS float* lgs = (LAS float*)(F.lds + 65536);
    if (ROUTER) { for (int i = F.tid; i < NE * D; i += 512) { const int k = i >> 4, e = i & 15; rw[e * D + k] = A.in[14][i]; } __syncthreads(); }
    Route* route = WSP(Route, WS_ROUTE);
    const int nblk = T / 64;
    for (int blk = blockIdx.x; blk < nblk; blk += F.G) {
        u32x2 hn[4]; u32x2 ya[4], yb[4]; float rw0 = 0.f, rw1 = 0.f;
#define LN_LOAD(mrow) do { const int m_ = (mrow); \
            _Pragma("unroll") for (int j = 0; j < 4; ++j) hn[j] = *((const GAS u32x2*)(hold + (size_t)m_ * D) + F.lane + 64 * j); \
            if (MODE == 0) { _Pragma("unroll") for (int j = 0; j < 4; ++j) ya[j] = *((const GAS u32x2*)(Y + (size_t)m_ * D) + F.lane + 64 * j); } \
            else { const Route r_ = route[m_]; rw0 = r_.w0; rw1 = r_.w1; \
                _Pragma("unroll") for (int j = 0; j < 4; ++j) { ya[j] = *((const GAS u32x2*)(Y + (size_t)r_.s0 * D) + F.lane + 64 * j); yb[j] = *((const GAS u32x2*)(Y + (size_t)r_.s1 * D) + F.lane + 64 * j); } } } while (0)
        LN_LOAD(blk * 64 + F.wave * 8);
#pragma unroll 1
        for (int rr = 0; rr < 8; ++rr) {
            const int m = blk * 64 + F.wave * 8 + rr;
            f32x4 v[4];
#pragma unroll
            for (int j = 0; j < 4; ++j) { v[j][0] = bflo(hn[j].x) * ALPHA; v[j][1] = bfhi(hn[j].x) * ALPHA; v[j][2] = bflo(hn[j].y) * ALPHA; v[j][3] = bfhi(hn[j].y) * ALPHA; }
            if (MODE == 0) {
#pragma unroll
                for (int j = 0; j < 4; ++j) { const u32x2 w = ya[j]; v[j][0] += bflo(w.x); v[j][1] += bfhi(w.x); v[j][2] += bflo(w.y); v[j][3] += bfhi(w.y); }
            } else {
#pragma unroll
                for (int j = 0; j < 4; ++j) { const u32x2 w0 = ya[j], w1 = yb[j];
                    v[j][0] += rw0 * bflo(w0.x) + rw1 * bflo(w1.x); v[j][1] += rw0 * bfhi(w0.x) + rw1 * bfhi(w1.x); v[j][2] += rw0 * bflo(w0.y) + rw1 * bflo(w1.y); v[j][3] += rw0 * bfhi(w0.y) + rw1 * bfhi(w1.y); }
            }
            if (rr < 7) LN_LOAD(m + 1);
            float s = 0.f;
#pragma unroll
            for (int j = 0; j < 4; ++j) s += (v[j][0] + v[j][1]) + (v[j][2] + v[j][3]);
            const float mean = wave_sum(s) * (1.f / D); float s2 = 0.f;
#pragma unroll
            for (int j = 0; j < 4; ++j) { v[j] = v[j] - mean; s2 += (v[j][0] * v[j][0] + v[j][1] * v[j][1]) + (v[j][2] * v[j][2] + v[j][3] * v[j][3]); }
            const float rstd = 1.f / sqrtf(wave_sum(s2) * (1.f / D) + LN_EPS);
#pragma unroll
            for (int j = 0; j < 4; ++j) v[j] = v[j] * rstd * gv[j] + bv[j];
            if (FINAL) {
#pragma unroll
                for (int j = 0; j < 4; ++j) *((GAS f32x4*)(hnew + (size_t)m * D) + F.lane + 64 * j) = v[j];
            } else {
#pragma unroll
                for (int j = 0; j < 4; ++j) { u32x2 w; w.x = pk2(v[j][0], v[j][1]); w.y = pk2(v[j][2], v[j][3]); *((GAS u32x2*)(hb + (size_t)m * D) + F.lane + 64 * j) = w; }
            }
            if (ROUTER) {
                float lg[16];
#pragma unroll
                for (int e = 0; e < 16; ++e) { float d = 0.f;
#pragma unroll
                    for (int j = 0; j < 4; ++j) { const f32x4 w = *(const LAS f32x4*)(rw + e * D + 256 * j + 4 * F.lane); d += v[j][0] * w[0] + v[j][1] * w[1] + v[j][2] * w[2] + v[j][3] * w[3]; }
                    lg[e] = wave_sum(d); }
                if (F.lane == 0) { LAS f32x4* lp = (LAS f32x4*)(lgs + (F.wave * 8 + rr) * 16);
                    lp[0] = (f32x4){lg[0], lg[1], lg[2], lg[3]}; lp[1] = (f32x4){lg[4], lg[5], lg[6], lg[7]}; lp[2] = (f32x4){lg[8], lg[9], lg[10], lg[11]}; lp[3] = (f32x4){lg[12], lg[13], lg[14], lg[15]}; }
            }
        }
        if (ROUTER) {
            __syncthreads();
            if (F.wave == 0) {
                float lg[16];
#pragma unroll
                for (int q = 0; q < 4; ++q) { const f32x4 v4 = *(const LAS f32x4*)(lgs + F.lane * 16 + 4 * q); lg[4 * q] = v4[0]; lg[4 * q + 1] = v4[1]; lg[4 * q + 2] = v4[2]; lg[4 * q + 3] = v4[3]; }
                float mxl = lg[0];
#pragma unroll
                for (int e = 1; e < 16; ++e) mxl = fmaxf(mxl, lg[e]);
                float sc[16], se = 0.f;
#pragma unroll
                for (int e = 0; e < 16; ++e) { sc[e] = __expf(lg[e] - mxl); se += sc[e]; }
                const float inv = 1.f / se; float sl[16];
#pragma unroll
                for (int e = 0; e < 16; ++e) { sc[e] *= inv; sl[e] = sc[e] + A.in[15][e]; }
                int bg = 0; float bgs = -3.0e38f;
#pragma unroll
                for (int g4 = 0; g4 < 4; ++g4) { const float a = sl[4 * g4], b = sl[4 * g4 + 1], c = sl[4 * g4 + 2], d = sl[4 * g4 + 3];
                    const float hi1 = fmaxf(a, b), lo1 = fminf(a, b), hi2 = fmaxf(c, d), lo2 = fminf(c, d);
                    const float top = fmaxf(hi1, hi2), second = fmaxf(fminf(hi1, hi2), fmaxf(lo1, lo2)); const float gs = top + second;
                    if (gs > bgs) { bgs = gs; bg = g4; } }
                float s4[4], c4[4];
#pragma unroll
                for (int q = 0; q < 4; ++q) { s4[q] = bg == 0 ? sl[q] : bg == 1 ? sl[4 + q] : bg == 2 ? sl[8 + q] : sl[12 + q]; c4[q] = bg == 0 ? sc[q] : bg == 1 ? sc[4 + q] : bg == 2 ? sc[8 + q] : sc[12 + q]; }
                int i0 = 0; float b0 = s4[0];
#pragma unroll
                for (int q = 1; q < 4; ++q) if (s4[q] > b0) { b0 = s4[q]; i0 = q; }
                int i1 = -1; float b1 = -3.0e38f;
#pragma unroll
                for (int q = 0; q < 4; ++q) if (q != i0 && s4[q] > b1) { b1 = s4[q]; i1 = q; }
                const float p0 = i0 == 0 ? c4[0] : i0 == 1 ? c4[1] : i0 == 2 ? c4[2] : c4[3];
                const float p1 = i1 == 0 ? c4[0] : i1 == 1 ? c4[1] : i1 == 2 ? c4[2] : c4[3];
                const int e0 = bg * 4 + i0, e1 = bg * 4 + i1;
                const unsigned long long lt = (1ull << F.lane) - 1ull;
                int r0 = 0, r1 = 0, mycount = 0;
#pragma unroll
                for (int e = 0; e < 16; ++e) { const unsigned long long m0 = __ballot(e0 == e), m1 = __ballot(e1 == e);
                    const int before = __popcll(m0 & lt) + __popcll(m1 & lt);
                    if (e0 == e) r0 = before; if (e1 == e) r1 = before;
                    if (F.lane == e) mycount = __popcll(m0) + __popcll(m1); }
                int base = 0; if (F.lane < 16 && mycount > 0 && !DRY) base = (int)atomicAdd(cnt + F.lane, (unsigned)mycount);
                Route r; r.e0 = e0; r.e1 = e1; r.r0 = r0 + __shfl(base, e0); r.r1 = r1 + __shfl(base, e1); r.w0 = p0 / (p0 + p1); r.w1 = p1 / (p0 + p1); r.s0 = 0; r.s1 = 0;
                if (!DRY) route[blk * 64 + F.lane] = r;
            }
            __syncthreads();
        }
    }
}
constexpr int LR_WR = 0, LR_HN = 65792, LR_PART = 131584, LR_LGS = 139776, LR_RS = 1028;
template <bool DRY> __device__ __forceinline__ void ln_router_pass(Frame& F, const Args& A, const bf16* hold, const bf16* Y, int li, bf16* hb, unsigned* cnt) {
    const float* gam = A.in[19] + (size_t)li * D; const float* bet = A.in[20] + (size_t)li * D;
    f32x4 gv[4], bv[4];
#pragma unroll
    for (int j = 0; j < 4; ++j) { gv[j] = *(const GAS f32x4*)(gam + 256 * j + 4 * F.lane); bv[j] = *(const GAS f32x4*)(bet + 256 * j + 4 * F.lane); }
    LAS unsigned char* L = opq_v(F.lds); LAS unsigned char* Lh = opq_v(F.lds + LR_HN); LAS unsigned char* Lp = opq_v(F.lds + LR_PART);
    LAS float* WR = (LAS float*)L; LAS float* HN = (LAS float*)Lh; LAS float* PART = (LAS float*)Lp; LAS float* lgs = (LAS float*)(Lp + (LR_LGS - LR_PART));
    for (int i = F.tid; i < NE * D; i += 512) { const int k = i >> 4, e = i & 15; WR[e * LR_RS + (k & 3) * 256 + (k >> 2)] = ((const GAS float*)A.in[14])[i]; }
    __syncthreads();
    Route* route = WSP(Route, WS_ROUTE);
    const int lane = F.lane, wave = F.wave;
    for (int blk = blockIdx.x; blk < T / 64; blk += F.G) {
        u32x2 hn[4], ya[4];
#define LR_LOAD(mrow) do { const int m_ = (mrow); \
            _Pragma("unroll") for (int j = 0; j < 4; ++j) { hn[j] = *((const GAS u32x2*)(hold + (size_t)m_ * D) + lane + 64 * j); ya[j] = *((const GAS u32x2*)(Y + (size_t)m_ * D) + lane + 64 * j); } } while (0)
        LR_LOAD(blk * 64 + 2 * wave);
#pragma unroll 1
        for (int grp = 0; grp < 4; ++grp) {
#pragma unroll
            for (int q = 0; q < 2; ++q) {
                const int tk = grp * 16 + 2 * wave + q, m = blk * 64 + tk;
                f32x4 v[4];
#pragma unroll
                for (int j = 0; j < 4; ++j) { v[j][0] = bflo(hn[j].x) * ALPHA + bflo(ya[j].x); v[j][1] = bfhi(hn[j].x) * ALPHA + bfhi(ya[j].x); v[j][2] = bflo(hn[j].y) * ALPHA + bflo(ya[j].y); v[j][3] = bfhi(hn[j].y) * ALPHA + bfhi(ya[j].y); }
                if (!(grp == 3 && q == 1)) LR_LOAD(q == 0 ? m + 1 : blk * 64 + (grp + 1) * 16 + 2 * wave);
                float s = 0.f;
#pragma unroll
                for (int j = 0; j < 4; ++j) s += (v[j][0] + v[j][1]) + (v[j][2] + v[j][3]);
                const float mean = wave_sum(s) * (1.f / D); float s2 = 0.f;
#pragma unroll
                for (int j = 0; j < 4; ++j) { v[j] = v[j] - mean; s2 += (v[j][0] * v[j][0] + v[j][1] * v[j][1]) + (v[j][2] * v[j][2] + v[j][3] * v[j][3]); }
                const float rstd = 1.f / sqrtf(wave_sum(s2) * (1.f / D) + LN_EPS);
#pragma unroll
                for (int j = 0; j < 4; ++j) v[j] = v[j] * rstd * gv[j] + bv[j];
                bf16* hrow = (DRY ? hb + (size_t)(m & 16383) * D : hb + (size_t)m * D);
#pragma unroll
                for (int j = 0; j < 4; ++j) { u32x2 w; w.x = pk2(v[j][0], v[j][1]); w.y = pk2(v[j][2], v[j][3]); *((GAS u32x2*)hrow + lane + 64 * j) = w; }
#pragma unroll
                for (int j = 0; j < 4; ++j)
#pragma unroll
                    for (int e = 0; e < 4; ++e) HN[(2 * wave + q) * LR_RS + e * 256 + lane + 64 * j] = v[j][e];
            }
            __syncthreads();
            {
                const int r16 = lane & 15, kq = lane >> 4;
                f32x4 acc = {0.f, 0.f, 0.f, 0.f};
#pragma unroll
                for (int i = 0; i < 8; ++i) { const f32x4 a4 = *(const LAS f32x4*)(HN + r16 * LR_RS + kq * 256 + 32 * wave + 4 * i), b4 = *(const LAS f32x4*)(WR + r16 * LR_RS + kq * 256 + 32 * wave + 4 * i);
#pragma unroll
                    for (int jj = 0; jj < 4; ++jj) acc = __builtin_amdgcn_mfma_f32_16x16x4f32(a4[jj], b4[jj], acc, 0, 0, 0); }
                *(LAS f32x4*)(PART + (wave * 64 + lane) * 4) = acc;
            }
            __syncthreads();
            if (F.tid < 256) { const int row = F.tid >> 4, e = F.tid & 15, src = ((row >> 2) * 16 + e) * 4 + (row & 3); float sum = 0.f;
#pragma unroll
                for (int w8 = 0; w8 < 8; ++w8) sum += PART[w8 * 256 + src];
                lgs[(grp * 16 + row) * 16 + e] = sum; }
        }
#undef LR_LOAD
        __syncthreads();
        if (wave == 0) {
            float lg[16];
#pragma unroll
            for (int q = 0; q < 4; ++q) { const f32x4 v4 = *(const LAS f32x4*)(lgs + lane * 16 + 4 * q); lg[4 * q] = v4[0]; lg[4 * q + 1] = v4[1]; lg[4 * q + 2] = v4[2]; lg[4 * q + 3] = v4[3]; }
            float mxl = lg[0];
#pragma unroll
            for (int e = 1; e < 16; ++e) mxl = fmaxf(mxl, lg[e]);
            float sc[16], se = 0.f;
#pragma unroll
            for (int e = 0; e < 16; ++e) { sc[e] = __expf(lg[e] - mxl); se += sc[e]; }
            const float inv = 1.f / se; float sl[16];
#pragma unroll
            for (int e = 0; e < 16; ++e) { sc[e] *= inv; sl[e] = sc[e] + A.in[15][e]; }
            int bg = 0; float bgs = -3.0e38f;
#pragma unroll
            for (int g4 = 0; g4 < 4; ++g4) { const float a = sl[4 * g4], b = sl[4 * g4 + 1], c = sl[4 * g4 + 2], d = sl[4 * g4 + 3];
                const float hi1 = fmaxf(a, b), lo1 = fminf(a, b), hi2 = fmaxf(c, d), lo2 = fminf(c, d);
                const float top = fmaxf(hi1, hi2), second = fmaxf(fminf(hi1, hi2), fmaxf(lo1, lo2)); const float gs = top + second;
                if (gs > bgs) { bgs = gs; bg = g4; } }
            float s4[4], c4[4];
#pragma unroll
            for (int q = 0; q < 4; ++q) { s4[q] = bg == 0 ? sl[q] : bg == 1 ? sl[4 + q] : bg == 2 ? sl[8 + q] : sl[12 + q]; c4[q] = bg == 0 ? sc[q] : bg == 1 ? sc[4 + q] : bg == 2 ? sc[8 + q] : sc[12 + q]; }
            int i0 = 0; float b0 = s4[0];
#pragma unroll
            for (int q = 1; q < 4; ++q) if (s4[q] > b0) { b0 = s4[q]; i0 = q; }
            int i1 = -1; float b1 = -3.0e38f;
#pragma unroll
            for (int q = 0; q < 4; ++q) if (q != i0 && s4[q] > b1) { b1 = s4[q]; i1 = q; }
            const float p0 = i0 == 0 ? c4[0] : i0 == 1 ? c4[1] : i0 == 2 ? c4[2] : c4[3];
            const float p1 = i1 == 0 ? c4[0] : i1 == 1 ? c4[1] : i1 == 2 ? c4[2] : c4[3];
            const int e0 = bg * 4 + i0, e1 = bg * 4 + i1;
            const unsigned long long lt = (1ull << lane) - 1ull;
            int r0 = 0, r1 = 0, mycount = 0;
#pragma unroll
            for (int e = 0; e < 16; ++e) { const unsigned long long m0 = __ballot(e0 == e), m1 = __ballot(e1 == e);
                const int before = __popcll(m0 & lt) + __popcll(m1 & lt);
                if (e0 == e) r0 = before; if (e1 == e) r1 = before;
                if (lane == e) mycount = __popcll(m0) + __popcll(m1); }
            int base = 0; if (lane < 16 && mycount > 0 && !DRY) base = (int)atomicAdd(cnt + lane, (unsigned)mycount);
            Route r; r.e0 = e0; r.e1 = e1; r.r0 = r0 + __shfl(base, e0); r.r1 = r1 + __shfl(base, e1); r.w0 = p0 / (p0 + p1); r.w1 = p1 / (p0 + p1); r.s0 = 0; r.s1 = 0;
            if (!DRY) route[blk * 64 + lane] = r;
        }
        __syncthreads();
    }
}

__device__ __forceinline__ void moe_table(Frame& F, const unsigned* cnt, volatile LAS unsigned* tab) {
    if (F.tid == 0) { unsigned t = 0; for (int e = 0; e < 16; ++e) { tab[e] = t; t += (__hip_atomic_load(cnt + e, RLX_AGENT) + 255u) >> 8; } tab[16] = t; }
    __syncthreads();
    if (F.tid < 144) { unsigned e = 0; for (int j = 1; j < 16; ++j) e += (tab[j] <= (unsigned)F.tid) ? 1u : 0u; tab[32 + F.tid] = e; }
    __syncthreads();
}
__device__ __forceinline__ void moe_slots(Frame& F, volatile LAS unsigned* tab, int* inv) {
    Route* route = WSP(Route, WS_ROUTE);
    for (int m = blockIdx.x * 512 + F.tid; m < T; m += F.G * 512) {
        const Route r = route[m];
        const int s0 = (int)tab[r.e0] * 256 + r.r0, s1 = (int)tab[r.e1] * 256 + r.r1;
        route[m].s0 = s0; route[m].s1 = s1; inv[s0] = m; inv[s1] = m;
    }
}

__device__ __forceinline__ void conv_pass(Frame& F, const Args& A, const bf16* prj, bf16* ub) {
    const float* cw = A.in[9];
    for (int it = F.gw; it < (T / 16) * 2; it += F.NGW) {
        const int tb = it >> 1, c0 = (it & 1) * 512 + F.lane * 8; const int t0 = tb * 16, pos0 = t0 % SEQ;
        float w[3][8];
#pragma unroll
        for (int j = 0; j < 3; ++j) { const f32x4 a = *(const GAS f32x4*)(cw + j * D + c0), b = *(const GAS f32x4*)(cw + j * D + c0 + 4);
#pragma unroll
            for (int e = 0; e < 4; ++e) { w[j][e] = a[e]; w[j][4 + e] = b[e]; } }
        float p2[8], p1[8];
#pragma unroll
        for (int e = 0; e < 8; ++e) { p2[e] = 0.f; p1[e] = 0.f; }
#pragma unroll
        for (int q = 0; q < 2; ++q) { if (pos0 - 2 + q >= 0) { const bf16* r = prj + (size_t)(t0 - 2 + q) * 3072;
                const u32x4 gc = *(const GAS u32x4*)(r + 1024 + c0), hd = *(const GAS u32x4*)(r + 2048 + c0);
#pragma unroll
                for (int e = 0; e < 4; ++e) { const float lo = bflo(gc[e]) * bflo(hd[e]), hi = bfhi(gc[e]) * bfhi(hd[e]); if (q == 0) { p2[2 * e] = lo; p2[2 * e + 1] = hi; } else { p1[2 * e] = lo; p1[2 * e + 1] = hi; } } } }
#pragma unroll 4
        for (int tt = 0; tt < 16; ++tt) { const bf16* r = prj + (size_t)(t0 + tt) * 3072;
            const u32x4 gb = *(const GAS u32x4*)(r + c0), gc = *(const GAS u32x4*)(r + 1024 + c0), hd = *(const GAS u32x4*)(r + 2048 + c0);
            float p0[8], o[8];
#pragma unroll
            for (int e = 0; e < 4; ++e) { p0[2 * e] = bflo(gc[e]) * bflo(hd[e]); p0[2 * e + 1] = bfhi(gc[e]) * bfhi(hd[e]); }
#pragma unroll
            for (int e = 0; e < 8; ++e) { const float cv = w[0][e] * p2[e] + w[1][e] * p1[e] + w[2][e] * p0[e]; const float g = (e & 1) ? bfhi(gb[e >> 1]) : bflo(gb[e >> 1]); o[e] = g * cv; p2[e] = p1[e]; p1[e] = p0[e]; }
            u32x4 wv; wv.x = pk2(o[0], o[1]); wv.y = pk2(o[2], o[3]); wv.z = pk2(o[4], o[5]); wv.w = pk2(o[6], o[7]);
            *(GAS u32x4*)(ub + (size_t)(t0 + tt) * D + c0) = wv; }
    }
}

constexpr int D1_QB = 0, D1_KB = 17408, D1_E = D1_KB, D1_AT = 34816, D1_KT = 44032, D1_RT = 62464, D1_P = 99328, D1_PT = D1_P + 9216, D1_ET = D1_PT + 9216, D1_UW = D1_P, D1_GC = 136192;
constexpr int RSB = 272, RSS = 144;
static_assert(D1_GC + 2 * 256 <= MISC_OFF && D1_UW + 36864 <= D1_GC && D1_RT + 3 * 67 * 272 <= D1_ET, "D1 LDS");
__device__ __forceinline__ f32x4 tile_k64(const LAS unsigned char* xr, const LAS unsigned char* yr, f32x4 acc) {
#pragma unroll
    for (int s = 0; s < 2; ++s) acc = __builtin_amdgcn_mfma_f32_16x16x32_bf16(*(const LAS bf16x8*)(xr + 64 * s), *(const LAS bf16x8*)(yr + 64 * s), acc, 0, 0, 0);
    return acc;
}
template <int VAR> __device__ __forceinline__ void d1_unit(Frame& F, const Args& A, int unit) {
    if (VAR == 4) return;
    const int bh = unit >> 6, n = unit & 63, b = bh >> 2, h = bh & 3;
    const int t0 = b * SEQ + n * 64;
    const int lane = F.lane, wave = F.wave, g = lane >> 4, c = lane & 15;
    LAS unsigned char* L = F.lds;
    LAS unsigned char* L0 = opq_v(L); LAS unsigned char* L1 = opq_v(L + D1_RT); LAS unsigned char* L2 = opq_v(L + D1_P);
    LAS float* gcs = (LAS float*)(L2 + (D1_GC - D1_P)); LAS float* betas = gcs + 64;
    LAS unsigned char* LQB = L0 + D1_QB; LAS unsigned char* LKB = L0 + D1_KB; LAS unsigned char* LAT = L0 + D1_AT; LAS unsigned char* LKT = L0 + D1_KT;
    LAS unsigned char* LRT = L1; LAS unsigned char* LP = L2; LAS unsigned char* LPT = L2 + 9216; LAS unsigned char* LET = L2 + 18432;
    LAS unsigned char* LUW = L2; LAS unsigned char* LE = L0 + D1_E;
    const int i = lane;
    float gc = ((const GAS float*)WSP(float, WS_GG))[(size_t)(t0 + lane) * 4 + h];
    const float bt = ((const GAS float*)WSP(float, WS_BETA))[(size_t)(t0 + lane) * 4 + h];
    int wvb[3];
    LAS unsigned char* RAW = L1;
    {
        const bf16* pre = WSP(bf16, WS_QKVPRE);
        const float* cwp = A.in[3];
#pragma unroll
        for (int x = 0; x < 3; ++x) wvb[x] = __float_as_int(((const GAS float*)cwp)[(lane >> 4) * 1536 + x * 512 + h * 128 + 16 * wave + (lane & 15)]);
        u32x4 rv[7];
#pragma unroll
        for (int k = 0; k < 7; ++k) { int p = F.tid + 512 * k; p = p < 3216 ? p : 3215; const int x = p / 1072, rem = p - x * 1072, row = rem >> 4, pc = rem & 15;
            const bool okr = (n * 64 - 3 + row >= 0); const int rowi = okr ? (t0 - 3 + row) : t0;
            rv[k] = *(const GAS u32x4*)(pre + (size_t)rowi * 1536 + x * 512 + h * 128 + pc * 8); if (!okr) rv[k] = (u32x4){0u, 0u, 0u, 0u}; }
#pragma unroll
        for (int k = 0; k < 7; ++k) { const int p = F.tid + 512 * k; if (p < 3216) { const int x = p / 1072, rem = p - x * 1072, row = rem >> 4, pc = rem & 15; *(LAS u32x4*)(RAW + (x * 67 + row) * RSB + pc * 16) = rv[k]; } }
    }
    __syncthreads();
#pragma unroll
    for (int o = 1; o < 64; o <<= 1) { const float t = __shfl_up(gc, o); if (lane >= o) gc += t; }
    const float gc63 = __shfl(gc, 63);
    if (wave == 0) { gcs[lane] = gc; betas[lane] = bt; }
    {
        float ov[3][16];
#pragma unroll
        for (int x = 0; x < 3; ++x) {
#define RL(k) __int_as_float(__builtin_amdgcn_readlane(wvb[x], (k)))
            float acc[16];
#pragma unroll
            for (int e = 0; e < 16; ++e) acc[e] = 0.f;
#pragma unroll
            for (int j = 0; j < 4; ++j) {
                const u32x4 r0 = *(const LAS u32x4*)(RAW + (x * 67 + i + j) * RSB + 32 * wave), r1 = *(const LAS u32x4*)(RAW + (x * 67 + i + j) * RSB + 32 * wave + 16);
#pragma unroll
                for (int e = 0; e < 4; ++e) { const float w0 = RL(j * 16 + 2 * e), w1 = RL(j * 16 + 2 * e + 1), w2 = RL(j * 16 + 8 + 2 * e), w3 = RL(j * 16 + 8 + 2 * e + 1);
                    acc[2 * e] += w0 * bflo(r0[e]); acc[2 * e + 1] += w1 * bfhi(r0[e]); acc[8 + 2 * e] += w2 * bflo(r1[e]); acc[8 + 2 * e + 1] += w3 * bfhi(r1[e]); }
            }
#pragma unroll
            for (int e = 0; e < 16; ++e) ov[x][e] = silu_f(acc[e]);
#undef RL
        }
        float sq = 0.f, sk = 0.f;
#pragma unroll
        for (int e = 0; e < 16; ++e) { sq += ov[0][e] * ov[0][e]; sk += ov[1][e] * ov[1][e]; }
        LAS float* part = (LAS float*)LET;
        part[wave * 64 + i] = sq; part[512 + wave * 64 + i] = sk;
        __syncthreads();
        float tq = 0.f, tk = 0.f;
#pragma unroll
        for (int w8 = 0; w8 < 8; ++w8) { tq += part[w8 * 64 + i]; tk += part[512 + w8 * 64 + i]; }
        const float rq = rsqrtf(tq + RMS_EPS) * 0.08838834764831845f, rk = rsqrtf(tk + RMS_EPS);
        const float kt = __expf(gc63 - gc), be = bt * __expf(gc);
        u32x4 qw[2], kw[2];
#pragma unroll
        for (int e = 0; e < 8; ++e) { qw[e >> 2][e & 3] = pk2(ov[0][2 * e] * rq, ov[0][2 * e + 1] * rq); kw[e >> 2][e & 3] = pk2(ov[1][2 * e] * rk, ov[1][2 * e + 1] * rk); }
        *(LAS u32x4*)(LQB + i * RSB + 32 * wave) = qw[0]; *(LAS u32x4*)(LQB + i * RSB + 32 * wave + 16) = qw[1];
        *(LAS u32x4*)(LKB + i * RSB + 32 * wave) = kw[0]; *(LAS u32x4*)(LKB + i * RSB + 32 * wave + 16) = kw[1];
#pragma unroll
        for (int e = 0; e < 16; ++e) { const float kv = ov[1][e] * rk; const int d = 16 * wave + e;
            *(LAS unsigned short*)(LKT + d * RSS + 2 * i) = (unsigned short)f2bf(kv * kt);
            *(LAS unsigned short*)(LRT + d * RSS + 2 * i) = (unsigned short)f2bf(ov[2][e] * bt);
            *(LAS unsigned short*)(LRT + (128 + d) * RSS + 2 * i) = (unsigned short)f2bf(kv * be); }
    }
    __syncthreads();
    if (VAR == 1) return;
    f32x4 Er[2], Pcur[2];
#pragma unroll
    for (int it = 0; it < 4; ++it) {
        const int id = wave + 8 * (it & 1), isq = it >> 1, mi = id >> 2, nj = id & 3;
        f32x4 acc = {0.f, 0.f, 0.f, 0.f};
        if (mi >= nj) {
            const LAS unsigned char* xr = (isq ? LQB : LKB) + (16 * mi + c) * RSB + 16 * g;
            const LAS unsigned char* yr = LKB + (16 * nj + c) * RSB + 16 * g;
#pragma unroll
            for (int s = 0; s < 4; ++s) acc = __builtin_amdgcn_mfma_f32_16x16x32_bf16(*(const LAS bf16x8*)(xr + 64 * s), *(const LAS bf16x8*)(yr + 64 * s), acc, 0, 0, 0);
        }
        const int j = 16 * nj + c; const float gj = gcs[j];
        f32x4 o;
#pragma unroll
        for (int r = 0; r < 4; ++r) { const int i = 16 * mi + 4 * g + r; const float dec = (i >= j) ? __expf(gcs[i] - gj) : 0.f;
            o[r] = isq ? ((i >= j) ? acc[r] * dec : 0.f) : ((i > j) ? -betas[i] * acc[r] * dec : 0.f); }
        if (!isq) { Er[it & 1] = o; Pcur[it & 1] = o;
            u32x2 w; w.x = pk2(o[0], o[1]); w.y = pk2(o[2], o[3]);
            *(LAS u32x2*)(LPT + j * RSS + 2 * (16 * mi + 4 * g)) = w; *(LAS u32x2*)(LET + j * RSS + 2 * (16 * mi + 4 * g)) = w;
#pragma unroll
            for (int r = 0; r < 4; ++r) *(LAS unsigned short*)(LP + (16 * mi + 4 * g + r) * RSS + 2 * j) = (unsigned short)f2bf(o[r]);
        } else {
#pragma unroll
            for (int r = 0; r < 4; ++r) *(LAS unsigned short*)(LAT + (16 * mi + 4 * g + r) * RSS + 2 * j) = (unsigned short)f2bf(o[r]);
        }
    }
#pragma unroll 1
    for (int s6 = 0; s6 < 6; ++s6) {
        __syncthreads();
        f32x4 Pn[2], En[2];
#pragma unroll
        for (int tt = 0; tt < 2; ++tt) { const int id = wave + 8 * tt, mi = id >> 2, nj = id & 3;
            const LAS unsigned char* pr = LP + (16 * mi + c) * RSS + 16 * g;
            if (s6 < 5) Pn[tt] = tile_k64(pr, LPT + (16 * nj + c) * RSS + 16 * g, (f32x4){0.f, 0.f, 0.f, 0.f});
            if (s6 > 0) En[tt] = tile_k64(pr, LET + (16 * nj + c) * RSS + 16 * g, Er[tt] + Pcur[tt]); }
        __syncthreads();
#pragma unroll
        for (int tt = 0; tt < 2; ++tt) { const int id = wave + 8 * tt, mi = id >> 2, nj = id & 3, j = 16 * nj + c;
            if (s6 > 0) { Er[tt] = En[tt]; u32x2 w; w.x = pk2(En[tt][0], En[tt][1]); w.y = pk2(En[tt][2], En[tt][3]); *(LAS u32x2*)(LET + j * RSS + 2 * (16 * mi + 4 * g)) = w; }
            if (s6 < 5) { Pcur[tt] = Pn[tt]; u32x2 w; w.x = pk2(Pn[tt][0], Pn[tt][1]); w.y = pk2(Pn[tt][2], Pn[tt][3]); *(LAS u32x2*)(LPT + j * RSS + 2 * (16 * mi + 4 * g)) = w;
#pragma unroll
                for (int r = 0; r < 4; ++r) *(LAS unsigned short*)(LP + (16 * mi + 4 * g + r) * RSS + 2 * j) = (unsigned short)f2bf(Pn[tt][r]); } }
    }
    if (VAR == 2) { __syncthreads(); return; }
#pragma unroll
    for (int tt = 0; tt < 2; ++tt) { const int id = wave + 8 * tt, mi = id >> 2, nj = id & 3, j = 16 * nj + c;
#pragma unroll
        for (int r = 0; r < 4; ++r) *(LAS unsigned short*)(LE + (16 * mi + 4 * g + r) * RSS + 2 * j) = (unsigned short)f2bf(Er[tt][r]); }
    __syncthreads();
    {
        f32x4 xo[8];
#pragma unroll
        for (int q = 0; q < 8; ++q) { const int t = wave + 8 * q, mi = t >> 4, ct = t & 15;
            const u32x2 rv = *(const LAS u32x2*)(LRT + (16 * ct + c) * RSS + 2 * (16 * mi + 4 * g));
            xo[q] = tile_k64(LE + (16 * mi + c) * RSS + 16 * g, LRT + (16 * ct + c) * RSS + 16 * g, (f32x4){bflo(rv.x), bfhi(rv.x), bflo(rv.y), bfhi(rv.y)}); }
        __syncthreads();
#pragma unroll
        for (int q = 0; q < 8; ++q) { const int t = wave + 8 * q, mi = t >> 4, ct = t & 15;
            u32x2 w; w.x = pk2(xo[q][0], xo[q][1]); w.y = pk2(xo[q][2], xo[q][3]);
            *(LAS u32x2*)(LUW + (16 * ct + c) * RSS + 2 * (16 * mi + 4 * g)) = w; }
    }
    __syncthreads();
    if (VAR == 3) return;
    const LAS unsigned char* UWr = LUW; const LAS unsigned char* ATr = LAT; const LAS unsigned char* KTr = LKT;
    const size_t cbase = (size_t)unit; const f32x4 z4 = {0.f, 0.f, 0.f, 0.f};
#pragma unroll 2
    for (int q_ = 0; q_ < 4; ++q_) { const int t = wave + 8 * q_; const int xi = t >> 3, yj = t & 7;
        const f32x4 d = tile_k64(ATr + (16 * xi + c) * RSS + 16 * g, UWr + (16 * yj + c) * RSS + 16 * g, z4);
        u32x2 w; w.x = pk2(d[0], d[1]); w.y = pk2(d[2], d[3]);
        *(GAS u32x2*)(WSP(bf16, WS_OLOCT) + cbase * 8192 + (size_t)((yj * 4 + xi) * 64 + lane) * 4) = w; }
#pragma unroll 2
    for (int q_ = 0; q_ < 4; ++q_) { const int t = wave + 8 * q_; const int xi = t >> 2, yj = t & 3;
        const f32x4 d = tile_k64(UWr + (128 + 16 * xi + c) * RSS + 16 * g, ATr + (16 * yj + c) * RSS + 16 * g, z4);
        const int i2 = 16 * yj + c, dd = 16 * xi + 4 * g; const float eg = __expf(gcs[i2]);
        const u32x2 qv = *(const LAS u32x2*)(LQB + i2 * RSB + 2 * dd);
        u32x2 w; w.x = pk2(bflo(qv.x) * eg - d[0], bfhi(qv.x) * eg - d[1]); w.y = pk2(bflo(qv.y) * eg - d[2], bfhi(qv.y) * eg - d[3]);
        *(GAS u32x2*)(WSP(bf16, WS_QEFF) + cbase * 8192 + (size_t)(((yj * 4 + (xi >> 1)) * 64 + (2 * (xi & 1) + (g >> 1)) * 16 + c) * 8 + 4 * (g & 1))) = w; }
#pragma unroll 2
    for (int q_ = 0; q_ < 8; ++q_) { const int t = wave + 8 * q_; const int xi = t >> 3, yj = t & 7;
        const f32x4 d = tile_k64(KTr + (16 * xi + c) * RSS + 16 * g, UWr + (16 * yj + c) * RSS + 16 * g, z4);
        u32x2 w; w.x = pk2(d[0], d[1]); w.y = pk2(d[2], d[3]);
        *(GAS u32x2*)(WSP(bf16, WS_BMT) + cbase * 16384 + (size_t)(((yj * 4 + (xi >> 1)) * 2 + (xi & 1)) * 64 + lane) * 4) = w; }
#pragma unroll 2
    for (int q_ = 0; q_ < 8; ++q_) { const int t = wave + 8 * q_; const int xi = t >> 3, yj = t & 7;
        const f32x4 d = tile_k64(UWr + (128 + 16 * xi + c) * RSS + 16 * g, KTr + (16 * yj + c) * RSS + 16 * g, z4);
        u32x2 w; w.x = pk2(-d[0], -d[1]); w.y = pk2(-d[2], -d[3]);
        *(GAS u32x2*)(WSP(bf16, WS_MNEG) + cbase * 16384 + (size_t)(((yj * 4 + (xi >> 1)) * 64 + (2 * (xi & 1) + (g >> 1)) * 16 + c) * 8 + 4 * (g & 1))) = w; }
    if (F.tid == 0) WSP(float, WS_GLAST)[unit] = __expf(gc63);
    __syncthreads();
}

constexpr int SCAN_PF = 4;
__device__ __forceinline__ void scan_wg(Frame& F, int sw) {
    const int bh = sw & 15, slice = sw >> 4, b = bh >> 2, h = bh & 3;
    const int lane = F.lane, wave = F.wave, g = lane >> 4, c = lane & 15;
    LAS unsigned char* ST = opq_v(F.lds);
    LAS unsigned char* OS = ST + 8704;
    for (int i = F.tid; i < 2 * 4352 / 4; i += 512) ((LAS unsigned*)ST)[i] = 0u;
    __syncthreads();
    const GAS bf16* MN = (const GAS bf16*)(WSP(bf16, WS_MNEG) + (size_t)bh * 64 * 16384); const GAS bf16* BM = (const GAS bf16*)(WSP(bf16, WS_BMT) + (size_t)bh * 64 * 16384);
    const GAS bf16* QE = (const GAS bf16*)(WSP(bf16, WS_QEFF) + (size_t)bh * 64 * 8192); const GAS bf16* OL = (const GAS bf16*)(WSP(bf16, WS_OLOCT) + (size_t)bh * 64 * 8192);
    const GAS float* GL = (const GAS float*)(WSP(float, WS_GLAST) + bh * 64);
    (void)b; (void)h;
    if (wave < 4) {
        f32x4 Sreg[2] = {{0.f, 0.f, 0.f, 0.f}, {0.f, 0.f, 0.f, 0.f}};
        bf16x8 Af[SCAN_PF][2][4]; u32x2 bm[SCAN_PF][2]; float gl[SCAN_PF];
#define SCAN_LOAD_REC(j, n) do { const size_t cb_ = (size_t)(n) * 16384; \
        _Pragma("unroll") for (int mt = 0; mt < 2; ++mt) { _Pragma("unroll") for (int s = 0; s < 4; ++s) Af[j][mt][s] = *(const GAS bf16x8*)(MN + cb_ + (size_t)(((wave * 2 + mt) * 4 + s) * 64 + lane) * 8); \
            bm[j][mt] = *(const GAS u32x2*)(BM + cb_ + (size_t)(((slice * 4 + wave) * 2 + mt) * 64 + lane) * 4); } gl[j] = GL[n]; } while (0)
#pragma unroll
        for (int j = 0; j < SCAN_PF; ++j) SCAN_LOAD_REC(j, j);
#pragma unroll 1
        for (int n0 = 0; n0 < 64; n0 += SCAN_PF) {
#pragma unroll
            for (int j = 0; j < SCAN_PF; ++j) {
                const int n = n0 + j; const int cur = n & 1;
                bf16x8 Sb[4];
#pragma unroll
                for (int s = 0; s < 4; ++s) Sb[s] = *(const LAS bf16x8*)(ST + cur * 4352 + c * 272 + 64 * s + 16 * g);
#pragma unroll
                for (int mt = 0; mt < 2; ++mt) {
                    f32x4 acc; acc[0] = gl[j] * Sreg[mt][0] + bflo(bm[j][mt].x); acc[1] = gl[j] * Sreg[mt][1] + bfhi(bm[j][mt].x); acc[2] = gl[j] * Sreg[mt][2] + bflo(bm[j][mt].y); acc[3] = gl[j] * Sreg[mt][3] + bfhi(bm[j][mt].y);
#pragma unroll
                    for (int s = 0; s < 4; ++s) acc = __builtin_amdgcn_mfma_f32_16x16x32_bf16(Af[j][mt][s], Sb[s], acc, 0, 0, 0);
                    Sreg[mt] = acc;
                    u32x2 w; w.x = pk2(acc[0], acc[1]); w.y = pk2(acc[2], acc[3]);
                    *(LAS u32x2*)(ST + (cur ^ 1) * 4352 + c * 272 + 2 * (32 * wave + 16 * mt + 4 * g)) = w;
                }
                if (n + SCAN_PF < 64) SCAN_LOAD_REC(j, n + SCAN_PF);
                __syncthreads();
            }
        }
#undef SCAN_LOAD_REC
        __syncthreads();
    } else {
        const int m = wave - 4;
        bf16x8 Qf[SCAN_PF][4]; u32x2 ol[SCAN_PF];
        GAS bf16* OU = (GAS bf16*)(WSP(bf16, WS_OUN) + ((size_t)(bh * 8 + slice) * SEQ) * 16);
#define SCAN_LOAD_OUT(j, n) do { const size_t cb_ = (size_t)(n) * 8192; \
        _Pragma("unroll") for (int s = 0; s < 4; ++s) Qf[j][s] = *(const GAS bf16x8*)(QE + cb_ + (size_t)((m * 4 + s) * 64 + lane) * 8); \
        ol[j] = *(const GAS u32x2*)(OL + cb_ + (size_t)((slice * 4 + m) * 64 + lane) * 4); } while (0)
#define SCAN_FLUSH(n) do { if (m < 2) { const int q_ = m * 64 + lane; const u32x4 v_ = *(const LAS u32x4*)(OS + ((n) & 1) * 2048 + q_ * 16); *(GAS u32x4*)(OU + (size_t)(n) * 1024 + q_ * 8) = v_; } } while (0)
#pragma unroll
        for (int j = 0; j < SCAN_PF; ++j) SCAN_LOAD_OUT(j, j);
#pragma unroll 1
        for (int n0 = 0; n0 < 64; n0 += SCAN_PF) {
#pragma unroll
            for (int j = 0; j < SCAN_PF; ++j) {
                const int n = n0 + j; const int cur = n & 1;
                if (n > 0) SCAN_FLUSH(n - 1);
                bf16x8 Sb[4];
#pragma unroll
                for (int s = 0; s < 4; ++s) Sb[s] = *(const LAS bf16x8*)(ST + cur * 4352 + c * 272 + 64 * s + 16 * g);
                f32x4 acc; acc[0] = bflo(ol[j].x); acc[1] = bfhi(ol[j].x); acc[2] = bflo(ol[j].y); acc[3] = bfhi(ol[j].y);
#pragma unroll
                for (int s = 0; s < 4; ++s) acc = __builtin_amdgcn_mfma_f32_16x16x32_bf16(Qf[j][s], Sb[s], acc, 0, 0, 0);
#pragma unroll
                for (int r = 0; r < 4; ++r) *(LAS unsigned short*)(OS + cur * 2048 + (16 * m + 4 * g + r) * 32 + 2 * c) = (unsigned short)f2bf(acc[r]);
                if (n + SCAN_PF < 64) SCAN_LOAD_OUT(j, n + SCAN_PF);
                __syncthreads();
            }
        }
        SCAN_FLUSH(63);
        __syncthreads();
#undef SCAN_LOAD_OUT
#undef SCAN_FLUSH
    }
}

constexpr int AT_KS = 0, AT_VS = 36864, AT_OS = 73728, N_ATT_UNITS = NB * DAH * 96;
__device__ __forceinline__ s16x4 vtr(const LAS unsigned char* p) { typedef short v4i16_t __attribute__((ext_vector_type(4))); return __builtin_bit_cast(s16x4, __builtin_amdgcn_ds_read_tr16_b64_v4i16((LAS v4i16_t*)p)); }
struct AttU { int b, hh, br, dil, res, n; };
__device__ __forceinline__ AttU att_decode(int a) { AttU u; const int bhh = a / 96, rem = a % 96; u.br = rem >> 5; const int idx = rem & 31; u.b = bhh >> 3; u.hh = bhh & 7;
    u.dil = u.br == 0 ? 1 : u.br == 1 ? 4 : 16; const int nblk = 32 / u.dil; u.res = idx / nblk; u.n = idx % nblk; return u; }
__device__ __forceinline__ void att_load(Frame& F, int a, u32x4 (&kv)[4], u32x4 (&vv)[4], bf16x8 (&Bq)[2]) {
    const AttU u = att_decode(a); const bf16* QKVD = WSP(bf16, WS_QKVD);
#pragma unroll
    for (int p = 0; p < 4; ++p) { const int j = (F.tid >> 3) + 64 * p, kidx = 128 * (u.n - 1) + j; const bool ok = kidx >= 0;
        const bf16* src = QKVD + (size_t)(u.b * SEQ + (ok ? kidx : 0) * u.dil + u.res) * 1536 + u.hh * 64 + (F.tid & 7) * 8;
        kv[p] = *(const GAS u32x4*)(src + 512); vv[p] = *(const GAS u32x4*)(src + 1024);
        if (!ok) { kv[p] = (u32x4){0u, 0u, 0u, 0u}; vv[p] = (u32x4){0u, 0u, 0u, 0u}; } }
    const int qi = 16 * F.wave + (F.lane & 15); const size_t qtok = (size_t)(u.b * SEQ + (128 * u.n + qi) * u.dil + u.res);
#pragma unroll
    for (int s = 0; s < 2; ++s) Bq[s] = *(const GAS bf16x8*)(QKVD + qtok * 1536 + u.hh * 64 + 32 * s + 8 * (F.lane >> 4));
}
__device__ __forceinline__ void att_compute(Frame& F, int a, LAS unsigned char* L, const bf16x8 (&Bq)[2]) {
    const AttU u = att_decode(a); const int n = u.n;
    const int lane = F.lane, wave = F.wave, g = lane >> 4, c = lane & 15;
    const int qi = 16 * wave + c;
    f32x4 sc[9];
    float mx = -1.0e30f;
#pragma unroll
    for (int t = 0; t < 9; ++t) {
        const LAS unsigned char* kr = L + AT_KS + (16 * (wave + t) + c) * RSS + 16 * g;
        f32x4 acc = {0.f, 0.f, 0.f, 0.f};
        acc = __builtin_amdgcn_mfma_f32_16x16x32_bf16(*(const LAS bf16x8*)kr, Bq[0], acc, 0, 0, 0);
        acc = __builtin_amdgcn_mfma_f32_16x16x32_bf16(*(const LAS bf16x8*)(kr + 64), Bq[1], acc, 0, 0, 0);
        if (t == 0) {
#pragma unroll
            for (int r = 0; r < 4; ++r) { const int j = 16 * wave + 4 * g + r; if (j < qi) acc[r] = -1.0e30f; } }
        if (t == 8) {
#pragma unroll
            for (int r = 0; r < 4; ++r) { const int j = 16 * (wave + 8) + 4 * g + r; if (j > qi + 128) acc[r] = -1.0e30f; } }
        if (n == 0 && wave + t < 8) acc = (f32x4){-1.0e30f, -1.0e30f, -1.0e30f, -1.0e30f};
        mx = fmaxf(fmaxf(mx, fmaxf(acc[0], acc[1])), fmaxf(acc[2], acc[3]));
        sc[t] = acc;
    }
    mx = xrow_max(mx);
    float lsum = 0.f;
#pragma unroll
    for (int t = 0; t < 9; ++t)
#pragma unroll
        for (int r = 0; r < 4; ++r) { const float p = __builtin_amdgcn_exp2f(sc[t][r] - mx); sc[t][r] = p; lsum += p; }
    lsum = xrow_sum(lsum);
    { const float li = __builtin_amdgcn_rcpf(lsum);
#pragma unroll
      for (int t = 0; t < 9; ++t) sc[t] = sc[t] * li; }
    bf16x8 pf[5];
#pragma unroll
    for (int q = 0; q < 5; ++q) { u32x4 w; w.x = pk2(sc[2 * q][0], sc[2 * q][1]); w.y = pk2(sc[2 * q][2], sc[2 * q][3]);
        if (q < 4) { w.z = pk2(sc[2 * q + 1][0], sc[2 * q + 1][1]); w.w = pk2(sc[2 * q + 1][2], sc[2 * q + 1][3]); } else { w.z = 0u; w.w = 0u; }
        pf[q] = __builtin_bit_cast(bf16x8, w); }
    LAS unsigned char* OS = L + AT_OS + wave * 2304;
#pragma unroll
    for (int dt = 0; dt < 4; ++dt) {
        f32x4 acc = {0.f, 0.f, 0.f, 0.f};
#pragma unroll
        for (int q = 0; q < 5; ++q) { const int kb = 16 * (wave + 2 * q);
            const LAS unsigned char* vp = L + AT_VS + (kb + 4 * g + (c >> 2)) * RSS + (16 * dt + 4 * (c & 3)) * 2;
            const s16x4 lo = vtr(vp); s16x4 hi = {0, 0, 0, 0}; if (q < 4) hi = vtr(vp + 16 * RSS);
            const bf16x8 bv = {lo[0], lo[1], lo[2], lo[3], hi[0], hi[1], hi[2], hi[3]};
            acc = __builtin_amdgcn_mfma_f32_16x16x32_bf16(pf[q], bv, acc, 0, 0, 0); }
#pragma unroll
        for (int r = 0; r < 4; ++r) *(LAS unsigned short*)(OS + (4 * g + r) * RSS + (16 * dt + c) * 2) = (unsigned short)f2bf(acc[r]);
    }
    const size_t qtok = (size_t)(u.b * SEQ + (128 * n + qi) * u.dil + u.res);
    if (g == 0) ((GAS float*)WSP(float, WS_LSE))[((size_t)u.br * T + qtok) * 8 + u.hh] = (mx + __log2f(lsum)) * 0.6931471805599453f;
    { const int row = lane >> 2, pc = lane & 3; const size_t tok = (size_t)(u.b * SEQ + (128 * n + 16 * wave + row) * u.dil + u.res);
      const u32x4 v0 = *(const LAS u32x4*)(OS + row * RSS + pc * 32), v1 = *(const LAS u32x4*)(OS + row * RSS + pc * 32 + 16);
      GAS u32x4* dst = (GAS u32x4*)(WSP(bf16, WS_OPART) + ((size_t)u.br * T + tok) * 512 + u.hh * 64 + pc * 16); dst[0] = v0; dst[1] = v1; }
}
__device__ __forceinline__ void attn_queue(Frame& F, unsigned* qword, volatile LAS unsigned* MISC) {
    LAS unsigned char* L = opq_v(F.lds);
    u32x4 kv[4], vv[4]; bf16x8 Bq[2], BqN[2];
    unsigned pend = 0u;
    if (F.tid == 0) { MISC[22] = __hip_atomic_fetch_add(qword, 1u, RLX_AGENT); pend = __hip_atomic_fetch_add(qword, 1u, RLX_AGENT); }
    __syncthreads();
    int a = (int)MISC[22];
    if (a < N_ATT_UNITS) att_load(F, a, kv, vv, Bq);
    while (a < N_ATT_UNITS) {
#pragma unroll
        for (int p = 0; p < 4; ++p) { const int j = (F.tid >> 3) + 64 * p; *(LAS u32x4*)(L + AT_KS + j * RSS + (F.tid & 7) * 16) = kv[p]; *(LAS u32x4*)(L + AT_VS + j * RSS + (F.tid & 7) * 16) = vv[p]; }
        if (F.tid == 0) { MISC[20] = pend; pend = __hip_atomic_fetch_add(qword, 1u, RLX_AGENT); }
        __syncthreads();
        const int an = (int)MISC[20];
        if (an < N_ATT_UNITS) att_load(F, an, kv, vv, BqN);
        att_compute(F, a, L, Bq);
        __syncthreads();
        a = an; Bq[0] = BqN[0]; Bq[1] = BqN[1];
    }
}

__device__ __forceinline__ void mix_pass(Frame& F, const Args& A) {
    const int lane = F.lane;
    float nw[8];
    { const f32x4 a = *(const GAS f32x4*)(A.in[6] + 8 * (lane & 15)), b = *(const GAS f32x4*)(A.in[6] + 8 * (lane & 15) + 4);
#pragma unroll
      for (int e = 0; e < 4; ++e) { nw[e] = a[e]; nw[4 + e] = b[e]; } }
    const bf16* OU = WSP(bf16, WS_OUN); const bf16* ZB = WSP(bf16, WS_ZB); const bf16* OP = WSP(bf16, WS_OPART); const float* LSE = WSP(float, WS_LSE); bf16* MIX = WSP(bf16, WS_MIX);
    for (int t = F.gw; t < T; t += F.NGW) {
        const u32x4 uo = *(const GAS u32x4*)(OU + ((size_t)(((t >> 12) * 4 + (lane >> 4)) * 8 + ((lane & 15) >> 1)) * SEQ + (t & 4095)) * 16 + 8 * (lane & 1)), uz = *(const GAS u32x4*)(ZB + (size_t)t * 512 + 8 * lane);
        float x[8], z[8];
#pragma unroll
        for (int e = 0; e < 4; ++e) { x[2 * e] = bflo(uo[e]); x[2 * e + 1] = bfhi(uo[e]); z[2 * e] = bflo(uz[e]); z[2 * e + 1] = bfhi(uz[e]); }
        float ss = 0.f;
#pragma unroll
        for (int e = 0; e < 8; ++e) ss += x[e] * x[e];
        ss += dpp_f(ss, 0xB1, 0xf); ss += dpp_f(ss, 0x4E, 0xf); ss += dpp_f(ss, 0x141, 0xf); ss += dpp_f(ss, 0x140, 0xf);
        const float rstd = rsqrtf(ss * (1.f / 128.f) + RMS_EPS);
        float o[8];
#pragma unroll
        for (int e = 0; e < 8; ++e) o[e] = x[e] * rstd * nw[e] * silu_f(z[e]);
        u32x4 w; w.x = pk2(o[0], o[1]); w.y = pk2(o[2], o[3]); w.z = pk2(o[4], o[5]); w.w = pk2(o[6], o[7]);
        *(GAS u32x4*)(MIX + (size_t)t * D + 8 * lane) = w;
        const int hh = lane >> 3;
        const float l0 = LSE[((size_t)0 * T + t) * 8 + hh], l1 = LSE[((size_t)1 * T + t) * 8 + hh], l2 = LSE[((size_t)2 * T + t) * 8 + hh];
        const float lm = fmaxf(l0, fmaxf(l1, l2)); const float e0 = __expf(l0 - lm), e1 = __expf(l1 - lm), e2 = __expf(l2 - lm); const float inv = 1.f / (e0 + e1 + e2);
        const u32x4 p0 = *(const GAS u32x4*)(OP + ((size_t)0 * T + t) * 512 + 8 * lane), p1 = *(const GAS u32x4*)(OP + ((size_t)1 * T + t) * 512 + 8 * lane), p2 = *(const GAS u32x4*)(OP + ((size_t)2 * T + t) * 512 + 8 * lane);
        const float w0 = e0 * inv, w1 = e1 * inv, w2 = e2 * inv;
        u32x4 wo;
#pragma unroll
        for (int e = 0; e < 4; ++e) wo[e] = pk2(w0 * bflo(p0[e]) + w1 * bflo(p1[e]) + w2 * bflo(p2[e]), w0 * bfhi(p0[e]) + w1 * bfhi(p1[e]) + w2 * bfhi(p2[e]));
        *(GAS u32x4*)(MIX + (size_t)t * D + 512 + 8 * lane) = wo;
    }
}

constexpr int N_PHASES = 29;
#define D1V 0
#define DRYV 0
__global__ void __launch_bounds__(512, 2) fwd_kernel(Args args) {
    extern __shared__ __attribute__((aligned(16))) unsigned char lds_raw[];
    Frame F;
    F.lds = (LAS unsigned char*)lds_raw; F.ws = args.ws; F.ctl = (gu32*)(args.ws + WS_CTL);
    F.tid = threadIdx.x; F.lane = F.tid & 63; F.wave = __builtin_amdgcn_readfirstlane(F.tid >> 6);
    F.G = gridDim.x; F.gw = blockIdx.x * 8 + F.wave; F.NGW = F.G * 8;
    volatile LAS unsigned* MISC = (volatile LAS unsigned*)(F.lds + MISC_OFF); const char* wsb = (const char*)args.ws;
    for (int u = F.tid; u < 256; u += 512) MISC[u] = 0u;
    __syncthreads();
    const int lo = args.ph_lo, hi = args.ph_hi;
    XcdBarrier bar; bar.bar = (unsigned*)(F.ctl + CW_BAR); bar.x = 0; bar.st = MISC + 8;
    if (hi - lo > 1) bar = xcd_barrier_post((unsigned*)(F.ctl + CW_BAR), MISC + 8);
    LAS unsigned char* ring = F.lds; LAS unsigned char* xch = F.lds + XCH_OFF;
    volatile LAS unsigned* tab = MISC + 32;
    const int c = blockIdx.x, G = F.G; int qsel = 0;
#ifndef PHASE_MASK
#define PHASE_MASK 0xFFFFFFFFu
#endif
#define IN(k) ((((PHASE_MASK) >> (k)) & 1u) && lo <= (k) && (k) < hi)
#define SEAM(k) do { if (IN(k) && IN((k) + 1)) xcd_barrier(bar); } while (0)
#define PH_BEGIN() do { const int t_ = opq_v((int)threadIdx.x); F.tid = t_; F.lane = t_ & 63; F.wave = __builtin_amdgcn_readfirstlane(t_ >> 6); F.gw = blockIdx.x * 8 + F.wave; \
        unsigned char* w_ = opq_s(args.ws); F.ws = w_; F.ctl = (gu32*)(w_ + WS_CTL); xch = opq_v(F.lds + XCH_OFF); MISC = (volatile LAS unsigned*)opq_v(F.lds + MISC_OFF); tab = MISC + 32; bar.st = MISC + 8; wsb = (const char*)w_; } while (0)
#define HBc (wsb + WS_HB)

    if (IN(0)) { PH_BEGIN(); p0_prologue(F, args); SEAM(0); }
    if (IN(1)) { PH_BEGIN();
        SchedP1 S{HBc, (const char*)(wsb + WS_W_IN), (const char*)(wsb + WS_MEMB), (const char*)(wsb + WS_W_KV), G, c};
        EpiP1 E{WSP(bf16, WS_QKVPRE), WSP(bf16, WS_ZB), WSP(bf16, WS_QKVD), WSP(bf16, WS_KMEM), WSP(bf16, WS_VT)};
        pg8::gemm_phase(ring, xch, pg8::Gemm{D, D, D}, S, E);
        deferred_weights_q(F, args, (unsigned*)(F.ctl + CW_CVQ + 64), MISC);
        SEAM(1);
    }
    if (IN(2)) { PH_BEGIN(); for (int u = c; u < NB * DNH * NCHUNK; u += G) d1_unit<D1V>(F, args, u); SEAM(2); }
    if (IN(3)) { PH_BEGIN();
        if (c < 128) scan_wg(F, c);
        attn_queue(F, (unsigned*)(F.ctl + CW_QUEUE + 16 * qsel), MISC);
        ++qsel;
        SEAM(3);
    }
    if (IN(4)) { PH_BEGIN();
        { SchedPrep S{(const char*)(wsb + WS_KMEM), (const char*)(wsb + WS_W_Q), (const char*)(wsb + WS_W_O), (const char*)(wsb + WS_VT), G, c}; EpiPrep E{WSP(bf16, WS_MT), WSP(bf16, WS_VWT)};
          pg8::gemm_phase(ring, xch, pg8::Gemm{D, D, XD}, S, E); }
        mix_pass(F, args); SEAM(4); }

#pragma unroll
    for (int layer = 0; layer < 2; ++layer) {
        const int pb = layer * 13;
        if (layer == 0) {
            if (IN(5)) { PH_BEGIN(); convert_moe_q(F, args, 0, 0, WSP(bf16, WS_MOEW_GU), (unsigned*)(F.ctl + CW_CVQ), MISC); convert_moe_q(F, args, 0, 1, WSP(bf16, WS_MOEW_D), (unsigned*)(F.ctl + CW_CVQ + 16), MISC); __syncthreads();
                SchedDense S{(const char*)(wsb + WS_MIX), (const char*)(wsb + WS_W_ABO), D, D, 64, 4, G, c}; EpiDense E{WSP(bf16, 288 * MiB), D, 1.f};
                pg8::gemm_phase(ring, xch, pg8::Gemm{D, D, D}, S, E); SEAM(5); }
            if (IN(6)) { PH_BEGIN(); ln_pass<0, false, false, (DRYV != 0)>(F, args, WSP(bf16, WS_HB), WSP(bf16, 288 * MiB), 0, nullptr, DRYV ? WSP(bf16, 112 * MiB) : WSP(bf16, WS_HB), nullptr); SEAM(6); }
        } else {
            if (IN(16)) { PH_BEGIN();
                SchedDense S{HBc, (const char*)(wsb + WS_W_SCI), D, D, 64, 12, G, c}; EpiDense E{WSP(bf16, 192 * MiB), 3 * D, 1.f};
                pg8::gemm_phase(ring, xch, pg8::Gemm{D, D, D}, S, E); SEAM(16); }
            if (IN(17)) { PH_BEGIN(); conv_pass(F, args, WSP(bf16, 192 * MiB), WSP(bf16, 288 * MiB)); SEAM(17); }
            if (IN(18)) { PH_BEGIN(); SchedDense S{(const char*)(wsb + 288 * MiB), (const char*)(wsb + WS_W_SCO), D, D, 64, 4, G, c}; EpiDense E{WSP(bf16, 192 * MiB), D, 1.f};
                pg8::gemm_phase(ring, xch, pg8::Gemm{D, D, D}, S, E); SEAM(18); }
            if (IN(19)) { PH_BEGIN(); ln_pass<0, false, false>(F, args, WSP(bf16, WS_HB), WSP(bf16, 192 * MiB), 3, nullptr, WSP(bf16, WS_HB), nullptr); SEAM(19); }
        }
        const size_t oP = (layer == 0 ? 224 : 256) * MiB, oY = (layer == 0 ? 288 : 192) * MiB;
        const int p7 = layer == 0 ? 7 : 20;
        if (IN(p7)) { PH_BEGIN(); SchedXB S{HBc, (const char*)(wsb + WS_MT + (size_t)layer * NB * D * D * 2), G, c}; EpiSoftmax E{WSP(bf16, oP)};
            pg8::gemm_phase(ring, xch, pg8::Gemm{D, D, D}, S, E); SEAM(p7); }
        if (IN(p7 + 1)) { PH_BEGIN(); SchedXB S{(const char*)(wsb + oP), (const char*)(wsb + WS_VWT + (size_t)layer * NB * D * D * 2), G, c}; EpiDense E{WSP(bf16, oY), D, 1.f};
            pg8::gemm_phase(ring, xch, pg8::Gemm{D, D, D}, S, E); SEAM(p7 + 1); }
        unsigned* cnt = (unsigned*)(F.ctl + (layer == 0 ? CW_CNT0 : CW_CNT1));
        if (IN(p7 + 4)) { PH_BEGIN(); ln_router_pass<(DRYV != 0)>(F, args, WSP(bf16, WS_HB), WSP(bf16, oY), layer * 3 + 1, DRYV ? WSP(bf16, 112 * MiB) : WSP(bf16, WS_HB), cnt); SEAM(p7 + 4); }
        if (IN(p7 + 5)) { PH_BEGIN(); moe_table(F, cnt, tab); moe_slots(F, tab, WSP(int, WS_INV + (size_t)layer * MOE_ROWS * 4)); SEAM(p7 + 5); }
        if (IN(p7 + 6)) { PH_BEGIN(); moe_table(F, cnt, tab);
            SchedMoE<true> S{HBc, (const char*)(wsb + (layer == 0 ? WS_MOEW_GU : WS_MOEW_GU1)), tab, WSP(int, WS_INV + (size_t)layer * MOE_ROWS * 4), D, D, D, G, c}; EpiSwiglu E{WSP(bf16, WS_HACT), (layer == 1 && MK_ONE_LAUNCH) ? (unsigned*)(F.ctl + CW_G1DONE) : nullptr, 2 * G};
            pg8::gemm_phase(ring, xch, pg8::Gemm{D, D, D}, S, E);
            if (layer == 0) convert_moe_q(F, args, 1, 0, WSP(bf16, WS_MOEW_GU1), (unsigned*)(F.ctl + CW_CVQ + 32), MISC);
            SEAM((layer == 1 && MK_ONE_LAUNCH) ? 31 : p7 + 6); }
        if (IN(p7 + 7)) { PH_BEGIN(); moe_table(F, cnt, tab);
            EpiDense E{WSP(bf16, WS_XG), D, 1.f};
            if (layer == 1 && MK_ONE_LAUNCH) { moe_wait_gemm1(F, (unsigned*)(F.ctl + CW_G1DONE), tab, G, c);
                SchedMoE2 S{(const char*)(wsb + WS_HACT), (const char*)(wsb + WS_MOEW_D1), tab, G, c}; pg8::gemm_phase(ring, xch, pg8::Gemm{DE, DE, DE}, S, E); }
            else { SchedMoE<false> S{(const char*)(wsb + WS_HACT), (const char*)(wsb + (layer == 0 ? WS_MOEW_D : WS_MOEW_D1)), tab, nullptr, DE, D, DE, G, c}; pg8::gemm_phase(ring, xch, pg8::Gemm{DE, DE, DE}, S, E); }
            if (layer == 0) convert_moe_q(F, args, 1, 1, WSP(bf16, WS_MOEW_D1), (unsigned*)(F.ctl + CW_CVQ + 48), MISC);
            SEAM(p7 + 7); }
        if (layer == 0) { if (IN(15)) { PH_BEGIN(); ln_pass<1, false, false>(F, args, WSP(bf16, WS_HB), WSP(bf16, WS_XG), 2, nullptr, WSP(bf16, WS_HB), nullptr); SEAM(15); } }
        else { if (IN(28)) { PH_BEGIN(); ln_pass<1, false, true>(F, args, WSP(bf16, WS_HB), WSP(bf16, WS_XG), 5, args.out, nullptr, nullptr); SEAM(28); } }
        (void)pb;
    }
#undef IN
#undef SEAM
}

extern "C" void kernel_launch(void* const* d_in, const int* in_sizes, int n_in, void* d_out, int out_size, void* d_ws, size_t ws_size, hipStream_t stream) {
    static int grid = 0;
    if (grid == 0) {
        if (n_in != 21 || out_size != T * D || ws_size < WS_END) { fprintf(stderr, "kernel_launch: unexpected problem (n_in %d, out %d, ws %zu < %zu)\n", n_in, out_size, ws_size, (size_t)WS_END); grid = -1; return; }
        int dev = 0, cus = 0, per_cu = 0;
        if (hipGetDevice(&dev) != hipSuccess || hipDeviceGetAttribute(&cus, hipDeviceAttributeMultiprocessorCount, dev) != hipSuccess) { grid = -1; return; }
        if (hipFuncSetAttribute((const void*)fwd_kernel, hipFuncAttributeMaxDynamicSharedMemorySize, LDS_BYTES) != hipSuccess) { fprintf(stderr, "kernel_launch: hipFuncSetAttribute failed\n"); grid = -1; return; }
        if (hipOccupancyMaxActiveBlocksPerMultiprocessor(&per_cu, (const void*)fwd_kernel, 512, LDS_BYTES) != hipSuccess || per_cu < 1) { fprintf(stderr, "kernel_launch: occupancy query says %d blocks per CU\n", per_cu); (void)hipGetLastError(); per_cu = 1; }
        grid = cus;
    }
    if (grid < 0) return;
    (void)hipMemsetAsync((char*)d_ws + WS_CTL, 0, CTL_ZERO_BYTES, stream);
    Args a{};
    for (int i = 0; i < 21; ++i) a.in[i] = (const float*)d_in[i];
    a.out = (float*)d_out; a.ws = (unsigned char*)d_ws;
#if MK_ONE_LAUNCH
    a.ph_lo = 0; a.ph_hi = N_PHASES;
    hipLaunchKernelGGL(fwd_kernel, dim3(grid), dim3(512), LDS_BYTES, stream, a);
#else
    for (int p = 0; p < N_PHASES; ++p) { a.ph_lo = p; a.ph_hi = p + 1; hipLaunchKernelGGL(fwd_kernel, dim3(grid), dim3(512), LDS_BYTES, stream, a); }
#endif
}
```

```cpp
#include <hip/hip_runtime.h>
#include <cstdio>
#include <cstdint>

#ifndef MK_ONE_LAUNCH
#define MK_ONE_LAUNCH 1
#endif

#define LAS __attribute__((address_space(3)))
#define GAS __attribute__((address_space(1)))
typedef unsigned short bf16;
typedef short bf16x8 __attribute__((ext_vector_type(8)));
typedef short s16x4 __attribute__((ext_vector_type(4)));
typedef float f32x4 __attribute__((ext_vector_type(4)));
typedef float f32x2 __attribute__((ext_vector_type(2)));
typedef unsigned u32x4 __attribute__((ext_vector_type(4)));
typedef unsigned u32x2 __attribute__((ext_vector_type(2)));
typedef GAS unsigned gu32;
#define RLX_AGENT __ATOMIC_RELAXED, __HIP_MEMORY_SCOPE_AGENT
#define LDS_WAIT() asm volatile("s_waitcnt lgkmcnt(0)" ::: "memory")
#define VM_WAIT() asm volatile("s_waitcnt vmcnt(0)" ::: "memory")

constexpr int NB = 4, SEQ = 4096, T = NB * SEQ, D = 1024;
constexpr int NMEM = 256, TM = NB * NMEM;
constexpr int DNH = 4, DND = 128, DNW = 512, DNC = 64, NCHUNK = SEQ / DNC;
constexpr int DAH = 8, DAD = 64, DAW = 512;
constexpr int AB_IN = 3592;
constexpr int XH = 4, XD = 256;
constexpr int NE = 16, DE = 512;
constexpr float ALPHA = 1.41421356237f;
constexpr float LN_EPS = 1e-5f, RMS_EPS = 1e-6f;
constexpr int MOE_ROWS = 2 * T + NE * 256;

constexpr size_t MiB = 1u << 20;
constexpr size_t WS_CTL = 0, CTL_ZERO_BYTES = 1 * MiB;
constexpr size_t WS_W_IN = 1 * MiB, WS_W_ABO = 8 * MiB, WS_W_SCI = 10 * MiB, WS_W_SCO = 16 * MiB, WS_W_Q = 18 * MiB, WS_W_KV = 22 * MiB, WS_W_O = 30 * MiB;
constexpr size_t WS_MEMB = 34 * MiB, WS_KMEM = 36 * MiB, WS_VT = 40 * MiB, WS_BETA = 44 * MiB, WS_GG = 45 * MiB, WS_ROUTE = 46 * MiB, WS_GLAST = 47 * MiB;
constexpr size_t WS_MT = 80 * MiB, WS_VWT = 96 * MiB;
constexpr size_t WS_HB = 48 * MiB, WS_H = 80 * MiB, WS_ARENA = 144 * MiB, WS_END = 320 * MiB;
constexpr size_t WS_QKVPRE = 144 * MiB, WS_ZB = 192 * MiB, WS_QKVD = 208 * MiB, WS_MNEG = 80 * MiB, WS_BMT = 112 * MiB, WS_QEFF = 256 * MiB, WS_OLOCT = 272 * MiB;
constexpr size_t WS_OUN = 288 * MiB, WS_LSE = 304 * MiB, WS_OPART = 144 * MiB, WS_MIX = 256 * MiB;
constexpr size_t WS_MOEW_GU = 144 * MiB, WS_MOEW_D = 176 * MiB, WS_XG = 192 * MiB, WS_HACT = 264 * MiB;
constexpr size_t WS_MOEW_GU1 = 112 * MiB, WS_MOEW_D1 = 144 * MiB;
static_assert((size_t)MOE_ROWS * D * 2 <= 72 * MiB && (size_t)MOE_ROWS * DE * 2 <= 36 * MiB, "moe buffers");
constexpr size_t WS_INV = 256 * 1024;
constexpr int CW_TMO = 0, CW_BAR = 4096, CW_QUEUE = 64, CW_CNT0 = 128, CW_CNT1 = 192, CW_CVQ = 256, CW_G1DONE = 512;

constexpr int LDS_BYTES = 163840, MISC_OFF = 162816, XCH_OFF = 131072;

typedef __bf16 bf16x2_t __attribute__((ext_vector_type(2)));
__device__ __forceinline__ unsigned pk2(float lo, float hi) { const f32x2 v = {lo, hi}; const bf16x2_t b = __builtin_convertvector(v, bf16x2_t); return __builtin_bit_cast(unsigned, b); }
__device__ __forceinline__ unsigned f2bf(float f) { return pk2(f, f) & 0xffffu; }
__device__ __forceinline__ float bf2f(unsigned short b) { return __builtin_bit_cast(float, (unsigned)b << 16); }
__device__ __forceinline__ float bflo(unsigned w) { return __builtin_bit_cast(float, w << 16); }
__device__ __forceinline__ float bfhi(unsigned w) { return __builtin_bit_cast(float, w & 0xffff0000u); }
#define dpp_f(v, ctrl, row_mask) __int_as_float(__builtin_amdgcn_update_dpp(0, __float_as_int(v), (ctrl), (row_mask), 0xf, false))
__device__ __forceinline__ float wave_sum(float v) {
    v += dpp_f(v, 0xB1, 0xf); v += dpp_f(v, 0x4E, 0xf); v += dpp_f(v, 0x141, 0xf); v += dpp_f(v, 0x140, 0xf);
    v += dpp_f(v, 0x142, 0xa); v += dpp_f(v, 0x143, 0xc);
    return __int_as_float(__builtin_amdgcn_readlane(__float_as_int(v), 63));
}
__device__ __forceinline__ float xrow_max(float v) {
    const auto a = __builtin_amdgcn_permlane16_swap(__float_as_uint(v), __float_as_uint(v), false, false); v = fmaxf(__uint_as_float(a[0]), __uint_as_float(a[1]));
    const auto b = __builtin_amdgcn_permlane32_swap(__float_as_uint(v), __float_as_uint(v), false, false); return fmaxf(__uint_as_float(b[0]), __uint_as_float(b[1])); }
__device__ __forceinline__ float xrow_sum(float v) {
    const auto a = __builtin_amdgcn_permlane16_swap(__float_as_uint(v), __float_as_uint(v), false, false); v = __uint_as_float(a[0]) + __uint_as_float(a[1]);
    const auto b = __builtin_amdgcn_permlane32_swap(__float_as_uint(v), __float_as_uint(v), false, false); return __uint_as_float(b[0]) + __uint_as_float(b[1]); }
template <class P> __device__ __forceinline__ P opq_v(P p) { asm volatile("" : "+v"(p)); return p; }
template <class P> __device__ __forceinline__ P opq_s(P p) { asm volatile("" : "+s"(p)); return p; }
__device__ __forceinline__ float silu_f(float x) { return x * __builtin_amdgcn_rcpf(1.f + __expf(-x)); }

namespace pg8 {
constexpr int BM = 256, BK = 64, HALF = 128, HTB = HALF * BK * 2, STAGE_BYTES = 8 * HTB;
__host__ __device__ __forceinline__ int lds_byte(int r, int c) { const int st = (r >> 4) * 2 + (c >> 5), rr = r & 15, cc = c & 31, ob = rr * 64 + cc * 2; return st * 1024 + (ob ^ (((ob >> 9) & 1) << 5)); }
__host__ __device__ __forceinline__ void stage_rc(int b, int& R, int& C) { const int st = b / 1024, sb = b % 1024, swz = sb ^ (((sb >> 9) & 1) << 5); R = (st >> 1) * 16 + swz / 64; C = (st & 1) * 32 + (swz % 64) / 2; }
__host__ __device__ __forceinline__ int perm32(int rho) { const int n = rho >> 4, i = rho & 15; return 8 * (i >> 2) + 4 * n + (i & 3); }

struct Unit { int pm, pn, aux; const char* a; const char* b; };
struct Gemm { int lda, ldb, K; };
__device__ __forceinline__ unsigned cvt_pk_bf16(float lo, float hi) { unsigned r; asm volatile("v_cvt_pk_bf16_f32 %0, %1, %2" : "=v"(r) : "v"(lo), "v"(hi)); return r; }

__device__ __forceinline__ void swz_tile(int L, int nM, int nN, int& pm, int& pn) {
    const int nwg = nM * nN; int wgid = L; { const int q = nwg / 8, r = nwg % 8, xcd = wgid % 8, off = wgid / 8; wgid = (xcd < r ? xcd * (q + 1) : r * (q + 1) + (xcd - r) * q) + off; }
    const int nig = 8 * nN, gid = wgid / nig, fm = gid * 8, gsz = (nM - fm) < 8 ? (nM - fm) : 8;
    pm = fm + ((wgid % nig) % gsz); pn = (wgid % nig) / gsz;
}

template <class Epi, class Sched>
__device__ __forceinline__ void gemm_phase(LAS unsigned char* lds, LAS unsigned char* xch, const Gemm g, const Sched& S, const Epi& E) {
    const int tid = opq_v((int)threadIdx.x), wid = __builtin_amdgcn_readfirstlane(tid >> 6), lane = tid & 63, wr = wid >> 2, wc = wid & 3, fr = lane & 15, fq = lane >> 4;
    const int K = g.K, nt = K / BK;
    unsigned voffA[2], voffB[2];
#pragma unroll
    for (int i = 0; i < 2; ++i) { int R, C; stage_rc(tid * 16 + i * 8192, R, C); const int Rb = Epi::PERM ? ((R & ~31) + perm32(R & 31)) : R;
        voffA[i] = (unsigned)(R * g.lda + C) * 2u; voffB[i] = (unsigned)(Rb * g.ldb + C) * 2u; }
    const size_t kstep = (size_t)(BK * 2);
    const size_t hstepA = Sched::GATHER ? (size_t)0 : (size_t)HALF * g.lda * 2, hstepB = (size_t)HALF * g.ldb * 2;
    unsigned vGc[2][2], vGn[2][2];
#pragma unroll
    for (int i = 0; i < 2; ++i) vGc[0][i] = vGc[1][i] = vGn[0][i] = vGn[1][i] = 0u;
#define PG8_GLOAD(dst, u_) do { if (Sched::GATHER) { _Pragma("unroll") for (int hh_ = 0; hh_ < 2; ++hh_) _Pragma("unroll") for (int i_ = 0; i_ < 2; ++i_) { int R_, C_; stage_rc(tid * 16 + i_ * 8192, R_, C_); \
        dst[hh_][i_] = (unsigned)S.row((u_), hh_ * HALF + R_) * (unsigned)(g.lda * 2) + (unsigned)C_ * 2u; } } } while (0)
    const unsigned ldsw = (unsigned)wid * 1024u;
    const int aoff = lds_byte(wr * 64 + fr, fq * 8), boff = lds_byte(wc * 32 + fr, fq * 8);
#define PG8_SA(b, h) (((b) * 2 + (h)) * HTB)
#define PG8_SB(b, h) ((4 + (b) * 2 + (h)) * HTB)
#define PG8_STAGE(bufoff, gbase, voff) do { _Pragma("unroll") for (int _i = 0; _i < 2; ++_i) \
        __builtin_amdgcn_global_load_lds((const unsigned*)((const char*)(gbase) + (voff)[_i]), (LAS unsigned*)(lds + (bufoff) + ldsw + _i * 8192), 16, 0, 0); } while (0)
#define PG8_STAGE_A(bufoff, gbase, hf, vg) do { if (Sched::GATHER) { PG8_STAGE(bufoff, gbase, vg[hf]); } else { PG8_STAGE(bufoff, (gbase) + (hf) * hstepA, voffA); } } while (0)
#define PG8_LDA(dst, b, h) do { _Pragma("unroll") for (int m = 0; m < 4; ++m) _Pragma("unroll") for (int k = 0; k < 2; ++k) dst[m][k] = *(const LAS bf16x8*)(lds + PG8_SA(b, h) + aoff + m * 2048 + k * 1024); } while (0)
#define PG8_LDB(dst, b, h) do { _Pragma("unroll") for (int n = 0; n < 2; ++n) _Pragma("unroll") for (int k = 0; k < 2; ++k) dst[n][k] = *(const LAS bf16x8*)(lds + PG8_SB(b, h) + boff + n * 2048 + k * 1024); } while (0)
#define PG8_MMA(ai, bj, At, Bt) do { __builtin_amdgcn_s_setprio(1); _Pragma("unroll") for (int m = 0; m < 4; ++m) _Pragma("unroll") for (int n = 0; n < 2; ++n) _Pragma("unroll") for (int k = 0; k < 2; ++k) \
        acc[ai][bj][m][n] = __builtin_amdgcn_mfma_f32_16x16x32_bf16(Bt[n][k], At[m][k], acc[ai][bj][m][n], 0, 0, 0); __builtin_amdgcn_s_setprio(0); } while (0)
#define PG8_WAIT_V(n) asm volatile("s_waitcnt vmcnt(" #n ")" ::: "memory")
#define PG8_WAIT_L(n) asm volatile("s_waitcnt lgkmcnt(" #n ")" ::: "memory")
#define PG8_BAR __builtin_amdgcn_s_barrier()
#define PG8_SCHED __builtin_amdgcn_sched_barrier(0)
    Unit cur, nxt; int ui = 0;
    if (!S.next(0, cur)) return;
    f32x4 acc[2][2][4][2];
#pragma unroll
    for (int a = 0; a < 2; ++a)
#pragma unroll
        for (int b = 0; b < 2; ++b)
#pragma unroll
            for (int m = 0; m < 4; ++m)
#pragma unroll
                for (int n = 0; n < 2; ++n) acc[a][b][m][n] = (f32x4){0.f, 0.f, 0.f, 0.f};
    bf16x8 At[4][2], B0[2][2], B1[2][2];
    const char* cA = cur.a; const char* cB = cur.b;
    PG8_GLOAD(vGc, cur);
    PG8_STAGE(PG8_SB(0, 0), cB, voffB); PG8_STAGE(PG8_SB(0, 1), cB + hstepB, voffB); PG8_STAGE_A(PG8_SA(0, 0), cA, 0, vGc); PG8_STAGE_A(PG8_SA(0, 1), cA, 1, vGc);
    if (wr == 1) PG8_BAR;
    PG8_WAIT_V(2); PG8_BAR;
    PG8_STAGE(PG8_SB(1, 0), cB + kstep, voffB); PG8_STAGE_A(PG8_SA(1, 0), cA + kstep, 0, vGc); PG8_STAGE(PG8_SB(1, 1), cB + hstepB + kstep, voffB);
    PG8_WAIT_V(6); PG8_BAR;
#pragma unroll 1
    for (;;) {
        const bool has_next = S.next(ui + 1, nxt);
        const char* nA = has_next ? nxt.a : cA; const char* nB = has_next ? nxt.b : cB;
        if (Sched::GATHER) { if (has_next) { PG8_GLOAD(vGn, nxt); } else {
#pragma unroll
                for (int hh_ = 0; hh_ < 2; ++hh_)
#pragma unroll
                    for (int i_ = 0; i_ < 2; ++i_) vGn[hh_][i_] = vGc[hh_][i_]; } }
#pragma unroll 1
        for (int t = 0; t < nt; t += 2) {
            const bool last = (t == nt - 2);
            const char* a1 = cA + (size_t)(t + 1) * kstep;
            const char* a2 = last ? nA : cA + (size_t)(t + 2) * kstep; const char* b2 = last ? nB : cB + (size_t)(t + 2) * kstep;
            const char* a3 = a2 + kstep; const char* b3 = b2 + kstep;
            unsigned v2[2][2];
#pragma unroll
            for (int hh_ = 0; hh_ < 2; ++hh_)
#pragma unroll
                for (int i_ = 0; i_ < 2; ++i_) v2[hh_][i_] = last ? vGn[hh_][i_] : vGc[hh_][i_];
            PG8_LDB(B0, 0, 0); PG8_LDB(B1, 0, 1); PG8_SCHED; PG8_LDA(At, 0, 0); PG8_STAGE_A(PG8_SA(1, 1), a1, 1, vGc);
            PG8_WAIT_V(8); PG8_WAIT_L(0); PG8_BAR; PG8_MMA(0, 0, At, B0); PG8_MMA(0, 1, At, B1); PG8_BAR; PG8_SCHED;
            PG8_LDA(At, 0, 1); PG8_STAGE(PG8_SB(0, 0), b2, voffB); PG8_STAGE(PG8_SB(0, 1), b2 + hstepB, voffB); PG8_STAGE_A(PG8_SA(0, 0), a2, 0, v2);
            PG8_WAIT_V(8); PG8_WAIT_L(0); PG8_BAR; PG8_MMA(1, 0, At, B0); PG8_MMA(1, 1, At, B1); PG8_BAR; PG8_SCHED;
            PG8_LDB(B0, 1, 0); PG8_LDB(B1, 1, 1); PG8_SCHED; PG8_LDA(At, 1, 0); PG8_STAGE_A(PG8_SA(0, 1), a2, 1, v2);
            PG8_WAIT_V(8); PG8_WAIT_L(0); PG8_BAR; PG8_MMA(0, 0, At, B0); PG8_MMA(0, 1, At, B1); PG8_BAR; PG8_SCHED;
            PG8_LDA(At, 1, 1); PG8_STAGE(PG8_SB(1, 0), b3, voffB); PG8_STAGE(PG8_SB(1, 1), b3 + hstepB, voffB); PG8_STAGE_A(PG8_SA(1, 0), a3, 0, v2);
            PG8_WAIT_V(8); PG8_WAIT_L(0); PG8_BAR; PG8_MMA(1, 0, At, B0); PG8_MMA(1, 1, At, B1); PG8_BAR; PG8_SCHED;
        }
        if (wr == 0) PG8_BAR;
        E(acc, cur, wr, wc, fr, fq, xch);
        if (!has_next) break;
#pragma unroll
        for (int a = 0; a < 2; ++a)
#pragma unroll
            for (int b = 0; b < 2; ++b)
#pragma unroll
                for (int m = 0; m < 4; ++m)
#pragma unroll
                    for (int n = 0; n < 2; ++n) acc[a][b][m][n] = (f32x4){0.f, 0.f, 0.f, 0.f};
        cur = nxt; cA = nA; cB = nB; ++ui;
#pragma unroll
        for (int hh_ = 0; hh_ < 2; ++hh_)
#pragma unroll
            for (int i_ = 0; i_ < 2; ++i_) vGc[hh_][i_] = vGn[hh_][i_];
        if (wr == 1) PG8_BAR;
    }
    PG8_WAIT_V(0);
    PG8_BAR;
#undef PG8_SA
#undef PG8_SB
#undef PG8_STAGE
#undef PG8_LDA
#undef PG8_STAGE_A
#undef PG8_GLOAD
#undef PG8_LDB
#undef PG8_MMA
#undef PG8_WAIT_V
#undef PG8_WAIT_L
#undef PG8_BAR
#undef PG8_SCHED
}

struct Dst { bf16* p; int ld; };
__device__ __forceinline__ void store_tile_bf16(const f32x4 (&acc)[2][2][4][2], const Dst d, float sc, int wr, int wc, int fr, int fq) {
    unsigned lane_off = (unsigned)((wr * 64 + fr) * d.ld + wc * 32 + 8 * fq);
    asm volatile("" : "+v"(lane_off));
#pragma unroll
    for (int ai = 0; ai < 2; ++ai)
#pragma unroll
        for (int m = 0; m < 4; ++m) { bf16* rowp = d.p + (size_t)lane_off + (size_t)((ai * HALF + m * 16) * d.ld);
#pragma unroll
            for (int bj = 0; bj < 2; ++bj) { const f32x4 v0 = acc[ai][bj][m][0] * sc, v1 = acc[ai][bj][m][1] * sc;
                u32x4 w; w.x = cvt_pk_bf16(v0[0], v0[1]); w.y = cvt_pk_bf16(v0[2], v0[3]); w.z = cvt_pk_bf16(v1[0], v1[1]); w.w = cvt_pk_bf16(v1[2], v1[3]);
                *(GAS u32x4*)(rowp + bj * HALF) = w; } }
}
}

#define XB_TMO      128
#define XB_XCNT(j)  (256  + 64 * (j))
#define XB_XSUB(j)  (1280 + 64 * (j))
#define XB_XGEN(j)  (2304 + 64 * (j))
#define XB_TOP      3328
#define XB_TOPGEN   3392
#define XCD_BAR_WORDS 3456
#define XB_SPIN_CAP (1u << 20)
__device__ __forceinline__ unsigned xb_ld(unsigned* p)              { return __hip_atomic_load(p, __ATOMIC_RELAXED, __HIP_MEMORY_SCOPE_AGENT); }
__device__ __forceinline__ unsigned xb_add(unsigned* p, unsigned v) { return __hip_atomic_fetch_add(p, v, __ATOMIC_RELAXED, __HIP_MEMORY_SCOPE_AGENT); }
__device__ __forceinline__ unsigned xb_xcc_id() { return (unsigned)__builtin_amdgcn_s_getreg((3 << 11) | 20) & 0xFu; }
#define XB_SPIN(cond, bar) do { unsigned _sp = 0; while (cond) { __builtin_amdgcn_s_sleep(1); \
    if ((++_sp & 255u) == 0u) { if (xb_ld(&(bar)[XB_TMO])) break; if (_sp > XB_SPIN_CAP) { atomicAdd(&(bar)[XB_TMO], 1u); break; } } } } while (0)
struct XcdBarrier { unsigned* bar; unsigned x; volatile LAS unsigned* st; };
__device__ __forceinline__ XcdBarrier xcd_barrier_post(unsigned* bar, volatile LAS unsigned* st) {
    XcdBarrier b; b.bar = bar; b.x = xb_xcc_id(); b.st = st;
    if (threadIdx.x == 0) (void)xb_add(&bar[XB_XCNT(b.x)], 1u);
    return b;
}
__device__ __forceinline__ void xcd_barrier_complete(unsigned* bar, unsigned x, unsigned& nloc, unsigned& nx) {
    const unsigned G = gridDim.x * gridDim.y * gridDim.z;
    unsigned sum, cnt, mine, sp = 0u;
    for (;;) {
        sum = 0u; cnt = 0u; mine = 0u;
#pragma unroll
        for (unsigned j = 0; j < 16; ++j) { const unsigned c = xb_ld(&bar[XB_XCNT(j)]); sum += c; cnt += (c > 0u) ? 1u : 0u; mine = (j == x) ? c : mine; }
        if (sum == G) break;
        __builtin_amdgcn_s_sleep(1);
        if ((++sp & 255u) == 0u) { if (xb_ld(&bar[XB_TMO])) break; if (sp > XB_SPIN_CAP) { atomicAdd(&bar[XB_TMO], 1u); break; } }
    }
    nloc = mine > 0u ? mine : 1u; nx = cnt > 0u ? cnt : 1u;
}
__device__ __forceinline__ void xcd_barrier(const XcdBarrier& b) {
    asm volatile("s_waitcnt vmcnt(0)" ::: "memory");
    __syncthreads();
    if (threadIdx.x == 0) {
        unsigned* bar = b.bar;
        __builtin_amdgcn_s_waitcnt(0);
        unsigned nloc = b.st[0], nx = b.st[1];
        if (nloc == 0u) { xcd_barrier_complete(bar, b.x, nloc, nx); b.st[0] = nloc; b.st[1] = nx; }
        const unsigned old = xb_add(&bar[XB_XSUB(b.x)], 1u);
        const unsigned gen = old / nloc;
        if (old + 1u == (gen + 1u) * nloc) {
            __builtin_amdgcn_fence(__ATOMIC_RELEASE, "agent");
            asm volatile("s_waitcnt vmcnt(0)" ::: "memory");
            const unsigned og = xb_add(&bar[XB_TOP], 1u);
            const unsigned tg = og / nx;
            if (og + 1u == (tg + 1u) * nx) xb_add(&bar[XB_TOPGEN], 1u);
            else XB_SPIN(xb_ld(&bar[XB_TOPGEN]) == tg, bar);
            __builtin_amdgcn_fence(__ATOMIC_ACQUIRE, "agent");
            xb_add(&bar[XB_XGEN(b.x)], 1u);
            asm volatile("s_waitcnt vmcnt(0)" ::: "memory");
        } else {
            XB_SPIN(xb_ld(&bar[XB_XGEN(b.x)]) == gen, bar);
            __builtin_amdgcn_fence(__ATOMIC_ACQUIRE, "agent");
            asm volatile("s_waitcnt vmcnt(0)" ::: "memory");
        }
    }
    __syncthreads();
}

struct Args { const float* in[21]; float* out; unsigned char* ws; int ph_lo, ph_hi; };
struct Frame {
    LAS unsigned char* lds;
    unsigned char* ws;
    gu32* ctl;
    int tid, lane, wave, G, gw, NGW;
};
#define WSP(T_, off) ((T_*)(F.ws + (off)))

__device__ __forceinline__ void tr_item(const float* W, int ldw, int k0, int c0, bf16* dst, int ldd, LAS float* scr, int lane) {
    const int r8 = lane >> 3, c4 = lane & 7;
#pragma unroll
    for (int it = 0; it < 8; ++it) { const int kk = it * 8 + r8; const f32x4 v = *(const GAS f32x4*)(W + (size_t)(k0 + kk) * ldw + c0 + 4 * c4);
        LAS float* s = scr + kk * 33 + 4 * c4; s[0] = v[0]; s[1] = v[1]; s[2] = v[2]; s[3] = v[3]; }
    LDS_WAIT(); asm volatile("" ::: "memory");
    const int c = lane & 7;
#pragma unroll
    for (int j = 0; j < 4; ++j) { const int n = (lane >> 3) + 8 * j; const LAS float* s = scr + (8 * c) * 33 + n;
        u32x4 o; o.x = pk2(s[0 * 33], s[1 * 33]); o.y = pk2(s[2 * 33], s[3 * 33]); o.z = pk2(s[4 * 33], s[5 * 33]); o.w = pk2(s[6 * 33], s[7 * 33]);
        *(GAS u32x4*)(dst + (size_t)n * ldd + k0 + 8 * c) = o; }
    LDS_WAIT(); asm volatile("" ::: "memory");
}
__device__ __forceinline__ void tr_matrix(Frame& F, const float* W, int K, int N, int ldw, bf16* dst, LAS float* scr, int it) {
    const int nblk = N / 32, kb = it / nblk, nb = it % nblk;
    tr_item(W, ldw, 64 * kb, 32 * nb, dst + (size_t)(32 * nb) * K, K, scr, F.lane);
}
__device__ __forceinline__ void p0_prologue(Frame& F, const Args& A) {
    LAS float* scr = (LAS float*)(F.lds + F.wave * 16384);
    constexpr int I_IN = 16 * 112, I_KV = 16 * 64;
    for (int it = F.gw; it < I_IN + 2 * I_KV; it += F.NGW) {
        int r = it;
        if (r < I_IN) { const int kb = r / 112, nb = r % 112;
            tr_item(A.in[2], AB_IN, 64 * kb, 32 * nb + (nb >= 64 ? 8 : 0), WSP(bf16, WS_W_IN) + (size_t)(32 * nb) * D, D, scr, F.lane); continue; } r -= I_IN;
        { const int l = r / I_KV; tr_matrix(F, A.in[12] + (size_t)l * D * 2 * D, D, 2 * D, 2 * D, WSP(bf16, WS_W_KV) + (size_t)l * 2 * D * D, scr, r % I_KV); }
    }
    __syncthreads();
    LAS float* wt = (LAS float*)F.lds;
    for (int i = F.tid; i < 8 * D; i += 512) { const int k = i >> 3, c = i & 7; wt[c * D + k] = A.in[2][(size_t)k * AB_IN + 2048 + c]; }
    __syncthreads();
    const float* x = A.in[0];
    float alg[4], dtb[4];
#pragma unroll
    for (int h = 0; h < 4; ++h) { alg[h] = -__expf(A.in[4][h]); dtb[h] = A.in[5][h]; }
    for (int m = F.gw; m < T; m += F.NGW) {
        const GAS f32x4* xr = (const GAS f32x4*)(x + (size_t)m * D) + F.lane;
        f32x4 v[4];
#pragma unroll
        for (int j = 0; j < 4; ++j) v[j] = xr[64 * j];
        GAS u32x2* o8 = (GAS u32x2*)(WSP(bf16, WS_HB) + (size_t)m * D) + F.lane;
#pragma unroll
        for (int j = 0; j < 4; ++j) { u32x2 w; w.x = pk2(v[j][0], v[j][1]); w.y = pk2(v[j][2], v[j][3]); o8[64 * j] = w; }
        float dot[8];
#pragma unroll
        for (int c = 0; c < 8; ++c) { float s = 0.f;
#pragma unroll
            for (int j = 0; j < 4; ++j) { const f32x4 w = *(const LAS f32x4*)(wt + c * D + 256 * j + 4 * F.lane); s += v[j][0] * w[0] + v[j][1] * w[1] + v[j][2] * w[2] + v[j][3] * w[3]; }
            dot[c] = wave_sum(s); }
        if (F.lane == 0) {
            f32x4 bo, go;
#pragma unroll
            for (int hq = 0; hq < 4; ++hq) { bo[hq] = 1.f / (1.f + __expf(-dot[hq])); const float xx = dot[4 + hq] + dtb[hq]; const float sp = xx > 20.f ? xx : log1pf(__expf(xx)); go[hq] = alg[hq] * sp; }
            *(GAS f32x4*)(WSP(float, WS_BETA) + (size_t)m * 4) = bo;
            *(GAS f32x4*)(WSP(float, WS_GG) + (size_t)m * 4) = go;
        }
    }
    for (int m = F.gw; m < TM; m += F.NGW) {
        const GAS f32x4* xr = (const GAS f32x4*)(A.in[1] + (size_t)m * D) + F.lane;
        GAS u32x2* o8 = (GAS u32x2*)(WSP(bf16, WS_MEMB) + (size_t)m * D) + F.lane;
#pragma unroll
        for (int j = 0; j < 4; ++j) { const f32x4 v = xr[64 * j]; u32x2 w; w.x = pk2(v[0], v[1]); w.y = pk2(v[2], v[3]); o8[64 * j] = w; }
    }
}
constexpr int MOE_I_GU = 16 * 32, MOE_I_D = 8 * 32;
__device__ __forceinline__ void convert_moe_q(Frame& F, const Args& A, int layer, int which  , bf16* dst, unsigned* qword, volatile LAS unsigned* MISC) {
    LAS float* scr = (LAS float*)(F.lds + F.wave * 16384);
    const int nitems = NE * (which == 0 ? MOE_I_GU : MOE_I_D);
    for (;;) {
        __syncthreads();
        if (F.tid == 0) MISC[21] = __hip_atomic_fetch_add(qword, 8u, RLX_AGENT);
        __syncthreads();
        const int it = (int)MISC[21] + F.wave;
        if ((int)MISC[21] >= nitems) break;
        if (it < nitems) {
            if (which == 0) { const int e = it / MOE_I_GU, r = it % MOE_I_GU, kb = r / 32, rb = r % 32, pn = rb >> 3, sub = rb & 7;
                const float* src = (sub < 4 ? A.in[16] : A.in[17]) + ((size_t)layer * NE + e) * D * DE;
                tr_item(src, DE, 64 * kb, 128 * pn + 32 * (sub & 3), dst + ((size_t)e * D + 32 * rb) * D, D, scr, F.lane);
            } else { const int e = it / MOE_I_D, r = it % MOE_I_D, kb = r / 32, nb = r % 32;
                tr_item(A.in[18] + ((size_t)layer * NE + e) * DE * D, D, 64 * kb, 32 * nb, dst + ((size_t)e * D + 32 * nb) * DE, DE, scr, F.lane); }
        }
    }
}

__device__ __forceinline__ void deferred_weights_q(Frame& F, const Args& A, unsigned* qword, volatile LAS unsigned* MISC) {
    LAS float* scr = (LAS float*)(F.lds + F.wave * 16384);
    constexpr int I_SQ = 16 * 32, I_SCI = 16 * 96, I_WQ = 2 * D / 4;
    constexpr int NITEMS = I_SQ + I_SCI + I_SQ + 2 * I_SQ + I_WQ;
    for (;;) {
        __syncthreads();
        if (F.tid == 0) MISC[21] = __hip_atomic_fetch_add(qword, 8u, RLX_AGENT);
        __syncthreads();
        if ((int)MISC[21] >= NITEMS) break;
        int r = (int)MISC[21] + F.wave;
        if (r >= NITEMS) continue;
        if (r < I_SQ) { tr_matrix(F, A.in[7], D, D, D, WSP(bf16, WS_W_ABO), scr, r); continue; } r -= I_SQ;
        if (r < I_SCI) { const int kb = r / 96, rb = r % 96; int c0;
            if (rb < 32) c0 = 32 * rb; else { const int q = rb - 32, tp = q >> 3, sub = q & 7; c0 = (sub < 4 ? D : 2 * D) + 128 * tp + 32 * (sub & 3); }
            tr_item(A.in[8], 3 * D, 64 * kb, c0, WSP(bf16, WS_W_SCI) + (size_t)(32 * rb) * D, D, scr, F.lane); continue; } r -= I_SCI;
        if (r < I_SQ) { tr_matrix(F, A.in[10], D, D, D, WSP(bf16, WS_W_SCO), scr, r); continue; } r -= I_SQ;
        if (r < 2 * I_SQ) { const int l = r / I_SQ; tr_matrix(F, A.in[13] + (size_t)l * D * D, D, D, D, WSP(bf16, WS_W_O) + (size_t)l * D * D, scr, r % I_SQ); continue; } r -= 2 * I_SQ;
        for (int q = 0; q < 4; ++q) { const int m = r * 4 + q;
            const GAS f32x4* xr = (const GAS f32x4*)(A.in[11] + (size_t)m * D) + F.lane; GAS u32x2* o8 = (GAS u32x2*)(WSP(bf16, WS_W_Q) + (size_t)m * D) + F.lane;
#pragma unroll
            for (int j = 0; j < 4; ++j) { const f32x4 v = xr[64 * j]; u32x2 w; w.x = pk2(v[0], v[1]); w.y = pk2(v[2], v[3]); o8[64 * j] = w; } }
    }
}

struct SchedDense {
    static constexpr bool GATHER = false; __device__ __forceinline__ int row(const pg8::Unit&, int) const { return 0; }
    const char* A; const char* B; int lda, ldb, nM, nN, G, c;
    __device__ __forceinline__ bool next(int i, pg8::Unit& u) const {
        const int L = i * G + c; if (L >= nM * nN) return false;
        pg8::swz_tile(L, nM, nN, u.pm, u.pn); u.aux = 0;
        u.a = A + (size_t)u.pm * 256 * lda * 2; u.b = B + (size_t)u.pn * 256 * ldb * 2; return true; }
};
struct EpiDense {
    static constexpr bool PERM = true;
    bf16* O; int ld; float sc;
    __device__ __forceinline__ void operator()(const f32x4 (&acc)[2][2][4][2], const pg8::Unit& u, int wr, int wc, int fr, int fq, LAS unsigned char*) const {
        pg8::store_tile_bf16(acc, pg8::Dst{O + (size_t)u.pm * 256 * ld + u.pn * 256, ld}, sc, wr, wc, fr, fq); }
};
struct EpiScIn {
    static constexpr bool PERM = true;
    bf16* O;
    __device__ __forceinline__ void operator()(const f32x4 (&acc)[2][2][4][2], const pg8::Unit& u, int wr, int wc, int fr, int fq, LAS unsigned char*) const {
        if (u.pn < 4) { pg8::store_tile_bf16(acc, pg8::Dst{O + (size_t)u.pm * 256 * 2048 + u.pn * 256, 2048}, 1.f, wr, wc, fr, fq); return; }
        unsigned lane_off = (unsigned)((wr * 64 + fr) * 2048 + wc * 32 + 8 * fq);
        asm volatile("" : "+v"(lane_off));
        bf16* base = O + (size_t)u.pm * 256 * 2048 + 1024 + (u.pn - 4) * 128 + lane_off;
#pragma unroll
        for (int ai = 0; ai < 2; ++ai)
#pragma unroll
            for (int m = 0; m < 4; ++m) { const f32x4 p0 = acc[ai][0][m][0] * acc[ai][1][m][0], p1 = acc[ai][0][m][1] * acc[ai][1][m][1];
                u32x4 w; w.x = pg8::cvt_pk_bf16(p0[0], p0[1]); w.y = pg8::cvt_pk_bf16(p0[2], p0[3]); w.z = pg8::cvt_pk_bf16(p1[0], p1[1]); w.w = pg8::cvt_pk_bf16(p1[2], p1[3]);
                *(GAS u32x4*)(base + (size_t)((ai * 128 + m * 16) * 2048)) = w; }
    }
};
struct SchedP1 {
    static constexpr bool GATHER = false; __device__ __forceinline__ int row(const pg8::Unit&, int) const { return 0; }
    const char* XB; const char* WIN; const char* MEMB; const char* WKV; int G, c;
    __device__ __forceinline__ bool next(int i, pg8::Unit& u) const {
        const int L = i * G + c; if (L >= 896 + 64) return false;
        if (L < 896) { pg8::swz_tile(L, 64, 14, u.pm, u.pn); u.aux = 0; u.a = XB + (size_t)u.pm * 256 * D * 2; u.b = WIN + (size_t)u.pn * 256 * D * 2; }
        else { const int r = L - 896, l = r >> 5; u.pm = (r & 31) >> 3; u.pn = r & 7; u.aux = 1 + l; u.a = MEMB + (size_t)u.pm * 256 * D * 2; u.b = WKV + ((size_t)l * 2 * D + u.pn * 256) * D * 2; }
        return true; }
};
struct EpiP1 {
    static constexpr bool PERM = true;
    bf16 *QKVPRE, *ZB, *QKVD, *KMEM, *VT;
    __device__ __forceinline__ void operator()(const f32x4 (&acc)[2][2][4][2], const pg8::Unit& u, int wr, int wc, int fr, int fq, LAS unsigned char*) const {
        if (u.aux == 0) {
            pg8::Dst d;
            if (u.pn < 6) d = pg8::Dst{QKVPRE + (size_t)u.pm * 256 * 1536 + u.pn * 256, 1536};
            else if (u.pn < 8) d = pg8::Dst{ZB + (size_t)u.pm * 256 * 512 + (u.pn - 6) * 256, 512};
            else d = pg8::Dst{QKVD + (size_t)u.pm * 256 * 1536 + (u.pn - 8) * 256, 1536};
            pg8::store_tile_bf16(acc, d, (u.pn == 8 || u.pn == 9) ? 0.125f * 1.4426950408889634f : 1.f, wr, wc, fr, fq);
        } else {
            const int l = u.aux - 1;
            if (u.pn < 4) pg8::store_tile_bf16(acc, pg8::Dst{KMEM + ((size_t)l * TM + u.pm * 256) * D + u.pn * 256, D}, 1.f, wr, wc, fr, fq);
            else pg8::store_tile_bf16(acc, pg8::Dst{VT + ((size_t)l * TM + u.pm * 256) * D + (u.pn - 4) * 256, D}, 1.f, wr, wc, fr, fq);
        }
    }
};
struct SchedPrep {
    static constexpr bool GATHER = false; __device__ __forceinline__ int row(const pg8::Unit&, int) const { return 0; }
    const char* KM; const char* WQO; const char* WOT; const char* VM; int G, c;
    __device__ __forceinline__ bool next(int i, pg8::Unit& u) const {
        const int L = i * G + c; if (L >= 256) return false;
        const int l = L >> 7, r = L & 127, kind = r >> 6, q = r & 63, bh = q >> 2, t4 = q & 3, b = bh >> 2, hd = bh & 3;
        u.aux = L; u.pm = 0; u.pn = 0;
        if (kind == 0) { u.a = KM + (((size_t)(l * NB + b) * NMEM) * D + hd * XD) * 2; u.b = WQO + (((size_t)l * D + t4 * 256) * D + hd * XD) * 2; }
        else           { u.a = WOT + (((size_t)l * D + t4 * 256) * D + hd * XD) * 2; u.b = VM + (((size_t)(l * NB + b) * NMEM) * D + hd * XD) * 2; }
        return true; }
};
struct EpiPrep {
    static constexpr bool PERM = true;
    bf16 *MT, *VWT;
    __device__ __forceinline__ void operator()(const f32x4 (&acc)[2][2][4][2], const pg8::Unit& u, int wr, int wc, int fr, int fq, LAS unsigned char*) const {
        const int L = u.aux, l = L >> 7, r = L & 127, kind = r >> 6, q = r & 63, bh = q >> 2, t4 = q & 3, b = bh >> 2, hd = bh & 3;
        if (kind == 0) pg8::store_tile_bf16(acc, pg8::Dst{MT + ((size_t)(l * NB + b) * D + hd * XD) * D + t4 * 256, D}, 0.0625f * 1.4426950408889634f, wr, wc, fr, fq);
        else           pg8::store_tile_bf16(acc, pg8::Dst{VWT + ((size_t)(l * NB + b) * D + t4 * 256) * D + hd * XD, D}, 1.f, wr, wc, fr, fq);
    }
};
struct SchedXB {
    static constexpr bool GATHER = false; __device__ __forceinline__ int row(const pg8::Unit&, int) const { return 0; }
    const char* AB; const char* BB; int G, c;
    __device__ __forceinline__ bool next(int i, pg8::Unit& u) const {
        const int L = i * G + c; if (L >= 256) return false;
        u.pm = L >> 2; u.pn = L & 3; u.aux = 0;
        u.a = AB + (size_t)u.pm * 256 * D * 2; u.b = BB + ((size_t)(u.pm >> 4) * D + u.pn * 256) * D * 2; return true; }
};
struct EpiSoftmax {
    static constexpr bool PERM = true;
    bf16* P;
    __device__ __forceinline__ void operator()(f32x4 (&acc)[2][2][4][2], const pg8::Unit& u, int wr, int wc, int fr, int fq, LAS unsigned char* xch) const {
        LAS float* MX = opq_v((LAS float*)xch + (wr * 64 + fr) * 4);
        LAS float* SM = MX + 1024;
#pragma unroll
        for (int ai = 0; ai < 2; ++ai)
#pragma unroll
            for (int m = 0; m < 4; ++m) { float v = -3.0e38f;
#pragma unroll
                for (int bj = 0; bj < 2; ++bj)
#pragma unroll
                    for (int n = 0; n < 2; ++n) { const f32x4 x = acc[ai][bj][m][n]; v = fmaxf(v, fmaxf(fmaxf(x[0], x[1]), fmaxf(x[2], x[3]))); }
                v = xrow_max(v);
                if (fq == 0) MX[(ai * 128 + m * 16) * 4 + wc] = v; }
        LDS_WAIT(); __builtin_amdgcn_s_barrier(); asm volatile("" ::: "memory");
#pragma unroll
        for (int ai = 0; ai < 2; ++ai)
#pragma unroll
            for (int m = 0; m < 4; ++m) { float s = 0.f; const f32x4 q = *(const LAS f32x4*)(MX + (ai * 128 + m * 16) * 4); const float mxr = fmaxf(fmaxf(q[0], q[1]), fmaxf(q[2], q[3]));
#pragma unroll
                for (int bj = 0; bj < 2; ++bj)
#pragma unroll
                    for (int n = 0; n < 2; ++n) { f32x4 x = acc[ai][bj][m][n];
#pragma unroll
                        for (int e = 0; e < 4; ++e) { x[e] = __builtin_amdgcn_exp2f(x[e] - mxr); s += x[e]; }
                        acc[ai][bj][m][n] = x; }
                s = xrow_sum(s);
                if (fq == 0) SM[(ai * 128 + m * 16) * 4 + wc] = s; asm volatile("" ::: "memory"); }
        LDS_WAIT(); __builtin_amdgcn_s_barrier(); asm volatile("" ::: "memory");
        unsigned lane_off = (unsigned)((wr * 64 + fr) * D + wc * 32 + 8 * fq);
        asm volatile("" : "+v"(lane_off));
        bf16* base = P + (size_t)u.pm * 256 * D + u.pn * XD + lane_off;
#pragma unroll
        for (int ai = 0; ai < 2; ++ai)
#pragma unroll
            for (int m = 0; m < 4; ++m) { const f32x4 q = *(const LAS f32x4*)(SM + (ai * 128 + m * 16) * 4); const float inv = 1.f / ((q[0] + q[1]) + (q[2] + q[3]));
                bf16* rowp = base + (size_t)((ai * 128 + m * 16) * D);
#pragma unroll
                for (int bj = 0; bj < 2; ++bj) { const f32x4 v0 = acc[ai][bj][m][0] * inv, v1 = acc[ai][bj][m][1] * inv;
                    u32x4 w; w.x = pg8::cvt_pk_bf16(v0[0], v0[1]); w.y = pg8::cvt_pk_bf16(v0[2], v0[3]); w.z = pg8::cvt_pk_bf16(v1[0], v1[1]); w.w = pg8::cvt_pk_bf16(v1[2], v1[3]);
                    *(GAS u32x4*)(rowp + bj * 128) = w; } asm volatile("" ::: "memory"); }
        LDS_WAIT(); __builtin_amdgcn_s_barrier(); asm volatile("" ::: "memory");
    }
};
template <bool G_> struct SchedMoE {
    static constexpr bool GATHER = G_;
    const char* Aall; const char* Wall; volatile LAS unsigned* tab; const int* rowmap; int lda, wrows  , ldb, G, c;
    __device__ __forceinline__ int row(const pg8::Unit& u, int r) const { return ((const GAS int*)rowmap)[u.pm * 256 + r]; }
    __device__ __forceinline__ bool next(int i, pg8::Unit& u) const {
        const int L = i * G + c; const int ntile = __builtin_amdgcn_readfirstlane((int)tab[16]); if (L >= ntile * 4) return false;
        u.pm = L >> 2; u.pn = L & 3; const int e = __builtin_amdgcn_readfirstlane((int)tab[32 + u.pm]);
        u.aux = e; u.a = G_ ? Aall : Aall + (size_t)u.pm * 256 * lda * 2; u.b = Wall + ((size_t)e * wrows + u.pn * 256) * ldb * 2; return true; }
};
struct EpiSwiglu {
    static constexpr bool PERM = true;
    bf16* HACT; unsigned* done; int twoG;
    __device__ __forceinline__ void operator()(const f32x4 (&acc)[2][2][4][2], const pg8::Unit& u, int wr, int wc, int fr, int fq, LAS unsigned char*) const {
#pragma unroll
        for (int ai = 0; ai < 2; ++ai)
#pragma unroll
            for (int m = 0; m < 4; ++m) { bf16* rowp = HACT + (size_t)(u.pm * 256 + ai * 128 + wr * 64 + m * 16 + fr) * DE + u.pn * 128 + wc * 32 + 8 * fq;
                float h[8];
#pragma unroll
                for (int n = 0; n < 2; ++n)
#pragma unroll
                    for (int e = 0; e < 4; ++e) { const float gt = acc[ai][0][m][n][e], up = acc[ai][1][m][n][e]; h[n * 4 + e] = silu_f(gt) * up; }
                u32x4 w; w.x = pg8::cvt_pk_bf16(h[0], h[1]); w.y = pg8::cvt_pk_bf16(h[2], h[3]); w.z = pg8::cvt_pk_bf16(h[4], h[5]); w.w = pg8::cvt_pk_bf16(h[6], h[7]);
                if (done) asm volatile("global_store_dwordx4 %0, %1, off sc1\n\ts_nop 1" :: "v"((GAS u32x4*)rowp), "v"(w) : "memory");
                else *(GAS u32x4*)rowp = w; }
        if (done) {
            asm volatile("s_waitcnt vmcnt(0)" ::: "memory"); __builtin_amdgcn_s_barrier(); asm volatile("" ::: "memory");
            if (threadIdx.x == 0) __hip_atomic_fetch_add(done + ((u.pm * 4 + u.pn) < twoG ? 0 : 64), 1u, __ATOMIC_RELAXED, __HIP_MEMORY_SCOPE_AGENT);
        }
    }
};
struct SchedMoE2 {
    static constexpr bool GATHER = false; __device__ __forceinline__ int row(const pg8::Unit&, int) const { return 0; }
    const char* Aall; const char* Wall; volatile LAS unsigned* tab; int G, c;
    __device__ __forceinline__ bool next(int i, pg8::Unit& u) const {
        const int n = 4 * __builtin_amdgcn_readfirstlane((int)tab[16]), G2 = 2 * G, H = n > G2 ? n - G2 : 0; int L;
        if (c < H) { if (i > 0) return false; L = G2 + c; } else { L = (c - H) + i * (G - H); if (L >= (n < G2 ? n : G2)) return false; }
        u.pm = L >> 2; u.pn = L & 3; const int e = __builtin_amdgcn_readfirstlane((int)tab[32 + u.pm]);
        u.aux = e; u.a = Aall + (size_t)u.pm * 256 * DE * 2; u.b = Wall + ((size_t)e * D + u.pn * 256) * DE * 2; return true; }
};
__device__ __forceinline__ void moe_wait_gemm1(Frame& F, unsigned* done, volatile LAS unsigned* tab, int G, int c) {
    if (F.tid == 0) {
        const unsigned n = 4u * tab[16], G2 = 2u * (unsigned)G, needA = n < G2 ? n : G2, H = n > G2 ? n - G2 : 0u; const bool heavy = (unsigned)c < H;
        unsigned sp = 0;
        while (__hip_atomic_load(done, RLX_AGENT) < needA || (heavy && __hip_atomic_load(done + 64, RLX_AGENT) < H)) { __builtin_amdgcn_s_sleep(2); if (++sp > (1u << 22)) break; }
        __builtin_amdgcn_fence(__ATOMIC_ACQUIRE, "agent");
        asm volatile("s_waitcnt vmcnt(0)" ::: "memory");
    }
    __syncthreads();
}


struct Route { int e0, e1, r0, r1; float w0, w1; int s0, s1; };
template <int MODE, bool ROUTER, bool FINAL, bool DRY = false>
__device__ __forceinline__ void ln_pass(Frame& F, const Args& A, const bf16* hold, const bf16* Y, int li  , float* hnew  , bf16* hb, unsigned* cnt) {
    const float* gam = A.in[19] + (size_t)li * D; const float* bet = A.in[20] + (size_t)li * D;
    f32x4 gv[4], bv[4];
#pragma unroll
    for (int j = 0; j < 4; ++j) { gv[j] = *(const GAS f32x4*)(gam + 256 * j + 4 * F.lane); bv[j] = *(const GAS f32x4*)(bet + 256 * j + 4 * F.lane); }
    LAS float* rw = (LAS float*)F.lds;
    LAS float* lgs = (LAS float*)(F.lds + 65536);
    if (ROUTER) { for (int i = F.tid; i < NE * D; i += 512) { const int k = i >> 4, e = i & 15; rw[e * D + k] = A.in[14][i]; } __syncthreads(); }
    Route* route = WSP(Route, WS_ROUTE);
    const int nblk = T / 64;
    for (int blk = blockIdx.x; blk < nblk; blk += F.G) {
        u32x2 hn[4]; u32x2 ya[4], yb[4]; float rw0 = 0.f, rw1 = 0.f;
#define LN_LOAD(mrow) do { const int m_ = (mrow); \
            _Pragma("unroll") for (int j = 0; j < 4; ++j) hn[j] = *((const GAS u32x2*)(hold + (size_t)m_ * D) + F.lane + 64 * j); \
            if (MODE == 0) { _Pragma("unroll") for (int j = 0; j < 4; ++j) ya[j] = *((const GAS u32x2*)(Y + (size_t)m_ * D) + F.lane + 64 * j); } \
            else { const Route r_ = route[m_]; rw0 = r_.w0; rw1 = r_.w1; \
                _Pragma("unroll") for (int j = 0; j < 4; ++j) { ya[j] = *((const GAS u32x2*)(Y + (size_t)r_.s0 * D) + F.lane + 64 * j); yb[j] = *((const GAS u32x2*)(Y + (size_t)r_.s1 * D) + F.lane + 64 * j); } } } while (0)
        LN_LOAD(blk * 64 + F.wave * 8);
#pragma unroll 1
        for (int rr = 0; rr < 8; ++rr) {
            const int m = blk * 64 + F.wave * 8 + rr;
            f32x4 v[4];
#pragma unroll
            for (int j = 0; j < 4; ++j) { v[j][0] = bflo(hn[j].x) * ALPHA; v[j][1] = bfhi(hn[j].x) * ALPHA; v[j][2] = bflo(hn[j].y) * ALPHA; v[j][3] = bfhi(hn[j].y) * ALPHA; }
            if (MODE == 0) {
#pragma unroll
                for (int j = 0; j < 4; ++j) { const u32x2 w = ya[j]; v[j][0] += bflo(w.x); v[j][1] += bfhi(w.x); v[j][2] += bflo(w.y); v[j][3] += bfhi(w.y); }
            } else {
#pragma unroll
                for (int j = 0; j < 4; ++j) { const u32x2 w0 = ya[j], w1 = yb[j];
                    v[j][0] += rw0 * bflo(w0.x) + rw1 * bflo(w1.x); v[j][1] += rw0 * bfhi(w0.x) + rw1 * bfhi(w1.x); v[j][2] += rw0 * bflo(w0.y) + rw1 * bflo(w1.y); v[j][3] += rw0 * bfhi(w0.y) + rw1 * bfhi(w1.y); }
            }
            if (rr < 7) LN_LOAD(m + 1);
            float s = 0.f;
#pragma unroll
            for (int j = 0; j < 4; ++j) s += (v[j][0] + v[j][1]) + (v[j][2] + v[j][3]);
            const float mean = wave_sum(s) * (1.f / D); float s2 = 0.f;
#pragma unroll
            for (int j = 0; j < 4; ++j) { v[j] = v[j] - mean; s2 += (v[j][0] * v[j][0] + v[j][1] * v[j][1]) + (v[j][2] * v[j][2] + v[j][3] * v[j][3]); }
            const float rstd = 1.f / sqrtf(wave_sum(s2) * (1.f / D) + LN_EPS);
#pragma unroll
            for (int j = 0; j < 4; ++j) v[j] = v[j] * rstd * gv[j] + bv[j];
            if (FINAL) {
#pragma unroll
                for (int j = 0; j < 4; ++j) *((GAS f32x4*)(hnew + (size_t)m * D) + F.lane + 64 * j) = v[j];
            } else {
#pragma unroll
                for (int j = 0; j < 4; ++j) { u32x2 w; w.x = pk2(v[j][0], v[j][1]); w.y = pk2(v[j][2], v[j][3]); *((GAS u32x2*)(hb + (size_t)m * D) + F.lane + 64 * j) = w; }
            }
            if (ROUTER) {
                float lg[16];
#pragma unroll
                for (int e = 0; e < 16; ++e) { float d = 0.f;
#pragma unroll
                    for (int j = 0; j < 4; ++j) { const f32x4 w = *(const LAS f32x4*)(rw + e * D + 256 * j + 4 * F.lane); d += v[j][0] * w[0] + v[j][1] * w[1] + v[j][2] * w[2] + v[j][3] * w[3]; }
                    lg[e] = wave_sum(d); }
                if (F.lane == 0) { LAS f32x4* lp = (LAS f32x4*)(lgs + (F.wave * 8 + rr) * 16);
                    lp[0] = (f32x4){lg[0], lg[1], lg[2], lg[3]}; lp[1] = (f32x4){lg[4], lg[5], lg[6], lg[7]}; lp[2] = (f32x4){lg[8], lg[9], lg[10], lg[11]}; lp[3] = (f32x4){lg[12], lg[13], lg[14], lg[15]}; }
            }
        }
        if (ROUTER) {
            __syncthreads();
            if (F.wave == 0) {
                float lg[16];
#pragma unroll
                for (int q = 0; q < 4; ++q) { const f32x4 v4 = *(const LAS f32x4*)(lgs + F.lane * 16 + 4 * q); lg[4 * q] = v4[0]; lg[4 * q + 1] = v4[1]; lg[4 * q + 2] = v4[2]; lg[4 * q + 3] = v4[3]; }
                float mxl = lg[0];
#pragma unroll
                for (int e = 1; e < 16; ++e) mxl = fmaxf(mxl, lg[e]);
                float sc[16], se = 0.f;
#pragma unroll
                for (int e = 0; e < 16; ++e) { sc[e] = __expf(lg[e] - mxl); se += sc[e]; }
                const float inv = 1.f / se; float sl[16];
#pragma unroll
                for (int e = 0; e < 16; ++e) { sc[e] *= inv; sl[e] = sc[e] + A.in[15][e]; }
                int bg = 0; float bgs = -3.0e38f;
#pragma unroll
                for (int g4 = 0; g4 < 4; ++g4) { const float a = sl[4 * g4], b = sl[4 * g4 + 1], c = sl[4 * g4 + 2], d = sl[4 * g4 + 3];
                    const float hi1 = fmaxf(a, b), lo1 = fminf(a, b), hi2 = fmaxf(c, d), lo2 = fminf(c, d);
                    const float top = fmaxf(hi1, hi2), second = fmaxf(fminf(hi1, hi2), fmaxf(lo1, lo2)); const float gs = top + second;
                    if (gs > bgs) { bgs = gs; bg = g4; } }
                float s4[4], c4[4];
#pragma unroll
                for (int q = 0; q < 4; ++q) { s4[q] = bg == 0 ? sl[q] : bg == 1 ? sl[4 + q] : bg == 2 ? sl[8 + q] : sl[12 + q]; c4[q] = bg == 0 ? sc[q] : bg == 1 ? sc[4 + q] : bg == 2 ? sc[8 + q] : sc[12 + q]; }
                int i0 = 0; float b0 = s4[0];
#pragma unroll
                for (int q = 1; q < 4; ++q) if (s4[q] > b0) { b0 = s4[q]; i0 = q; }
                int i1 = -1; float b1 = -3.0e38f;
#pragma unroll
                for (int q = 0; q < 4; ++q) if (q != i0 && s4[q] > b1) { b1 = s4[q]; i1 = q; }
                const float p0 = i0 == 0 ? c4[0] : i0 == 1 ? c4[1] : i0 == 2 ? c4[2] : c4[3];
                const float p1 = i1 == 0 ? c4[0] : i1 == 1 ? c4[1] : i1 == 2 ? c4[2] : c4[3];
                const int e0 = bg * 4 + i0, e1 = bg * 4 + i1;
                const unsigned long long lt = (1ull << F.lane) - 1ull;
                int r0 = 0, r1 = 0, mycount = 0;
#pragma unroll
                for (int e = 0; e < 16; ++e) { const unsigned long long m0 = __ballot(e0 == e), m1 = __ballot(e1 == e);
                    const int before = __popcll(m0 & lt) + __popcll(m1 & lt);
                    if (e0 == e) r0 = before; if (e1 == e) r1 = before;
                    if (F.lane == e) mycount = __popcll(m0) + __popcll(m1); }
                int base = 0; if (F.lane < 16 && mycount > 0 && !DRY) base = (int)atomicAdd(cnt + F.lane, (unsigned)mycount);
                Route r; r.e0 = e0; r.e1 = e1; r.r0 = r0 + __shfl(base, e0); r.r1 = r1 + __shfl(base, e1); r.w0 = p0 / (p0 + p1); r.w1 = p1 / (p0 + p1); r.s0 = 0; r.s1 = 0;
                if (!DRY) route[blk * 64 + F.lane] = r;
            }
            __syncthreads();
        }
    }
}
constexpr int LR_WR = 0, LR_HN = 65792, LR_PART = 131584, LR_LGS = 139776, LR_RS = 1028;
template <bool DRY> __device__ __forceinline__ void ln_router_pass(Frame& F, const Args& A, const bf16* hold, const bf16* Y, int li, bf16* hb, unsigned* cnt) {
    const float* gam = A.in[19] + (size_t)li * D; const float* bet = A.in[20] + (size_t)li * D;
    f32x4 gv[4], bv[4];
#pragma unroll
    for (int j = 0; j < 4; ++j) { gv[j] = *(const GAS f32x4*)(gam + 256 * j + 4 * F.lane); bv[j] = *(const GAS f32x4*)(bet + 256 * j + 4 * F.lane); }
    LAS unsigned char* L = opq_v(F.lds); LAS unsigned char* Lh = opq_v(F.lds + LR_HN); LAS unsigned char* Lp = opq_v(F.lds + LR_PART);
    LAS float* WR = (LAS float*)L; LAS float* HN = (LAS float*)Lh; LAS float* PART = (LAS float*)Lp; LAS float* lgs = (LAS float*)(Lp + (LR_LGS - LR_PART));
    for (int i = F.tid; i < NE * D; i += 512) { const int k = i >> 4, e = i & 15; WR[e * LR_RS + (k & 3) * 256 + (k >> 2)] = ((const GAS float*)A.in[14])[i]; }
    __syncthreads();
    Route* route = WSP(Route, WS_ROUTE);
    const int lane = F.lane, wave = F.wave;
    for (int blk = blockIdx.x; blk < T / 64; blk += F.G) {
        u32x2 hn[4], ya[4];
#define LR_LOAD(mrow) do { const int m_ = (mrow); \
            _Pragma("unroll") for (int j = 0; j < 4; ++j) { hn[j] = *((const GAS u32x2*)(hold + (size_t)m_ * D) + lane + 64 * j); ya[j] = *((const GAS u32x2*)(Y + (size_t)m_ * D) + lane + 64 * j); } } while (0)
        LR_LOAD(blk * 64 + 2 * wave);
#pragma unroll 1
        for (int grp = 0; grp < 4; ++grp) {
#pragma unroll
            for (int q = 0; q < 2; ++q) {
                const int tk = grp * 16 + 2 * wave + q, m = blk * 64 + tk;
                f32x4 v[4];
#pragma unroll
                for (int j = 0; j < 4; ++j) { v[j][0] = bflo(hn[j].x) * ALPHA + bflo(ya[j].x); v[j][1] = bfhi(hn[j].x) * ALPHA + bfhi(ya[j].x); v[j][2] = bflo(hn[j].y) * ALPHA + bflo(ya[j].y); v[j][3] = bfhi(hn[j].y) * ALPHA + bfhi(ya[j].y); }
                if (!(grp == 3 && q == 1)) LR_LOAD(q == 0 ? m + 1 : blk * 64 + (grp + 1) * 16 + 2 * wave);
                float s = 0.f;
#pragma unroll
                for (int j = 0; j < 4; ++j) s += (v[j][0] + v[j][1]) + (v[j][2] + v[j][3]);
                const float mean = wave_sum(s) * (1.f / D); float s2 = 0.f;
#pragma unroll
                for (int j = 0; j < 4; ++j) { v[j] = v[j] - mean; s2 += (v[j][0] * v[j][0] + v[j][1] * v[j][1]) + (v[j][2] * v[j][2] + v[j][3] * v[j][3]); }
                const float rstd = 1.f / sqrtf(wave_sum(s2) * (1.f / D) + LN_EPS);
#pragma unroll
                for (int j = 0; j < 4; ++j) v[j] = v[j] * rstd * gv[j] + bv[j];
                bf16* hrow = (DRY ? hb + (size_t)(m & 16383) * D : hb + (size_t)m * D);
#pragma unroll
                for (int j = 0; j < 4; ++j) { u32x2 w; w.x = pk2(v[j][0], v[j][1]); w.y = pk2(v[j][2], v[j][3]); *((GAS u32x2*)hrow + lane + 64 * j) = w; }
#pragma unroll
                for (int j = 0; j < 4; ++j)
#pragma unroll
                    for (int e = 0; e < 4; ++e) HN[(2 * wave + q) * LR_RS + e * 256 + lane + 64 * j] = v[j][e];
            }
            __syncthreads();
            {
                const int r16 = lane & 15, kq = lane >> 4;
                f32x4 acc = {0.f, 0.f, 0.f, 0.f};
#pragma unroll
                for (int i = 0; i < 8; ++i) { const f32x4 a4 = *(const LAS f32x4*)(HN + r16 * LR_RS + kq * 256 + 32 * wave + 4 * i), b4 = *(const LAS f32x4*)(WR + r16 * LR_RS + kq * 256 + 32 * wave + 4 * i);
#pragma unroll
                    for (int jj = 0; jj < 4; ++jj) acc = __builtin_amdgcn_mfma_f32_16x16x4f32(a4[jj], b4[jj], acc, 0, 0, 0); }
                *(LAS f32x4*)(PART + (wave * 64 + lane) * 4) = acc;
            }
            __syncthreads();
            if (F.tid < 256) { const int row = F.tid >> 4, e = F.tid & 15, src = ((row >> 2) * 16 + e) * 4 + (row & 3); float sum = 0.f;
#pragma unroll
                for (int w8 = 0; w8 < 8; ++w8) sum += PART[w8 * 256 + src];
                lgs[(grp * 16 + row) * 16 + e] = sum; }
        }
#undef LR_LOAD
        __syncthreads();
        if (wave == 0) {
            float lg[16];
#pragma unroll
            for (int q = 0; q < 4; ++q) { const f32x4 v4 = *(const LAS f32x4*)(lgs + lane * 16 + 4 * q); lg[4 * q] = v4[0]; lg[4 * q + 1] = v4[1]; lg[4 * q + 2] = v4[2]; lg[4 * q + 3] = v4[3]; }
            float mxl = lg[0];
#pragma unroll
            for (int e = 1; e < 16; ++e) mxl = fmaxf(mxl, lg[e]);
            float sc[16], se = 0.f;
#pragma unroll
            for (int e = 0; e < 16; ++e) { sc[e] = __expf(lg[e] - mxl); se += sc[e]; }
            const float inv = 1.f / se; float sl[16];
#pragma unroll
            for (int e = 0; e < 16; ++e) { sc[e] *= inv; sl[e] = sc[e] + A.in[15][e]; }
            int bg = 0; float bgs = -3.0e38f;
#pragma unroll
            for (int g4 = 0; g4 < 4; ++g4) { const float a = sl[4 * g4], b = sl[4 * g4 + 1], c = sl[4 * g4 + 2], d = sl[4 * g4 + 3];
                const float hi1 = fmaxf(a, b), lo1 = fminf(a, b), hi2 = fmaxf(c, d), lo2 = fminf(c, d);
                const float top = fmaxf(hi1, hi2), second = fmaxf(fminf(hi1, hi2), fmaxf(lo1, lo2)); const float gs = top + second;
                if (gs > bgs) { bgs = gs; bg = g4; } }
            float s4[4], c4[4];
#pragma unroll
            for (int q = 0; q < 4; ++q) { s4[q] = bg == 0 ? sl[q] : bg == 1 ? sl[4 + q] : bg == 2 ? sl[8 + q] : sl[12 + q]; c4[q] = bg == 0 ? sc[q] : bg == 1 ? sc[4 + q] : bg == 2 ? sc[8 + q] : sc[12 + q]; }
            int i0 = 0; float b0 = s4[0];
#pragma unroll
            for (int q = 1; q < 4; ++q) if (s4[q] > b0) { b0 = s4[q]; i0 = q; }
            int i1 = -1; float b1 = -3.0e38f;
#pragma unroll
            for (int q = 0; q < 4; ++q) if (q != i0 && s4[q] > b1) { b1 = s4[q]; i1 = q; }
            const float p0 = i0 == 0 ? c4[0] : i0 == 1 ? c4[1] : i0 == 2 ? c4[2] : c4[3];
            const float p1 = i1 == 0 ? c4[0] : i1 == 1 ? c4[1] : i1 == 2 ? c4[2] : c4[3];
            const int e0 = bg * 4 + i0, e1 = bg * 4 + i1;
            const unsigned long long lt = (1ull << lane) - 1ull;
            int r0 = 0, r1 = 0, mycount = 0;
#pragma unroll
            for (int e = 0; e < 16; ++e) { const unsigned long long m0 = __ballot(e0 == e), m1 = __ballot(e1 == e);
                const int before = __popcll(m0 & lt) + __popcll(m1 & lt);
                if (e0 == e) r0 = before; if (e1 == e) r1 = before;
                if (lane == e) mycount = __popcll(m0) + __popcll(m1); }
            int base = 0; if (lane < 16 && mycount > 0 && !DRY) base = (int)atomicAdd(cnt + lane, (unsigned)mycount);
            Route r; r.e0 = e0; r.e1 = e1; r.r0 = r0 + __shfl(base, e0); r.r1 = r1 + __shfl(base, e1); r.w0 = p0 / (p0 + p1); r.w1 = p1 / (p0 + p1); r.s0 = 0; r.s1 = 0;
            if (!DRY) route[blk * 64 + lane] = r;
        }
        __syncthreads();
    }
}

__device__ __forceinline__ void moe_table(Frame& F, const unsigned* cnt, volatile LAS unsigned* tab) {
    if (F.tid == 0) { unsigned t = 0; for (int e = 0; e < 16; ++e) { tab[e] = t; t += (__hip_atomic_load(cnt + e, RLX_AGENT) + 255u) >> 8; } tab[16] = t; }
    __syncthreads();
    if (F.tid < 144) { unsigned e = 0; for (int j = 1; j < 16; ++j) e += (tab[j] <= (unsigned)F.tid) ? 1u : 0u; tab[32 + F.tid] = e; }
    __syncthreads();
}
__device__ __forceinline__ void moe_slots(Frame& F, volatile LAS unsigned* tab, int* inv) {
    Route* route = WSP(Route, WS_ROUTE);
    for (int m = blockIdx.x * 512 + F.tid; m < T; m += F.G * 512) {
        const Route r = route[m];
        const int s0 = (int)tab[r.e0] * 256 + r.r0, s1 = (int)tab[r.e1] * 256 + r.r1;
        route[m].s0 = s0; route[m].s1 = s1; inv[s0] = m; inv[s1] = m;
    }
}

__device__ __forceinline__ void conv_pass(Frame& F, const Args& A, const bf16* prj, bf16* ub) {
    const float* cw = A.in[9];
    for (int it = F.gw; it < (T / 16) * 2; it += F.NGW) {
        const int tb = it >> 1, c0 = (it & 1) * 512 + F.lane * 8; const int t0 = tb * 16, pos0 = t0 % SEQ;
        float w[3][8];
#pragma unroll
        for (int j = 0; j < 3; ++j) { const f32x4 a = *(const GAS f32x4*)(cw + j * D + c0), b = *(const GAS f32x4*)(cw + j * D + c0 + 4);
#pragma unroll
            for (int e = 0; e < 4; ++e) { w[j][e] = a[e]; w[j][4 + e] = b[e]; } }
        float p2[8], p1[8];
#pragma unroll
        for (int e = 0; e < 8; ++e) { p2[e] = 0.f; p1[e] = 0.f; }
#pragma unroll
        for (int q = 0; q < 2; ++q) { const bool ok = pos0 - 2 + q >= 0; const bf16* r = prj + (size_t)(ok ? t0 - 2 + q : t0) * 2048;
            u32x4 pv = *(const GAS u32x4*)(r + 1024 + c0); if (!ok) pv = (u32x4){0u, 0u, 0u, 0u};
#pragma unroll
            for (int e = 0; e < 4; ++e) { const float lo = bflo(pv[e]), hi = bfhi(pv[e]); if (q == 0) { p2[2 * e] = lo; p2[2 * e + 1] = hi; } else { p1[2 * e] = lo; p1[2 * e + 1] = hi; } } }
#pragma unroll 4
        for (int tt = 0; tt < 16; ++tt) { const bf16* r = prj + (size_t)(t0 + tt) * 2048;
            const u32x4 gb = *(const GAS u32x4*)(r + c0), pv = *(const GAS u32x4*)(r + 1024 + c0);
            float p0[8], o[8];
#pragma unroll
            for (int e = 0; e < 4; ++e) { p0[2 * e] = bflo(pv[e]); p0[2 * e + 1] = bfhi(pv[e]); }
#pragma unroll
            for (int e = 0; e < 8; ++e) { const float cv = w[0][e] * p2[e] + w[1][e] * p1[e] + w[2][e] * p0[e]; const float g = (e & 1) ? bfhi(gb[e >> 1]) : bflo(gb[e >> 1]); o[e] = g * cv; p2[e] = p1[e]; p1[e] = p0[e]; }
            u32x4 wv; wv.x = pk2(o[0], o[1]); wv.y = pk2(o[2], o[3]); wv.z = pk2(o[4], o[5]); wv.w = pk2(o[6], o[7]);
            *(GAS u32x4*)(ub + (size_t)(t0 + tt) * D + c0) = wv; }
    }
}

constexpr int D1_QB = 0, D1_KB = 17408, D1_E = D1_KB, D1_AT = 34816, D1_KT = 44032, D1_RT = 62464, D1_P = 99328, D1_PT = D1_P + 9216, D1_ET = D1_PT + 9216, D1_UW = D1_P, D1_GC = 136192;
constexpr int RSB = 272, RSS = 144;
static_assert(D1_GC + 2 * 256 <= MISC_OFF && D1_UW + 36864 <= D1_GC && D1_RT + 3 * 67 * 272 <= D1_ET, "D1 LDS");
__device__ __forceinline__ f32x4 tile_k64(const LAS unsigned char* xr, const LAS unsigned char* yr, f32x4 acc) {
#pragma unroll
    for (int s = 0; s < 2; ++s) acc = __builtin_amdgcn_mfma_f32_16x16x32_bf16(*(const LAS bf16x8*)(xr + 64 * s), *(const LAS bf16x8*)(yr + 64 * s), acc, 0, 0, 0);
    return acc;
}
template <int VAR> __device__ __forceinline__ void d1_unit(Frame& F, const Args& A, int unit) {
    if (VAR == 4) return;
    const int bh = unit >> 6, n = unit & 63, b = bh >> 2, h = bh & 3;
    const int t0 = b * SEQ + n * 64;
    const int lane = F.lane, wave = F.wave, g = lane >> 4, c = lane & 15;
    LAS unsigned char* L = F.lds;
    LAS unsigned char* L0 = opq_v(L); LAS unsigned char* L1 = opq_v(L + D1_RT); LAS unsigned char* L2 = opq_v(L + D1_P);
    LAS float* gcs = (LAS float*)(L2 + (D1_GC - D1_P)); LAS float* betas = gcs + 64;
    LAS unsigned char* LQB = L0 + D1_QB; LAS unsigned char* LKB = L0 + D1_KB; LAS unsigned char* LAT = L0 + D1_AT; LAS unsigned char* LKT = L0 + D1_KT;
    LAS unsigned char* LRT = L1; LAS unsigned char* LP = L2; LAS unsigned char* LPT = L2 + 9216; LAS unsigned char* LET = L2 + 18432;
    LAS unsigned char* LUW = L2; LAS unsigned char* LE = L0 + D1_E;
    const int i = lane;
    float gc = ((const GAS float*)WSP(float, WS_GG))[(size_t)(t0 + lane) * 4 + h];
    const float bt = ((const GAS float*)WSP(float, WS_BETA))[(size_t)(t0 + lane) * 4 + h];
    LAS unsigned char* RAW = L1;
    {
        const bf16* pre = WSP(bf16, WS_QKVPRE);
        u32x4 rv[7];
#pragma unroll
        for (int k = 0; k < 7; ++k) { int p = F.tid + 512 * k; p = p < 3216 ? p : 3215; const int x = p / 1072, rem = p - x * 1072, row = rem >> 4, pc = rem & 15;
            const bool okr = (n * 64 - 3 + row >= 0); const int rowi = okr ? (t0 - 3 + row) : t0;
            rv[k] = *(const GAS u32x4*)(pre + (size_t)rowi * 1536 + x * 512 + h * 128 + pc * 8); if (!okr) rv[k] = (u32x4){0u, 0u, 0u, 0u}; }
#pragma unroll
        for (int k = 0; k < 7; ++k) { const int p = F.tid + 512 * k; if (p < 3216) { const int x = p / 1072, rem = p - x * 1072, row = rem >> 4, pc = rem & 15; *(LAS u32x4*)(RAW + (x * 67 + row) * RSB + pc * 16) = rv[k]; } }
    }
    __syncthreads();
#pragma unroll
    for (int o = 1; o < 64; o <<= 1) { const float t = __shfl_up(gc, o); if (lane >= o) gc += t; }
    const float gc63 = __shfl(gc, 63);
    if (wave == 0) { gcs[lane] = gc; betas[lane] = bt; }
    {
        const __attribute__((address_space(4))) float* cwc = (const __attribute__((address_space(4))) float*)A.in[3];
        float ov[3][16];
#pragma unroll
        for (int x = 0; x < 3; ++x) {
#define RL(k) (cwc[((k) >> 4) * 1536 + x * 512 + h * 128 + 16 * wave + ((k) & 15)])
            float acc[16];
#pragma unroll
            for (int e = 0; e < 16; ++e) acc[e] = 0.f;
#pragma unroll
            for (int j = 0; j < 4; ++j) {
                const u32x4 r0 = *(const LAS u32x4*)(RAW + (x * 67 + i + j) * RSB + 32 * wave), r1 = *(const LAS u32x4*)(RAW + (x * 67 + i + j) * RSB + 32 * wave + 16);
#pragma unroll
                for (int e = 0; e < 4; ++e) { const float w0 = RL(j * 16 + 2 * e), w1 = RL(j * 16 + 2 * e + 1), w2 = RL(j * 16 + 8 + 2 * e), w3 = RL(j * 16 + 8 + 2 * e + 1);
                    acc[2 * e] += w0 * bflo(r0[e]); acc[2 * e + 1] += w1 * bfhi(r0[e]); acc[8 + 2 * e] += w2 * bflo(r1[e]); acc[8 + 2 * e + 1] += w3 * bfhi(r1[e]); }
            }
#pragma unroll
            for (int e = 0; e < 16; ++e) ov[x][e] = silu_f(acc[e]);
#undef RL
        }
        float sq = 0.f, sk = 0.f;
#pragma unroll
        for (int e = 0; e < 16; ++e) { sq += ov[0][e] * ov[0][e]; sk += ov[1][e] * ov[1][e]; }
        LAS float* part = (LAS float*)LET;
        part[wave * 64 + i] = sq; part[512 + wave * 64 + i] = sk;
        __syncthreads();
        float tq = 0.f, tk = 0.f;
#pragma unroll
        for (int w8 = 0; w8 < 8; ++w8) { tq += part[w8 * 64 + i]; tk += part[512 + w8 * 64 + i]; }
        const float rq = rsqrtf(tq + RMS_EPS) * 0.08838834764831845f, rk = rsqrtf(tk + RMS_EPS);
        const float kt = __expf(gc63 - gc), be = bt * __expf(gc);
        u32x4 qw[2], kw[2];
#pragma unroll
        for (int e = 0; e < 8; ++e) { qw[e >> 2][e & 3] = pk2(ov[0][2 * e] * rq, ov[0][2 * e + 1] * rq); kw[e >> 2][e & 3] = pk2(ov[1][2 * e] * rk, ov[1][2 * e + 1] * rk); }
        *(LAS u32x4*)(LQB + i * RSB + 32 * wave) = qw[0]; *(LAS u32x4*)(LQB + i * RSB + 32 * wave + 16) = qw[1];
        *(LAS u32x4*)(LKB + i * RSB + 32 * wave) = kw[0]; *(LAS u32x4*)(LKB + i * RSB + 32 * wave + 16) = kw[1];
#pragma unroll
        for (int e = 0; e < 16; ++e) { const float kv = ov[1][e] * rk; const int d = 16 * wave + e;
            *(LAS unsigned short*)(LKT + d * RSS + 2 * i) = (unsigned short)f2bf(kv * kt);
            *(LAS unsigned short*)(LRT + d * RSS + 2 * i) = (unsigned short)f2bf(ov[2][e] * bt);
            *(LAS unsigned short*)(LRT + (128 + d) * RSS + 2 * i) = (unsigned short)f2bf(kv * be); }
    }
    __syncthreads();
    if (VAR == 1) return;
    f32x4 Er[2], Pcur[2];
#pragma unroll
    for (int it = 0; it < 4; ++it) {
        const int id = wave + 8 * (it & 1), isq = it >> 1, mi = id >> 2, nj = id & 3;
        f32x4 acc = {0.f, 0.f, 0.f, 0.f};
        if (mi >= nj) {
            const LAS unsigned char* xr = (isq ? LQB : LKB) + (16 * mi + c) * RSB + 16 * g;
            const LAS unsigned char* yr = LKB + (16 * nj + c) * RSB + 16 * g;
#pragma unroll
            for (int s = 0; s < 4; ++s) acc = __builtin_amdgcn_mfma_f32_16x16x32_bf16(*(const LAS bf16x8*)(xr + 64 * s), *(const LAS bf16x8*)(yr + 64 * s), acc, 0, 0, 0);
        }
        const int j = 16 * nj + c; const float gj = gcs[j];
        f32x4 o;
#pragma unroll
        for (int r = 0; r < 4; ++r) { const int i = 16 * mi + 4 * g + r; const float dec = (i >= j) ? __expf(gcs[i] - gj) : 0.f;
            o[r] = isq ? ((i >= j) ? acc[r] * dec : 0.f) : ((i > j) ? -betas[i] * acc[r] * dec : 0.f); }
        if (!isq) { Er[it & 1] = o; Pcur[it & 1] = o;
            u32x2 w; w.x = pk2(o[0], o[1]); w.y = pk2(o[2], o[3]);
            *(LAS u32x2*)(LPT + j * RSS + 2 * (16 * mi + 4 * g)) = w; *(LAS u32x2*)(LET + j * RSS + 2 * (16 * mi + 4 * g)) = w;
#pragma unroll
            for (int r = 0; r < 4; ++r) *(LAS unsigned short*)(LP + (16 * mi + 4 * g + r) * RSS + 2 * j) = (unsigned short)f2bf(o[r]);
        } else {
#pragma unroll
            for (int r = 0; r < 4; ++r) *(LAS unsigned short*)(LAT + (16 * mi + 4 * g + r) * RSS + 2 * j) = (unsigned short)f2bf(o[r]);
        }
    }
#pragma unroll 1
    for (int s6 = 0; s6 < 6; ++s6) {
        __syncthreads();
        f32x4 Pn[2], En[2];
#pragma unroll
        for (int tt = 0; tt < 2; ++tt) { const int id = wave + 8 * tt, mi = id >> 2, nj = id & 3;
            const LAS unsigned char* pr = LP + (16 * mi + c) * RSS + 16 * g;
            if (s6 < 5) Pn[tt] = tile_k64(pr, LPT + (16 * nj + c) * RSS + 16 * g, (f32x4){0.f, 0.f, 0.f, 0.f});
            if (s6 > 0) En[tt] = tile_k64(pr, LET + (16 * nj + c) * RSS + 16 * g, Er[tt] + Pcur[tt]); }
        __syncthreads();
#pragma unroll
        for (int tt = 0; tt < 2; ++tt) { const int id = wave + 8 * tt, mi = id >> 2, nj = id & 3, j = 16 * nj + c;
            if (s6 > 0) { Er[tt] = En[tt]; u32x2 w; w.x = pk2(En[tt][0], En[tt][1]); w.y = pk2(En[tt][2], En[tt][3]); *(LAS u32x2*)(LET + j * RSS + 2 * (16 * mi + 4 * g)) = w; }
            if (s6 < 5) { Pcur[tt] = Pn[tt]; u32x2 w; w.x = pk2(Pn[tt][0], Pn[tt][1]); w.y = pk2(Pn[tt][2], Pn[tt][3]); *(LAS u32x2*)(LPT + j * RSS + 2 * (16 * mi + 4 * g)) = w;
#pragma unroll
                for (int r = 0; r < 4; ++r) *(LAS unsigned short*)(LP + (16 * mi + 4 * g + r) * RSS + 2 * j) = (unsigned short)f2bf(Pn[tt][r]); } }
    }
    if (VAR == 2) { __syncthreads(); return; }
#pragma unroll
    for (int tt = 0; tt < 2; ++tt) { const int id = wave + 8 * tt, mi = id >> 2, nj = id & 3, j = 16 * nj + c;
#pragma unroll
        for (int r = 0; r < 4; ++r) *(LAS unsigned short*)(LE + (16 * mi + 4 * g + r) * RSS + 2 * j) = (unsigned short)f2bf(Er[tt][r]); }
    __syncthreads();
    {
        f32x4 xo[8];
#pragma unroll
        for (int q = 0; q < 8; ++q) { const int t = wave + 8 * q, mi = t >> 4, ct = t & 15;
            const u32x2 rv = *(const LAS u32x2*)(LRT + (16 * ct + c) * RSS + 2 * (16 * mi + 4 * g));
            xo[q] = tile_k64(LE + (16 * mi + c) * RSS + 16 * g, LRT + (16 * ct + c) * RSS + 16 * g, (f32x4){bflo(rv.x), bfhi(rv.x), bflo(rv.y), bfhi(rv.y)}); }
        __syncthreads();
#pragma unroll
        for (int q = 0; q < 8; ++q) { const int t = wave + 8 * q, mi = t >> 4, ct = t & 15;
            u32x2 w; w.x = pk2(xo[q][0], xo[q][1]); w.y = pk2(xo[q][2], xo[q][3]);
            *(LAS u32x2*)(LUW + (16 * ct + c) * RSS + 2 * (16 * mi + 4 * g)) = w; }
    }
    __syncthreads();
    if (VAR == 3) return;
    const LAS unsigned char* UWr = LUW; const LAS unsigned char* ATr = LAT; const LAS unsigned char* KTr = LKT;
    const size_t cbase = (size_t)unit; const f32x4 z4 = {0.f, 0.f, 0.f, 0.f};
#pragma unroll 2
    for (int q_ = 0; q_ < 4; ++q_) { const int t = wave + 8 * q_; const int xi = t >> 3, yj = t & 7;
        const f32x4 d = tile_k64(ATr + (16 * xi + c) * RSS + 16 * g, UWr + (16 * yj + c) * RSS + 16 * g, z4);
        u32x2 w; w.x = pk2(d[0], d[1]); w.y = pk2(d[2], d[3]);
        *(GAS u32x2*)(WSP(bf16, WS_OLOCT) + cbase * 8192 + (size_t)((yj * 4 + xi) * 64 + lane) * 4) = w; }
#pragma unroll 2
    for (int q_ = 0; q_ < 4; ++q_) { const int t = wave + 8 * q_; const int xi = t >> 2, yj = t & 3;
        const f32x4 d = tile_k64(UWr + (128 + 16 * xi + c) * RSS + 16 * g, ATr + (16 * yj + c) * RSS + 16 * g, z4);
        const int i2 = 16 * yj + c, dd = 16 * xi + 4 * g; const float eg = __expf(gcs[i2]);
        const u32x2 qv = *(const LAS u32x2*)(LQB + i2 * RSB + 2 * dd);
        u32x2 w; w.x = pk2(bflo(qv.x) * eg - d[0], bfhi(qv.x) * eg - d[1]); w.y = pk2(bflo(qv.y) * eg - d[2], bfhi(qv.y) * eg - d[3]);
        *(GAS u32x2*)(WSP(bf16, WS_QEFF) + cbase * 8192 + (size_t)(((yj * 4 + (xi >> 1)) * 64 + (2 * (xi & 1) + (g >> 1)) * 16 + c) * 8 + 4 * (g & 1))) = w; }
#pragma unroll 2
    for (int q_ = 0; q_ < 8; ++q_) { const int t = wave + 8 * q_; const int xi = t >> 3, yj = t & 7;
        const f32x4 d = tile_k64(KTr + (16 * xi + c) * RSS + 16 * g, UWr + (16 * yj + c) * RSS + 16 * g, z4);
        u32x2 w; w.x = pk2(d[0], d[1]); w.y = pk2(d[2], d[3]);
        *(GAS u32x2*)(WSP(bf16, WS_BMT) + cbase * 16384 + (size_t)(((yj * 4 + (xi >> 1)) * 2 + (xi & 1)) * 64 + lane) * 4) = w; }
#pragma unroll 2
    for (int q_ = 0; q_ < 8; ++q_) { const int t = wave + 8 * q_; const int xi = t >> 3, yj = t & 7;
        const f32x4 d = tile_k64(UWr + (128 + 16 * xi + c) * RSS + 16 * g, KTr + (16 * yj + c) * RSS + 16 * g, z4);
        u32x2 w; w.x = pk2(-d[0], -d[1]); w.y = pk2(-d[2], -d[3]);
        *(GAS u32x2*)(WSP(bf16, WS_MNEG) + cbase * 16384 + (size_t)(((yj * 4 + (xi >> 1)) * 64 + (2 * (xi & 1) + (g >> 1)) * 16 + c) * 8 + 4 * (g & 1))) = w; }
    if (F.tid == 0) WSP(float, WS_GLAST)[unit] = __expf(gc63);
    __syncthreads();
}

constexpr int SCAN_PF = 4;
__device__ __forceinline__ void scan_wg(Frame& F, int sw) {
    const int bh = sw & 15, slice = sw >> 4, b = bh >> 2, h = bh & 3;
    const int lane = F.lane, wave = F.wave, g = lane >> 4, c = lane & 15;
    LAS unsigned char* ST = opq_v(F.lds);
    LAS unsigned char* OS = ST + 8704;
    for (int i = F.tid; i < 2 * 4352 / 4; i += 512) ((LAS unsigned*)ST)[i] = 0u;
    __syncthreads();
    const GAS bf16* MN = (const GAS bf16*)(WSP(bf16, WS_MNEG) + (size_t)bh * 64 * 16384); const GAS bf16* BM = (const GAS bf16*)(WSP(bf16, WS_BMT) + (size_t)bh * 64 * 16384);
    const GAS bf16* QE = (const GAS bf16*)(WSP(bf16, WS_QEFF) + (size_t)bh * 64 * 8192); const GAS bf16* OL = (const GAS bf16*)(WSP(bf16, WS_OLOCT) + (size_t)bh * 64 * 8192);
    const GAS float* GL = (const GAS float*)(WSP(float, WS_GLAST) + bh * 64);
    (void)b; (void)h;
    if (wave < 4) {
        f32x4 Sreg[2] = {{0.f, 0.f, 0.f, 0.f}, {0.f, 0.f, 0.f, 0.f}};
        bf16x8 Af[SCAN_PF][2][4]; u32x2 bm[SCAN_PF][2]; float gl[SCAN_PF];
#define SCAN_LOAD_REC(j, n) do { const size_t cb_ = (size_t)(n) * 16384; \
        _Pragma("unroll") for (int mt = 0; mt < 2; ++mt) { _Pragma("unroll") for (int s = 0; s < 4; ++s) Af[j][mt][s] = *(const GAS bf16x8*)(MN + cb_ + (size_t)(((wave * 2 + mt) * 4 + s) * 64 + lane) * 8); \
            bm[j][mt] = *(const GAS u32x2*)(BM + cb_ + (size_t)(((slice * 4 + wave) * 2 + mt) * 64 + lane) * 4); } gl[j] = GL[n]; } while (0)
#pragma unroll
        for (int j = 0; j < SCAN_PF; ++j) SCAN_LOAD_REC(j, j);
#pragma unroll 1
        for (int n0 = 0; n0 < 64; n0 += SCAN_PF) {
#pragma unroll
            for (int j = 0; j < SCAN_PF; ++j) {
                const int n = n0 + j; const int cur = n & 1;
                bf16x8 Sb[4];
#pragma unroll
                for (int s = 0; s < 4; ++s) Sb[s] = *(const LAS bf16x8*)(ST + cur * 4352 + c * 272 + 64 * s + 16 * g);
#pragma unroll
                for (int mt = 0; mt < 2; ++mt) {
                    f32x4 acc; acc[0] = gl[j] * Sreg[mt][0] + bflo(bm[j][mt].x); acc[1] = gl[j] * Sreg[mt][1] + bfhi(bm[j][mt].x); acc[2] = gl[j] * Sreg[mt][2] + bflo(bm[j][mt].y); acc[3] = gl[j] * Sreg[mt][3] + bfhi(bm[j][mt].y);
#pragma unroll
                    for (int s = 0; s < 4; ++s) acc = __builtin_amdgcn_mfma_f32_16x16x32_bf16(Af[j][mt][s], Sb[s], acc, 0, 0, 0);
                    Sreg[mt] = acc;
                    u32x2 w; w.x = pk2(acc[0], acc[1]); w.y = pk2(acc[2], acc[3]);
                    *(LAS u32x2*)(ST + (cur ^ 1) * 4352 + c * 272 + 2 * (32 * wave + 16 * mt + 4 * g)) = w;
                }
                if (n + SCAN_PF < 64) SCAN_LOAD_REC(j, n + SCAN_PF);
                __syncthreads();
            }
        }
#undef SCAN_LOAD_REC
        __syncthreads();
    } else {
        const int m = wave - 4;
        bf16x8 Qf[SCAN_PF][4]; u32x2 ol[SCAN_PF];
        GAS bf16* OU = (GAS bf16*)(WSP(bf16, WS_OUN) + ((size_t)(bh * 8 + slice) * SEQ) * 16);
#define SCAN_LOAD_OUT(j, n) do { const size_t cb_ = (size_t)(n) * 8192; \
        _Pragma("unroll") for (int s = 0; s < 4; ++s) Qf[j][s] = *(const GAS bf16x8*)(QE + cb_ + (size_t)((m * 4 + s) * 64 + lane) * 8); \
        ol[j] = *(const GAS u32x2*)(OL + cb_ + (size_t)((slice * 4 + m) * 64 + lane) * 4); } while (0)
#define SCAN_FLUSH(n) do { if (m < 2) { const int q_ = m * 64 + lane; const u32x4 v_ = *(const LAS u32x4*)(OS + ((n) & 1) * 2048 + q_ * 16); *(GAS u32x4*)(OU + (size_t)(n) * 1024 + q_ * 8) = v_; } } while (0)
#pragma unroll
        for (int j = 0; j < SCAN_PF; ++j) SCAN_LOAD_OUT(j, j);
#pragma unroll 1
        for (int n0 = 0; n0 < 64; n0 += SCAN_PF) {
#pragma unroll
            for (int j = 0; j < SCAN_PF; ++j) {
                const int n = n0 + j; const int cur = n & 1;
                if (n > 0) SCAN_FLUSH(n - 1);
                bf16x8 Sb[4];
#pragma unroll
                for (int s = 0; s < 4; ++s) Sb[s] = *(const LAS bf16x8*)(ST + cur * 4352 + c * 272 + 64 * s + 16 * g);
                f32x4 acc; acc[0] = bflo(ol[j].x); acc[1] = bfhi(ol[j].x); acc[2] = bflo(ol[j].y); acc[3] = bfhi(ol[j].y);
#pragma unroll
                for (int s = 0; s < 4; ++s) acc = __builtin_amdgcn_mfma_f32_16x16x32_bf16(Qf[j][s], Sb[s], acc, 0, 0, 0);
#pragma unroll
                for (int r = 0; r < 4; ++r) *(LAS unsigned short*)(OS + cur * 2048 + (16 * m + 4 * g + r) * 32 + 2 * c) = (unsigned short)f2bf(acc[r]);
                if (n + SCAN_PF < 64) SCAN_LOAD_OUT(j, n + SCAN_PF);
                __syncthreads();
            }
        }
        SCAN_FLUSH(63);
        __syncthreads();
#undef SCAN_LOAD_OUT
#undef SCAN_FLUSH
    }
}

constexpr int AT_KS = 0, AT_VS = 36864, AT_OS = 73728, N_ATT_UNITS = NB * DAH * 96;
__device__ __forceinline__ s16x4 vtr(const LAS unsigned char* p) { typedef short v4i16_t __attribute__((ext_vector_type(4))); return __builtin_bit_cast(s16x4, __builtin_amdgcn_ds_read_tr16_b64_v4i16((LAS v4i16_t*)p)); }
struct AttU { int b, hh, br, dil, res, n; };
__device__ __forceinline__ AttU att_decode(int a) { AttU u; const int bhh = a / 96, rem = a % 96; u.br = rem >> 5; const int idx = rem & 31; u.b = bhh >> 3; u.hh = bhh & 7;
    u.dil = u.br == 0 ? 1 : u.br == 1 ? 4 : 16; const int nblk = 32 / u.dil; u.res = idx / nblk; u.n = idx % nblk; return u; }
__device__ __forceinline__ void att_load(Frame& F, int a, u32x4 (&kv)[4], u32x4 (&vv)[4], bf16x8 (&Bq)[2]) {
    const AttU u = att_decode(a); const bf16* QKVD = WSP(bf16, WS_QKVD);
#pragma unroll
    for (int p = 0; p < 4; ++p) { const int j = (F.tid >> 3) + 64 * p, kidx = 128 * (u.n - 1) + j; const bool ok = kidx >= 0;
        const bf16* src = QKVD + (size_t)(u.b * SEQ + (ok ? kidx : 0) * u.dil + u.res) * 1536 + u.hh * 64 + (F.tid & 7) * 8;
        kv[p] = *(const GAS u32x4*)(src + 512); vv[p] = *(const GAS u32x4*)(src + 1024);
        if (!ok) { kv[p] = (u32x4){0u, 0u, 0u, 0u}; vv[p] = (u32x4){0u, 0u, 0u, 0u}; } }
    const int qi = 16 * F.wave + (F.lane & 15); const size_t qtok = (size_t)(u.b * SEQ + (128 * u.n + qi) * u.dil + u.res);
#pragma unroll
    for (int s = 0; s < 2; ++s) Bq[s] = *(const GAS bf16x8*)(QKVD + qtok * 1536 + u.hh * 64 + 32 * s + 8 * (F.lane >> 4));
}
__device__ __forceinline__ void att_compute(Frame& F, int a, LAS unsigned char* L, const bf16x8 (&Bq)[2]) {
    const AttU u = att_decode(a); const int n = u.n;
    const int lane = F.lane, wave = F.wave, g = lane >> 4, c = lane & 15;
    const int qi = 16 * wave + c;
    f32x4 sc[9];
    float mx = -1.0e30f;
#pragma unroll
    for (int t = 0; t < 9; ++t) {
        const LAS unsigned char* kr = L + AT_KS + (16 * (wave + t) + c) * RSS + 16 * g;
        f32x4 acc = {0.f, 0.f, 0.f, 0.f};
        acc = __builtin_amdgcn_mfma_f32_16x16x32_bf16(*(const LAS bf16x8*)kr, Bq[0], acc, 0, 0, 0);
        acc = __builtin_amdgcn_mfma_f32_16x16x32_bf16(*(const LAS bf16x8*)(kr + 64), Bq[1], acc, 0, 0, 0);
        if (t == 0) {
#pragma unroll
            for (int r = 0; r < 4; ++r) { const int j = 16 * wave + 4 * g + r; if (j < qi) acc[r] = -1.0e30f; } }
        if (t == 8) {
#pragma unroll
            for (int r = 0; r < 4; ++r) { const int j = 16 * (wave + 8) + 4 * g + r; if (j > qi + 128) acc[r] = -1.0e30f; } }
        if (n == 0 && wave + t < 8) acc = (f32x4){-1.0e30f, -1.0e30f, -1.0e30f, -1.0e30f};
        mx = fmaxf(fmaxf(mx, fmaxf(acc[0], acc[1])), fmaxf(acc[2], acc[3]));
        sc[t] = acc;
    }
    mx = xrow_max(mx);
    float lsum = 0.f;
#pragma unroll
    for (int t = 0; t < 9; ++t)
#pragma unroll
        for (int r = 0; r < 4; ++r) { const float p = __builtin_amdgcn_exp2f(sc[t][r] - mx); sc[t][r] = p; lsum += p; }
    lsum = xrow_sum(lsum);
    { const float li = __builtin_amdgcn_rcpf(lsum);
#pragma unroll
      for (int t = 0; t < 9; ++t) sc[t] = sc[t] * li; }
    bf16x8 pf[5];
#pragma unroll
    for (int q = 0; q < 5; ++q) { u32x4 w; w.x = pk2(sc[2 * q][0], sc[2 * q][1]); w.y = pk2(sc[2 * q][2], sc[2 * q][3]);
        if (q < 4) { w.z = pk2(sc[2 * q + 1][0], sc[2 * q + 1][1]); w.w = pk2(sc[2 * q + 1][2], sc[2 * q + 1][3]); } else { w.z = 0u; w.w = 0u; }
        pf[q] = __builtin_bit_cast(bf16x8, w); }
    LAS unsigned char* OS = L + AT_OS + wave * 2304;
#pragma unroll
    for (int dt = 0; dt < 4; ++dt) {
        f32x4 acc = {0.f, 0.f, 0.f, 0.f};
#pragma unroll
        for (int q = 0; q < 5; ++q) { const int kb = 16 * (wave + 2 * q);
            const LAS unsigned char* vp = L + AT_VS + (kb + 4 * g + (c >> 2)) * RSS + (16 * dt + 4 * (c & 3)) * 2;
            const s16x4 lo = vtr(vp); s16x4 hi = {0, 0, 0, 0}; if (q < 4) hi = vtr(vp + 16 * RSS);
            const bf16x8 bv = {lo[0], lo[1], lo[2], lo[3], hi[0], hi[1], hi[2], hi[3]};
            acc = __builtin_amdgcn_mfma_f32_16x16x32_bf16(pf[q], bv, acc, 0, 0, 0); }
#pragma unroll
        for (int r = 0; r < 4; ++r) *(LAS unsigned short*)(OS + (4 * g + r) * RSS + (16 * dt + c) * 2) = (unsigned short)f2bf(acc[r]);
    }
    const size_t qtok = (size_t)(u.b * SEQ + (128 * n + qi) * u.dil + u.res);
    if (g == 0) ((GAS float*)WSP(float, WS_LSE))[((size_t)u.br * T + qtok) * 8 + u.hh] = (mx + __log2f(lsum)) * 0.6931471805599453f;
    { const int row = lane >> 2, pc = lane & 3; const size_t tok = (size_t)(u.b * SEQ + (128 * n + 16 * wave + row) * u.dil + u.res);
      const u32x4 v0 = *(const LAS u32x4*)(OS + row * RSS + pc * 32), v1 = *(const LAS u32x4*)(OS + row * RSS + pc * 32 + 16);
      GAS u32x4* dst = (GAS u32x4*)(WSP(bf16, WS_OPART) + ((size_t)u.br * T + tok) * 512 + u.hh * 64 + pc * 16); dst[0] = v0; dst[1] = v1; }
}
__device__ __forceinline__ void attn_queue(Frame& F, unsigned* qword, volatile LAS unsigned* MISC) {
    LAS unsigned char* L = opq_v(F.lds);
    u32x4 kv[4], vv[4]; bf16x8 Bq[2], BqN[2];
    unsigned pend = 0u;
    if (F.tid == 0) { MISC[22] = __hip_atomic_fetch_add(qword, 1u, RLX_AGENT); pend = __hip_atomic_fetch_add(qword, 1u, RLX_AGENT); }
    __syncthreads();
    int a = (int)MISC[22];
    if (a < N_ATT_UNITS) att_load(F, a, kv, vv, Bq);
    while (a < N_ATT_UNITS) {
#pragma unroll
        for (int p = 0; p < 4; ++p) { const int j = (F.tid >> 3) + 64 * p; *(LAS u32x4*)(L + AT_KS + j * RSS + (F.tid & 7) * 16) = kv[p]; *(LAS u32x4*)(L + AT_VS + j * RSS + (F.tid & 7) * 16) = vv[p]; }
        if (F.tid == 0) { MISC[20] = pend; pend = __hip_atomic_fetch_add(qword, 1u, RLX_AGENT); }
        __syncthreads();
        const int an = (int)MISC[20];
        if (an < N_ATT_UNITS) att_load(F, an, kv, vv, BqN);
        att_compute(F, a, L, Bq);
        __syncthreads();
        a = an; Bq[0] = BqN[0]; Bq[1] = BqN[1];
    }
}

__device__ __forceinline__ void mix_pass(Frame& F, const Args& A) {
    const int lane = F.lane;
    float nw[8];
    { const f32x4 a = *(const GAS f32x4*)(A.in[6] + 8 * (lane & 15)), b = *(const GAS f32x4*)(A.in[6] + 8 * (lane & 15) + 4);
#pragma unroll
      for (int e = 0; e < 4; ++e) { nw[e] = a[e]; nw[4 + e] = b[e]; } }
    const bf16* OU = WSP(bf16, WS_OUN); const bf16* ZB = WSP(bf16, WS_ZB); const bf16* OP = WSP(bf16, WS_OPART); const float* LSE = WSP(float, WS_LSE); bf16* MIX = WSP(bf16, WS_MIX);
    for (int t = F.gw; t < T; t += F.NGW) {
        const u32x4 uo = *(const GAS u32x4*)(OU + ((size_t)(((t >> 12) * 4 + (lane >> 4)) * 8 + ((lane & 15) >> 1)) * SEQ + (t & 4095)) * 16 + 8 * (lane & 1)), uz = *(const GAS u32x4*)(ZB + (size_t)t * 512 + 8 * lane);
        float x[8], z[8];
#pragma unroll
        for (int e = 0; e < 4; ++e) { x[2 * e] = bflo(uo[e]); x[2 * e + 1] = bfhi(uo[e]); z[2 * e] = bflo(uz[e]); z[2 * e + 1] = bfhi(uz[e]); }
        float ss = 0.f;
#pragma unroll
        for (int e = 0; e < 8; ++e) ss += x[e] * x[e];
        ss += dpp_f(ss, 0xB1, 0xf); ss += dpp_f(ss, 0x4E, 0xf); ss += dpp_f(ss, 0x141, 0xf); ss += dpp_f(ss, 0x140, 0xf);
        const float rstd = rsqrtf(ss * (1.f / 128.f) + RMS_EPS);
        float o[8];
#pragma unroll
        for (int e = 0; e < 8; ++e) o[e] = x[e] * rstd * nw[e] * silu_f(z[e]);
        u32x4 w; w.x = pk2(o[0], o[1]); w.y = pk2(o[2], o[3]); w.z = pk2(o[4], o[5]); w.w = pk2(o[6], o[7]);
        *(GAS u32x4*)(MIX + (size_t)t * D + 8 * lane) = w;
        const int hh = lane >> 3;
        const float l0 = LSE[((size_t)0 * T + t) * 8 + hh], l1 = LSE[((size_t)1 * T + t) * 8 + hh], l2 = LSE[((size_t)2 * T + t) * 8 + hh];
        const float lm = fmaxf(l0, fmaxf(l1, l2)); const float e0 = __expf(l0 - lm), e1 = __expf(l1 - lm), e2 = __expf(l2 - lm); const float inv = 1.f / (e0 + e1 + e2);
        const u32x4 p0 = *(const GAS u32x4*)(OP + ((size_t)0 * T + t) * 512 + 8 * lane), p1 = *(const GAS u32x4*)(OP + ((size_t)1 * T + t) * 512 + 8 * lane), p2 = *(const GAS u32x4*)(OP + ((size_t)2 * T + t) * 512 + 8 * lane);
        const float w0 = e0 * inv, w1 = e1 * inv, w2 = e2 * inv;
        u32x4 wo;
#pragma unroll
        for (int e = 0; e < 4; ++e) wo[e] = pk2(w0 * bflo(p0[e]) + w1 * bflo(p1[e]) + w2 * bflo(p2[e]), w0 * bfhi(p0[e]) + w1 * bfhi(p1[e]) + w2 * bfhi(p2[e]));
        *(GAS u32x4*)(MIX + (size_t)t * D + 512 + 8 * lane) = wo;
    }
}

constexpr int N_PHASES = 29;
#define D1V 0
#define DRYV 0
__global__ void __launch_bounds__(512, 2) fwd_kernel(Args args) {
    extern __shared__ __attribute__((aligned(16))) unsigned char lds_raw[];
    Frame F;
    F.lds = (LAS unsigned char*)lds_raw; F.ws = args.ws; F.ctl = (gu32*)(args.ws + WS_CTL);
    F.tid = threadIdx.x; F.lane = F.tid & 63; F.wave = __builtin_amdgcn_readfirstlane(F.tid >> 6);
    F.G = gridDim.x; F.gw = blockIdx.x * 8 + F.wave; F.NGW = F.G * 8;
    volatile LAS unsigned* MISC = (volatile LAS unsigned*)(F.lds + MISC_OFF); const char* wsb = (const char*)args.ws;
    for (int u = F.tid; u < 256; u += 512) MISC[u] = 0u;
    __syncthreads();
    const int lo = args.ph_lo, hi = args.ph_hi;
    XcdBarrier bar; bar.bar = (unsigned*)(F.ctl + CW_BAR); bar.x = 0; bar.st = MISC + 8;
    if (hi - lo > 1) bar = xcd_barrier_post((unsigned*)(F.ctl + CW_BAR), MISC + 8);
    LAS unsigned char* ring = F.lds; LAS unsigned char* xch = F.lds + XCH_OFF;
    volatile LAS unsigned* tab = MISC + 32;
    const int c = blockIdx.x, G = F.G; int qsel = 0;
#ifndef PHASE_MASK
#define PHASE_MASK 0xFFFFFFFFu
#endif
#define IN(k) ((((PHASE_MASK) >> (k)) & 1u) && lo <= (k) && (k) < hi)
#define SEAM(k) do { if (IN(k) && IN((k) + 1)) xcd_barrier(bar); } while (0)
#define PH_BEGIN() do { const int t_ = opq_v((int)threadIdx.x); F.tid = t_; F.lane = t_ & 63; F.wave = __builtin_amdgcn_readfirstlane(t_ >> 6); F.gw = blockIdx.x * 8 + F.wave; \
        unsigned char* w_ = opq_s(args.ws); F.ws = w_; F.ctl = (gu32*)(w_ + WS_CTL); xch = opq_v(F.lds + XCH_OFF); MISC = (volatile LAS unsigned*)opq_v(F.lds + MISC_OFF); tab = MISC + 32; bar.st = MISC + 8; wsb = (const char*)w_; } while (0)
#define HBc (wsb + WS_HB)

    if (IN(0)) { PH_BEGIN(); p0_prologue(F, args); SEAM(0); }
    if (IN(1)) { PH_BEGIN();
        SchedP1 S{HBc, (const char*)(wsb + WS_W_IN), (const char*)(wsb + WS_MEMB), (const char*)(wsb + WS_W_KV), G, c};
        EpiP1 E{WSP(bf16, WS_QKVPRE), WSP(bf16, WS_ZB), WSP(bf16, WS_QKVD), WSP(bf16, WS_KMEM), WSP(bf16, WS_VT)};
        pg8::gemm_phase(ring, xch, pg8::Gemm{D, D, D}, S, E);
        deferred_weights_q(F, args, (unsigned*)(F.ctl + CW_CVQ + 64), MISC);
        SEAM(1);
    }
    if (IN(2)) { PH_BEGIN(); for (int u = c; u < NB * DNH * NCHUNK; u += G) d1_unit<D1V>(F, args, u); SEAM(2); }
    if (IN(3)) { PH_BEGIN();
        if (c < 128) scan_wg(F, c);
        attn_queue(F, (unsigned*)(F.ctl + CW_QUEUE + 16 * qsel), MISC);
        ++qsel;
        SEAM(3);
    }
    if (IN(4)) { PH_BEGIN();
        { SchedPrep S{(const char*)(wsb + WS_KMEM), (const char*)(wsb + WS_W_Q), (const char*)(wsb + WS_W_O), (const char*)(wsb + WS_VT), G, c}; EpiPrep E{WSP(bf16, WS_MT), WSP(bf16, WS_VWT)};
          pg8::gemm_phase(ring, xch, pg8::Gemm{D, D, XD}, S, E); }
        mix_pass(F, args); SEAM(4); }

#pragma unroll
    for (int layer = 0; layer < 2; ++layer) {
        const int pb = layer * 13;
        if (layer == 0) {
            if (IN(5)) { PH_BEGIN(); convert_moe_q(F, args, 0, 0, WSP(bf16, WS_MOEW_GU), (unsigned*)(F.ctl + CW_CVQ), MISC); convert_moe_q(F, args, 0, 1, WSP(bf16, WS_MOEW_D), (unsigned*)(F.ctl + CW_CVQ + 16), MISC); __syncthreads();
                SchedDense S{(const char*)(wsb + WS_MIX), (const char*)(wsb + WS_W_ABO), D, D, 64, 4, G, c}; EpiDense E{WSP(bf16, 288 * MiB), D, 1.f};
                pg8::gemm_phase(ring, xch, pg8::Gemm{D, D, D}, S, E); SEAM(5); }
            if (IN(6)) { PH_BEGIN(); ln_pass<0, false, false, (DRYV != 0)>(F, args, WSP(bf16, WS_HB), WSP(bf16, 288 * MiB), 0, nullptr, DRYV ? WSP(bf16, 112 * MiB) : WSP(bf16, WS_HB), nullptr); SEAM(6); }
        } else {
            if (IN(16)) { PH_BEGIN();
                SchedDense S{HBc, (const char*)(wsb + WS_W_SCI), D, D, 64, 12, G, c}; EpiScIn E{WSP(bf16, 192 * MiB)};
                pg8::gemm_phase(ring, xch, pg8::Gemm{D, D, D}, S, E); SEAM(16); }
            if (IN(17)) { PH_BEGIN(); conv_pass(F, args, WSP(bf16, 192 * MiB), WSP(bf16, 288 * MiB)); SEAM(17); }
            if (IN(18)) { PH_BEGIN(); SchedDense S{(const char*)(wsb + 288 * MiB), (const char*)(wsb + WS_W_SCO), D, D, 64, 4, G, c}; EpiDense E{WSP(bf16, 192 * MiB), D, 1.f};
                pg8::gemm_phase(ring, xch, pg8::Gemm{D, D, D}, S, E); SEAM(18); }
            if (IN(19)) { PH_BEGIN(); ln_pass<0, false, false>(F, args, WSP(bf16, WS_HB), WSP(bf16, 192 * MiB), 3, nullptr, WSP(bf16, WS_HB), nullptr); SEAM(19); }
        }
        const size_t oP = (layer == 0 ? 224 : 256) * MiB, oY = (layer == 0 ? 288 : 192) * MiB;
        const int p7 = layer == 0 ? 7 : 20;
        if (IN(p7)) { PH_BEGIN(); SchedXB S{HBc, (const char*)(wsb + WS_MT + (size_t)layer * NB * D * D * 2), G, c}; EpiSoftmax E{WSP(bf16, oP)};
            pg8::gemm_phase(ring, xch, pg8::Gemm{D, D, D}, S, E); SEAM(p7); }
        if (IN(p7 + 1)) { PH_BEGIN(); SchedXB S{(const char*)(wsb + oP), (const char*)(wsb + WS_VWT + (size_t)layer * NB * D * D * 2), G, c}; EpiDense E{WSP(bf16, oY), D, 1.f};
            pg8::gemm_phase(ring, xch, pg8::Gemm{D, D, D}, S, E); SEAM(p7 + 1); }
        unsigned* cnt = (unsigned*)(F.ctl + (layer == 0 ? CW_CNT0 : CW_CNT1));
        if (IN(p7 + 4)) { PH_BEGIN(); ln_router_pass<(DRYV != 0)>(F, args, WSP(bf16, WS_HB), WSP(bf16, oY), layer * 3 + 1, DRYV ? WSP(bf16, 112 * MiB) : WSP(bf16, WS_HB), cnt); SEAM(p7 + 4); }
        if (IN(p7 + 5)) { PH_BEGIN(); moe_table(F, cnt, tab); moe_slots(F, tab, WSP(int, WS_INV + (size_t)layer * MOE_ROWS * 4)); SEAM(p7 + 5); }
        if (IN(p7 + 6)) { PH_BEGIN(); moe_table(F, cnt, tab);
            SchedMoE<true> S{HBc, (const char*)(wsb + (layer == 0 ? WS_MOEW_GU : WS_MOEW_GU1)), tab, WSP(int, WS_INV + (size_t)layer * MOE_ROWS * 4), D, D, D, G, c}; EpiSwiglu E{WSP(bf16, WS_HACT), (layer == 1 && MK_ONE_LAUNCH) ? (unsigned*)(F.ctl + CW_G1DONE) : nullptr, 2 * G};
            pg8::gemm_phase(ring, xch, pg8::Gemm{D, D, D}, S, E);
            if (layer == 0) convert_moe_q(F, args, 1, 0, WSP(bf16, WS_MOEW_GU1), (unsigned*)(F.ctl + CW_CVQ + 32), MISC);
            SEAM((layer == 1 && MK_ONE_LAUNCH) ? 31 : p7 + 6); }
        if (IN(p7 + 7)) { PH_BEGIN(); moe_table(F, cnt, tab);
            EpiDense E{WSP(bf16, WS_XG), D, 1.f};
            if (layer == 1 && MK_ONE_LAUNCH) { moe_wait_gemm1(F, (unsigned*)(F.ctl + CW_G1DONE), tab, G, c);
                SchedMoE2 S{(const char*)(wsb + WS_HACT), (const char*)(wsb + WS_MOEW_D1), tab, G, c}; pg8::gemm_phase(ring, xch, pg8::Gemm{DE, DE, DE}, S, E); }
            else { SchedMoE<false> S{(const char*)(wsb + WS_HACT), (const char*)(wsb + (layer == 0 ? WS_MOEW_D : WS_MOEW_D1)), tab, nullptr, DE, D, DE, G, c}; pg8::gemm_phase(ring, xch, pg8::Gemm{DE, DE, DE}, S, E); }
            if (layer == 0) convert_moe_q(F, args, 1, 1, WSP(bf16, WS_MOEW_D1), (unsigned*)(F.ctl + CW_CVQ + 48), MISC);
            SEAM(p7 + 7); }
        if (layer == 0) { if (IN(15)) { PH_BEGIN(); ln_pass<1, false, false>(F, args, WSP(bf16, WS_HB), WSP(bf16, WS_XG), 2, nullptr, WSP(bf16, WS_HB), nullptr); SEAM(15); } }
        else { if (IN(28)) { PH_BEGIN(); ln_pass<1, false, true>(F, args, WSP(bf16, WS_HB), WSP(bf16, WS_XG), 5, args.out, nullptr, nullptr); SEAM(28); } }
        (void)pb;
    }
#undef IN
#undef SEAM
}

extern "C" void kernel_launch(void* const* d_in, const int* in_sizes, int n_in, void* d_out, int out_size, void* d_ws, size_t ws_size, hipStream_t stream) {
    static int grid = 0;
    if (grid == 0) {
        if (n_in != 21 || out_size != T * D || ws_size < WS_END) { fprintf(stderr, "kernel_launch: unexpected problem (n_in %d, out %d, ws %zu < %zu)\n", n_in, out_size, ws_size, (size_t)WS_END); grid = -1; return; }
        int dev = 0, cus = 0, per_cu = 0;
        if (hipGetDevice(&dev) != hipSuccess || hipDeviceGetAttribute(&cus, hipDeviceAttributeMultiprocessorCount, dev) != hipSuccess) { grid = -1; return; }
        if (hipFuncSetAttribute((const void*)fwd_kernel, hipFuncAttributeMaxDynamicSharedMemorySize, LDS_BYTES) != hipSuccess) { fprintf(stderr, "kernel_launch: hipFuncSetAttribute failed\n"); grid = -1; return; }
        if (hipOccupancyMaxActiveBlocksPerMultiprocessor(&per_cu, (const void*)fwd_kernel, 512, LDS_BYTES) != hipSuccess || per_cu < 1) { fprintf(stderr, "kernel_launch: occupancy query says %d blocks per CU\n", per_cu); (void)hipGetLastError(); per_cu = 1; }
        grid = cus;
    }
    if (grid < 0) return;
    (void)hipMemsetAsync((char*)d_ws + WS_CTL, 0, CTL_ZERO_BYTES, stream);
    Args a{};
    for (int i = 0; i < 21; ++i) a.in[i] = (const float*)d_in[i];
    a.out = (float*)d_out; a.ws = (unsigned char*)d_ws;
#if MK_ONE_LAUNCH
    a.ph_lo = 0; a.ph_hi = N_PHASES;
    hipLaunchKernelGGL(fwd_kernel, dim3(grid), dim3(512), LDS_BYTES, stream, a);
#else
    for (int p = 0; p < N_PHASES; ++p) { a.ph_lo = p; a.ph_hi = p + 1; hipLaunchKernelGGL(fwd_kernel, dim3(grid), dim3(512), LDS_BYTES, stream, a); }
#endif
}
```
